# Optimizing an MI355X kernel written in HIP

```python
import jax, jax.numpy as jnp
from jax import lax
import numpy as np

D_MODEL = 1024
BATCH = 2
SEQ = 8192
DEPTH = 2
DEC_BATCH = 8
DEC_SEQ = 4096
PAST_LEN = 128

GRID_W = 64
NA_HEAD_DIM = 32
NA_HEADS = D_MODEL // NA_HEAD_DIM
NA_ROWS = 8
NA_COLS = 16
NA_Q_COLS = 16
NA_K_COLS = NA_Q_COLS + NA_COLS
RWKV_HEAD_DIM = 64
RWKV_HEADS = D_MODEL // RWKV_HEAD_DIM
DECAY_LORA = 64
ICLR_LORA = 64
GATE_LORA = 160
GN_EPS = 64e-5
D_FF = 2816
N_EXPERTS = 8
TOP_K = 2
D_EXPERT = 3584
LN_EPS = 1e-5
N_EVEN = (DEPTH + 1) // 2
N_ODD = DEPTH // 2
ALPHA = (2 * DEPTH) ** 0.25
BETA = (8 * DEPTH) ** -0.25

kernel_name = 'hybrid_na_rwkv7_deepnorm_encoder'


def layer_norm(x, g, b):
    xf = x.astype(jnp.float32)
    xc = xf - jnp.mean(xf, axis=-1, keepdims=True)
    var = jnp.mean(xc * xc, axis=-1, keepdims=True)
    return (xc * lax.rsqrt(var + LN_EPS) * g.astype(jnp.float32) + b.astype(jnp.float32)).astype(x.dtype)


def _na_column_layout():
    n_cb = GRID_W // NA_Q_COLS
    q_cols = np.arange(GRID_W).reshape(n_cb, NA_Q_COLS)
    q_start = np.clip(q_cols - NA_COLS // 2, 0, GRID_W - NA_COLS)
    blk_start = np.clip(np.arange(n_cb) * NA_Q_COLS - NA_COLS // 2, 0, GRID_W - NA_K_COLS)
    key_cols = blk_start[:, None] + np.arange(NA_K_COLS)
    kc = key_cols[:, None, :]
    valid = (kc >= q_start[..., None]) & (kc < q_start[..., None] + NA_COLS)
    dc_idx = np.clip(kc - q_cols[..., None] + NA_COLS - 1, 0, 2 * NA_COLS - 2)
    return key_cols, valid, dc_idx


def neighbourhood_attention(x, w_qkv, rpb, w_o):
    b, l, d = x.shape
    rows = l // GRID_W
    kr = min(NA_ROWS, rows)
    n_cb = GRID_W // NA_Q_COLS
    key_cols, valid, dc_idx = _na_column_layout()
    qkv = jnp.einsum('bld,de->ble', x, w_qkv).reshape(b, rows, GRID_W, 3, NA_HEADS, NA_HEAD_DIM)
    q = qkv[:, :, :, 0] * (NA_HEAD_DIM ** -0.5)
    k = qkv[:, :, :, 1]
    v = qkv[:, :, :, 2]
    mask = np.broadcast_to(valid[:, :, None, :], (n_cb, NA_Q_COLS, kr, NA_K_COLS)).reshape(n_cb, NA_Q_COLS, kr * NA_K_COLS)

    def row_block(r):
        rs = jnp.clip(r - kr // 2, 0, rows - kr)
        q_r = lax.dynamic_index_in_dim(q, r, axis=1, keepdims=False).reshape(b, n_cb, NA_Q_COLS, NA_HEADS, NA_HEAD_DIM)

        def gather(t):
            t_r = lax.dynamic_slice_in_dim(t, rs, kr, axis=1)[:, :, key_cols]
            return jnp.moveaxis(t_r, 2, 1).reshape(b, n_cb, kr * NA_K_COLS, NA_HEADS, NA_HEAD_DIM)

        k_blk = gather(k)
        v_blk = gather(v)
        dr_idx = rs + jnp.arange(kr) - r + NA_ROWS - 1
        bias = rpb[:, dr_idx][:, :, dc_idx]
        bias = jnp.transpose(bias, (0, 2, 3, 1, 4)).reshape(NA_HEADS, n_cb, NA_Q_COLS, kr * NA_K_COLS)
        s = jnp.einsum('bcqhd,bckhd->bhcqk', q_r, k_blk).astype(jnp.float32) + bias.astype(jnp.float32)
        s = jnp.where(mask, s, -jnp.inf)
        p = jax.nn.softmax(s, axis=-1).astype(v.dtype)
        o = jnp.einsum('bhcqk,bckhd->bcqhd', p, v_blk)
        return o.reshape(b, GRID_W, d)

    out = lax.map(row_block, jnp.arange(rows))
    out = jnp.moveaxis(out, 0, 1).reshape(b, l, d)
    return jnp.einsum('bld,de->ble', out, w_o)


def _delta_rule_scan(r, w, k, v, a, bb, reverse):
    def step(S, inp):
        r_t, w_t, k_t, v_t, a_t, b_t = inp
        sa = jnp.einsum('bhvk,bhk->bhv', S, a_t)
        S = S * w_t[:, :, None, :] + sa[..., None] * b_t[:, :, None, :] + v_t[..., None] * k_t[:, :, None, :]
        return S, jnp.einsum('bhvk,bhk->bhv', S, r_t)
    s0 = jnp.zeros(r.shape[1:3] + (RWKV_HEAD_DIM, RWKV_HEAD_DIM), jnp.float32)
    _, y = lax.scan(step, s0, (r, w, k, v, a, bb), reverse=reverse)
    return jnp.moveaxis(y, 0, 1)


def rwkv7_bidirectional(x, mu, w_rkv, w0, w1, w2, a0, a1, a2, g1, g2, k_k, k_a, r_k, lnx_g, lnx_b, w_o):
    b, l, d = x.shape
    f32 = jnp.float32
    xp = jnp.pad(x, ((0, 0), (1, 1), (0, 0)))
    xx = 0.5 * (xp[:, :-2] + xp[:, 2:]) - x
    mix = lambda i: x + xx * mu[i]
    r, k, v = jnp.einsum('nbld,nde->nble', jnp.stack([mix(0), mix(2), mix(3)]), w_rkv)
    wl = w0[:, None, None, :] + jnp.einsum('zblr,zrd->zbld', jnp.tanh(jnp.einsum('bld,zdr->zblr', mix(1), w1)), w2)
    decay = jnp.exp(-jnp.exp(-jax.nn.softplus(-wl.astype(f32)) - 0.5))
    a = jax.nn.sigmoid((a0[:, None, None, :] + jnp.einsum('zblr,zrd->zbld', jnp.einsum('bld,zdr->zblr', mix(4), a1), a2)).astype(f32))
    g = jnp.einsum('blr,rd->bld', jax.nn.sigmoid(jnp.einsum('bld,dr->blr', mix(5), g1)), g2)
    heads = lambda t: t.reshape(t.shape[:-1] + (RWKV_HEADS, RWKV_HEAD_DIM))
    rf, kf, vf = heads(r.astype(f32)), heads(k.astype(f32)), heads(v.astype(f32))
    kk = heads(k.astype(f32) * k_k.astype(f32))
    kk = kk / jnp.maximum(jnp.sqrt(jnp.sum(kk * kk, axis=-1, keepdims=True)), 1e-12)
    a_h = heads(a)
    k_dir = kf[None] * (1.0 + (a_h - 1.0) * heads(k_a.astype(f32)))
    bb = kk[None] * a_h
    decay = heads(decay)
    tm = lambda t: jnp.moveaxis(t, 1, 0)
    r_t, v_t, na_t = tm(rf), tm(vf), tm(-kk)
    y_f = _delta_rule_scan(r_t, tm(decay[0]), tm(k_dir[0]), v_t, na_t, tm(bb[0]), reverse=False)
    y_b = _delta_rule_scan(r_t, tm(decay[1]), tm(k_dir[1]), v_t, na_t, tm(bb[1]), reverse=True)
    y = y_f + y_b
    yc = y - jnp.mean(y, axis=-1, keepdims=True)
    yn = (yc * lax.rsqrt(jnp.mean(yc * yc, axis=-1, keepdims=True) + GN_EPS)).reshape(b, l, d)
    yn = yn * lnx_g.astype(f32) + lnx_b.astype(f32)
    bonus = (jnp.sum(rf * (k_dir[0] + k_dir[1]) * r_k.astype(f32), axis=-1, keepdims=True) * vf).reshape(b, l, d)
    out = ((yn + bonus) * g.astype(f32)).astype(x.dtype)
    return jnp.einsum('bld,de->ble', out, w_o)


def swiglu(x, w_gate, w_up, w_down):
    h = jax.nn.silu(jnp.einsum('bld,df->blf', x, w_gate)) * jnp.einsum('bld,df->blf', x, w_up)
    return jnp.einsum('blf,fd->bld', h, w_down)


def moe_swiglu(x, w_router, b_router, w_gate, w_up, w_down):
    logits = jnp.einsum('bld,de->ble', x, w_router).astype(jnp.float32) + b_router.astype(jnp.float32)
    top_v, top_i = lax.top_k(logits, TOP_K)
    gates = jax.nn.softmax(top_v, axis=-1)
    combine = jnp.sum(jax.nn.one_hot(top_i, N_EXPERTS, dtype=jnp.float32) * gates[..., None], axis=-2).astype(x.dtype)
    out = jnp.zeros_like(x)
    for e in range(N_EXPERTS):
        out = out + combine[..., e:e + 1] * swiglu(x, w_gate[e], w_up[e], w_down[e])
    return out


def encoder_trunk(x, na_w_qkv, na_rpb, na_w_o, ffn_w_gate, ffn_w_up, ffn_w_down,
                  rwkv_mu, rwkv_w_rkv, rwkv_w0, rwkv_w1, rwkv_w2, rwkv_a0, rwkv_a1, rwkv_a2,
                  rwkv_g1, rwkv_g2, rwkv_k_k, rwkv_k_a, rwkv_r_k, rwkv_lnx_g, rwkv_lnx_b, rwkv_w_o,
                  moe_w_router, moe_b_router, moe_w_gate, moe_w_up, moe_w_down,
                  ln_mix_g, ln_mix_b, ln_ffn_g, ln_ffn_b):
    for i in range(DEPTH):
        j = i // 2
        if i % 2 == 0:
            h = neighbourhood_attention(x, na_w_qkv[j], na_rpb[j], na_w_o[j])
        else:
            h = rwkv7_bidirectional(x, rwkv_mu[j], rwkv_w_rkv[j], rwkv_w0[j], rwkv_w1[j], rwkv_w2[j],
                                    rwkv_a0[j], rwkv_a1[j], rwkv_a2[j], rwkv_g1[j], rwkv_g2[j],
                                    rwkv_k_k[j], rwkv_k_a[j], rwkv_r_k[j], rwkv_lnx_g[j], rwkv_lnx_b[j], rwkv_w_o[j])
        x = layer_norm(ALPHA * x + h, ln_mix_g[i], ln_mix_b[i])
        if i % 2 == 0:
            f = swiglu(x, ffn_w_gate[j], ffn_w_up[j], ffn_w_down[j])
        else:
            f = moe_swiglu(x, moe_w_router[j], moe_b_router[j], moe_w_gate[j], moe_w_up[j], moe_w_down[j])
        x = layer_norm(ALPHA * x + f, ln_ffn_g[i], ln_ffn_b[i])
    return x


def setup_inputs(seed: int = 0) -> dict:
    key = jax.random.key(seed)
    ks = iter(jax.random.split(key, 64))
    nrm = lambda shape, scale: jax.random.normal(next(ks), shape, jnp.float32) * scale
    D = D_MODEL
    s = D ** -0.5
    inp = {}
    inp['x_prompt'] = nrm((BATCH, SEQ, D), 1.0)
    inp['x_sample'] = nrm((DEC_BATCH, DEC_SEQ, D), 1.0)
    inp['na_w_qkv'] = jnp.concatenate([nrm((N_EVEN, D, D), s), nrm((N_EVEN, D, D), s), nrm((N_EVEN, D, D), s * BETA)], axis=-1)
    inp['na_rpb'] = nrm((N_EVEN, NA_HEADS, 2 * NA_ROWS - 1, 2 * NA_COLS - 1), 0.02)
    inp['na_w_o'] = nrm((N_EVEN, D, D), s * BETA)
    inp['ffn_w_gate'] = nrm((N_EVEN, D, D_FF), s * BETA)
    inp['ffn_w_up'] = nrm((N_EVEN, D, D_FF), s * BETA)
    inp['ffn_w_down'] = nrm((N_EVEN, D_FF, D), D_FF ** -0.5 * BETA)
    inp['rwkv_mu'] = jax.random.uniform(next(ks), (N_ODD, 6, D), jnp.float32)
    inp['rwkv_w_rkv'] = jnp.stack([nrm((N_ODD, D, D), s), nrm((N_ODD, D, D), s), nrm((N_ODD, D, D), s * BETA)], axis=1)
    inp['rwkv_w0'] = jnp.linspace(-6.0, -1.0, D, dtype=jnp.float32) + 0.5 + nrm((N_ODD, 2, D), 0.1)
    inp['rwkv_w1'] = nrm((N_ODD, 2, D, DECAY_LORA), s)
    inp['rwkv_w2'] = nrm((N_ODD, 2, DECAY_LORA, D), 0.1 * DECAY_LORA ** -0.5)
    inp['rwkv_a0'] = nrm((N_ODD, 2, D), 0.1)
    inp['rwkv_a1'] = nrm((N_ODD, 2, D, ICLR_LORA), s)
    inp['rwkv_a2'] = nrm((N_ODD, 2, ICLR_LORA, D), 0.1 * ICLR_LORA ** -0.5)
    inp['rwkv_g1'] = nrm((N_ODD, D, GATE_LORA), s)
    inp['rwkv_g2'] = nrm((N_ODD, GATE_LORA, D), GATE_LORA ** -0.5)
    inp['rwkv_k_k'] = 0.85 + nrm((N_ODD, D), 0.02)
    inp['rwkv_k_a'] = 1.0 + nrm((N_ODD, D), 0.02)
    inp['rwkv_r_k'] = nrm((N_ODD, RWKV_HEADS, RWKV_HEAD_DIM), 0.1)
    inp['rwkv_lnx_g'] = 1.0 + nrm((N_ODD, D), 0.02)
    inp['rwkv_lnx_b'] = nrm((N_ODD, D), 0.02)
    inp['rwkv_w_o'] = nrm((N_ODD, D, D), s * BETA)
    inp['moe_w_router'] = nrm((N_ODD, D, N_EXPERTS), s)
    inp['moe_b_router'] = nrm((N_ODD, N_EXPERTS), 0.01)
    inp['moe_w_gate'] = nrm((N_ODD, N_EXPERTS, D, D_EXPERT), s * BETA)
    inp['moe_w_up'] = nrm((N_ODD, N_EXPERTS, D, D_EXPERT), s * BETA)
    inp['moe_w_down'] = nrm((N_ODD, N_EXPERTS, D_EXPERT, D), D_EXPERT ** -0.5 * BETA)
    inp['ln_mix_g'] = 1.0 + nrm((DEPTH, D), 0.02)
    inp['ln_mix_b'] = nrm((DEPTH, D), 0.02)
    inp['ln_ffn_g'] = 1.0 + nrm((DEPTH, D), 0.02)
    inp['ln_ffn_b'] = nrm((DEPTH, D), 0.02)
    return inp


def reference(x_prompt, x_sample, na_w_qkv, na_rpb, na_w_o, ffn_w_gate, ffn_w_up, ffn_w_down,
              rwkv_mu, rwkv_w_rkv, rwkv_w0, rwkv_w1, rwkv_w2, rwkv_a0, rwkv_a1, rwkv_a2,
              rwkv_g1, rwkv_g2, rwkv_k_k, rwkv_k_a, rwkv_r_k, rwkv_lnx_g, rwkv_lnx_b, rwkv_w_o,
              moe_w_router, moe_b_router, moe_w_gate, moe_w_up, moe_w_down,
              ln_mix_g, ln_mix_b, ln_ffn_g, ln_ffn_b):
    weights = (na_w_qkv, na_rpb, na_w_o, ffn_w_gate, ffn_w_up, ffn_w_down,
               rwkv_mu, rwkv_w_rkv, rwkv_w0, rwkv_w1, rwkv_w2, rwkv_a0, rwkv_a1, rwkv_a2,
               rwkv_g1, rwkv_g2, rwkv_k_k, rwkv_k_a, rwkv_r_k, rwkv_lnx_g, rwkv_lnx_b, rwkv_w_o,
               moe_w_router, moe_b_router, moe_w_gate, moe_w_up, moe_w_down,
               ln_mix_g, ln_mix_b, ln_ffn_g, ln_ffn_b)
    y_prompt = encoder_trunk(x_prompt, *weights)
    y_sample = encoder_trunk(x_sample, *weights)
    return (y_prompt, y_sample)
```

```cpp
#include <hip/hip_runtime.h>
#include <hip/hip_cooperative_groups.h>
#include <cstdio>
namespace cg = cooperative_groups;

#define LAS __attribute__((address_space(3)))
typedef unsigned short bf16_t;
typedef short bf16x8 __attribute__((ext_vector_type(8)));
typedef float f32x4 __attribute__((ext_vector_type(4)));
typedef float f32x16 __attribute__((ext_vector_type(16)));
typedef unsigned u32x4 __attribute__((ext_vector_type(4)));
typedef unsigned u32x2 __attribute__((ext_vector_type(2)));

constexpr int T = 49152, D = 1024;
constexpr float ALPHA = 1.41421356237309515f;
constexpr size_t SZ = (size_t)T * 1024 * 2;
constexpr size_t OFF_WRT = 0;
constexpr size_t OFF_W2T = OFF_WRT + 14680064;
constexpr size_t OFF_G2T = OFF_W2T + 524288;
constexpr size_t OFF_RWOT = OFF_G2T + 524288;
constexpr size_t OFF_CNT = OFF_RWOT + 2097152;
constexpr size_t OFF_TOKE = OFF_CNT + 256;
constexpr size_t OFF_TOKG = OFF_TOKE + 393216;
constexpr size_t OFF_TOKP = OFF_TOKG + 393216;
constexpr size_t OFF_ROWL = OFF_TOKP + 393216;
constexpr size_t OFF_ROWG = OFF_ROWL + 409600;
constexpr size_t OFF_BONUS = OFF_ROWG + 409600;
constexpr size_t BIG = 26214400;
constexpr size_t OFF_XB = BIG, OFF_QK = BIG + SZ, OFF_VT = BIG + 3 * SZ, OFF_O = BIG + 4 * SZ;
constexpr size_t OFF_WQKT = BIG + 5 * SZ, OFF_WVT = OFF_WQKT + 4194304, OFF_WOT = OFF_WVT + 2097152, OFF_WGUT = OFF_WOT + 2097152, OFF_WDT = OFF_WGUT + 11534336;
constexpr size_t OFF_H = BIG + SZ;
constexpr size_t OFF_XB2 = BIG, OFF_RKV = BIG + 2 * SZ, OFF_LBWA = BIG + 5 * SZ, OFF_LBG = OFF_LBWA + 25165824;
constexpr size_t OFF_YF = BIG, OFF_YB = BIG + SZ;
constexpr size_t OFF_WMGU = BIG, OFF_WMD = BIG + 117440512, OFF_XS = BIG + 176160768, OFF_XBM = OFF_XS + 209715200, OFF_HID = OFF_XBM;
constexpr size_t WS_NEED = OFF_HID + 183500800;
constexpr int MOE_CHUNK = 100;
constexpr int LDS_BYTES = 131072 + 512;

struct Params { const float* in[33]; float* X; unsigned char* ws; };
extern __shared__ __attribute__((aligned(16))) unsigned char shm[];
constexpr int LDS_TS = 131072, LDS_TAB = 131072 + 128;
__device__ __forceinline__ const float* INP(int i) {
  const LAS unsigned* tab = (const LAS unsigned*)((LAS unsigned char*)shm + LDS_TAB);
  const unsigned lo = __builtin_amdgcn_readfirstlane(tab[2 * i]), hi = __builtin_amdgcn_readfirstlane(tab[2 * i + 1]);
  return (const float*)(((unsigned long long)hi << 32) | lo);
}

__device__ __forceinline__ int tid_() { int t = threadIdx.x; asm volatile("" : "+v"(t)); return t; }
__device__ __forceinline__ unsigned cvt_pk_bf16(float lo, float hi) { unsigned r; asm("v_cvt_pk_bf16_f32 %0, %1, %2" : "=v"(r) : "v"(lo), "v"(hi)); return r; }
__device__ __forceinline__ bf16_t f2bf(float f) { return (bf16_t)(cvt_pk_bf16(f, 0.f) & 0xffffu); }
__device__ __forceinline__ float bflo(unsigned u) { return __uint_as_float(u << 16); }
__device__ __forceinline__ float bfhi(unsigned u) { return __uint_as_float(u & 0xffff0000u); }
__device__ __forceinline__ float wave_sum(float v) { for (int o = 32; o; o >>= 1) v += __shfl_xor(v, o); return v; }
template <int CTRL> __device__ __forceinline__ float dppf(float v) { return __builtin_bit_cast(float, __builtin_amdgcn_mov_dpp(__builtin_bit_cast(int, v), CTRL, 0xf, 0xf, true)); }
__device__ __forceinline__ float red4(float v) { v += dppf<0xB1>(v); v += dppf<0x4E>(v); return v; }
__device__ __forceinline__ float red8(float v) { v = red4(v); v += dppf<0x141>(v); return v; }
__device__ __forceinline__ float red16(float v) { v = red8(v); v += dppf<0x140>(v); return v; }
__device__ __forceinline__ float sigmoidf_(float x) { return 1.f / (1.f + __expf(-x)); }

struct CvtJob { const float* src; int ldsrc, K, N; bf16_t* dst; int lddst, row0, col0; const float* kscale; float scale; int mode; };
__device__ __forceinline__ CvtJob mkjob(const float* src, int ldsrc, int K, int N, bf16_t* dst, int lddst, int row0, int col0, const float* kscale, float scale, int mode) {
  CvtJob j; j.src = src; j.ldsrc = ldsrc; j.K = K; j.N = N; j.dst = dst; j.lddst = lddst; j.row0 = row0; j.col0 = col0; j.kscale = kscale; j.scale = scale; j.mode = mode; return j; }
__device__ __forceinline__ int cvt_run(const CvtJob J, float* tile, int rot) {
  const int tk = (J.K + 63) >> 6, tn = (J.N + 63) >> 6, nt = tk * tn, G = gridDim.x;
  const int tx = tid_() & 63, ty = tid_() >> 6;
  int start = (int)blockIdx.x - rot; if (start < 0) start += G;
  for (int t = start; t < nt; t += G) {
    const int k0 = (t / tn) * 64, n0 = (t % tn) * 64;
    __syncthreads();
#pragma unroll
    for (int r = 0; r < 8; ++r) { const int kk = r * 8 + ty, k = k0 + kk, n = n0 + tx; float v = 0.f;
      if (J.src && k < J.K && n < J.N) { v = J.src[(size_t)k * J.ldsrc + n] * J.scale; if (J.kscale) v *= J.kscale[k]; }
      tile[kk * 65 + tx] = v; }
    __syncthreads();
#pragma unroll
    for (int r = 0; r < 8; ++r) { const int nn = r * 8 + ty, n = n0 + nn, k = k0 + tx;
      if (n < J.N && k < J.K) { const int row = J.mode ? ((n >> 7) * 256 + (n & 127)) : n;
        J.dst[(size_t)(J.row0 + row) * J.lddst + J.col0 + k] = f2bf(tile[tx * 65 + nn]); } }
  }
  return (rot + nt) % G;
}

constexpr int BM = 256, BK = 64, HALF = 128, HTB = HALF * BK * 2, NXCD = 8, WGM = 8;
__device__ __forceinline__ int lds_byte(int r, int c) { const int st = (r >> 4) * 2 + (c >> 5), rr = r & 15, cc = c & 31, ob = rr * 64 + cc * 2; return st * 1024 + (ob ^ (((ob >> 9) & 1) << 5)); }
__device__ __forceinline__ void stage_rc(int b, int& R, int& C) { const int st = b / 1024, sb = b % 1024, swz = sb ^ (((sb >> 9) & 1) << 5); R = (st >> 1) * 16 + swz / 64; C = (st & 1) * 32 + (swz % 64) / 2; }
__device__ __forceinline__ int perm32(int rho) { const int n = rho >> 4, i = rho & 15; return 8 * (i >> 2) + 4 * n + (i & 3); }
struct Unit { int pm, pn; };
struct Gemm { const bf16_t* A; const bf16_t* Bt; int K; };
struct StaticOrder {
  int nM, nN, nwg, G, c;
  __device__ void init(int M, int N) { nM = M / BM; nN = N / BM; nwg = nM * nN; G = gridDim.x; c = blockIdx.x; }
  __device__ bool next(int i, Unit& u) const {
    const long L = (long)i * G + c; if (L >= nwg) return false;
    int wgid = (int)L; { const int q = nwg / NXCD, r = nwg % NXCD, xcd = wgid % NXCD, off = wgid / NXCD; wgid = (xcd < r ? xcd * (q + 1) : r * (q + 1) + (xcd - r) * q) + off; }
    const int nig = WGM * nN, gid = wgid / nig, fm = gid * WGM, gsz = (nM - fm) < WGM ? (nM - fm) : WGM;
    u.pm = fm + ((wgid % nig) % gsz); u.pn = (wgid % nig) / gsz; return true;
  }
};
template <int NC> struct MoeOrder {
  int first, ntile, G, c; const LAS int* ts;
  __device__ bool next(int i, Unit& u) const {
    const long L = (long)i * G + c; if (L >= (long)ntile * NC) return false;
    const int l = (int)L, nig = WGM * NC, gid = l / nig, fm = gid * WGM, gsz = (ntile - fm) < WGM ? (ntile - fm) : WGM;
    const int pm = first + fm + ((l % nig) % gsz), pn = (l % nig) / gsz;
    int g = 0;
#pragma unroll
    for (int k = 1; k < 16; ++k) g += (pm >= ts[k]) ? 1 : 0;
    u.pm = pm; u.pn = (g & 7) * NC + pn; return true;
  }
};

template <class Epi, class Sched>
__device__ __forceinline__ void gemm_phase(LAS unsigned char* lds, const Gemm g, const Sched& S, const Epi& E) {
  const int tid = tid_(), wid = __builtin_amdgcn_readfirstlane(tid >> 6), lane = tid & 63, wr = wid >> 2, wc = wid & 3, fr = lane & 15, fq = lane >> 4;
  const int K = g.K, nt = K / BK;
  unsigned voffA[2], voffB[2];
#pragma unroll
  for (int i = 0; i < 2; ++i) { int R, C; stage_rc(tid * 16 + i * 8192, R, C); const int Rb = Epi::PERM ? ((R & ~31) + perm32(R & 31)) : R;
    voffA[i] = (unsigned)(R * K + C) * 2u; voffB[i] = (unsigned)(Rb * K + C) * 2u; }
  const size_t kstep = (size_t)(BK * 2);
  const size_t hstep = (size_t)HALF * K * 2;
  const size_t tstep = 2 * hstep;
  const unsigned ldsw = (unsigned)wid * 1024u;
  const int aoff = lds_byte(wr * 64 + fr, fq * 8), boff = lds_byte(wc * 32 + fr, fq * 8);
#define PG8_SA(b, h) (((b) * 2 + (h)) * HTB)
#define PG8_SB(b, h) ((4 + (b) * 2 + (h)) * HTB)
#define PG8_STAGE(bufoff, gbase, voff) do { _Pragma("unroll") for (int _i = 0; _i < 2; ++_i) \
    __builtin_amdgcn_global_load_lds((const unsigned*)((const char*)(gbase) + (voff)[_i]), (LAS unsigned*)(lds + (bufoff) + ldsw + _i * 8192), 16, 0, 0); } while (0)
#define PG8_LDA(dst, b, h) do { _Pragma("unroll") for (int m = 0; m < 4; ++m) _Pragma("unroll") for (int k = 0; k < 2; ++k) dst[m][k] = *(const LAS bf16x8*)(lds + PG8_SA(b, h) + aoff + m * 2048 + k * 1024); } while (0)
#define PG8_LDB(dst, b, h) do { _Pragma("unroll") for (int n = 0; n < 2; ++n) _Pragma("unroll") for (int k = 0; k < 2; ++k) dst[n][k] = *(const LAS bf16x8*)(lds + PG8_SB(b, h) + boff + n * 2048 + k * 1024); } while (0)
#define PG8_MMA(ai, bj, At, Bt) do { __builtin_amdgcn_s_setprio(1); _Pragma("unroll") for (int m = 0; m < 4; ++m) _Pragma("unroll") for (int n = 0; n < 2; ++n) _Pragma("unroll") for (int k = 0; k < 2; ++k) \
    acc[ai][bj][m][n] = __builtin_amdgcn_mfma_f32_16x16x32_bf16(Bt[n][k], At[m][k], acc[ai][bj][m][n], 0, 0, 0); __builtin_amdgcn_s_setprio(0); } while (0)
#define PG8_WAIT_V(n) asm volatile("s_waitcnt vmcnt(" #n ")" ::: "memory")
#define PG8_WAIT_L(n) asm volatile("s_waitcnt lgkmcnt(" #n ")" ::: "memory")
#define PG8_BAR __builtin_amdgcn_s_barrier()
#define PG8_SCHED __builtin_amdgcn_sched_barrier(0)
  Unit cur, nxt; int ui = 0;
  if (!S.next(0, cur)) return;
  f32x4 acc[2][2][4][2];
#pragma unroll
  for (int a = 0; a < 2; ++a)
#pragma unroll
    for (int b = 0; b < 2; ++b)
#pragma unroll
      for (int m = 0; m < 4; ++m)
#pragma unroll
        for (int n = 0; n < 2; ++n) acc[a][b][m][n] = (f32x4){0.f, 0.f, 0.f, 0.f};
  bf16x8 At[4][2], B0[2][2], B1[2][2];
  const char* cA = (const char*)g.A + (size_t)cur.pm * tstep; const char* cB = (const char*)g.Bt + (size_t)cur.pn * tstep;
  PG8_STAGE(PG8_SB(0, 0), cB, voffB); PG8_STAGE(PG8_SA(0, 0), cA, voffA); PG8_STAGE(PG8_SB(0, 1), cB + hstep, voffB); PG8_STAGE(PG8_SA(0, 1), cA + hstep, voffA);
  if (wr == 1) PG8_BAR;
  PG8_WAIT_V(4); PG8_BAR;
  PG8_STAGE(PG8_SB(1, 0), cB + kstep, voffB); PG8_STAGE(PG8_SA(1, 0), cA + kstep, voffA); PG8_STAGE(PG8_SB(1, 1), cB + hstep + kstep, voffB);
  PG8_WAIT_V(6); PG8_BAR;
  for (;;) {
    const bool has_next = S.next(ui + 1, nxt);
    const char* nA = has_next ? (const char*)g.A + (size_t)nxt.pm * tstep : cA; const char* nB = has_next ? (const char*)g.Bt + (size_t)nxt.pn * tstep : cB;
    for (int t = 0; t < nt; t += 2) {
      const bool last = (t == nt - 2);
      const char* a1 = cA + (size_t)(t + 1) * kstep;
      const char* a2 = last ? nA : cA + (size_t)(t + 2) * kstep; const char* b2 = last ? nB : cB + (size_t)(t + 2) * kstep;
      const char* a3 = a2 + kstep; const char* b3 = b2 + kstep;
      PG8_LDB(B0, 0, 0); PG8_SCHED; PG8_LDA(At, 0, 0); PG8_STAGE(PG8_SA(1, 1), a1 + hstep, voffA);
      PG8_WAIT_L(8); PG8_BAR; PG8_WAIT_L(0); PG8_MMA(0, 0, At, B0); PG8_BAR; PG8_SCHED;
      PG8_LDB(B1, 0, 1); PG8_STAGE(PG8_SB(0, 0), b2, voffB);
      PG8_BAR; PG8_WAIT_L(0); PG8_MMA(0, 1, At, B1); PG8_BAR;
      PG8_LDA(At, 0, 1); PG8_STAGE(PG8_SA(0, 0), a2, voffA);
      PG8_BAR; PG8_WAIT_L(0); PG8_MMA(1, 0, At, B0); PG8_BAR; PG8_SCHED;
      PG8_STAGE(PG8_SB(0, 1), b2 + hstep, voffB);
      PG8_WAIT_V(6); PG8_BAR; PG8_MMA(1, 1, At, B1); PG8_BAR;
      PG8_LDB(B0, 1, 0); PG8_SCHED; PG8_LDA(At, 1, 0); PG8_STAGE(PG8_SA(0, 1), a2 + hstep, voffA);
      PG8_WAIT_L(8); PG8_BAR; PG8_WAIT_L(0); PG8_MMA(0, 0, At, B0); PG8_BAR; PG8_SCHED;
      PG8_LDB(B1, 1, 1); PG8_STAGE(PG8_SB(1, 0), b3, voffB);
      PG8_BAR; PG8_WAIT_L(0); PG8_MMA(0, 1, At, B1); PG8_BAR;
      PG8_LDA(At, 1, 1); PG8_STAGE(PG8_SA(1, 0), a3, voffA);
      PG8_BAR; PG8_WAIT_L(0); PG8_MMA(1, 0, At, B0); PG8_BAR; PG8_SCHED;
      PG8_STAGE(PG8_SB(1, 1), b3 + hstep, voffB);
      PG8_WAIT_V(6); PG8_BAR; PG8_MMA(1, 1, At, B1); PG8_BAR;
    }
    E(acc, cur, wr, wc, fr, fq);
    if (!has_next) break;
#pragma unroll
    for (int a = 0; a < 2; ++a)
#pragma unroll
      for (int b = 0; b < 2; ++b)
#pragma unroll
        for (int m = 0; m < 4; ++m)
#pragma unroll
          for (int n = 0; n < 2; ++n) acc[a][b][m][n] = (f32x4){0.f, 0.f, 0.f, 0.f};
    cur = nxt; cA = nA; cB = nB; ++ui;
  }
  PG8_WAIT_V(0);
  if (wr == 0) PG8_BAR;
  PG8_BAR;
#undef PG8_SA
#undef PG8_SB
#undef PG8_STAGE
#undef PG8_LDA
#undef PG8_LDB
#undef PG8_MMA
#undef PG8_WAIT_V
#undef PG8_WAIT_L
#undef PG8_BAR
#undef PG8_SCHED
}

typedef f32x4 Acc[2][2][4][2];
__device__ __forceinline__ u32x4 pack8(f32x4 a, f32x4 b) { u32x4 o; o[0] = cvt_pk_bf16(a[0], a[1]); o[1] = cvt_pk_bf16(a[2], a[3]); o[2] = cvt_pk_bf16(b[0], b[1]); o[3] = cvt_pk_bf16(b[2], b[3]); return o; }

struct EpiStore {
  static constexpr bool PERM = true; bf16_t* O; int ldc;
  __device__ __forceinline__ void operator()(const Acc& acc, const Unit& u, int wr, int wc, int fr, int fq) const {
    const int row0 = u.pm * BM + wr * 64 + fr, col0 = u.pn * BM + wc * 32 + 8 * fq;
#pragma unroll
    for (int ai = 0; ai < 2; ++ai)
#pragma unroll
      for (int m = 0; m < 4; ++m) { bf16_t* rp = O + (size_t)(row0 + ai * HALF + m * 16) * ldc + col0;
#pragma unroll
        for (int bj = 0; bj < 2; ++bj) *(u32x4*)(rp + bj * HALF) = pack8(acc[ai][bj][m][0], acc[ai][bj][m][1]); }
  }
};
struct EpiVT {
  static constexpr bool PERM = true; bf16_t* O;
  __device__ __forceinline__ void operator()(const Acc& acc, const Unit& u, int wr, int wc, int fr, int fq) const {
    const int row0 = u.pm * BM + wr * 64 + fr, col0 = u.pn * BM + wc * 32 + 8 * fq;
#pragma unroll
    for (int ai = 0; ai < 2; ++ai)
#pragma unroll
      for (int m = 0; m < 4; ++m) { const int ch = row0 + ai * HALF + m * 16;
#pragma unroll
        for (int bj = 0; bj < 2; ++bj) { const int tok = col0 + bj * HALF;
          *(u32x4*)(O + (size_t)(tok >> 6) * 65536 + ch * 64 + (tok & 63)) = pack8(acc[ai][bj][m][0], acc[ai][bj][m][1]); } }
  }
};
struct EpiResid {
  static constexpr bool PERM = false; float* X;
  __device__ __forceinline__ void operator()(const Acc& acc, const Unit& u, int wr, int wc, int fr, int fq) const {
    const int row0 = u.pm * BM + wr * 64 + fr, col0 = u.pn * BM + wc * 32 + 4 * fq;
#pragma unroll
    for (int ai = 0; ai < 2; ++ai)
#pragma unroll
      for (int m = 0; m < 4; ++m) { float* rp = X + (size_t)(row0 + ai * HALF + m * 16) * 1024 + col0;
#pragma unroll
        for (int bj = 0; bj < 2; ++bj)
#pragma unroll
          for (int n = 0; n < 2; ++n) { f32x4* q = (f32x4*)(rp + bj * HALF + n * 16); *q = *q * ALPHA + acc[ai][bj][m][n]; } __builtin_amdgcn_sched_barrier(0); }
  }
};
__device__ __forceinline__ f32x4 swiglu4(f32x4 g, f32x4 u) { f32x4 o;
#pragma unroll
  for (int j = 0; j < 4; ++j) o[j] = g[j] / (1.f + __expf(-g[j])) * u[j];
  return o; }
struct EpiSwiglu {
  static constexpr bool PERM = true; bf16_t* H; int ldh, NC, row_base;
  __device__ __forceinline__ void operator()(const Acc& acc, const Unit& u, int wr, int wc, int fr, int fq) const {
    const int row0 = u.pm * BM - row_base + wr * 64 + fr, col0 = (u.pn % NC) * HALF + wc * 32 + 8 * fq;
#pragma unroll
    for (int ai = 0; ai < 2; ++ai)
#pragma unroll
      for (int m = 0; m < 4; ++m)
        *(u32x4*)(H + (size_t)(row0 + ai * HALF + m * 16) * ldh + col0) = pack8(swiglu4(acc[ai][0][m][0], acc[ai][1][m][0]), swiglu4(acc[ai][0][m][1], acc[ai][1][m][1]));
  }
};
struct EpiRwkv {
  static constexpr bool PERM = true; bf16_t* RKV; bf16_t* LBWA; bf16_t* LBG;
  __device__ __forceinline__ void operator()(const Acc& acc, const Unit& u, int wr, int wc, int fr, int fq) const {
    const int row0 = u.pm * BM + wr * 64 + fr;
    if (u.pn < 12) {
      const int col0 = u.pn * BM + wc * 32 + 8 * fq;
#pragma unroll
      for (int ai = 0; ai < 2; ++ai)
#pragma unroll
        for (int m = 0; m < 4; ++m) { bf16_t* rp = RKV + (size_t)(row0 + ai * HALF + m * 16) * 3072 + col0;
#pragma unroll
          for (int bj = 0; bj < 2; ++bj) *(u32x4*)(rp + bj * HALF) = pack8(acc[ai][bj][m][0], acc[ai][bj][m][1]); }
    } else {
      const bool isg = (u.pn == 13); bf16_t* O = isg ? LBG : LBWA; const int c0 = wc * 32 + 8 * fq;
#pragma unroll
      for (int ai = 0; ai < 2; ++ai)
#pragma unroll
        for (int m = 0; m < 4; ++m) { bf16_t* rp = O + (size_t)(row0 + ai * HALF + m * 16) * 256 + c0;
#pragma unroll
          for (int bj = 0; bj < 2; ++bj) { f32x4 v0 = acc[ai][bj][m][0], v1 = acc[ai][bj][m][1]; const int c = bj * HALF + c0;
            if (isg) { if (c < 160) {
#pragma unroll
                for (int j = 0; j < 4; ++j) { v0[j] = sigmoidf_(v0[j]); v1[j] = sigmoidf_(v1[j]); } } else { v0 = (f32x4){0.f, 0.f, 0.f, 0.f}; v1 = v0; } }
            else if (bj == 0) {
#pragma unroll
              for (int j = 0; j < 4; ++j) { v0[j] = 1.f - 2.f / (1.f + __expf(2.f * v0[j])); v1[j] = 1.f - 2.f / (1.f + __expf(2.f * v1[j])); } }
            *(u32x4*)(rp + bj * HALF) = pack8(v0, v1); } }
    }
  }
};
struct EpiMulPre {
  static constexpr bool PERM = true; bf16_t* P;
  __device__ __forceinline__ void operator()(const Acc& acc, const Unit& u, int wr, int wc, int fr, int fq) const {
    const int row0 = u.pm * BM + wr * 64 + fr, col0 = u.pn * BM + wc * 32 + 8 * fq;
#pragma unroll
    for (int ai = 0; ai < 2; ++ai)
#pragma unroll
      for (int m = 0; m < 4; ++m) { bf16_t* rp = P + (size_t)(row0 + ai * HALF + m * 16) * 1024 + col0;
#pragma unroll
        for (int bj = 0; bj < 2; ++bj) { u32x4* q = (u32x4*)(rp + bj * HALF); const u32x4 pv = *q; f32x4 a = acc[ai][bj][m][0], b = acc[ai][bj][m][1];
          a[0] *= bflo(pv[0]); a[1] *= bfhi(pv[0]); a[2] *= bflo(pv[1]); a[3] *= bfhi(pv[1]); b[0] *= bflo(pv[2]); b[1] *= bfhi(pv[2]); b[2] *= bflo(pv[3]); b[3] *= bfhi(pv[3]);
          *q = pack8(a, b); } __builtin_amdgcn_sched_barrier(0); }
  }
};
struct EpiMoeDown {
  static constexpr bool PERM = false; float* X; const int* rowl; const float* rowg; int row_base;
  __device__ __forceinline__ void operator()(const Acc& acc, const Unit& u, int wr, int wc, int fr, int fq) const {
    const int row0 = row_base + u.pm * BM + wr * 64 + fr, col0 = (u.pn & 3) * BM + wc * 32 + 4 * fq;
#pragma unroll
    for (int ai = 0; ai < 2; ++ai)
#pragma unroll
      for (int m = 0; m < 4; ++m) { const int lr = row0 + ai * HALF + m * 16; const int tok = rowl[lr];
        if (tok >= 0) { const float gt = rowg[lr]; float* rp = X + (size_t)tok * 1024 + col0;
#pragma unroll
          for (int bj = 0; bj < 2; ++bj)
#pragma unroll
            for (int n = 0; n < 2; ++n) { f32x4* q = (f32x4*)(rp + bj * HALF + n * 16); *q = *q + acc[ai][bj][m][n] * gt; } } __builtin_amdgcn_sched_barrier(0); }
  }
};
struct MoeDownOrder {
  int first, ntile, G, c; const LAS int* ts;
  __device__ bool next(int i, Unit& u) const {
    const long L = (long)i * G + c; if (L >= (long)ntile * 4) return false;
    const int l = (int)L, pm = l >> 2, pn = l & 3; int g = 0;
#pragma unroll
    for (int k = 1; k < 16; ++k) g += ((first + pm) >= ts[k]) ? 1 : 0;
    u.pm = pm; u.pn = (g & 7) * 4 + pn; return true;
  }
};

__device__ __forceinline__ void ln_row(const float* y, const float* g, const float* b, int lane, f32x4 (&o)[4]) {
  f32x4 v[4]; float s = 0.f;
#pragma unroll
  for (int k = 0; k < 4; ++k) { v[k] = *(const f32x4*)(y + k * 256 + lane * 4); s += v[k][0] + v[k][1] + v[k][2] + v[k][3]; }
  const float mean = wave_sum(s) * (1.f / 1024.f); float q = 0.f;
#pragma unroll
  for (int k = 0; k < 4; ++k) { v[k] = v[k] - mean; q += v[k][0] * v[k][0] + v[k][1] * v[k][1] + v[k][2] * v[k][2] + v[k][3] * v[k][3]; }
  const float rstd = rsqrtf(wave_sum(q) * (1.f / 1024.f) + 1e-5f);
#pragma unroll
  for (int k = 0; k < 4; ++k) { const f32x4 gg = *(const f32x4*)(g + k * 256 + lane * 4), bb = *(const f32x4*)(b + k * 256 + lane * 4); o[k] = v[k] * rstd * gg + bb; }
}

__device__ void attn_phase(const bf16_t* QK, const bf16_t* VT, const float* rpb, bf16_t* O) {
  const int tid = tid_(), lane = tid & 63, qi = lane & 15, g = lane >> 4;
  const int nw = gridDim.x * 8, w0 = blockIdx.x * 8 + (tid >> 6);
  for (int u = w0; u < 768 * 4 * 32; u += nw) {
    const int h = u & 31, c = (u >> 5) & 3, R = u >> 7;
    int seq_row0, rows; if (R < 256) { seq_row0 = R & ~127; rows = 128; } else { seq_row0 = 256 + ((R - 256) & ~63); rows = 64; }
    const int r = R - seq_row0; int rs = r - 4; rs = rs < 0 ? 0 : rs; rs = rs > rows - 8 ? rows - 8 : rs;
    const int blk = (c == 0) ? 0 : (c == 1) ? 8 : (c == 2) ? 24 : 32;
    const int qcol = 16 * c + qi; int qstart = qcol - 8; qstart = qstart < 0 ? 0 : qstart; qstart = qstart > 48 ? 48 : qstart;
    const bf16x8 qf = *(const bf16x8*)(QK + (size_t)(R * 64 + qcol) * 2048 + h * 32 + g * 8);
    f32x4 s[8][2];
    const int krho = ((qi >> 2) * 8) + (qi & 3);
#pragma unroll
    for (int i = 0; i < 8; ++i)
#pragma unroll
      for (int hh = 0; hh < 2; ++hh) {
        const size_t tok = (size_t)(seq_row0 + rs + i) * 64 + blk + krho + hh * 4;
        const bf16x8 kf = *(const bf16x8*)(QK + tok * 2048 + 1024 + h * 32 + g * 8);
        s[i][hh] = __builtin_amdgcn_mfma_f32_16x16x32_bf16(kf, qf, (f32x4){0.f, 0.f, 0.f, 0.f}, 0, 0, 0);
      }
    float mx = -3.0e38f;
#pragma unroll
    for (int i = 0; i < 8; ++i) { const float* bp = rpb + (h * 15 + (rs + i - r + 7)) * 31;
#pragma unroll
      for (int hh = 0; hh < 2; ++hh)
#pragma unroll
        for (int j = 0; j < 4; ++j) { const int kcol = blk + g * 8 + hh * 4 + j; const bool valid = (kcol >= qstart) && (kcol < qstart + 16);
          int dc = kcol - qcol + 15; dc = dc < 0 ? 0 : dc; dc = dc > 30 ? 30 : dc;
          const float v = valid ? s[i][hh][j] + bp[dc] : -3.0e38f; s[i][hh][j] = v; mx = fmaxf(mx, v); } }
    mx = fmaxf(mx, __shfl_xor(mx, 16)); mx = fmaxf(mx, __shfl_xor(mx, 32));
    float sum = 0.f;
#pragma unroll
    for (int i = 0; i < 8; ++i)
#pragma unroll
      for (int hh = 0; hh < 2; ++hh)
#pragma unroll
        for (int j = 0; j < 4; ++j) { const float e = (s[i][hh][j] > -1.0e38f) ? __expf(s[i][hh][j] - mx) : 0.f; s[i][hh][j] = e; sum += e; }
    sum += __shfl_xor(sum, 16); sum += __shfl_xor(sum, 32);
    f32x4 o0 = {0.f, 0.f, 0.f, 0.f}, o1 = {0.f, 0.f, 0.f, 0.f};
#pragma unroll
    for (int i = 0; i < 8; ++i) {
      const u32x4 pu = pack8(s[i][0], s[i][1]); const bf16x8 pf = __builtin_bit_cast(bf16x8, pu);
      const bf16_t* vb = VT + (size_t)(seq_row0 + rs + i) * 65536 + (size_t)(h * 32 + qi) * 64 + blk + g * 8;
      const bf16x8 v0 = *(const bf16x8*)vb, v1 = *(const bf16x8*)(vb + 16 * 64);
      o0 = __builtin_amdgcn_mfma_f32_16x16x32_bf16(v0, pf, o0, 0, 0, 0);
      o1 = __builtin_amdgcn_mfma_f32_16x16x32_bf16(v1, pf, o1, 0, 0, 0);
    }
    const float inv = 1.f / sum;
    bf16_t* op = O + (size_t)(R * 64 + qcol) * 1024 + h * 32 + g * 4;
    u32x2 a, b; a[0] = cvt_pk_bf16(o0[0] * inv, o0[1] * inv); a[1] = cvt_pk_bf16(o0[2] * inv, o0[3] * inv); b[0] = cvt_pk_bf16(o1[0] * inv, o1[1] * inv); b[1] = cvt_pk_bf16(o1[2] * inv, o1[3] * inv);
    *(u32x2*)op = a; *(u32x2*)(op + 16) = b;
  }
}

constexpr int SC_WD = 0, SC_AA = 2048, SC_KD = 4096, SC_BB = 6144, SC_NA = 8192, SC_RR = 10240, SC_VV = 12288, SC_YO = 14336;
__device__ void scan_chain(unsigned char* ws, LAS float* L, int chain) {
  const int tid = tid_(), wid = tid >> 6, lane = tid & 63;
  int h, z, Lq; size_t tok0;
  if (chain < 64) { h = (chain & 31) >> 1; z = chain & 1; Lq = 8192; tok0 = (size_t)(chain >> 5) * 8192; }
  else { const int c2 = chain - 64; h = (c2 & 31) >> 1; z = c2 & 1; Lq = 4096; tok0 = 16384 + (size_t)(c2 >> 5) * 4096; }
  const bf16_t* RKV = (const bf16_t*)(ws + OFF_RKV); const bf16_t* LBWA = (const bf16_t*)(ws + OFF_LBWA); const bf16_t* W2T = (const bf16_t*)(ws + OFF_W2T);
  bf16_t* Y = (bf16_t*)(ws + (z ? OFF_YB : OFF_YF)); float* bonus = (float*)(ws + OFF_BONUS);
  const int tk = tid >> 4, c4 = (tid & 15) * 4;
  const int vrow = wid * 8 + (lane >> 3), ko = lane & 7;
  const int mat = wid >> 1, ntile = wid & 1;
  const int ch0 = h * 64 + c4;
  const f32x4 kk4 = *(const f32x4*)(INP(18) + ch0), ka4 = *(const f32x4*)(INP(19) + ch0), rk4 = *(const f32x4*)(INP(20) + ch0);
  bf16x8 bfrag[4]; float bias0 = 0.f;
  if (wid < 4) { const int chb = h * 64 + ntile * 32 + (lane & 31);
#pragma unroll
    for (int ks = 0; ks < 4; ++ks) bfrag[ks] = *(const bf16x8*)(W2T + ((size_t)(mat * 2 + z) * 1024 + chb) * 64 + ks * 16 + (lane >> 5) * 8);
    bias0 = (mat ? INP(13) : INP(10))[z * 1024 + chb]; }
  const int nchunk = Lq / 32;
  u32x2 rawr, rawk, rawv; bf16x8 afrag[4];
  { const size_t tb = tok0 + (size_t)(z ? nchunk - 1 : 0) * 32; const bf16_t* rp = RKV + (tb + tk) * 3072 + ch0;
    rawr = *(const u32x2*)rp; rawk = *(const u32x2*)(rp + 1024); rawv = *(const u32x2*)(rp + 2048);
    if (wid < 4) {
#pragma unroll
      for (int ks = 0; ks < 4; ++ks) afrag[ks] = *(const bf16x8*)(LBWA + (tb + (lane & 31)) * 256 + mat * 128 + z * 64 + ks * 16 + (lane >> 5) * 8); } }
  float S[8];
#pragma unroll
  for (int j = 0; j < 8; ++j) S[j] = 0.f;
  for (int ci = 0; ci < nchunk; ++ci) {
    const size_t tb = tok0 + (size_t)(z ? nchunk - 1 - ci : ci) * 32;
    if (wid < 4) {
      f32x16 acc;
#pragma unroll
      for (int j = 0; j < 16; ++j) acc[j] = 0.f;
#pragma unroll
      for (int ks = 0; ks < 4; ++ks) acc = __builtin_amdgcn_mfma_f32_32x32x16_bf16(afrag[ks], bfrag[ks], acc, 0, 0, 0);
      LAS float* dst = L + (mat ? SC_AA : SC_WD) + ntile * 32 + (lane & 31);
#pragma unroll
      for (int rg = 0; rg < 16; ++rg) { const int row = (rg & 3) + 8 * (rg >> 2) + 4 * (lane >> 5); const float sg = sigmoidf_(acc[rg] + bias0);
        dst[row * 64] = mat ? sg : __expf(-0.60653065971263342f * sg); }
    }
    __syncthreads();
    {
      const float r4[4] = {bflo(rawr[0]), bfhi(rawr[0]), bflo(rawr[1]), bfhi(rawr[1])};
      const float k4[4] = {bflo(rawk[0]), bfhi(rawk[0]), bflo(rawk[1]), bfhi(rawk[1])};
      f32x4 kx; float ss = 0.f;
#pragma unroll
      for (int j = 0; j < 4; ++j) { kx[j] = k4[j] * kk4[j]; ss += kx[j] * kx[j]; }
      ss = red16(ss); const float inv = 1.f / fmaxf(sqrtf(ss), 1e-12f);
      const f32x4 a4 = *(const LAS f32x4*)(L + SC_AA + tk * 64 + c4);
      f32x4 kd, bb, na, rr, vv; float bon = 0.f;
#pragma unroll
      for (int j = 0; j < 4; ++j) { const float kn = kx[j] * inv; kd[j] = k4[j] * (1.f + (a4[j] - 1.f) * ka4[j]); bb[j] = kn * a4[j]; na[j] = -kn; rr[j] = r4[j]; bon += r4[j] * kd[j] * rk4[j]; }
      vv[0] = bflo(rawv[0]); vv[1] = bfhi(rawv[0]); vv[2] = bflo(rawv[1]); vv[3] = bfhi(rawv[1]);
      *(LAS f32x4*)(L + SC_KD + tk * 64 + c4) = kd; *(LAS f32x4*)(L + SC_BB + tk * 64 + c4) = bb; *(LAS f32x4*)(L + SC_NA + tk * 64 + c4) = na;
      *(LAS f32x4*)(L + SC_RR + tk * 64 + c4) = rr; *(LAS f32x4*)(L + SC_VV + tk * 64 + c4) = vv;
      bon = red16(bon); if ((tid & 15) == 0) bonus[((tb + tk) * 16 + h) * 2 + z] = bon;
    }
    __syncthreads();
    if (ci + 1 < nchunk) { const size_t tn = tok0 + (size_t)(z ? nchunk - 2 - ci : ci + 1) * 32; const bf16_t* rp = RKV + (tn + tk) * 3072 + ch0;
      rawr = *(const u32x2*)rp; rawk = *(const u32x2*)(rp + 1024); rawv = *(const u32x2*)(rp + 2048);
      if (wid < 4) {
#pragma unroll
        for (int ks = 0; ks < 4; ++ks) afrag[ks] = *(const bf16x8*)(LBWA + (tn + (lane & 31)) * 256 + mat * 128 + z * 64 + ks * 16 + (lane >> 5) * 8); } }
#pragma unroll 2
    for (int si = 0; si < 32; ++si) { const int s = z ? 31 - si : si; const LAS float* base = L + s * 64 + ko * 8;
      const f32x4 na0 = *(const LAS f32x4*)(base + SC_NA), na1 = *(const LAS f32x4*)(base + SC_NA + 4);
      const f32x4 w0 = *(const LAS f32x4*)(base + SC_WD), w1 = *(const LAS f32x4*)(base + SC_WD + 4);
      const f32x4 b0 = *(const LAS f32x4*)(base + SC_BB), b1 = *(const LAS f32x4*)(base + SC_BB + 4);
      const f32x4 d0 = *(const LAS f32x4*)(base + SC_KD), d1 = *(const LAS f32x4*)(base + SC_KD + 4);
      const f32x4 r0 = *(const LAS f32x4*)(base + SC_RR), r1 = *(const LAS f32x4*)(base + SC_RR + 4);
      const float vv = L[SC_VV + s * 64 + vrow];
      float sa = (S[0] * na0[0] + S[1] * na0[1]) + (S[2] * na0[2] + S[3] * na0[3]) + (S[4] * na1[0] + S[5] * na1[1]) + (S[6] * na1[2] + S[7] * na1[3]);
      sa = red8(sa);
#pragma unroll
      for (int j = 0; j < 4; ++j) { S[j] = S[j] * w0[j] + (sa * b0[j] + vv * d0[j]); S[4 + j] = S[4 + j] * w1[j] + (sa * b1[j] + vv * d1[j]); }
      float y = (S[0] * r0[0] + S[1] * r0[1]) + (S[2] * r0[2] + S[3] * r0[3]) + (S[4] * r1[0] + S[5] * r1[1]) + (S[6] * r1[2] + S[7] * r1[3]);
      y = red8(y);
      if (ko == 0) L[SC_YO + s * 64 + vrow] = y;
    }
    __syncthreads();
    { const f32x4 yv = *(const LAS f32x4*)(L + SC_YO + tk * 64 + c4); u32x2 o; o[0] = cvt_pk_bf16(yv[0], yv[1]); o[1] = cvt_pk_bf16(yv[2], yv[3]);
      *(u32x2*)(Y + (tb + tk) * 1024 + ch0) = o; }
  }
  __syncthreads();
}

__global__ void __launch_bounds__(512, 2) mega(Params p) {
  cg::grid_group grid = cg::this_grid();
  LAS unsigned char* lds = (LAS unsigned char*)shm;
  LAS int* TS = (LAS int*)(lds + LDS_TS);
  unsigned char* ws = p.ws;
  { const unsigned* ka = (const unsigned*)__builtin_amdgcn_kernarg_segment_ptr(); if (threadIdx.x < 66) ((LAS unsigned*)(lds + LDS_TAB))[threadIdx.x] = ka[threadIdx.x]; }
  __syncthreads();
  const int G = gridDim.x, nw = G * 8;
  const long ngt = (long)G * 512;
#define PH_VARS const int tid = tid_(), lane = tid & 63, wid = tid >> 6, gw = blockIdx.x * 8 + wid; const long gt = (long)blockIdx.x * 512 + tid; (void)lane; (void)gw; (void)gt;
  float* X = p.X;

  { PH_VARS
  {
    int rot = 0; float* tile = (float*)shm;
    const float* wqkv = INP(2);
    rot = cvt_run(mkjob(wqkv, 3072, 1024, 1024, (bf16_t*)(ws + OFF_WQKT), 1024, 0, 0, nullptr, 0.17677669529663687f, 0), tile, rot);
    rot = cvt_run(mkjob(wqkv + 1024, 3072, 1024, 1024, (bf16_t*)(ws + OFF_WQKT), 1024, 1024, 0, nullptr, 1.f, 0), tile, rot);
    rot = cvt_run(mkjob(wqkv + 2048, 3072, 1024, 1024, (bf16_t*)(ws + OFF_WVT), 1024, 0, 0, nullptr, 1.f, 0), tile, rot);
    rot = cvt_run(mkjob(INP(4), 1024, 1024, 1024, (bf16_t*)(ws + OFF_WOT), 1024, 0, 0, nullptr, 1.f, 0), tile, rot);
    rot = cvt_run(mkjob(INP(5), 2816, 1024, 2816, (bf16_t*)(ws + OFF_WGUT), 1024, 0, 0, nullptr, 1.f, 1), tile, rot);
    rot = cvt_run(mkjob(INP(6), 2816, 1024, 2816, (bf16_t*)(ws + OFF_WGUT), 1024, 128, 0, nullptr, 1.f, 1), tile, rot);
    rot = cvt_run(mkjob(INP(7), 1024, 2816, 1024, (bf16_t*)(ws + OFF_WDT), 2816, 0, 0, nullptr, 1.f, 0), tile, rot);
    bf16_t* wrt = (bf16_t*)(ws + OFF_WRT); const float* mu = INP(8);
    for (int half = 0; half < 2; ++half) {
      const int c0 = half * 1024;
      rot = cvt_run(mkjob(INP(9), 1024, 1024, 1024, wrt, 2048, 0, c0, half ? mu + 0 * 1024 : nullptr, 1.f, 0), tile, rot);
      rot = cvt_run(mkjob(INP(9) + 1048576, 1024, 1024, 1024, wrt, 2048, 1024, c0, half ? mu + 2 * 1024 : nullptr, 1.f, 0), tile, rot);
      rot = cvt_run(mkjob(INP(9) + 2097152, 1024, 1024, 1024, wrt, 2048, 2048, c0, half ? mu + 3 * 1024 : nullptr, 1.f, 0), tile, rot);
      rot = cvt_run(mkjob(INP(11), 64, 1024, 64, wrt, 2048, 3072, c0, half ? mu + 1 * 1024 : nullptr, 1.f, 0), tile, rot);
      rot = cvt_run(mkjob(INP(11) + 65536, 64, 1024, 64, wrt, 2048, 3136, c0, half ? mu + 1 * 1024 : nullptr, 1.f, 0), tile, rot);
      rot = cvt_run(mkjob(INP(14), 64, 1024, 64, wrt, 2048, 3200, c0, half ? mu + 4 * 1024 : nullptr, 1.f, 0), tile, rot);
      rot = cvt_run(mkjob(INP(14) + 65536, 64, 1024, 64, wrt, 2048, 3264, c0, half ? mu + 4 * 1024 : nullptr, 1.f, 0), tile, rot);
      rot = cvt_run(mkjob(INP(16), 160, 1024, 160, wrt, 2048, 3328, c0, half ? mu + 5 * 1024 : nullptr, 1.f, 0), tile, rot);
    }
    rot = cvt_run(mkjob(nullptr, 0, 2048, 96, wrt, 2048, 3488, 0, nullptr, 1.f, 0), tile, rot);
    bf16_t* w2t = (bf16_t*)(ws + OFF_W2T);
    rot = cvt_run(mkjob(INP(12), 1024, 64, 1024, w2t, 64, 0, 0, nullptr, 1.f, 0), tile, rot);
    rot = cvt_run(mkjob(INP(12) + 65536, 1024, 64, 1024, w2t, 64, 1024, 0, nullptr, 1.f, 0), tile, rot);
    rot = cvt_run(mkjob(INP(15), 1024, 64, 1024, w2t, 64, 2048, 0, nullptr, 1.f, 0), tile, rot);
    rot = cvt_run(mkjob(INP(15) + 65536, 1024, 64, 1024, w2t, 64, 3072, 0, nullptr, 1.f, 0), tile, rot);
    rot = cvt_run(mkjob(INP(17), 1024, 160, 1024, (bf16_t*)(ws + OFF_G2T), 256, 0, 0, nullptr, 1.f, 0), tile, rot);
    rot = cvt_run(mkjob(nullptr, 0, 96, 1024, (bf16_t*)(ws + OFF_G2T), 256, 0, 160, nullptr, 1.f, 0), tile, rot);
    rot = cvt_run(mkjob(INP(23), 1024, 1024, 1024, (bf16_t*)(ws + OFF_RWOT), 1024, 0, 0, nullptr, 1.f, 0), tile, rot);
    bf16_t* xb = (bf16_t*)(ws + OFF_XB);
    for (long i = gt; i < (long)T * 256; i += ngt) {
      const f32x4 v = (i < 16384L * 256) ? *(const f32x4*)(INP(0) + i * 4) : *(const f32x4*)(INP(1) + (i - 16384L * 256) * 4);
      *(f32x4*)(X + i * 4) = v; u32x2 o; o[0] = cvt_pk_bf16(v[0], v[1]); o[1] = cvt_pk_bf16(v[2], v[3]); *(u32x2*)(xb + i * 4) = o; }
    int* cnt = (int*)(ws + OFF_CNT); int* rowl = (int*)(ws + OFF_ROWL);
    if (gt < 16) cnt[gt] = 0;
    for (long i = gt; i < 102400; i += ngt) rowl[i] = -1;
  }
  }
  grid.sync();
  { PH_VARS
  { Gemm g{(const bf16_t*)(ws + OFF_XB), (const bf16_t*)(ws + OFF_WQKT), 1024}; StaticOrder S; S.init(T, 2048); EpiStore E{(bf16_t*)(ws + OFF_QK), 2048}; gemm_phase(lds, g, S, E); }
  { Gemm g{(const bf16_t*)(ws + OFF_WVT), (const bf16_t*)(ws + OFF_XB), 1024}; StaticOrder S; S.init(1024, T); EpiVT E{(bf16_t*)(ws + OFF_VT)}; gemm_phase(lds, g, S, E); }
  }
  grid.sync();
  { PH_VARS
  attn_phase((const bf16_t*)(ws + OFF_QK), (const bf16_t*)(ws + OFF_VT), INP(3), (bf16_t*)(ws + OFF_O));
  }
  grid.sync();
  { PH_VARS
  { Gemm g{(const bf16_t*)(ws + OFF_O), (const bf16_t*)(ws + OFF_WOT), 1024}; StaticOrder S; S.init(T, 1024); EpiResid E{X}; gemm_phase(lds, g, S, E); }
  }
  grid.sync();
  { PH_VARS
  { bf16_t* xb = (bf16_t*)(ws + OFF_XB);
    for (int row = gw; row < T; row += nw) { f32x4 o[4]; ln_row(X + (size_t)row * 1024, INP(29), INP(30), lane, o);
#pragma unroll
      for (int k = 0; k < 4; ++k) { *(f32x4*)(X + (size_t)row * 1024 + k * 256 + lane * 4) = o[k]; u32x2 q; q[0] = cvt_pk_bf16(o[k][0], o[k][1]); q[1] = cvt_pk_bf16(o[k][2], o[k][3]); *(u32x2*)(xb + (size_t)row * 1024 + k * 256 + lane * 4) = q; } } }
  }
  grid.sync();
  { PH_VARS
  { Gemm g{(const bf16_t*)(ws + OFF_XB), (const bf16_t*)(ws + OFF_WGUT), 1024}; StaticOrder S; S.init(T, 5632); EpiSwiglu E{(bf16_t*)(ws + OFF_H), 2816, 1 << 20, 0}; gemm_phase(lds, g, S, E); }
  }
  grid.sync();
  { Gemm g{(const bf16_t*)(ws + OFF_H), (const bf16_t*)(ws + OFF_WDT), 2816}; StaticOrder S; S.init(T, 1024); EpiResid E{X}; gemm_phase(lds, g, S, E); }
  grid.sync();
  { PH_VARS
  for (int row = gw; row < T; row += nw) { f32x4 o[4]; ln_row(X + (size_t)row * 1024, INP(31), INP(32), lane, o);
#pragma unroll
    for (int k = 0; k < 4; ++k) *(f32x4*)(X + (size_t)row * 1024 + k * 256 + lane * 4) = o[k]; }
  }
  grid.sync();
  { PH_VARS
  { bf16_t* xb2 = (bf16_t*)(ws + OFF_XB2);
    for (int row = gw; row < T; row += nw) {
      const int s0 = row < 16384 ? (row & ~8191) : 16384 + ((row - 16384) & ~4095), len = row < 16384 ? 8192 : 4096;
      const bool hm = row > s0, hp = row < s0 + len - 1;
#pragma unroll
      for (int k = 0; k < 4; ++k) { const size_t off = (size_t)row * 1024 + k * 256 + lane * 4; const f32x4 x = *(const f32x4*)(X + off);
        const f32x4 xm = hm ? *(const f32x4*)(X + off - 1024) : (f32x4){0.f, 0.f, 0.f, 0.f}, xp = hp ? *(const f32x4*)(X + off + 1024) : (f32x4){0.f, 0.f, 0.f, 0.f};
        const f32x4 xx = (xm + xp) * 0.5f - x; u32x2 a, b; a[0] = cvt_pk_bf16(x[0], x[1]); a[1] = cvt_pk_bf16(x[2], x[3]); b[0] = cvt_pk_bf16(xx[0], xx[1]); b[1] = cvt_pk_bf16(xx[2], xx[3]);
        bf16_t* dp = xb2 + (size_t)row * 2048 + k * 256 + lane * 4; *(u32x2*)dp = a; *(u32x2*)(dp + 1024) = b; } } }
  }
  grid.sync();
  { PH_VARS
  { Gemm g{(const bf16_t*)(ws + OFF_XB2), (const bf16_t*)(ws + OFF_WRT), 2048}; StaticOrder S; S.init(T, 3584); EpiRwkv E{(bf16_t*)(ws + OFF_RKV), (bf16_t*)(ws + OFF_LBWA), (bf16_t*)(ws + OFF_LBG)}; gemm_phase(lds, g, S, E); }
  }
  grid.sync();
  { PH_VARS
  { LAS float* L = (LAS float*)lds; const int b = blockIdx.x;
    if (G > 64) { if (b < 64) scan_chain(ws, L, b); else for (int ch = 64 + (b - 64); ch < 320; ch += (G - 64)) scan_chain(ws, L, ch); }
    else for (int ch = b; ch < 320; ch += G) scan_chain(ws, L, ch); }
  }
  grid.sync();
  { PH_VARS
  { bf16_t* yf = (bf16_t*)(ws + OFF_YF); const bf16_t* yb = (const bf16_t*)(ws + OFF_YB); const bf16_t* rkv = (const bf16_t*)(ws + OFF_RKV); const float* bonus = (const float*)(ws + OFF_BONUS);
    for (int row = gw; row < T; row += nw) {
      const size_t off = (size_t)row * 1024 + lane * 16; const u32x4 a0 = *(const u32x4*)(yf + off), a1 = *(const u32x4*)(yf + off + 8), b0 = *(const u32x4*)(yb + off), b1 = *(const u32x4*)(yb + off + 8);
      const u32x4 v0 = *(const u32x4*)(rkv + (size_t)row * 3072 + 2048 + lane * 16), v1 = *(const u32x4*)(rkv + (size_t)row * 3072 + 2048 + lane * 16 + 8);
      float y[16], vv[16]; float s = 0.f;
#pragma unroll
      for (int j = 0; j < 4; ++j) { y[2 * j] = bflo(a0[j]) + bflo(b0[j]); y[2 * j + 1] = bfhi(a0[j]) + bfhi(b0[j]); y[8 + 2 * j] = bflo(a1[j]) + bflo(b1[j]); y[8 + 2 * j + 1] = bfhi(a1[j]) + bfhi(b1[j]);
        vv[2 * j] = bflo(v0[j]); vv[2 * j + 1] = bfhi(v0[j]); vv[8 + 2 * j] = bflo(v1[j]); vv[8 + 2 * j + 1] = bfhi(v1[j]); }
#pragma unroll
      for (int j = 0; j < 16; ++j) s += y[j];
      const float mean = red4(s) * (1.f / 64.f); float q = 0.f;
#pragma unroll
      for (int j = 0; j < 16; ++j) { y[j] -= mean; q += y[j] * y[j]; }
      const float rstd = rsqrtf(red4(q) * (1.f / 64.f) + 64e-5f);
      const float* bp = bonus + ((size_t)row * 16 + (lane >> 2)) * 2; const float bsum = bp[0] + bp[1];
      u32x4 o0, o1;
#pragma unroll
      for (int j = 0; j < 4; ++j) { const f32x4 gg = *(const f32x4*)(INP(21) + lane * 16 + j * 4), bb = *(const f32x4*)(INP(22) + lane * 16 + j * 4); float t[4];
#pragma unroll
        for (int e = 0; e < 4; ++e) t[e] = y[j * 4 + e] * rstd * gg[e] + bb[e] + bsum * vv[j * 4 + e];
        const unsigned lo = cvt_pk_bf16(t[0], t[1]), hi = cvt_pk_bf16(t[2], t[3]);
        if (j < 2) { o0[2 * j] = lo; o0[2 * j + 1] = hi; } else { o1[2 * (j - 2)] = lo; o1[2 * (j - 2) + 1] = hi; } }
      *(u32x4*)(yf + off) = o0; *(u32x4*)(yf + off + 8) = o1; } }
  }
  grid.sync();
  { PH_VARS
  { Gemm g{(const bf16_t*)(ws + OFF_LBG), (const bf16_t*)(ws + OFF_G2T), 256}; StaticOrder S; S.init(T, 1024); EpiMulPre E{(bf16_t*)(ws + OFF_YF)}; gemm_phase(lds, g, S, E); }
  }
  grid.sync();
  { PH_VARS
  { Gemm g{(const bf16_t*)(ws + OFF_YF), (const bf16_t*)(ws + OFF_RWOT), 1024}; StaticOrder S; S.init(T, 1024); EpiResid E{X}; gemm_phase(lds, g, S, E); }
  }
  grid.sync();
  { PH_VARS
  { bf16_t* xb = (bf16_t*)(ws + OFF_XBM); int* cnt = (int*)(ws + OFF_CNT); int* tokE = (int*)(ws + OFF_TOKE); float* tokG = (float*)(ws + OFF_TOKG); int* tokP = (int*)(ws + OFF_TOKP);
    const float* wr = INP(24); const float* br = INP(25);
    for (int row = gw; row < T; row += nw) { f32x4 o[4]; ln_row(X + (size_t)row * 1024, INP(29) + 1024, INP(30) + 1024, lane, o);
      float lg[8];
#pragma unroll
      for (int e = 0; e < 8; ++e) lg[e] = 0.f;
#pragma unroll
      for (int k = 0; k < 4; ++k) {
#pragma unroll
        for (int j = 0; j < 4; ++j) { const float* wp = wr + (size_t)(k * 256 + lane * 4 + j) * 8; const f32x4 wa = *(const f32x4*)wp, wb = *(const f32x4*)(wp + 4); const float xv = o[k][j];
          lg[0] += xv * wa[0]; lg[1] += xv * wa[1]; lg[2] += xv * wa[2]; lg[3] += xv * wa[3]; lg[4] += xv * wb[0]; lg[5] += xv * wb[1]; lg[6] += xv * wb[2]; lg[7] += xv * wb[3]; }
        *(f32x4*)(X + (size_t)row * 1024 + k * 256 + lane * 4) = o[k] * ALPHA; u32x2 q; q[0] = cvt_pk_bf16(o[k][0], o[k][1]); q[1] = cvt_pk_bf16(o[k][2], o[k][3]); *(u32x2*)(xb + (size_t)row * 1024 + k * 256 + lane * 4) = q; }
#pragma unroll
      for (int e = 0; e < 8; ++e) lg[e] = wave_sum(lg[e]) + br[e];
      int e0 = 0; float v0 = lg[0];
#pragma unroll
      for (int e = 1; e < 8; ++e) if (lg[e] > v0) { v0 = lg[e]; e0 = e; }
      int e1 = -1; float v1 = -3.0e38f;
#pragma unroll
      for (int e = 0; e < 8; ++e) if (e != e0 && lg[e] > v1) { v1 = lg[e]; e1 = e; }
      if (lane == 0) { const float ex = __expf(v1 - v0), g0 = 1.f / (1.f + ex), g1 = ex * g0;
        const int p0 = atomicAdd(cnt + e0, 1), p1 = atomicAdd(cnt + 8 + e1, 1);
        tokE[row * 2] = e0; tokE[row * 2 + 1] = e1; tokG[row * 2] = g0; tokG[row * 2 + 1] = g1; tokP[row * 2] = p0; tokP[row * 2 + 1] = p1; } }
    __syncthreads();
    int rot = 0; float* tile = (float*)shm;
    for (int e = 0; e < 8; ++e) {
      rot = cvt_run(mkjob(INP(26) + (size_t)e * 1024 * 3584, 3584, 1024, 3584, (bf16_t*)(ws + OFF_WMGU) + (size_t)e * 7168 * 1024, 1024, 0, 0, nullptr, 1.f, 1), tile, rot);
      rot = cvt_run(mkjob(INP(27) + (size_t)e * 1024 * 3584, 3584, 1024, 3584, (bf16_t*)(ws + OFF_WMGU) + (size_t)e * 7168 * 1024, 1024, 128, 0, nullptr, 1.f, 1), tile, rot);
      rot = cvt_run(mkjob(INP(28) + (size_t)e * 3584 * 1024, 1024, 3584, 1024, (bf16_t*)(ws + OFF_WMD) + (size_t)e * 1024 * 3584, 3584, 0, 0, nullptr, 1.f, 0), tile, rot);
    }
  }
  }
  grid.sync();
  { PH_VARS
  { const int* cnt = (const int*)(ws + OFF_CNT);
    __syncthreads();
    if (tid == 0) { int a = 0; for (int k = 0; k < 16; ++k) { TS[k] = a; a += (cnt[k] + 255) >> 8; } TS[16] = a; }
    __syncthreads();
    const int* tokE = (const int*)(ws + OFF_TOKE); const float* tokG = (const float*)(ws + OFF_TOKG); const int* tokP = (const int*)(ws + OFF_TOKP);
    int* rowl = (int*)(ws + OFF_ROWL); float* rowg = (float*)(ws + OFF_ROWG); const bf16_t* xb = (const bf16_t*)(ws + OFF_XBM); bf16_t* xs = (bf16_t*)(ws + OFF_XS);
    for (int pr = gw; pr < T * 2; pr += nw) { const int tok = pr >> 1, rk = pr & 1; const int e = tokE[pr]; const int row = TS[rk * 8 + e] * 256 + tokP[pr];
      if (lane == 0) { rowl[row] = tok; rowg[row] = tokG[pr]; }
      const u32x4* sp = (const u32x4*)(xb + (size_t)tok * 1024); u32x4* dp = (u32x4*)(xs + (size_t)row * 1024); dp[lane] = sp[lane]; dp[lane + 64] = sp[lane + 64]; }
  }
  }
  grid.sync();
  { PH_VARS
  { const int ts8 = TS[8], ts16 = TS[16];
    for (int rk = 0; rk < 2; ++rk) { const int t0 = rk ? ts8 : 0, t1 = rk ? ts16 : ts8;
      for (int cs = t0; cs < t1; cs += MOE_CHUNK) { const int ntile = (t1 - cs) < MOE_CHUNK ? (t1 - cs) : MOE_CHUNK;
        { Gemm g{(const bf16_t*)(ws + OFF_XS), (const bf16_t*)(ws + OFF_WMGU), 1024}; MoeOrder<28> S{cs, ntile, G, (int)blockIdx.x, TS}; EpiSwiglu E{(bf16_t*)(ws + OFF_HID), 3584, 28, cs * 256}; gemm_phase(lds, g, S, E); }
        grid.sync();
        { Gemm g{(const bf16_t*)(ws + OFF_HID), (const bf16_t*)(ws + OFF_WMD), 3584}; MoeDownOrder S{cs, ntile, G, (int)blockIdx.x, TS}; EpiMoeDown E{X, (const int*)(ws + OFF_ROWL), (const float*)(ws + OFF_ROWG), cs * 256}; gemm_phase(lds, g, S, E); }
        grid.sync();
      } }
  }
  }
  { PH_VARS
  for (int row = gw; row < T; row += nw) { f32x4 o[4]; ln_row(X + (size_t)row * 1024, INP(31) + 1024, INP(32) + 1024, lane, o);
#pragma unroll
    for (int k = 0; k < 4; ++k) *(f32x4*)(X + (size_t)row * 1024 + k * 256 + lane * 4) = o[k]; }
  }
}

extern "C" void kernel_launch(void* const* d_in, const int* in_sizes, int n_in, void* d_out, int out_size, void* d_ws, size_t ws_size, hipStream_t stream) {
  static int grid_blocks = 0;
  if (!grid_blocks) {
    int dev = 0, cus = 0, per_cu = 0;
    (void)hipGetDevice(&dev);
    (void)hipDeviceGetAttribute(&cus, hipDeviceAttributeMultiprocessorCount, dev);
    (void)hipFuncSetAttribute((const void*)mega, hipFuncAttributeMaxDynamicSharedMemorySize, LDS_BYTES);
    (void)hipOccupancyMaxActiveBlocksPerMultiprocessor(&per_cu, mega, 512, LDS_BYTES);
    if (per_cu > 1) per_cu = 1;
    grid_blocks = cus * per_cu;
    if (ws_size < WS_NEED) fprintf(stderr, "workspace too small: %zu < %zu\n", ws_size, (size_t)WS_NEED);
  }
  Params p{};
  for (int i = 0; i < 33; ++i) p.in[i] = (const float*)d_in[i];
  p.X = (float*)d_out; p.ws = (unsigned char*)d_ws;
  void* args[] = {&p};
  hipError_t e = hipLaunchCooperativeKernel((void*)mega, dim3(grid_blocks), dim3(512), args, LDS_BYTES, stream);
  if (e != hipSuccess) fprintf(stderr, "cooperative launch failed: %s (grid %d)\n", hipGetErrorString(e), grid_blocks);
}
```

```cpp
#include <hip/hip_runtime.h>
#include <hip/hip_cooperative_groups.h>
#include <cstdio>
namespace cg = cooperative_groups;

#define LAS __attribute__((address_space(3)))
typedef unsigned short bf16_t;
typedef short bf16x8 __attribute__((ext_vector_type(8)));
typedef float f32x4 __attribute__((ext_vector_type(4)));
typedef float f32x16 __attribute__((ext_vector_type(16)));
typedef unsigned u32x4 __attribute__((ext_vector_type(4)));
typedef unsigned u32x2 __attribute__((ext_vector_type(2)));

constexpr int T = 49152, D = 1024;
constexpr float ALPHA = 1.41421356237309515f;
constexpr size_t SZ = (size_t)T * 1024 * 2;
constexpr size_t OFF_WRT = 0;
constexpr size_t OFF_W2T = OFF_WRT + 14680064;
constexpr size_t OFF_G2T = OFF_W2T + 524288;
constexpr size_t OFF_RWOT = OFF_G2T + 524288;
constexpr size_t OFF_CNT = OFF_RWOT + 2097152;
constexpr size_t OFF_TOKE = OFF_CNT + 256;
constexpr size_t OFF_TOKG = OFF_TOKE + 393216;
constexpr size_t OFF_TOKP = OFF_TOKG + 393216;
constexpr size_t OFF_ROWL = OFF_TOKP + 393216;
constexpr size_t OFF_ROWG = OFF_ROWL + 409600;
constexpr size_t OFF_BONUS = OFF_ROWG + 409600;
constexpr size_t OFF_BAR = OFF_BONUS + 6291456;
constexpr size_t BIG = 26214400;
constexpr size_t OFF_XB = BIG, OFF_QK = BIG + SZ, OFF_VT = BIG + 3 * SZ, OFF_O = BIG + 4 * SZ;
constexpr size_t OFF_WQKT = BIG + 5 * SZ, OFF_WVT = OFF_WQKT + 4194304, OFF_WOT = OFF_WVT + 2097152, OFF_WGUT = OFF_WOT + 2097152, OFF_WDT = OFF_WGUT + 11534336;
constexpr size_t OFF_H = BIG + SZ;
constexpr size_t OFF_XB2 = BIG, OFF_RKV = BIG + 2 * SZ, OFF_LBWA = BIG + 5 * SZ, OFF_LBG = OFF_LBWA + 25165824;
constexpr size_t OFF_YF = BIG, OFF_YB = BIG + SZ;
constexpr size_t OFF_WMGU = BIG, OFF_WMD = BIG + 117440512, OFF_XS = BIG + 176160768, OFF_XBM = OFF_XS + 209715200, OFF_HID = OFF_XBM;
constexpr size_t WS_NEED = OFF_HID + 183500800;
constexpr int MOE_CHUNK = 100;
constexpr int LDS_BYTES = 131072 + 512;

struct Params { const float* in[33]; float* X; unsigned char* ws; };
extern __shared__ __attribute__((aligned(16))) unsigned char shm[];
constexpr int LDS_TS = 131072, LDS_TAB = 131072 + 128;
__device__ __forceinline__ const float* INP(int i) {
  const LAS unsigned* tab = (const LAS unsigned*)((LAS unsigned char*)shm + LDS_TAB);
  const unsigned lo = __builtin_amdgcn_readfirstlane(tab[2 * i]), hi = __builtin_amdgcn_readfirstlane(tab[2 * i + 1]);
  return (const float*)(((unsigned long long)hi << 32) | lo);
}

__device__ __forceinline__ int tid_() { int t = threadIdx.x; asm volatile("" : "+v"(t)); return t; }
__device__ __forceinline__ unsigned cvt_pk_bf16(float lo, float hi) { unsigned r; asm("v_cvt_pk_bf16_f32 %0, %1, %2" : "=v"(r) : "v"(lo), "v"(hi)); return r; }
__device__ __forceinline__ bf16_t f2bf(float f) { return (bf16_t)(cvt_pk_bf16(f, 0.f) & 0xffffu); }
__device__ __forceinline__ float bflo(unsigned u) { return __uint_as_float(u << 16); }
__device__ __forceinline__ float bfhi(unsigned u) { return __uint_as_float(u & 0xffff0000u); }
__device__ __forceinline__ float wave_sum(float v) { for (int o = 32; o; o >>= 1) v += __shfl_xor(v, o); return v; }
template <int CTRL> __device__ __forceinline__ float dppf(float v) { return __builtin_bit_cast(float, __builtin_amdgcn_mov_dpp(__builtin_bit_cast(int, v), CTRL, 0xf, 0xf, true)); }
__device__ __forceinline__ float red4(float v) { v += dppf<0xB1>(v); v += dppf<0x4E>(v); return v; }
__device__ __forceinline__ float red8(float v) { v = red4(v); v += dppf<0x141>(v); return v; }
__device__ __forceinline__ float red16(float v) { v = red8(v); v += dppf<0x140>(v); return v; }
__device__ __forceinline__ float sigmoidf_(float x) { return __builtin_amdgcn_rcpf(1.f + __expf(-x)); }


#define XB_TMO      128
#define XB_XCNT(j)  (256  + 64 * (j))
#define XB_XSUB(j)  (1280 + 64 * (j))
#define XB_XGEN(j)  (2304 + 64 * (j))
#define XB_TOP      3328
#define XB_TOPGEN   3392
#define XCD_BAR_WORDS 3456
#define XB_SPIN_CAP (1u << 18)
__device__ __forceinline__ unsigned xb_ld(unsigned* p)              { return __hip_atomic_load(p, __ATOMIC_RELAXED, __HIP_MEMORY_SCOPE_AGENT); }
__device__ __forceinline__ unsigned xb_add(unsigned* p, unsigned v) { return __hip_atomic_fetch_add(p, v, __ATOMIC_RELAXED, __HIP_MEMORY_SCOPE_AGENT); }
__device__ __forceinline__ unsigned xb_xcc_id() { return (unsigned)__builtin_amdgcn_s_getreg((3 << 11) | 20) & 0xFu; }
#define XB_SPIN(cond, bar) do { unsigned _sp = 0; while (cond) { __builtin_amdgcn_s_sleep(1); \
    if ((++_sp & 255u) == 0u) { if (xb_ld(&(bar)[XB_TMO])) break; if (_sp > XB_SPIN_CAP) { atomicAdd(&(bar)[XB_TMO], 1u); break; } } } } while (0)
struct XcdBarrier { unsigned* bar; unsigned x; volatile LAS unsigned* st; };
__device__ __forceinline__ XcdBarrier xcd_barrier_post(unsigned* bar, volatile LAS unsigned* st) {
  XcdBarrier b; b.bar = bar; b.x = xb_xcc_id(); b.st = st;
  if (threadIdx.x == 0) (void)xb_add(&bar[XB_XCNT(b.x)], 1u);
  return b;
}
__device__ __forceinline__ void xcd_barrier_complete(unsigned* bar, unsigned x, unsigned& nloc, unsigned& nx) {
  const unsigned G = gridDim.x * gridDim.y * gridDim.z;
  unsigned sum, cnt, mine, sp = 0u;
  for (;;) {
    sum = 0u; cnt = 0u; mine = 0u;
#pragma unroll
    for (unsigned j = 0; j < 16; ++j) { const unsigned c = xb_ld(&bar[XB_XCNT(j)]); sum += c; cnt += (c > 0u) ? 1u : 0u; mine = (j == x) ? c : mine; }
    if (sum == G) break;
    __builtin_amdgcn_s_sleep(1);
    if ((++sp & 255u) == 0u) { if (xb_ld(&bar[XB_TMO])) break; if (sp > XB_SPIN_CAP) { atomicAdd(&bar[XB_TMO], 1u); break; } }
  }
  nloc = mine > 0u ? mine : 1u; nx = cnt > 0u ? cnt : 1u;
}
__device__ __forceinline__ void xcd_barrier(const XcdBarrier& b) {
  asm volatile("s_waitcnt vmcnt(0)" ::: "memory");
  __syncthreads();
  if (threadIdx.x == 0) {
    unsigned* bar = b.bar;
    __builtin_amdgcn_s_waitcnt(0);
    unsigned nloc = b.st[0], nx = b.st[1];
    if (nloc == 0u) { xcd_barrier_complete(bar, b.x, nloc, nx); b.st[0] = nloc; b.st[1] = nx; }
    const unsigned old = xb_add(&bar[XB_XSUB(b.x)], 1u);
    const unsigned gen = old / nloc;
    if (old + 1u == (gen + 1u) * nloc) {
      __builtin_amdgcn_fence(__ATOMIC_RELEASE, "agent");
      asm volatile("s_waitcnt vmcnt(0)" ::: "memory");
      const unsigned og = xb_add(&bar[XB_TOP], 1u);
      const unsigned tg = og / nx;
      if (og + 1u == (tg + 1u) * nx) xb_add(&bar[XB_TOPGEN], 1u);
      else XB_SPIN(xb_ld(&bar[XB_TOPGEN]) == tg, bar);
      __builtin_amdgcn_fence(__ATOMIC_ACQUIRE, "agent");
      xb_add(&bar[XB_XGEN(b.x)], 1u);
      asm volatile("s_waitcnt vmcnt(0)" ::: "memory");
    } else {
      XB_SPIN(xb_ld(&bar[XB_XGEN(b.x)]) == gen, bar);
      __builtin_amdgcn_fence(__ATOMIC_ACQUIRE, "agent");
      asm volatile("s_waitcnt vmcnt(0)" ::: "memory");
    }
  }
  __syncthreads();
}

struct CvtJob { const float* src; int ldsrc, K, N; bf16_t* dst; int lddst, row0, col0; const float* kscale; float scale; int mode; };
__device__ __forceinline__ CvtJob mkjob(const float* src, int ldsrc, int K, int N, bf16_t* dst, int lddst, int row0, int col0, const float* kscale, float scale, int mode) {
  CvtJob j; j.src = src; j.ldsrc = ldsrc; j.K = K; j.N = N; j.dst = dst; j.lddst = lddst; j.row0 = row0; j.col0 = col0; j.kscale = kscale; j.scale = scale; j.mode = mode; return j; }
__device__ __forceinline__ int cvt_run(const CvtJob J, float* tile, int rot) {
  const int tk = (J.K + 63) >> 6, tn = (J.N + 63) >> 6, nt = tk * tn, G = gridDim.x;
  const int tx = tid_() & 63, ty = tid_() >> 6;
  int start = (int)blockIdx.x - rot; if (start < 0) start += G;
  for (int t = start; t < nt; t += G) {
    const int k0 = (t / tn) * 64, n0 = (t % tn) * 64;
    __syncthreads();
#pragma unroll
    for (int r = 0; r < 8; ++r) { const int kk = r * 8 + ty, k = k0 + kk, n = n0 + tx; float v = 0.f;
      if (J.src && k < J.K && n < J.N) { v = J.src[(size_t)k * J.ldsrc + n] * J.scale; if (J.kscale) v *= J.kscale[k]; }
      tile[kk * 65 + tx] = v; }
    __syncthreads();
#pragma unroll
    for (int r = 0; r < 8; ++r) { const int nn = r * 8 + ty, n = n0 + nn, k = k0 + tx;
      if (n < J.N && k < J.K) { const int row = J.mode ? ((n >> 7) * 256 + (n & 127)) : n;
        J.dst[(size_t)(J.row0 + row) * J.lddst + J.col0 + k] = f2bf(tile[tx * 65 + nn]); } }
  }
  return (rot + nt) % G;
}

constexpr int BM = 256, BK = 64, HALF = 128, HTB = HALF * BK * 2, NXCD = 8, WGM = 8;
__device__ __forceinline__ int lds_byte(int r, int c) { const int st = (r >> 4) * 2 + (c >> 5), rr = r & 15, cc = c & 31, ob = rr * 64 + cc * 2; return st * 1024 + (ob ^ (((ob >> 9) & 1) << 5)); }
__device__ __forceinline__ void stage_rc(int b, int& R, int& C) { const int st = b / 1024, sb = b % 1024, swz = sb ^ (((sb >> 9) & 1) << 5); R = (st >> 1) * 16 + swz / 64; C = (st & 1) * 32 + (swz % 64) / 2; }
__device__ __forceinline__ int perm32(int rho) { const int n = rho >> 4, i = rho & 15; return 8 * (i >> 2) + 4 * n + (i & 3); }
struct Unit { int pm, pn; };
struct Gemm { const bf16_t* A; const bf16_t* Bt; int K; };
struct StaticOrder {
  int nM, nN, nwg, G, c;
  __device__ void init(int M, int N) { nM = M / BM; nN = N / BM; nwg = nM * nN; G = gridDim.x; c = blockIdx.x; }
  __device__ bool next(int i, Unit& u) const {
    const long L = (long)i * G + c; if (L >= nwg) return false;
    int wgid = (int)L; { const int q = nwg / NXCD, r = nwg % NXCD, xcd = wgid % NXCD, off = wgid / NXCD; wgid = (xcd < r ? xcd * (q + 1) : r * (q + 1) + (xcd - r) * q) + off; }
    const int nig = WGM * nN, gid = wgid / nig, fm = gid * WGM, gsz = (nM - fm) < WGM ? (nM - fm) : WGM;
    u.pm = fm + ((wgid % nig) % gsz); u.pn = (wgid % nig) / gsz; return true;
  }
};
template <int NC> struct MoeOrder {
  int first, ntile, G, c; const LAS int* ts;
  __device__ bool next(int i, Unit& u) const {
    const long L = (long)i * G + c; if (L >= (long)ntile * NC) return false;
    const int l = (int)L, nig = WGM * NC, gid = l / nig, fm = gid * WGM, gsz = (ntile - fm) < WGM ? (ntile - fm) : WGM;
    const int pm = first + fm + ((l % nig) % gsz), pn = (l % nig) / gsz;
    int g = 0;
#pragma unroll
    for (int k = 1; k < 16; ++k) g += (pm >= ts[k]) ? 1 : 0;
    u.pm = pm; u.pn = (g & 7) * NC + pn; return true;
  }
};

template <class Epi, class Sched>
__device__ __forceinline__ void gemm_phase(LAS unsigned char* lds, const Gemm g, const Sched& S, const Epi& E) {
  const int tid = tid_(), wid = __builtin_amdgcn_readfirstlane(tid >> 6), lane = tid & 63, wr = wid >> 2, wc = wid & 3, fr = lane & 15, fq = lane >> 4;
  const int K = g.K, nt = K / BK;
  unsigned voffA[2], voffB[2];
#pragma unroll
  for (int i = 0; i < 2; ++i) { int R, C; stage_rc(tid * 16 + i * 8192, R, C); const int Rb = Epi::PERM ? ((R & ~31) + perm32(R & 31)) : R;
    voffA[i] = (unsigned)(R * K + C) * 2u; voffB[i] = (unsigned)(Rb * K + C) * 2u; }
  const size_t kstep = (size_t)(BK * 2);
  const size_t hstep = (size_t)HALF * K * 2;
  const size_t tstep = 2 * hstep;
  const unsigned ldsw = (unsigned)wid * 1024u;
  const int aoff = lds_byte(wr * 64 + fr, fq * 8), boff = lds_byte(wc * 32 + fr, fq * 8);
#define PG8_SA(b, h) (((b) * 2 + (h)) * HTB)
#define PG8_SB(b, h) ((4 + (b) * 2 + (h)) * HTB)
#define PG8_STAGE(bufoff, gbase, voff) do { _Pragma("unroll") for (int _i = 0; _i < 2; ++_i) \
    __builtin_amdgcn_global_load_lds((const unsigned*)((const char*)(gbase) + (voff)[_i]), (LAS unsigned*)(lds + (bufoff) + ldsw + _i * 8192), 16, 0, 0); } while (0)
#define PG8_LDA(dst, b, h) do { _Pragma("unroll") for (int m = 0; m < 4; ++m) _Pragma("unroll") for (int k = 0; k < 2; ++k) dst[m][k] = *(const LAS bf16x8*)(lds + PG8_SA(b, h) + aoff + m * 2048 + k * 1024); } while (0)
#define PG8_LDB(dst, b, h) do { _Pragma("unroll") for (int n = 0; n < 2; ++n) _Pragma("unroll") for (int k = 0; k < 2; ++k) dst[n][k] = *(const LAS bf16x8*)(lds + PG8_SB(b, h) + boff + n * 2048 + k * 1024); } while (0)
#define PG8_MMA(ai, bj, At, Bt) do { __builtin_amdgcn_s_setprio(1); _Pragma("unroll") for (int m = 0; m < 4; ++m) _Pragma("unroll") for (int n = 0; n < 2; ++n) _Pragma("unroll") for (int k = 0; k < 2; ++k) \
    acc[ai][bj][m][n] = __builtin_amdgcn_mfma_f32_16x16x32_bf16(Bt[n][k], At[m][k], acc[ai][bj][m][n], 0, 0, 0); __builtin_amdgcn_s_setprio(0); } while (0)
#define PG8_WAIT_V(n) asm volatile("s_waitcnt vmcnt(" #n ")" ::: "memory")
#define PG8_WAIT_L(n) asm volatile("s_waitcnt lgkmcnt(" #n ")" ::: "memory")
#define PG8_BAR __builtin_amdgcn_s_barrier()
#define PG8_SCHED __builtin_amdgcn_sched_barrier(0)
  Unit cur, nxt; int ui = 0;
  if (!S.next(0, cur)) return;
  f32x4 acc[2][2][4][2];
#pragma unroll
  for (int a = 0; a < 2; ++a)
#pragma unroll
    for (int b = 0; b < 2; ++b)
#pragma unroll
      for (int m = 0; m < 4; ++m)
#pragma unroll
        for (int n = 0; n < 2; ++n) acc[a][b][m][n] = (f32x4){0.f, 0.f, 0.f, 0.f};
  bf16x8 At[4][2], B0[2][2], B1[2][2];
  const char* cA = (const char*)g.A + (size_t)cur.pm * tstep; const char* cB = (const char*)g.Bt + (size_t)cur.pn * tstep;
  PG8_STAGE(PG8_SB(0, 0), cB, voffB); PG8_STAGE(PG8_SA(0, 0), cA, voffA); PG8_STAGE(PG8_SB(0, 1), cB + hstep, voffB); PG8_STAGE(PG8_SA(0, 1), cA + hstep, voffA);
  if (wr == 1) PG8_BAR;
  PG8_WAIT_V(4); PG8_BAR;
  PG8_STAGE(PG8_SB(1, 0), cB + kstep, voffB); PG8_STAGE(PG8_SA(1, 0), cA + kstep, voffA); PG8_STAGE(PG8_SB(1, 1), cB + hstep + kstep, voffB);
  PG8_WAIT_V(6); PG8_BAR;
  for (;;) {
    const bool has_next = S.next(ui + 1, nxt);
    const char* nA = has_next ? (const char*)g.A + (size_t)nxt.pm * tstep : cA; const char* nB = has_next ? (const char*)g.Bt + (size_t)nxt.pn * tstep : cB;
    for (int t = 0; t < nt; t += 2) {
      const bool last = (t == nt - 2);
      const char* a1 = cA + (size_t)(t + 1) * kstep;
      const char* a2 = last ? nA : cA + (size_t)(t + 2) * kstep; const char* b2 = last ? nB : cB + (size_t)(t + 2) * kstep;
      const char* a3 = a2 + kstep; const char* b3 = b2 + kstep;
      PG8_LDB(B0, 0, 0); PG8_SCHED; PG8_LDA(At, 0, 0); PG8_STAGE(PG8_SA(1, 1), a1 + hstep, voffA);
      PG8_WAIT_L(8); PG8_BAR; PG8_WAIT_L(0); PG8_MMA(0, 0, At, B0); PG8_BAR; PG8_SCHED;
      PG8_LDB(B1, 0, 1); PG8_STAGE(PG8_SB(0, 0), b2, voffB);
      PG8_BAR; PG8_WAIT_L(0); PG8_MMA(0, 1, At, B1); PG8_BAR;
      PG8_LDA(At, 0, 1); PG8_STAGE(PG8_SA(0, 0), a2, voffA);
      PG8_BAR; PG8_WAIT_L(0); PG8_MMA(1, 0, At, B0); PG8_BAR; PG8_SCHED;
      PG8_STAGE(PG8_SB(0, 1), b2 + hstep, voffB);
      PG8_WAIT_V(6); PG8_BAR; PG8_MMA(1, 1, At, B1); PG8_BAR;
      PG8_LDB(B0, 1, 0); PG8_SCHED; PG8_LDA(At, 1, 0); PG8_STAGE(PG8_SA(0, 1), a2 + hstep, voffA);
      PG8_WAIT_L(8); PG8_BAR; PG8_WAIT_L(0); PG8_MMA(0, 0, At, B0); PG8_BAR; PG8_SCHED;
      PG8_LDB(B1, 1, 1); PG8_STAGE(PG8_SB(1, 0), b3, voffB);
      PG8_BAR; PG8_WAIT_L(0); PG8_MMA(0, 1, At, B1); PG8_BAR;
      PG8_LDA(At, 1, 1); PG8_STAGE(PG8_SA(1, 0), a3, voffA);
      PG8_BAR; PG8_WAIT_L(0); PG8_MMA(1, 0, At, B0); PG8_BAR; PG8_SCHED;
      PG8_STAGE(PG8_SB(1, 1), b3 + hstep, voffB);
      PG8_WAIT_V(6); PG8_BAR; PG8_MMA(1, 1, At, B1); PG8_BAR;
    }
    E(acc, cur, wr, wc, fr, fq);
    if (!has_next) break;
#pragma unroll
    for (int a = 0; a < 2; ++a)
#pragma unroll
      for (int b = 0; b < 2; ++b)
#pragma unroll
        for (int m = 0; m < 4; ++m)
#pragma unroll
          for (int n = 0; n < 2; ++n) acc[a][b][m][n] = (f32x4){0.f, 0.f, 0.f, 0.f};
    cur = nxt; cA = nA; cB = nB; ++ui;
  }
  PG8_WAIT_V(0);
  if (wr == 0) PG8_BAR;
  PG8_BAR;
#undef PG8_SA
#undef PG8_SB
#undef PG8_STAGE
#undef PG8_LDA
#undef PG8_LDB
#undef PG8_MMA
#undef PG8_WAIT_V
#undef PG8_WAIT_L
#undef PG8_BAR
#undef PG8_SCHED
}

typedef f32x4 Acc[2][2][4][2];
__device__ __forceinline__ u32x4 pack8(f32x4 a, f32x4 b) { u32x4 o; o[0] = cvt_pk_bf16(a[0], a[1]); o[1] = cvt_pk_bf16(a[2], a[3]); o[2] = cvt_pk_bf16(b[0], b[1]); o[3] = cvt_pk_bf16(b[2], b[3]); return o; }

struct EpiStore {
  static constexpr bool PERM = true; bf16_t* O; int ldc;
  __device__ __forceinline__ void operator()(const Acc& acc, const Unit& u, int wr, int wc, int fr, int fq) const {
    const int row0 = u.pm * BM + wr * 64 + fr, col0 = u.pn * BM + wc * 32 + 8 * fq;
#pragma unroll
    for (int ai = 0; ai < 2; ++ai)
#pragma unroll
      for (int m = 0; m < 4; ++m) { bf16_t* rp = O + (size_t)(row0 + ai * HALF + m * 16) * ldc + col0;
#pragma unroll
        for (int bj = 0; bj < 2; ++bj) *(u32x4*)(rp + bj * HALF) = pack8(acc[ai][bj][m][0], acc[ai][bj][m][1]); }
  }
};
struct EpiVT {
  static constexpr bool PERM = true; bf16_t* O;
  __device__ __forceinline__ void operator()(const Acc& acc, const Unit& u, int wr, int wc, int fr, int fq) const {
    const int row0 = u.pm * BM + wr * 64 + fr, col0 = u.pn * BM + wc * 32 + 8 * fq;
#pragma unroll
    for (int ai = 0; ai < 2; ++ai)
#pragma unroll
      for (int m = 0; m < 4; ++m) { const int ch = row0 + ai * HALF + m * 16;
#pragma unroll
        for (int bj = 0; bj < 2; ++bj) { const int tok = col0 + bj * HALF;
          *(u32x4*)(O + (size_t)(tok >> 6) * 65536 + ch * 64 + (tok & 63)) = pack8(acc[ai][bj][m][0], acc[ai][bj][m][1]); } }
  }
};
struct EpiResid {
  static constexpr bool PERM = false; float* X;
  __device__ __forceinline__ void operator()(const Acc& acc, const Unit& u, int wr, int wc, int fr, int fq) const {
    const int row0 = u.pm * BM + wr * 64 + fr, col0 = u.pn * BM + wc * 32 + 4 * fq;
#pragma unroll
    for (int ai = 0; ai < 2; ++ai)
#pragma unroll
      for (int m = 0; m < 4; ++m) { float* rp = X + (size_t)(row0 + ai * HALF + m * 16) * 1024 + col0;
#pragma unroll
        for (int bj = 0; bj < 2; ++bj)
#pragma unroll
          for (int n = 0; n < 2; ++n) { f32x4* q = (f32x4*)(rp + bj * HALF + n * 16); *q = *q * ALPHA + acc[ai][bj][m][n]; } __builtin_amdgcn_sched_barrier(0); }
  }
};
__device__ __forceinline__ f32x4 swiglu4(f32x4 g, f32x4 u) { f32x4 o;
#pragma unroll
  for (int j = 0; j < 4; ++j) o[j] = g[j] * __builtin_amdgcn_rcpf(1.f + __expf(-g[j])) * u[j];
  return o; }
struct EpiSwiglu {
  static constexpr bool PERM = true; bf16_t* H; int ldh, NC, row_base;
  __device__ __forceinline__ void operator()(const Acc& acc, const Unit& u, int wr, int wc, int fr, int fq) const {
    const int row0 = u.pm * BM - row_base + wr * 64 + fr, col0 = (u.pn % NC) * HALF + wc * 32 + 8 * fq;
#pragma unroll
    for (int ai = 0; ai < 2; ++ai)
#pragma unroll
      for (int m = 0; m < 4; ++m)
        *(u32x4*)(H + (size_t)(row0 + ai * HALF + m * 16) * ldh + col0) = pack8(swiglu4(acc[ai][0][m][0], acc[ai][1][m][0]), swiglu4(acc[ai][0][m][1], acc[ai][1][m][1]));
  }
};
struct EpiRwkv {
  static constexpr bool PERM = true; bf16_t* RKV; bf16_t* LBWA; bf16_t* LBG;
  __device__ __forceinline__ void operator()(const Acc& acc, const Unit& u, int wr, int wc, int fr, int fq) const {
    const int row0 = u.pm * BM + wr * 64 + fr;
    if (u.pn < 12) {
      const int col0 = u.pn * BM + wc * 32 + 8 * fq;
#pragma unroll
      for (int ai = 0; ai < 2; ++ai)
#pragma unroll
        for (int m = 0; m < 4; ++m) { bf16_t* rp = RKV + (size_t)(row0 + ai * HALF + m * 16) * 3072 + col0;
#pragma unroll
          for (int bj = 0; bj < 2; ++bj) *(u32x4*)(rp + bj * HALF) = pack8(acc[ai][bj][m][0], acc[ai][bj][m][1]); }
    } else {
      const bool isg = (u.pn == 13); bf16_t* O = isg ? LBG : LBWA; const int c0 = wc * 32 + 8 * fq;
#pragma unroll
      for (int ai = 0; ai < 2; ++ai)
#pragma unroll
        for (int m = 0; m < 4; ++m) { bf16_t* rp = O + (size_t)(row0 + ai * HALF + m * 16) * 256 + c0;
#pragma unroll
          for (int bj = 0; bj < 2; ++bj) { f32x4 v0 = acc[ai][bj][m][0], v1 = acc[ai][bj][m][1]; const int c = bj * HALF + c0;
            if (isg) { if (c < 160) {
#pragma unroll
                for (int j = 0; j < 4; ++j) { v0[j] = sigmoidf_(v0[j]); v1[j] = sigmoidf_(v1[j]); } } else { v0 = (f32x4){0.f, 0.f, 0.f, 0.f}; v1 = v0; } }
            else if (bj == 0) {
#pragma unroll
              for (int j = 0; j < 4; ++j) { v0[j] = 1.f - 2.f * __builtin_amdgcn_rcpf(1.f + __expf(2.f * v0[j])); v1[j] = 1.f - 2.f * __builtin_amdgcn_rcpf(1.f + __expf(2.f * v1[j])); } }
            *(u32x4*)(rp + bj * HALF) = pack8(v0, v1); } }
    }
  }
};
struct EpiMulPre {
  static constexpr bool PERM = true; bf16_t* P;
  __device__ __forceinline__ void operator()(const Acc& acc, const Unit& u, int wr, int wc, int fr, int fq) const {
    const int row0 = u.pm * BM + wr * 64 + fr, col0 = u.pn * BM + wc * 32 + 8 * fq;
#pragma unroll
    for (int ai = 0; ai < 2; ++ai)
#pragma unroll
      for (int m = 0; m < 4; ++m) { bf16_t* rp = P + (size_t)(row0 + ai * HALF + m * 16) * 1024 + col0;
#pragma unroll
        for (int bj = 0; bj < 2; ++bj) { u32x4* q = (u32x4*)(rp + bj * HALF); const u32x4 pv = *q; f32x4 a = acc[ai][bj][m][0], b = acc[ai][bj][m][1];
          a[0] *= bflo(pv[0]); a[1] *= bfhi(pv[0]); a[2] *= bflo(pv[1]); a[3] *= bfhi(pv[1]); b[0] *= bflo(pv[2]); b[1] *= bfhi(pv[2]); b[2] *= bflo(pv[3]); b[3] *= bfhi(pv[3]);
          *q = pack8(a, b); } __builtin_amdgcn_sched_barrier(0); }
  }
};
struct EpiMoeDown {
  static constexpr bool PERM = false; float* X; const int* rowl; const float* rowg; int row_base;
  __device__ __forceinline__ void operator()(const Acc& acc, const Unit& u, int wr, int wc, int fr, int fq) const {
    const int row0 = row_base + u.pm * BM + wr * 64 + fr, col0 = (u.pn & 3) * BM + wc * 32 + 4 * fq;
#pragma unroll
    for (int ai = 0; ai < 2; ++ai)
#pragma unroll
      for (int m = 0; m < 4; ++m) { const int lr = row0 + ai * HALF + m * 16; const int tok = rowl[lr];
        if (tok >= 0) { const float gt = rowg[lr]; float* rp = X + (size_t)tok * 1024 + col0;
#pragma unroll
          for (int bj = 0; bj < 2; ++bj)
#pragma unroll
            for (int n = 0; n < 2; ++n) { f32x4* q = (f32x4*)(rp + bj * HALF + n * 16); *q = *q + acc[ai][bj][m][n] * gt; } } __builtin_amdgcn_sched_barrier(0); }
  }
};
struct MoeDownOrder {
  int first, ntile, G, c; const LAS int* ts;
  __device__ bool next(int i, Unit& u) const {
    const long L = (long)i * G + c; if (L >= (long)ntile * 4) return false;
    const int l = (int)L, pm = l >> 2, pn = l & 3; int g = 0;
#pragma unroll
    for (int k = 1; k < 16; ++k) g += ((first + pm) >= ts[k]) ? 1 : 0;
    u.pm = pm; u.pn = (g & 7) * 4 + pn; return true;
  }
};

__device__ __forceinline__ void ln_row(const float* y, const float* g, const float* b, int lane, f32x4 (&o)[4]) {
  f32x4 v[4]; float s = 0.f;
#pragma unroll
  for (int k = 0; k < 4; ++k) { v[k] = *(const f32x4*)(y + k * 256 + lane * 4); s += v[k][0] + v[k][1] + v[k][2] + v[k][3]; }
  const float mean = wave_sum(s) * (1.f / 1024.f); float q = 0.f;
#pragma unroll
  for (int k = 0; k < 4; ++k) { v[k] = v[k] - mean; q += v[k][0] * v[k][0] + v[k][1] * v[k][1] + v[k][2] * v[k][2] + v[k][3] * v[k][3]; }
  const float rstd = rsqrtf(wave_sum(q) * (1.f / 1024.f) + 1e-5f);
#pragma unroll
  for (int k = 0; k < 4; ++k) { const f32x4 gg = *(const f32x4*)(g + k * 256 + lane * 4), bb = *(const f32x4*)(b + k * 256 + lane * 4); o[k] = v[k] * rstd * gg + bb; }
}

__device__ void attn_phase(const bf16_t* QK, const bf16_t* VT, const float* rpb, bf16_t* O) {
  const int tid = tid_(), lane = tid & 63, qi = lane & 15, g = lane >> 4;
  const int nw = gridDim.x * 8, w0 = blockIdx.x * 8 + (tid >> 6);
  for (int u = w0; u < 768 * 4 * 32; u += nw) {
    const int h = u & 31, c = (u >> 5) & 3, R = u >> 7;
    int seq_row0, rows; if (R < 256) { seq_row0 = R & ~127; rows = 128; } else { seq_row0 = 256 + ((R - 256) & ~63); rows = 64; }
    const int r = R - seq_row0; int rs = r - 4; rs = rs < 0 ? 0 : rs; rs = rs > rows - 8 ? rows - 8 : rs;
    const int blk = (c == 0) ? 0 : (c == 1) ? 8 : (c == 2) ? 24 : 32;
    const int qcol = 16 * c + qi; int qstart = qcol - 8; qstart = qstart < 0 ? 0 : qstart; qstart = qstart > 48 ? 48 : qstart;
    const bf16x8 qf = *(const bf16x8*)(QK + (size_t)(R * 64 + qcol) * 2048 + h * 32 + g * 8);
    f32x4 s[8][2];
    const int krho = ((qi >> 2) * 8) + (qi & 3);
#pragma unroll
    for (int i = 0; i < 8; ++i)
#pragma unroll
      for (int hh = 0; hh < 2; ++hh) {
        const size_t tok = (size_t)(seq_row0 + rs + i) * 64 + blk + krho + hh * 4;
        const bf16x8 kf = *(const bf16x8*)(QK + tok * 2048 + 1024 + h * 32 + g * 8);
        s[i][hh] = __builtin_amdgcn_mfma_f32_16x16x32_bf16(kf, qf, (f32x4){0.f, 0.f, 0.f, 0.f}, 0, 0, 0);
      }
    float mx = -3.0e38f;
#pragma unroll
    for (int i = 0; i < 8; ++i) { const float* bp = rpb + (h * 15 + (rs + i - r + 7)) * 31;
#pragma unroll
      for (int hh = 0; hh < 2; ++hh)
#pragma unroll
        for (int j = 0; j < 4; ++j) { const int kcol = blk + g * 8 + hh * 4 + j; const bool valid = (kcol >= qstart) && (kcol < qstart + 16);
          int dc = kcol - qcol + 15; dc = dc < 0 ? 0 : dc; dc = dc > 30 ? 30 : dc;
          const float v = valid ? s[i][hh][j] + bp[dc] : -3.0e38f; s[i][hh][j] = v; mx = fmaxf(mx, v); } }
    mx = fmaxf(mx, __shfl_xor(mx, 16)); mx = fmaxf(mx, __shfl_xor(mx, 32));
    float sum = 0.f;
#pragma unroll
    for (int i = 0; i < 8; ++i)
#pragma unroll
      for (int hh = 0; hh < 2; ++hh)
#pragma unroll
        for (int j = 0; j < 4; ++j) { const float e = (s[i][hh][j] > -1.0e38f) ? __expf(s[i][hh][j] - mx) : 0.f; s[i][hh][j] = e; sum += e; }
    sum += __shfl_xor(sum, 16); sum += __shfl_xor(sum, 32);
    f32x4 o0 = {0.f, 0.f, 0.f, 0.f}, o1 = {0.f, 0.f, 0.f, 0.f};
#pragma unroll
    for (int i = 0; i < 8; ++i) {
      const u32x4 pu = pack8(s[i][0], s[i][1]); const bf16x8 pf = __builtin_bit_cast(bf16x8, pu);
      const bf16_t* vb = VT + (size_t)(seq_row0 + rs + i) * 65536 + (size_t)(h * 32 + qi) * 64 + blk + g * 8;
      const bf16x8 v0 = *(const bf16x8*)vb, v1 = *(const bf16x8*)(vb + 16 * 64);
      o0 = __builtin_amdgcn_mfma_f32_16x16x32_bf16(v0, pf, o0, 0, 0, 0);
      o1 = __builtin_amdgcn_mfma_f32_16x16x32_bf16(v1, pf, o1, 0, 0, 0);
    }
    const float inv = 1.f / sum;
    bf16_t* op = O + (size_t)(R * 64 + qcol) * 1024 + h * 32 + g * 4;
    u32x2 a, b; a[0] = cvt_pk_bf16(o0[0] * inv, o0[1] * inv); a[1] = cvt_pk_bf16(o0[2] * inv, o0[3] * inv); b[0] = cvt_pk_bf16(o1[0] * inv, o1[1] * inv); b[1] = cvt_pk_bf16(o1[2] * inv, o1[3] * inv);
    *(u32x2*)op = a; *(u32x2*)(op + 16) = b;
  }
}

constexpr int SC_WD = 0, SC_AA = 2048, SC_KD = 4096, SC_BB = 6144, SC_NA = 8192, SC_RR = 10240, SC_VV = 12288, SC_YO = 14336;
__device__ __forceinline__ void scan_chain(unsigned char* ws, LAS float* L, int chain) {
  const int tid = tid_(), wid = tid >> 6, lane = tid & 63;
  int h, z, Lq; size_t tok0;
  if (chain < 64) { h = (chain & 31) >> 1; z = chain & 1; Lq = 8192; tok0 = (size_t)(chain >> 5) * 8192; }
  else { const int c2 = chain - 64; h = (c2 & 31) >> 1; z = c2 & 1; Lq = 4096; tok0 = 16384 + (size_t)(c2 >> 5) * 4096; }
  const bf16_t* RKV = (const bf16_t*)(ws + OFF_RKV); const bf16_t* LBWA = (const bf16_t*)(ws + OFF_LBWA); const bf16_t* W2T = (const bf16_t*)(ws + OFF_W2T);
  bf16_t* Y = (bf16_t*)(ws + (z ? OFF_YB : OFF_YF)); float* bonus = (float*)(ws + OFF_BONUS);
  const int tk = tid >> 4, c4 = (tid & 15) * 4;
  const int vrow = wid * 8 + (lane >> 3), ko = lane & 7;
  const int mat = wid >> 1, ntile = wid & 1;
  const int ch0 = h * 64 + c4;
  const f32x4 kk4 = *(const f32x4*)(INP(18) + ch0), ka4 = *(const f32x4*)(INP(19) + ch0), rk4 = *(const f32x4*)(INP(20) + ch0);
  bf16x8 bfrag[4]; float bias0 = 0.f;
  if (wid < 4) { const int chb = h * 64 + ntile * 32 + (lane & 31);
#pragma unroll
    for (int ks = 0; ks < 4; ++ks) bfrag[ks] = *(const bf16x8*)(W2T + ((size_t)(mat * 2 + z) * 1024 + chb) * 64 + ks * 16 + (lane >> 5) * 8);
    bias0 = (mat ? INP(13) : INP(10))[z * 1024 + chb]; }
  const int nchunk = Lq / 32;
  u32x2 rawr, rawk, rawv; bf16x8 afrag[4];
  { const size_t tb = tok0 + (size_t)(z ? nchunk - 1 : 0) * 32; const bf16_t* rp = RKV + (tb + tk) * 3072 + ch0;
    rawr = *(const u32x2*)rp; rawk = *(const u32x2*)(rp + 1024); rawv = *(const u32x2*)(rp + 2048);
    if (wid < 4) {
#pragma unroll
      for (int ks = 0; ks < 4; ++ks) afrag[ks] = *(const bf16x8*)(LBWA + (tb + (lane & 31)) * 256 + mat * 128 + z * 64 + ks * 16 + (lane >> 5) * 8); } }
  float S[8];
#pragma unroll
  for (int j = 0; j < 8; ++j) S[j] = 0.f;
  for (int ci = 0; ci < nchunk; ++ci) {
    const size_t tb = tok0 + (size_t)(z ? nchunk - 1 - ci : ci) * 32;
    if (wid < 4) {
      f32x16 acc;
#pragma unroll
      for (int j = 0; j < 16; ++j) acc[j] = 0.f;
#pragma unroll
      for (int ks = 0; ks < 4; ++ks) acc = __builtin_amdgcn_mfma_f32_32x32x16_bf16(afrag[ks], bfrag[ks], acc, 0, 0, 0);
      LAS float* dst = L + (mat ? SC_AA : SC_WD) + ntile * 32 + (lane & 31);
#pragma unroll
      for (int rg = 0; rg < 16; ++rg) { const int row = (rg & 3) + 8 * (rg >> 2) + 4 * (lane >> 5); const float sg = sigmoidf_(acc[rg] + bias0);
        dst[row * 64] = mat ? sg : __expf(-0.60653065971263342f * sg); }
    }
    __syncthreads();
    {
      const float r4[4] = {bflo(rawr[0]), bfhi(rawr[0]), bflo(rawr[1]), bfhi(rawr[1])};
      const float k4[4] = {bflo(rawk[0]), bfhi(rawk[0]), bflo(rawk[1]), bfhi(rawk[1])};
      f32x4 kx; float ss = 0.f;
#pragma unroll
      for (int j = 0; j < 4; ++j) { kx[j] = k4[j] * kk4[j]; ss += kx[j] * kx[j]; }
      ss = red16(ss); const float inv = __builtin_amdgcn_rsqf(fmaxf(ss, 1e-24f));
      const f32x4 a4 = *(const LAS f32x4*)(L + SC_AA + tk * 64 + c4);
      f32x4 kd, bb, na, rr, vv; float bon = 0.f;
#pragma unroll
      for (int j = 0; j < 4; ++j) { const float kn = kx[j] * inv; kd[j] = k4[j] * (1.f + (a4[j] - 1.f) * ka4[j]); bb[j] = kn * a4[j]; na[j] = -kn; rr[j] = r4[j]; bon += r4[j] * kd[j] * rk4[j]; }
      vv[0] = bflo(rawv[0]); vv[1] = bfhi(rawv[0]); vv[2] = bflo(rawv[1]); vv[3] = bfhi(rawv[1]);
      *(LAS f32x4*)(L + SC_KD + tk * 64 + c4) = kd; *(LAS f32x4*)(L + SC_BB + tk * 64 + c4) = bb; *(LAS f32x4*)(L + SC_NA + tk * 64 + c4) = na;
      *(LAS f32x4*)(L + SC_RR + tk * 64 + c4) = rr; *(LAS f32x4*)(L + SC_VV + tk * 64 + c4) = vv;
      bon = red16(bon); if ((tid & 15) == 0) bonus[((tb + tk) * 16 + h) * 2 + z] = bon;
    }
    __syncthreads();
    if (ci + 1 < nchunk) { const size_t tn = tok0 + (size_t)(z ? nchunk - 2 - ci : ci + 1) * 32; const bf16_t* rp = RKV + (tn + tk) * 3072 + ch0;
      rawr = *(const u32x2*)rp; rawk = *(const u32x2*)(rp + 1024); rawv = *(const u32x2*)(rp + 2048);
      if (wid < 4) {
#pragma unroll
        for (int ks = 0; ks < 4; ++ks) afrag[ks] = *(const bf16x8*)(LBWA + (tn + (lane & 31)) * 256 + mat * 128 + z * 64 + ks * 16 + (lane >> 5) * 8); } }
    {
      typedef float f32x2 __attribute__((ext_vector_type(2)));
      const LAS float* base0 = L + ko * 8; const int sstep = z ? -64 : 64; const LAS float* bp = base0 + (z ? 31 * 64 : 0);
      const LAS float* vp = L + SC_VV + vrow + (z ? 31 * 64 : 0); LAS float* yp = L + SC_YO + vrow + (z ? 31 * 64 : 0);
      f32x4 cna0 = *(const LAS f32x4*)(bp + SC_NA), cna1 = *(const LAS f32x4*)(bp + SC_NA + 4), cw0 = *(const LAS f32x4*)(bp + SC_WD), cw1 = *(const LAS f32x4*)(bp + SC_WD + 4);
      f32x4 cb0 = *(const LAS f32x4*)(bp + SC_BB), cb1 = *(const LAS f32x4*)(bp + SC_BB + 4), cd0 = *(const LAS f32x4*)(bp + SC_KD), cd1 = *(const LAS f32x4*)(bp + SC_KD + 4);
      f32x4 cr0 = *(const LAS f32x4*)(bp + SC_RR), cr1 = *(const LAS f32x4*)(bp + SC_RR + 4); float cvv = *vp;
      f32x2 S0 = {S[0], S[1]}, S1 = {S[2], S[3]}, S2 = {S[4], S[5]}, S3 = {S[6], S[7]};
#define LO2(v) __builtin_shufflevector(v, v, 0, 1)
#define HI2(v) __builtin_shufflevector(v, v, 2, 3)
#pragma unroll 4
      for (int si = 0; si < 32; ++si) {
        f32x4 nna0, nna1, nw0, nw1, nb0, nb1, nd0, nd1, nr0, nr1; float nvv;
        const LAS float* bn = bp + ((si < 31) ? sstep : 0); const LAS float* vn = vp + ((si < 31) ? sstep : 0);
        nna0 = *(const LAS f32x4*)(bn + SC_NA); nna1 = *(const LAS f32x4*)(bn + SC_NA + 4); nw0 = *(const LAS f32x4*)(bn + SC_WD); nw1 = *(const LAS f32x4*)(bn + SC_WD + 4);
        nb0 = *(const LAS f32x4*)(bn + SC_BB); nb1 = *(const LAS f32x4*)(bn + SC_BB + 4); nd0 = *(const LAS f32x4*)(bn + SC_KD); nd1 = *(const LAS f32x4*)(bn + SC_KD + 4);
        nr0 = *(const LAS f32x4*)(bn + SC_RR); nr1 = *(const LAS f32x4*)(bn + SC_RR + 4); nvv = *vn;
        f32x2 p1 = S0 * LO2(cna0), p2 = S1 * HI2(cna0); p1 = S2 * LO2(cna1) + p1; p2 = S3 * HI2(cna1) + p2; p1 = p1 + p2;
        float sa = red8(p1[0] + p1[1]);
        const f32x2 sa2 = {sa, sa}, vv2 = {cvv, cvv};
        S0 = S0 * LO2(cw0) + (sa2 * LO2(cb0) + vv2 * LO2(cd0)); S1 = S1 * HI2(cw0) + (sa2 * HI2(cb0) + vv2 * HI2(cd0));
        S2 = S2 * LO2(cw1) + (sa2 * LO2(cb1) + vv2 * LO2(cd1)); S3 = S3 * HI2(cw1) + (sa2 * HI2(cb1) + vv2 * HI2(cd1));
        f32x2 q1 = S0 * LO2(cr0), q2 = S1 * HI2(cr0); q1 = S2 * LO2(cr1) + q1; q2 = S3 * HI2(cr1) + q2; q1 = q1 + q2;
        const float y = red8(q1[0] + q1[1]);
        if (ko == 0) *yp = y;
        cna0 = nna0; cna1 = nna1; cw0 = nw0; cw1 = nw1; cb0 = nb0; cb1 = nb1; cd0 = nd0; cd1 = nd1; cr0 = nr0; cr1 = nr1; cvv = nvv;
        bp = bn; vp = vn; yp += sstep;
      }
#undef LO2
#undef HI2
      S[0] = S0[0]; S[1] = S0[1]; S[2] = S1[0]; S[3] = S1[1]; S[4] = S2[0]; S[5] = S2[1]; S[6] = S3[0]; S[7] = S3[1];
    }
    __syncthreads();
    { const f32x4 yv = *(const LAS f32x4*)(L + SC_YO + tk * 64 + c4); u32x2 o; o[0] = cvt_pk_bf16(yv[0], yv[1]); o[1] = cvt_pk_bf16(yv[2], yv[3]);
      *(u32x2*)(Y + (tb + tk) * 1024 + ch0) = o; }
  }
  __syncthreads();
}

__global__ void __launch_bounds__(512, 2) mega(Params p) {
  cg::grid_group grid = cg::this_grid();
  LAS unsigned char* lds = (LAS unsigned char*)shm;
  LAS int* TS = (LAS int*)(lds + LDS_TS);
  unsigned char* ws = p.ws;
  { const unsigned* ka = (const unsigned*)__builtin_amdgcn_kernarg_segment_ptr(); if (threadIdx.x < 66) ((LAS unsigned*)(lds + LDS_TAB))[threadIdx.x] = ka[threadIdx.x]; }
  __syncthreads();
  const int G = gridDim.x, nw = G * 8;
  const long ngt = (long)G * 512;
#define PH_VARS const int tid = tid_(), lane = tid & 63, wid = tid >> 6, gw = blockIdx.x * 8 + wid; const long gt = (long)blockIdx.x * 512 + tid; (void)lane; (void)gw; (void)gt;
  float* X = p.X;

  { PH_VARS
  {
    int rot = 0; float* tile = (float*)shm;
    const float* wqkv = INP(2);
    rot = cvt_run(mkjob(wqkv, 3072, 1024, 1024, (bf16_t*)(ws + OFF_WQKT), 1024, 0, 0, nullptr, 0.17677669529663687f, 0), tile, rot);
    rot = cvt_run(mkjob(wqkv + 1024, 3072, 1024, 1024, (bf16_t*)(ws + OFF_WQKT), 1024, 1024, 0, nullptr, 1.f, 0), tile, rot);
    rot = cvt_run(mkjob(wqkv + 2048, 3072, 1024, 1024, (bf16_t*)(ws + OFF_WVT), 1024, 0, 0, nullptr, 1.f, 0), tile, rot);
    rot = cvt_run(mkjob(INP(4), 1024, 1024, 1024, (bf16_t*)(ws + OFF_WOT), 1024, 0, 0, nullptr, 1.f, 0), tile, rot);
    rot = cvt_run(mkjob(INP(5), 2816, 1024, 2816, (bf16_t*)(ws + OFF_WGUT), 1024, 0, 0, nullptr, 1.f, 1), tile, rot);
    rot = cvt_run(mkjob(INP(6), 2816, 1024, 2816, (bf16_t*)(ws + OFF_WGUT), 1024, 128, 0, nullptr, 1.f, 1), tile, rot);
    rot = cvt_run(mkjob(INP(7), 1024, 2816, 1024, (bf16_t*)(ws + OFF_WDT), 2816, 0, 0, nullptr, 1.f, 0), tile, rot);
    bf16_t* wrt = (bf16_t*)(ws + OFF_WRT); const float* mu = INP(8);
    for (int half = 0; half < 2; ++half) {
      const int c0 = half * 1024;
      rot = cvt_run(mkjob(INP(9), 1024, 1024, 1024, wrt, 2048, 0, c0, half ? mu + 0 * 1024 : nullptr, 1.f, 0), tile, rot);
      rot = cvt_run(mkjob(INP(9) + 1048576, 1024, 1024, 1024, wrt, 2048, 1024, c0, half ? mu + 2 * 1024 : nullptr, 1.f, 0), tile, rot);
      rot = cvt_run(mkjob(INP(9) + 2097152, 1024, 1024, 1024, wrt, 2048, 2048, c0, half ? mu + 3 * 1024 : nullptr, 1.f, 0), tile, rot);
      rot = cvt_run(mkjob(INP(11), 64, 1024, 64, wrt, 2048, 3072, c0, half ? mu + 1 * 1024 : nullptr, 1.f, 0), tile, rot);
      rot = cvt_run(mkjob(INP(11) + 65536, 64, 1024, 64, wrt, 2048, 3136, c0, half ? mu + 1 * 1024 : nullptr, 1.f, 0), tile, rot);
      rot = cvt_run(mkjob(INP(14), 64, 1024, 64, wrt, 2048, 3200, c0, half ? mu + 4 * 1024 : nullptr, 1.f, 0), tile, rot);
      rot = cvt_run(mkjob(INP(14) + 65536, 64, 1024, 64, wrt, 2048, 3264, c0, half ? mu + 4 * 1024 : nullptr, 1.f, 0), tile, rot);
      rot = cvt_run(mkjob(INP(16), 160, 1024, 160, wrt, 2048, 3328, c0, half ? mu + 5 * 1024 : nullptr, 1.f, 0), tile, rot);
    }
    rot = cvt_run(mkjob(nullptr, 0, 2048, 96, wrt, 2048, 3488, 0, nullptr, 1.f, 0), tile, rot);
    bf16_t* w2t = (bf16_t*)(ws + OFF_W2T);
    rot = cvt_run(mkjob(INP(12), 1024, 64, 1024, w2t, 64, 0, 0, nullptr, 1.f, 0), tile, rot);
    rot = cvt_run(mkjob(INP(12) + 65536, 1024, 64, 1024, w2t, 64, 1024, 0, nullptr, 1.f, 0), tile, rot);
    rot = cvt_run(mkjob(INP(15), 1024, 64, 1024, w2t, 64, 2048, 0, nullptr, 1.f, 0), tile, rot);
    rot = cvt_run(mkjob(INP(15) + 65536, 1024, 64, 1024, w2t, 64, 3072, 0, nullptr, 1.f, 0), tile, rot);
    rot = cvt_run(mkjob(INP(17), 1024, 160, 1024, (bf16_t*)(ws + OFF_G2T), 256, 0, 0, nullptr, 1.f, 0), tile, rot);
    rot = cvt_run(mkjob(nullptr, 0, 96, 1024, (bf16_t*)(ws + OFF_G2T), 256, 0, 160, nullptr, 1.f, 0), tile, rot);
    rot = cvt_run(mkjob(INP(23), 1024, 1024, 1024, (bf16_t*)(ws + OFF_RWOT), 1024, 0, 0, nullptr, 1.f, 0), tile, rot);
    bf16_t* xb = (bf16_t*)(ws + OFF_XB);
    for (long i = gt; i < (long)T * 256; i += ngt) {
      const f32x4 v = (i < 16384L * 256) ? *(const f32x4*)(INP(0) + i * 4) : *(const f32x4*)(INP(1) + (i - 16384L * 256) * 4);
      *(f32x4*)(X + i * 4) = v; u32x2 o; o[0] = cvt_pk_bf16(v[0], v[1]); o[1] = cvt_pk_bf16(v[2], v[3]); *(u32x2*)(xb + i * 4) = o; }
    int* cnt = (int*)(ws + OFF_CNT); int* rowl = (int*)(ws + OFF_ROWL);
    if (gt < 16) cnt[gt] = 0;
    if (blockIdx.x == 0) for (int i = tid; i < XCD_BAR_WORDS; i += 512) ((unsigned*)(ws + OFF_BAR))[i] = 0u;
    if (tid < 2) ((LAS unsigned*)(lds + LDS_TS + 80))[tid] = 0u;
    for (long i = gt; i < 102400; i += ngt) rowl[i] = -1;
  }
  }
  grid.sync();
  __syncthreads();
  const XcdBarrier xb = xcd_barrier_post((unsigned*)(ws + OFF_BAR), (volatile LAS unsigned*)(lds + LDS_TS + 80));
  { PH_VARS
  { Gemm g{(const bf16_t*)(ws + OFF_XB), (const bf16_t*)(ws + OFF_WQKT), 1024}; StaticOrder S; S.init(T, 2048); EpiStore E{(bf16_t*)(ws + OFF_QK), 2048}; gemm_phase(lds, g, S, E); }
  { Gemm g{(const bf16_t*)(ws + OFF_WVT), (const bf16_t*)(ws + OFF_XB), 1024}; StaticOrder S; S.init(1024, T); EpiVT E{(bf16_t*)(ws + OFF_VT)}; gemm_phase(lds, g, S, E); }
  }
  xcd_barrier(xb);
  { PH_VARS
  attn_phase((const bf16_t*)(ws + OFF_QK), (const bf16_t*)(ws + OFF_VT), INP(3), (bf16_t*)(ws + OFF_O));
  }
  xcd_barrier(xb);
  { PH_VARS
  { Gemm g{(const bf16_t*)(ws + OFF_O), (const bf16_t*)(ws + OFF_WOT), 1024}; StaticOrder S; S.init(T, 1024); EpiResid E{X}; gemm_phase(lds, g, S, E); }
  }
  xcd_barrier(xb);
  { PH_VARS
  { bf16_t* xb = (bf16_t*)(ws + OFF_XB);
    for (int row = gw; row < T; row += nw) { f32x4 o[4]; ln_row(X + (size_t)row * 1024, INP(29), INP(30), lane, o);
#pragma unroll
      for (int k = 0; k < 4; ++k) { *(f32x4*)(X + (size_t)row * 1024 + k * 256 + lane * 4) = o[k]; u32x2 q; q[0] = cvt_pk_bf16(o[k][0], o[k][1]); q[1] = cvt_pk_bf16(o[k][2], o[k][3]); *(u32x2*)(xb + (size_t)row * 1024 + k * 256 + lane * 4) = q; } } }
  }
  xcd_barrier(xb);
  { PH_VARS
  { Gemm g{(const bf16_t*)(ws + OFF_XB), (const bf16_t*)(ws + OFF_WGUT), 1024}; StaticOrder S; S.init(T, 5632); EpiSwiglu E{(bf16_t*)(ws + OFF_H), 2816, 1 << 20, 0}; gemm_phase(lds, g, S, E); }
  }
  xcd_barrier(xb);
  { Gemm g{(const bf16_t*)(ws + OFF_H), (const bf16_t*)(ws + OFF_WDT), 2816}; StaticOrder S; S.init(T, 1024); EpiResid E{X}; gemm_phase(lds, g, S, E); }
  xcd_barrier(xb);
  { PH_VARS
  for (int row = gw; row < T; row += nw) { f32x4 o[4]; ln_row(X + (size_t)row * 1024, INP(31), INP(32), lane, o);
#pragma unroll
    for (int k = 0; k < 4; ++k) *(f32x4*)(X + (size_t)row * 1024 + k * 256 + lane * 4) = o[k]; }
  }
  xcd_barrier(xb);
  { PH_VARS
  { bf16_t* xb2 = (bf16_t*)(ws + OFF_XB2);
    for (int row = gw; row < T; row += nw) {
      const int s0 = row < 16384 ? (row & ~8191) : 16384 + ((row - 16384) & ~4095), len = row < 16384 ? 8192 : 4096;
      const bool hm = row > s0, hp = row < s0 + len - 1;
#pragma unroll
      for (int k = 0; k < 4; ++k) { const size_t off = (size_t)row * 1024 + k * 256 + lane * 4; const f32x4 x = *(const f32x4*)(X + off);
        const f32x4 xm = hm ? *(const f32x4*)(X + off - 1024) : (f32x4){0.f, 0.f, 0.f, 0.f}, xp = hp ? *(const f32x4*)(X + off + 1024) : (f32x4){0.f, 0.f, 0.f, 0.f};
        const f32x4 xx = (xm + xp) * 0.5f - x; u32x2 a, b; a[0] = cvt_pk_bf16(x[0], x[1]); a[1] = cvt_pk_bf16(x[2], x[3]); b[0] = cvt_pk_bf16(xx[0], xx[1]); b[1] = cvt_pk_bf16(xx[2], xx[3]);
        bf16_t* dp = xb2 + (size_t)row * 2048 + k * 256 + lane * 4; *(u32x2*)dp = a; *(u32x2*)(dp + 1024) = b; } } }
  }
  xcd_barrier(xb);
  { PH_VARS
  { Gemm g{(const bf16_t*)(ws + OFF_XB2), (const bf16_t*)(ws + OFF_WRT), 2048}; StaticOrder S; S.init(T, 3584); EpiRwkv E{(bf16_t*)(ws + OFF_RKV), (bf16_t*)(ws + OFF_LBWA), (bf16_t*)(ws + OFF_LBG)}; gemm_phase(lds, g, S, E); }
  }
  xcd_barrier(xb);
  { PH_VARS
  { LAS float* L = (LAS float*)lds; const int b = blockIdx.x;
    const int first = (G > 64 && b >= 64) ? 64 + (b - 64) : b, stride = (G > 64) ? (b < 64 ? 1000 : G - 64) : G;
    for (int ch = first; ch < 320; ch += stride) scan_chain(ws, L, ch); }
  }
  xcd_barrier(xb);
  { PH_VARS
  { bf16_t* yf = (bf16_t*)(ws + OFF_YF); const bf16_t* yb = (const bf16_t*)(ws + OFF_YB); const bf16_t* rkv = (const bf16_t*)(ws + OFF_RKV); const float* bonus = (const float*)(ws + OFF_BONUS);
    for (int row = gw; row < T; row += nw) {
      const size_t off = (size_t)row * 1024 + lane * 16; const u32x4 a0 = *(const u32x4*)(yf + off), a1 = *(const u32x4*)(yf + off + 8), b0 = *(const u32x4*)(yb + off), b1 = *(const u32x4*)(yb + off + 8);
      const u32x4 v0 = *(const u32x4*)(rkv + (size_t)row * 3072 + 2048 + lane * 16), v1 = *(const u32x4*)(rkv + (size_t)row * 3072 + 2048 + lane * 16 + 8);
      float y[16], vv[16]; float s = 0.f;
#pragma unroll
      for (int j = 0; j < 4; ++j) { y[2 * j] = bflo(a0[j]) + bflo(b0[j]); y[2 * j + 1] = bfhi(a0[j]) + bfhi(b0[j]); y[8 + 2 * j] = bflo(a1[j]) + bflo(b1[j]); y[8 + 2 * j + 1] = bfhi(a1[j]) + bfhi(b1[j]);
        vv[2 * j] = bflo(v0[j]); vv[2 * j + 1] = bfhi(v0[j]); vv[8 + 2 * j] = bflo(v1[j]); vv[8 + 2 * j + 1] = bfhi(v1[j]); }
#pragma unroll
      for (int j = 0; j < 16; ++j) s += y[j];
      const float mean = red4(s) * (1.f / 64.f); float q = 0.f;
#pragma unroll
      for (int j = 0; j < 16; ++j) { y[j] -= mean; q += y[j] * y[j]; }
      const float rstd = rsqrtf(red4(q) * (1.f / 64.f) + 64e-5f);
      const float* bp = bonus + ((size_t)row * 16 + (lane >> 2)) * 2; const float bsum = bp[0] + bp[1];
      u32x4 o0, o1;
#pragma unroll
      for (int j = 0; j < 4; ++j) { const f32x4 gg = *(const f32x4*)(INP(21) + lane * 16 + j * 4), bb = *(const f32x4*)(INP(22) + lane * 16 + j * 4); float t[4];
#pragma unroll
        for (int e = 0; e < 4; ++e) t[e] = y[j * 4 + e] * rstd * gg[e] + bb[e] + bsum * vv[j * 4 + e];
        const unsigned lo = cvt_pk_bf16(t[0], t[1]), hi = cvt_pk_bf16(t[2], t[3]);
        if (j < 2) { o0[2 * j] = lo; o0[2 * j + 1] = hi; } else { o1[2 * (j - 2)] = lo; o1[2 * (j - 2) + 1] = hi; } }
      *(u32x4*)(yf + off) = o0; *(u32x4*)(yf + off + 8) = o1; } }
  }
  xcd_barrier(xb);
  { PH_VARS
  { Gemm g{(const bf16_t*)(ws + OFF_LBG), (const bf16_t*)(ws + OFF_G2T), 256}; StaticOrder S; S.init(T, 1024); EpiMulPre E{(bf16_t*)(ws + OFF_YF)}; gemm_phase(lds, g, S, E); }
  }
  xcd_barrier(xb);
  { PH_VARS
  { Gemm g{(const bf16_t*)(ws + OFF_YF), (const bf16_t*)(ws + OFF_RWOT), 1024}; StaticOrder S; S.init(T, 1024); EpiResid E{X}; gemm_phase(lds, g, S, E); }
  }
  xcd_barrier(xb);
  { PH_VARS
  { bf16_t* xb = (bf16_t*)(ws + OFF_XBM); int* cnt = (int*)(ws + OFF_CNT); int* tokE = (int*)(ws + OFF_TOKE); float* tokG = (float*)(ws + OFF_TOKG); int* tokP = (int*)(ws + OFF_TOKP);
    const float* wr = INP(24); const float* br = INP(25);
    for (int row = gw; row < T; row += nw) { f32x4 o[4]; ln_row(X + (size_t)row * 1024, INP(29) + 1024, INP(30) + 1024, lane, o);
      float lg[8];
#pragma unroll
      for (int e = 0; e < 8; ++e) lg[e] = 0.f;
#pragma unroll
      for (int k = 0; k < 4; ++k) {
#pragma unroll
        for (int j = 0; j < 4; ++j) { const float* wp = wr + (size_t)(k * 256 + lane * 4 + j) * 8; const f32x4 wa = *(const f32x4*)wp, wb = *(const f32x4*)(wp + 4); const float xv = o[k][j];
          lg[0] += xv * wa[0]; lg[1] += xv * wa[1]; lg[2] += xv * wa[2]; lg[3] += xv * wa[3]; lg[4] += xv * wb[0]; lg[5] += xv * wb[1]; lg[6] += xv * wb[2]; lg[7] += xv * wb[3]; }
        *(f32x4*)(X + (size_t)row * 1024 + k * 256 + lane * 4) = o[k] * ALPHA; u32x2 q; q[0] = cvt_pk_bf16(o[k][0], o[k][1]); q[1] = cvt_pk_bf16(o[k][2], o[k][3]); *(u32x2*)(xb + (size_t)row * 1024 + k * 256 + lane * 4) = q; }
#pragma unroll
      for (int e = 0; e < 8; ++e) lg[e] = wave_sum(lg[e]) + br[e];
      int e0 = 0; float v0 = lg[0];
#pragma unroll
      for (int e = 1; e < 8; ++e) if (lg[e] > v0) { v0 = lg[e]; e0 = e; }
      int e1 = -1; float v1 = -3.0e38f;
#pragma unroll
      for (int e = 0; e < 8; ++e) if (e != e0 && lg[e] > v1) { v1 = lg[e]; e1 = e; }
      if (lane == 0) { const float ex = __expf(v1 - v0), g0 = 1.f / (1.f + ex), g1 = ex * g0;
        const int p0 = atomicAdd(cnt + e0, 1), p1 = atomicAdd(cnt + 8 + e1, 1);
        tokE[row * 2] = e0; tokE[row * 2 + 1] = e1; tokG[row * 2] = g0; tokG[row * 2 + 1] = g1; tokP[row * 2] = p0; tokP[row * 2 + 1] = p1; } }
    __syncthreads();
    int rot = 0; float* tile = (float*)shm;
    for (int e = 0; e < 8; ++e) {
      rot = cvt_run(mkjob(INP(26) + (size_t)e * 1024 * 3584, 3584, 1024, 3584, (bf16_t*)(ws + OFF_WMGU) + (size_t)e * 7168 * 1024, 1024, 0, 0, nullptr, 1.f, 1), tile, rot);
      rot = cvt_run(mkjob(INP(27) + (size_t)e * 1024 * 3584, 3584, 1024, 3584, (bf16_t*)(ws + OFF_WMGU) + (size_t)e * 7168 * 1024, 1024, 128, 0, nullptr, 1.f, 1), tile, rot);
      rot = cvt_run(mkjob(INP(28) + (size_t)e * 3584 * 1024, 1024, 3584, 1024, (bf16_t*)(ws + OFF_WMD) + (size_t)e * 1024 * 3584, 3584, 0, 0, nullptr, 1.f, 0), tile, rot);
    }
  }
  }
  xcd_barrier(xb);
  { PH_VARS
  { const int* cnt = (const int*)(ws + OFF_CNT);
    __syncthreads();
    if (tid == 0) { int a = 0; for (int k = 0; k < 16; ++k) { TS[k] = a; a += (cnt[k] + 255) >> 8; } TS[16] = a; }
    __syncthreads();
    const int* tokE = (const int*)(ws + OFF_TOKE); const float* tokG = (const float*)(ws + OFF_TOKG); const int* tokP = (const int*)(ws + OFF_TOKP);
    int* rowl = (int*)(ws + OFF_ROWL); float* rowg = (float*)(ws + OFF_ROWG); const bf16_t* xb = (const bf16_t*)(ws + OFF_XBM); bf16_t* xs = (bf16_t*)(ws + OFF_XS);
    for (int pr = gw; pr < T * 2; pr += nw) { const int tok = pr >> 1, rk = pr & 1; const int e = tokE[pr]; const int row = TS[rk * 8 + e] * 256 + tokP[pr];
      if (lane == 0) { rowl[row] = tok; rowg[row] = tokG[pr]; }
      const u32x4* sp = (const u32x4*)(xb + (size_t)tok * 1024); u32x4* dp = (u32x4*)(xs + (size_t)row * 1024); dp[lane] = sp[lane]; dp[lane + 64] = sp[lane + 64]; }
  }
  }
  xcd_barrier(xb);
  { PH_VARS
  { const int ts8 = TS[8], ts16 = TS[16];
    for (int rk = 0; rk < 2; ++rk) { const int t0 = rk ? ts8 : 0, t1 = rk ? ts16 : ts8;
      for (int cs = t0; cs < t1; cs += MOE_CHUNK) { const int ntile = (t1 - cs) < MOE_CHUNK ? (t1 - cs) : MOE_CHUNK;
        { Gemm g{(const bf16_t*)(ws + OFF_XS), (const bf16_t*)(ws + OFF_WMGU), 1024}; MoeOrder<28> S{cs, ntile, G, (int)blockIdx.x, TS}; EpiSwiglu E{(bf16_t*)(ws + OFF_HID), 3584, 28, cs * 256}; gemm_phase(lds, g, S, E); }
        xcd_barrier(xb);
        { Gemm g{(const bf16_t*)(ws + OFF_HID), (const bf16_t*)(ws + OFF_WMD), 3584}; MoeDownOrder S{cs, ntile, G, (int)blockIdx.x, TS}; EpiMoeDown E{X, (const int*)(ws + OFF_ROWL), (const float*)(ws + OFF_ROWG), cs * 256}; gemm_phase(lds, g, S, E); }
        xcd_barrier(xb);
      } }
  }
  }
  { PH_VARS
  for (int row = gw; row < T; row += nw) { f32x4 o[4]; ln_row(X + (size_t)row * 1024, INP(31) + 1024, INP(32) + 1024, lane, o);
#pragma unroll
    for (int k = 0; k < 4; ++k) *(f32x4*)(X + (size_t)row * 1024 + k * 256 + lane * 4) = o[k]; }
  }
}

extern "C" void kernel_launch(void* const* d_in, const int* in_sizes, int n_in, void* d_out, int out_size, void* d_ws, size_t ws_size, hipStream_t stream) {
  static int grid_blocks = 0;
  if (!grid_blocks) {
    int dev = 0, cus = 0, per_cu = 0;
    (void)hipGetDevice(&dev);
    (void)hipDeviceGetAttribute(&cus, hipDeviceAttributeMultiprocessorCount, dev);
    (void)hipFuncSetAttribute((const void*)mega, hipFuncAttributeMaxDynamicSharedMemorySize, LDS_BYTES);
    (void)hipOccupancyMaxActiveBlocksPerMultiprocessor(&per_cu, mega, 512, LDS_BYTES);
    if (per_cu > 1) per_cu = 1;
    grid_blocks = cus * per_cu;
    if (ws_size < WS_NEED) fprintf(stderr, "workspace too small: %zu < %zu\n", ws_size, (size_t)WS_NEED);
  }
  Params p{};
  for (int i = 0; i < 33; ++i) p.in[i] = (const float*)d_in[i];
  p.X = (float*)d_out; p.ws = (unsigned char*)d_ws;
  void* args[] = {&p};
  hipError_t e = hipLaunchCooperativeKernel((void*)mega, dim3(grid_blocks), dim3(512), args, LDS_BYTES, stream);
  if (e != hipSuccess) fprintf(stderr, "cooperative launch failed: %s (grid %d)\n", hipGetErrorString(e), grid_blocks);
}
```

```cpp
#include <hip/hip_runtime.h>
#include <hip/hip_cooperative_groups.h>
#include <cstdio>
namespace cg = cooperative_groups;

#define LAS __attribute__((address_space(3)))
typedef unsigned short bf16_t;
typedef short bf16x8 __attribute__((ext_vector_type(8)));
typedef float f32x4 __attribute__((ext_vector_type(4)));
typedef float f32x16 __attribute__((ext_vector_type(16)));
typedef unsigned u32x4 __attribute__((ext_vector_type(4)));
typedef unsigned u32x2 __attribute__((ext_vector_type(2)));

constexpr int T = 49152, D = 1024;
constexpr float ALPHA = 1.41421356237309515f;
constexpr size_t SZ = (size_t)T * 1024 * 2;
constexpr size_t OFF_WRT = 0;
constexpr size_t OFF_W2T = OFF_WRT + 14680064;
constexpr size_t OFF_G2T = OFF_W2T + 524288;
constexpr size_t OFF_RWOT = OFF_G2T + 524288;
constexpr size_t OFF_CNT = OFF_RWOT + 2097152;
constexpr size_t OFF_TOKE = OFF_CNT + 256;
constexpr size_t OFF_TOKG = OFF_TOKE + 393216;
constexpr size_t OFF_TOKP = OFF_TOKG + 393216;
constexpr size_t OFF_ROWL = OFF_TOKP + 393216;
constexpr size_t OFF_ROWG = OFF_ROWL + 409600;
constexpr size_t OFF_BONUS = OFF_ROWG + 409600;
constexpr size_t OFF_BAR = OFF_BONUS + 6291456;
constexpr size_t BIG = 26214400;
constexpr size_t OFF_XB = BIG, OFF_QK = BIG + SZ, OFF_VT = BIG + 3 * SZ, OFF_O = BIG + 4 * SZ;
constexpr size_t OFF_WQKT = BIG + 5 * SZ, OFF_WVT = OFF_WQKT + 4194304, OFF_WOT = OFF_WVT + 2097152, OFF_WGUT = OFF_WOT + 2097152, OFF_WDT = OFF_WGUT + 11534336;
constexpr size_t OFF_EB = OFF_WDT + 5767168;
constexpr size_t OFF_H = BIG + SZ;
constexpr size_t OFF_XB2 = BIG, OFF_RKV = BIG + 2 * SZ, OFF_LBWA = BIG + 5 * SZ, OFF_LBG = OFF_LBWA + 25165824;
constexpr size_t OFF_YF = BIG, OFF_YB = BIG + SZ;
constexpr size_t OFF_WMGU = BIG, OFF_WMD = BIG + 117440512, OFF_XS = BIG + 176160768, OFF_XBM = OFF_XS + 209715200, OFF_HID = OFF_XBM;
constexpr size_t WS_NEED = OFF_HID + 183500800;
constexpr int MOE_CHUNK = 100;
constexpr int LDS_BYTES = 131072 + 512;

struct Params { const float* in[33]; float* X; unsigned char* ws; };
extern __shared__ __attribute__((aligned(16))) unsigned char shm[];
constexpr int LDS_TS = 131072, LDS_TAB = 131072 + 128;
__device__ __forceinline__ const float* INP(int i) {
  const LAS unsigned* tab = (const LAS unsigned*)((LAS unsigned char*)shm + LDS_TAB);
  const unsigned lo = __builtin_amdgcn_readfirstlane(tab[2 * i]), hi = __builtin_amdgcn_readfirstlane(tab[2 * i + 1]);
  return (const float*)(((unsigned long long)hi << 32) | lo);
}

__device__ __forceinline__ int tid_() { int t = threadIdx.x; asm volatile("" : "+v"(t)); return t; }
__device__ __forceinline__ unsigned cvt_pk_bf16(float lo, float hi) { unsigned r; asm("v_cvt_pk_bf16_f32 %0, %1, %2" : "=v"(r) : "v"(lo), "v"(hi)); return r; }
__device__ __forceinline__ bf16_t f2bf(float f) { return (bf16_t)(cvt_pk_bf16(f, 0.f) & 0xffffu); }
__device__ __forceinline__ float bflo(unsigned u) { return __uint_as_float(u << 16); }
__device__ __forceinline__ float bfhi(unsigned u) { return __uint_as_float(u & 0xffff0000u); }
__device__ __forceinline__ float wave_sum(float v) { for (int o = 32; o; o >>= 1) v += __shfl_xor(v, o); return v; }
template <int CTRL> __device__ __forceinline__ float dppf(float v) { return __builtin_bit_cast(float, __builtin_amdgcn_mov_dpp(__builtin_bit_cast(int, v), CTRL, 0xf, 0xf, true)); }
__device__ __forceinline__ float red4(float v) { v += dppf<0xB1>(v); v += dppf<0x4E>(v); return v; }
__device__ __forceinline__ float red8(float v) { v = red4(v); v += dppf<0x141>(v); return v; }
__device__ __forceinline__ float red16(float v) { v = red8(v); v += dppf<0x140>(v); return v; }
__device__ __forceinline__ float sigmoidf_(float x) { return __builtin_amdgcn_rcpf(1.f + __expf(-x)); }


#define XB_TMO      128
#define XB_XCNT(j)  (256  + 64 * (j))
#define XB_XSUB(j)  (1280 + 64 * (j))
#define XB_XGEN(j)  (2304 + 64 * (j))
#define XB_TOP      3328
#define XB_TOPGEN   3392
#define XCD_BAR_WORDS 3456
#define XB_SPIN_CAP (1u << 18)
__device__ __forceinline__ unsigned xb_ld(unsigned* p)              { return __hip_atomic_load(p, __ATOMIC_RELAXED, __HIP_MEMORY_SCOPE_AGENT); }
__device__ __forceinline__ unsigned xb_add(unsigned* p, unsigned v) { return __hip_atomic_fetch_add(p, v, __ATOMIC_RELAXED, __HIP_MEMORY_SCOPE_AGENT); }
__device__ __forceinline__ unsigned xb_xcc_id() { return (unsigned)__builtin_amdgcn_s_getreg((3 << 11) | 20) & 0xFu; }
#define XB_SPIN(cond, bar) do { unsigned _sp = 0; while (cond) { __builtin_amdgcn_s_sleep(1); \
    if ((++_sp & 255u) == 0u) { if (xb_ld(&(bar)[XB_TMO])) break; if (_sp > XB_SPIN_CAP) { atomicAdd(&(bar)[XB_TMO], 1u); break; } } } } while (0)
struct XcdBarrier { unsigned* bar; unsigned x; volatile LAS unsigned* st; };
__device__ __forceinline__ XcdBarrier xcd_barrier_post(unsigned* bar, volatile LAS unsigned* st) {
  XcdBarrier b; b.bar = bar; b.x = xb_xcc_id(); b.st = st;
  if (threadIdx.x == 0) (void)xb_add(&bar[XB_XCNT(b.x)], 1u);
  return b;
}
__device__ __forceinline__ void xcd_barrier_complete(unsigned* bar, unsigned x, unsigned& nloc, unsigned& nx) {
  const unsigned G = gridDim.x * gridDim.y * gridDim.z;
  unsigned sum, cnt, mine, sp = 0u;
  for (;;) {
    sum = 0u; cnt = 0u; mine = 0u;
#pragma unroll
    for (unsigned j = 0; j < 16; ++j) { const unsigned c = xb_ld(&bar[XB_XCNT(j)]); sum += c; cnt += (c > 0u) ? 1u : 0u; mine = (j == x) ? c : mine; }
    if (sum == G) break;
    __builtin_amdgcn_s_sleep(1);
    if ((++sp & 255u) == 0u) { if (xb_ld(&bar[XB_TMO])) break; if (sp > XB_SPIN_CAP) { atomicAdd(&bar[XB_TMO], 1u); break; } }
  }
  nloc = mine > 0u ? mine : 1u; nx = cnt > 0u ? cnt : 1u;
}
__device__ __forceinline__ void xcd_barrier(const XcdBarrier& b) {
  asm volatile("s_waitcnt vmcnt(0)" ::: "memory");
  __syncthreads();
  if (threadIdx.x == 0) {
    unsigned* bar = b.bar;
    __builtin_amdgcn_s_waitcnt(0);
    unsigned nloc = b.st[0], nx = b.st[1];
    if (nloc == 0u) { xcd_barrier_complete(bar, b.x, nloc, nx); b.st[0] = nloc; b.st[1] = nx; }
    const unsigned old = xb_add(&bar[XB_XSUB(b.x)], 1u);
    const unsigned gen = old / nloc;
    if (old + 1u == (gen + 1u) * nloc) {
      __builtin_amdgcn_fence(__ATOMIC_RELEASE, "agent");
      asm volatile("s_waitcnt vmcnt(0)" ::: "memory");
      const unsigned og = xb_add(&bar[XB_TOP], 1u);
      const unsigned tg = og / nx;
      if (og + 1u == (tg + 1u) * nx) xb_add(&bar[XB_TOPGEN], 1u);
      else XB_SPIN(xb_ld(&bar[XB_TOPGEN]) == tg, bar);
      __builtin_amdgcn_fence(__ATOMIC_ACQUIRE, "agent");
      xb_add(&bar[XB_XGEN(b.x)], 1u);
      asm volatile("s_waitcnt vmcnt(0)" ::: "memory");
    } else {
      XB_SPIN(xb_ld(&bar[XB_XGEN(b.x)]) == gen, bar);
      __builtin_amdgcn_fence(__ATOMIC_ACQUIRE, "agent");
      asm volatile("s_waitcnt vmcnt(0)" ::: "memory");
    }
  }
  __syncthreads();
}

struct CvtJob { const float* src; int ldsrc, K, N; bf16_t* dst; int lddst, row0, col0; const float* kscale; float scale; int mode; };
__device__ __forceinline__ CvtJob mkjob(const float* src, int ldsrc, int K, int N, bf16_t* dst, int lddst, int row0, int col0, const float* kscale, float scale, int mode) {
  CvtJob j; j.src = src; j.ldsrc = ldsrc; j.K = K; j.N = N; j.dst = dst; j.lddst = lddst; j.row0 = row0; j.col0 = col0; j.kscale = kscale; j.scale = scale; j.mode = mode; return j; }
__device__ __forceinline__ int cvt_run(const CvtJob J, float* tile, int rot) {
  const int tk = (J.K + 63) >> 6, tn = (J.N + 63) >> 6, nt = tk * tn, G = gridDim.x;
  const int tx = tid_() & 63, ty = tid_() >> 6;
  int start = (int)blockIdx.x - rot; if (start < 0) start += G;
  for (int t0 = start; t0 < nt; t0 += 4 * G) {
    float v[4][8];
#pragma unroll
    for (int q = 0; q < 4; ++q) { const int t = t0 + q * G; const int k0 = (t / tn) * 64, n0 = (t % tn) * 64;
#pragma unroll
      for (int r = 0; r < 8; ++r) { const int k = k0 + r * 8 + ty, n = n0 + tx; v[q][r] = 0.f;
        if (t < nt && J.src && k < J.K && n < J.N) v[q][r] = J.src[(size_t)k * J.ldsrc + n]; } }
    __syncthreads();
#pragma unroll
    for (int q = 0; q < 4; ++q) { const int t = t0 + q * G; const int k0 = (t / tn) * 64;
#pragma unroll
      for (int r = 0; r < 8; ++r) { const int kk = r * 8 + ty; float x = v[q][r] * J.scale; if (J.kscale && t < nt && k0 + kk < J.K) x *= J.kscale[k0 + kk]; tile[q * 4160 + kk * 65 + tx] = x; } }
    __syncthreads();
#pragma unroll
    for (int q = 0; q < 4; ++q) { const int t = t0 + q * G; const int k0 = (t / tn) * 64, n0 = (t % tn) * 64;
#pragma unroll
      for (int r = 0; r < 8; ++r) { const int nn = r * 8 + ty, n = n0 + nn, k = k0 + tx;
        if (t < nt && n < J.N && k < J.K) { const int row = J.mode ? ((n >> 7) * 256 + (n & 127)) : n;
          J.dst[(size_t)(J.row0 + row) * J.lddst + J.col0 + k] = f2bf(tile[q * 4160 + tx * 65 + nn]); } } }
  }
  return (rot + nt) % G;
}

constexpr int BM = 256, BK = 64, HALF = 128, HTB = HALF * BK * 2, NXCD = 8, WGM = 8;
__device__ __forceinline__ int lds_byte(int r, int c) { const int st = (r >> 4) * 2 + (c >> 5), rr = r & 15, cc = c & 31, ob = rr * 64 + cc * 2; return st * 1024 + (ob ^ (((ob >> 9) & 1) << 5)); }
__device__ __forceinline__ void stage_rc(int b, int& R, int& C) { const int st = b / 1024, sb = b % 1024, swz = sb ^ (((sb >> 9) & 1) << 5); R = (st >> 1) * 16 + swz / 64; C = (st & 1) * 32 + (swz % 64) / 2; }
__device__ __forceinline__ int perm32(int rho) { const int n = rho >> 4, i = rho & 15; return 8 * (i >> 2) + 4 * n + (i & 3); }
struct Unit { int pm, pn; };
struct Gemm { const bf16_t* A; const bf16_t* Bt; int K; };
struct StaticOrder {
  int nM, nN, nwg, G, c;
  __device__ void init(int M, int N) { nM = M / BM; nN = N / BM; nwg = nM * nN; G = gridDim.x; c = blockIdx.x; }
  __device__ bool next(int i, Unit& u) const {
    const long L = (long)i * G + c; if (L >= nwg) return false;
    int wgid = (int)L; { const int q = nwg / NXCD, r = nwg % NXCD, xcd = wgid % NXCD, off = wgid / NXCD; wgid = (xcd < r ? xcd * (q + 1) : r * (q + 1) + (xcd - r) * q) + off; }
    const int nig = WGM * nN, gid = wgid / nig, fm = gid * WGM, gsz = (nM - fm) < WGM ? (nM - fm) : WGM;
    u.pm = fm + ((wgid % nig) % gsz); u.pn = (wgid % nig) / gsz; return true;
  }
};
template <int NC> struct MoeOrder {
  int first, ntile, G, c; const LAS int* ts;
  __device__ bool next(int i, Unit& u) const {
    const long L = (long)i * G + c; if (L >= (long)ntile * NC) return false;
    const int l = (int)L, nig = WGM * NC, gid = l / nig, fm = gid * WGM, gsz = (ntile - fm) < WGM ? (ntile - fm) : WGM;
    const int pm = first + fm + ((l % nig) % gsz), pn = (l % nig) / gsz;
    int g = 0;
#pragma unroll
    for (int k = 1; k < 16; ++k) g += (pm >= ts[k]) ? 1 : 0;
    u.pm = pm; u.pn = (g & 7) * NC + pn; return true;
  }
};

template <class Epi, class Sched>
__device__ __forceinline__ void gemm_phase(LAS unsigned char* lds, const Gemm g, const Sched& S, const Epi& E) {
  const int tid = tid_(), wid = __builtin_amdgcn_readfirstlane(tid >> 6), lane = tid & 63, wr = wid >> 2, wc = wid & 3, fr = lane & 15, fq = lane >> 4;
  const int K = g.K, nt = K / BK;
  unsigned voffA[2], voffB[2];
#pragma unroll
  for (int i = 0; i < 2; ++i) { int R, C; stage_rc(tid * 16 + i * 8192, R, C); const int Rb = Epi::PERM ? ((R & ~31) + perm32(R & 31)) : R;
    voffA[i] = (unsigned)(R * K + C) * 2u; voffB[i] = (unsigned)(Rb * K + C) * 2u; }
  const size_t kstep = (size_t)(BK * 2);
  const size_t hstep = (size_t)HALF * K * 2;
  const size_t tstep = 2 * hstep;
  const unsigned ldsw = (unsigned)wid * 1024u;
  const int aoff = lds_byte(wr * 64 + fr, fq * 8), boff = lds_byte(wc * 32 + fr, fq * 8);
#define PG8_SA(b, h) (((b) * 2 + (h)) * HTB)
#define PG8_SB(b, h) ((4 + (b) * 2 + (h)) * HTB)
#define PG8_STAGE(bufoff, gbase, voff) do { _Pragma("unroll") for (int _i = 0; _i < 2; ++_i) \
    __builtin_amdgcn_global_load_lds((const unsigned*)((const char*)(gbase) + (voff)[_i]), (LAS unsigned*)(lds + (bufoff) + ldsw + _i * 8192), 16, 0, 0); } while (0)
#define PG8_LDA(dst, b, h) do { _Pragma("unroll") for (int m = 0; m < 4; ++m) _Pragma("unroll") for (int k = 0; k < 2; ++k) dst[m][k] = *(const LAS bf16x8*)(lds + PG8_SA(b, h) + aoff + m * 2048 + k * 1024); } while (0)
#define PG8_LDB(dst, b, h) do { _Pragma("unroll") for (int n = 0; n < 2; ++n) _Pragma("unroll") for (int k = 0; k < 2; ++k) dst[n][k] = *(const LAS bf16x8*)(lds + PG8_SB(b, h) + boff + n * 2048 + k * 1024); } while (0)
#define PG8_MMA(ai, bj, At, Bt) do { __builtin_amdgcn_s_setprio(1); _Pragma("unroll") for (int m = 0; m < 4; ++m) _Pragma("unroll") for (int n = 0; n < 2; ++n) _Pragma("unroll") for (int k = 0; k < 2; ++k) \
    acc[ai][bj][m][n] = __builtin_amdgcn_mfma_f32_16x16x32_bf16(Bt[n][k], At[m][k], acc[ai][bj][m][n], 0, 0, 0); __builtin_amdgcn_s_setprio(0); } while (0)
#define PG8_WAIT_V(n) asm volatile("s_waitcnt vmcnt(" #n ")" ::: "memory")
#define PG8_WAIT_L(n) asm volatile("s_waitcnt lgkmcnt(" #n ")" ::: "memory")
#define PG8_BAR __builtin_amdgcn_s_barrier()
#define PG8_SCHED __builtin_amdgcn_sched_barrier(0)
  Unit cur, nxt; int ui = 0;
  if (!S.next(0, cur)) return;
  f32x4 acc[2][2][4][2];
#pragma unroll
  for (int a = 0; a < 2; ++a)
#pragma unroll
    for (int b = 0; b < 2; ++b)
#pragma unroll
      for (int m = 0; m < 4; ++m)
#pragma unroll
        for (int n = 0; n < 2; ++n) acc[a][b][m][n] = (f32x4){0.f, 0.f, 0.f, 0.f};
  bf16x8 At[4][2], B0[2][2], B1[2][2];
  const char* cA = (const char*)g.A + (size_t)cur.pm * tstep; const char* cB = (const char*)g.Bt + (size_t)cur.pn * tstep;
  PG8_STAGE(PG8_SB(0, 0), cB, voffB); PG8_STAGE(PG8_SA(0, 0), cA, voffA); PG8_STAGE(PG8_SB(0, 1), cB + hstep, voffB); PG8_STAGE(PG8_SA(0, 1), cA + hstep, voffA);
  if (wr == 1) PG8_BAR;
  PG8_WAIT_V(4); PG8_BAR;
  PG8_STAGE(PG8_SB(1, 0), cB + kstep, voffB); PG8_STAGE(PG8_SA(1, 0), cA + kstep, voffA); PG8_STAGE(PG8_SB(1, 1), cB + hstep + kstep, voffB);
  PG8_WAIT_V(6); PG8_BAR;
  for (;;) {
    const bool has_next = S.next(ui + 1, nxt);
    const char* nA = has_next ? (const char*)g.A + (size_t)nxt.pm * tstep : cA; const char* nB = has_next ? (const char*)g.Bt + (size_t)nxt.pn * tstep : cB;
    for (int t = 0; t < nt; t += 2) {
      const bool last = (t == nt - 2);
      const char* a1 = cA + (size_t)(t + 1) * kstep;
      const char* a2 = last ? nA : cA + (size_t)(t + 2) * kstep; const char* b2 = last ? nB : cB + (size_t)(t + 2) * kstep;
      const char* a3 = a2 + kstep; const char* b3 = b2 + kstep;
      PG8_LDB(B0, 0, 0); PG8_SCHED; PG8_LDA(At, 0, 0); PG8_STAGE(PG8_SA(1, 1), a1 + hstep, voffA);
      PG8_WAIT_L(8); PG8_BAR; PG8_WAIT_L(0); PG8_MMA(0, 0, At, B0); PG8_BAR; PG8_SCHED;
      PG8_LDB(B1, 0, 1); PG8_STAGE(PG8_SB(0, 0), b2, voffB);
      PG8_BAR; PG8_WAIT_L(0); PG8_MMA(0, 1, At, B1); PG8_BAR;
      PG8_LDA(At, 0, 1); PG8_STAGE(PG8_SA(0, 0), a2, voffA);
      PG8_BAR; PG8_WAIT_L(0); PG8_MMA(1, 0, At, B0); PG8_BAR; PG8_SCHED;
      PG8_STAGE(PG8_SB(0, 1), b2 + hstep, voffB);
      PG8_WAIT_V(6); PG8_BAR; PG8_MMA(1, 1, At, B1); PG8_BAR;
      PG8_LDB(B0, 1, 0); PG8_SCHED; PG8_LDA(At, 1, 0); PG8_STAGE(PG8_SA(0, 1), a2 + hstep, voffA);
      PG8_WAIT_L(8); PG8_BAR; PG8_WAIT_L(0); PG8_MMA(0, 0, At, B0); PG8_BAR; PG8_SCHED;
      PG8_LDB(B1, 1, 1); PG8_STAGE(PG8_SB(1, 0), b3, voffB);
      PG8_BAR; PG8_WAIT_L(0); PG8_MMA(0, 1, At, B1); PG8_BAR;
      PG8_LDA(At, 1, 1); PG8_STAGE(PG8_SA(1, 0), a3, voffA);
      PG8_BAR; PG8_WAIT_L(0); PG8_MMA(1, 0, At, B0); PG8_BAR; PG8_SCHED;
      PG8_STAGE(PG8_SB(1, 1), b3 + hstep, voffB);
      PG8_WAIT_V(6); PG8_BAR; PG8_MMA(1, 1, At, B1); PG8_BAR;
    }
    E(acc, cur, wr, wc, fr, fq);
    if (!has_next) break;
#pragma unroll
    for (int a = 0; a < 2; ++a)
#pragma unroll
      for (int b = 0; b < 2; ++b)
#pragma unroll
        for (int m = 0; m < 4; ++m)
#pragma unroll
          for (int n = 0; n < 2; ++n) acc[a][b][m][n] = (f32x4){0.f, 0.f, 0.f, 0.f};
    cur = nxt; cA = nA; cB = nB; ++ui;
  }
  PG8_WAIT_V(0);
  if (wr == 0) PG8_BAR;
  PG8_BAR;
#undef PG8_SA
#undef PG8_SB
#undef PG8_STAGE
#undef PG8_LDA
#undef PG8_LDB
#undef PG8_MMA
#undef PG8_WAIT_V
#undef PG8_WAIT_L
#undef PG8_BAR
#undef PG8_SCHED
}

typedef f32x4 Acc[2][2][4][2];
__device__ __forceinline__ u32x4 pack8(f32x4 a, f32x4 b) { u32x4 o; o[0] = cvt_pk_bf16(a[0], a[1]); o[1] = cvt_pk_bf16(a[2], a[3]); o[2] = cvt_pk_bf16(b[0], b[1]); o[3] = cvt_pk_bf16(b[2], b[3]); return o; }

struct EpiStore {
  static constexpr bool PERM = true; bf16_t* O; int ldc;
  __device__ __forceinline__ void operator()(const Acc& acc, const Unit& u, int wr, int wc, int fr, int fq) const {
    const int row0 = u.pm * BM + wr * 64 + fr, col0 = u.pn * BM + wc * 32 + 8 * fq;
#pragma unroll
    for (int ai = 0; ai < 2; ++ai)
#pragma unroll
      for (int m = 0; m < 4; ++m) { bf16_t* rp = O + (size_t)(row0 + ai * HALF + m * 16) * ldc + col0;
#pragma unroll
        for (int bj = 0; bj < 2; ++bj) *(u32x4*)(rp + bj * HALF) = pack8(acc[ai][bj][m][0], acc[ai][bj][m][1]); }
  }
};
struct EpiVT {
  static constexpr bool PERM = true; bf16_t* O;
  __device__ __forceinline__ void operator()(const Acc& acc, const Unit& u, int wr, int wc, int fr, int fq) const {
    const int row0 = u.pm * BM + wr * 64 + fr, col0 = u.pn * BM + wc * 32 + 8 * fq;
#pragma unroll
    for (int ai = 0; ai < 2; ++ai)
#pragma unroll
      for (int m = 0; m < 4; ++m) { const int ch = row0 + ai * HALF + m * 16;
#pragma unroll
        for (int bj = 0; bj < 2; ++bj) { const int tok = col0 + bj * HALF;
          *(u32x4*)(O + (size_t)(tok >> 6) * 65536 + ch * 64 + (tok & 63)) = pack8(acc[ai][bj][m][0], acc[ai][bj][m][1]); } }
  }
};
struct EpiResid {
  static constexpr bool PERM = false; float* X;
  __device__ __forceinline__ void operator()(const Acc& acc, const Unit& u, int wr, int wc, int fr, int fq) const {
    const int row0 = u.pm * BM + wr * 64 + fr, col0 = u.pn * BM + wc * 32 + 4 * fq;
#pragma unroll
    for (int ai = 0; ai < 2; ++ai)
#pragma unroll
      for (int m = 0; m < 4; ++m) { float* rp = X + (size_t)(row0 + ai * HALF + m * 16) * 1024 + col0;
#pragma unroll
        for (int bj = 0; bj < 2; ++bj)
#pragma unroll
          for (int n = 0; n < 2; ++n) { f32x4* q = (f32x4*)(rp + bj * HALF + n * 16); *q = *q * ALPHA + acc[ai][bj][m][n]; } __builtin_amdgcn_sched_barrier(0); }
  }
};
__device__ __forceinline__ f32x4 swiglu4(f32x4 g, f32x4 u) { f32x4 o;
#pragma unroll
  for (int j = 0; j < 4; ++j) o[j] = g[j] * __builtin_amdgcn_rcpf(1.f + __expf(-g[j])) * u[j];
  return o; }
struct EpiSwiglu {
  static constexpr bool PERM = true; bf16_t* H; int ldh, NC, row_base;
  __device__ __forceinline__ void operator()(const Acc& acc, const Unit& u, int wr, int wc, int fr, int fq) const {
    const int row0 = u.pm * BM - row_base + wr * 64 + fr, col0 = (u.pn % NC) * HALF + wc * 32 + 8 * fq;
#pragma unroll
    for (int ai = 0; ai < 2; ++ai)
#pragma unroll
      for (int m = 0; m < 4; ++m)
        *(u32x4*)(H + (size_t)(row0 + ai * HALF + m * 16) * ldh + col0) = pack8(swiglu4(acc[ai][0][m][0], acc[ai][1][m][0]), swiglu4(acc[ai][0][m][1], acc[ai][1][m][1]));
  }
};
struct EpiRwkv {
  static constexpr bool PERM = true; bf16_t* RKV; bf16_t* LBWA; bf16_t* LBG;
  __device__ __forceinline__ void operator()(const Acc& acc, const Unit& u, int wr, int wc, int fr, int fq) const {
    const int row0 = u.pm * BM + wr * 64 + fr;
    if (u.pn < 12) {
      const int col0 = u.pn * BM + wc * 32 + 8 * fq;
#pragma unroll
      for (int ai = 0; ai < 2; ++ai)
#pragma unroll
        for (int m = 0; m < 4; ++m) { bf16_t* rp = RKV + (size_t)(row0 + ai * HALF + m * 16) * 3072 + col0;
#pragma unroll
          for (int bj = 0; bj < 2; ++bj) *(u32x4*)(rp + bj * HALF) = pack8(acc[ai][bj][m][0], acc[ai][bj][m][1]); }
    } else {
      const bool isg = (u.pn == 13); bf16_t* O = isg ? LBG : LBWA; const int c0 = wc * 32 + 8 * fq;
#pragma unroll
      for (int ai = 0; ai < 2; ++ai)
#pragma unroll
        for (int m = 0; m < 4; ++m) { bf16_t* rp = O + (size_t)(row0 + ai * HALF + m * 16) * 256 + c0;
#pragma unroll
          for (int bj = 0; bj < 2; ++bj) { f32x4 v0 = acc[ai][bj][m][0], v1 = acc[ai][bj][m][1]; const int c = bj * HALF + c0;
            if (isg) { if (c < 160) {
#pragma unroll
                for (int j = 0; j < 4; ++j) { v0[j] = sigmoidf_(v0[j]); v1[j] = sigmoidf_(v1[j]); } } else { v0 = (f32x4){0.f, 0.f, 0.f, 0.f}; v1 = v0; } }
            else if (bj == 0) {
#pragma unroll
              for (int j = 0; j < 4; ++j) { v0[j] = 1.f - 2.f * __builtin_amdgcn_rcpf(1.f + __expf(2.f * v0[j])); v1[j] = 1.f - 2.f * __builtin_amdgcn_rcpf(1.f + __expf(2.f * v1[j])); } }
            *(u32x4*)(rp + bj * HALF) = pack8(v0, v1); } }
    }
  }
};
struct EpiMulPre {
  static constexpr bool PERM = true; bf16_t* P;
  __device__ __forceinline__ void operator()(const Acc& acc, const Unit& u, int wr, int wc, int fr, int fq) const {
    const int row0 = u.pm * BM + wr * 64 + fr, col0 = u.pn * BM + wc * 32 + 8 * fq;
#pragma unroll
    for (int ai = 0; ai < 2; ++ai)
#pragma unroll
      for (int m = 0; m < 4; ++m) { bf16_t* rp = P + (size_t)(row0 + ai * HALF + m * 16) * 1024 + col0;
#pragma unroll
        for (int bj = 0; bj < 2; ++bj) { u32x4* q = (u32x4*)(rp + bj * HALF); const u32x4 pv = *q; f32x4 a = acc[ai][bj][m][0], b = acc[ai][bj][m][1];
          a[0] *= bflo(pv[0]); a[1] *= bfhi(pv[0]); a[2] *= bflo(pv[1]); a[3] *= bfhi(pv[1]); b[0] *= bflo(pv[2]); b[1] *= bfhi(pv[2]); b[2] *= bflo(pv[3]); b[3] *= bfhi(pv[3]);
          *q = pack8(a, b); } __builtin_amdgcn_sched_barrier(0); }
  }
};
struct EpiMoeDown {
  static constexpr bool PERM = false; float* X; const int* rowl; const float* rowg; int row_base;
  __device__ __forceinline__ void operator()(const Acc& acc, const Unit& u, int wr, int wc, int fr, int fq) const {
    const int row0 = row_base + u.pm * BM + wr * 64 + fr, col0 = (u.pn & 3) * BM + wc * 32 + 4 * fq;
#pragma unroll
    for (int ai = 0; ai < 2; ++ai)
#pragma unroll
      for (int m = 0; m < 4; ++m) { const int lr = row0 + ai * HALF + m * 16; const int tok = rowl[lr];
        if (tok >= 0) { const float gt = rowg[lr]; float* rp = X + (size_t)tok * 1024 + col0;
#pragma unroll
          for (int bj = 0; bj < 2; ++bj)
#pragma unroll
            for (int n = 0; n < 2; ++n) { f32x4* q = (f32x4*)(rp + bj * HALF + n * 16); *q = *q + acc[ai][bj][m][n] * gt; } } __builtin_amdgcn_sched_barrier(0); }
  }
};
struct MoeDownOrder {
  int first, ntile, G, c; const LAS int* ts;
  __device__ bool next(int i, Unit& u) const {
    const long L = (long)i * G + c; if (L >= (long)ntile * 4) return false;
    const int l = (int)L, pm = l >> 2, pn = l & 3; int g = 0;
#pragma unroll
    for (int k = 1; k < 16; ++k) g += ((first + pm) >= ts[k]) ? 1 : 0;
    u.pm = pm; u.pn = (g & 7) * 4 + pn; return true;
  }
};

__device__ __forceinline__ void ln_row(const float* y, const float* g, const float* b, int lane, f32x4 (&o)[4]) {
  f32x4 v[4]; float s = 0.f;
#pragma unroll
  for (int k = 0; k < 4; ++k) { v[k] = *(const f32x4*)(y + k * 256 + lane * 4); s += v[k][0] + v[k][1] + v[k][2] + v[k][3]; }
  const float mean = wave_sum(s) * (1.f / 1024.f); float q = 0.f;
#pragma unroll
  for (int k = 0; k < 4; ++k) { v[k] = v[k] - mean; q += v[k][0] * v[k][0] + v[k][1] * v[k][1] + v[k][2] * v[k][2] + v[k][3] * v[k][3]; }
  const float rstd = rsqrtf(wave_sum(q) * (1.f / 1024.f) + 1e-5f);
#pragma unroll
  for (int k = 0; k < 4; ++k) { const f32x4 gg = *(const f32x4*)(g + k * 256 + lane * 4), bb = *(const f32x4*)(b + k * 256 + lane * 4); o[k] = v[k] * rstd * gg + bb; }
}

__device__ __forceinline__ void ln_row2(const float* y0, const float* y1, const float* g, const float* b, int lane, f32x4 (&o0)[4], f32x4 (&o1)[4]) {
  f32x4 v[4], u[4]; float s0 = 0.f, s1 = 0.f;
#pragma unroll
  for (int k = 0; k < 4; ++k) { v[k] = *(const f32x4*)(y0 + k * 256 + lane * 4); u[k] = *(const f32x4*)(y1 + k * 256 + lane * 4); }
#pragma unroll
  for (int k = 0; k < 4; ++k) { s0 += v[k][0] + v[k][1] + v[k][2] + v[k][3]; s1 += u[k][0] + u[k][1] + u[k][2] + u[k][3]; }
  const float m0 = wave_sum(s0) * (1.f / 1024.f), m1 = wave_sum(s1) * (1.f / 1024.f); float q0 = 0.f, q1 = 0.f;
#pragma unroll
  for (int k = 0; k < 4; ++k) { v[k] = v[k] - m0; u[k] = u[k] - m1; q0 += v[k][0] * v[k][0] + v[k][1] * v[k][1] + v[k][2] * v[k][2] + v[k][3] * v[k][3]; q1 += u[k][0] * u[k][0] + u[k][1] * u[k][1] + u[k][2] * u[k][2] + u[k][3] * u[k][3]; }
  const float r0 = rsqrtf(wave_sum(q0) * (1.f / 1024.f) + 1e-5f), r1 = rsqrtf(wave_sum(q1) * (1.f / 1024.f) + 1e-5f);
#pragma unroll
  for (int k = 0; k < 4; ++k) { const f32x4 gg = *(const f32x4*)(g + k * 256 + lane * 4), bb = *(const f32x4*)(b + k * 256 + lane * 4); o0[k] = v[k] * r0 * gg + bb; o1[k] = u[k] * r1 * gg + bb; }
}

__device__ __forceinline__ void attn_phase(const bf16_t* __restrict__ QK, const bf16_t* __restrict__ VT, const float* __restrict__ EB, bf16_t* __restrict__ O) {
  const int tid = tid_(), lane = tid & 63, qi = lane & 15, g = lane >> 4;
  const int nw = gridDim.x * 8, w0 = blockIdx.x * 8 + (tid >> 6);
  const int krho = ((qi >> 2) * 8) + (qi & 3);
  int cur_combo = -1; f32x4 bias[8][2];
  for (int u = w0; u < 768 * 4 * 32; u += nw) {
    const int combo = u & 127, h = u & 31, c = (u >> 5) & 3, R = u >> 7;
    const float* eb = EB + (size_t)combo * (15 * 512) + lane * 8;
    if (combo != cur_combo) { cur_combo = combo;
#pragma unroll
      for (int i = 0; i < 8; ++i) { bias[i][0] = *(const f32x4*)(eb + (3 + i) * 512); bias[i][1] = *(const f32x4*)(eb + (3 + i) * 512 + 4); } }
    int seq_row0, rows; if (R < 256) { seq_row0 = R & ~127; rows = 128; } else { seq_row0 = 256 + ((R - 256) & ~63); rows = 64; }
    const int r = R - seq_row0; int rs = r - 4; rs = rs < 0 ? 0 : rs; rs = rs > rows - 8 ? rows - 8 : rs;
    const int blk = (c == 0) ? 0 : (c == 1) ? 8 : (c == 2) ? 24 : 32;
    const int qcol = 16 * c + qi;
    const bf16x8 qf = *(const bf16x8*)(QK + (size_t)(R * 64 + qcol) * 2048 + h * 32 + g * 8);
    f32x4 s[8][2];
    const bf16_t* kbase = QK + ((size_t)(seq_row0 + rs) * 64 + blk + krho) * 2048 + 1024 + h * 32 + g * 8;
#pragma unroll
    for (int i = 0; i < 8; ++i)
#pragma unroll
      for (int hh = 0; hh < 2; ++hh) {
        const bf16x8 kf = *(const bf16x8*)(kbase + (size_t)(i * 64 + hh * 4) * 2048);
        s[i][hh] = __builtin_amdgcn_mfma_f32_16x16x32_bf16(kf, qf, (f32x4){0.f, 0.f, 0.f, 0.f}, 0, 0, 0);
      }
    if (rs - r == -4) {
#pragma unroll
      for (int i = 0; i < 8; ++i) { s[i][0] = s[i][0] + bias[i][0]; s[i][1] = s[i][1] + bias[i][1]; }
    } else {
      const float* ebr = eb + (rs - r + 7) * 512;
#pragma unroll
      for (int i = 0; i < 8; ++i) { s[i][0] = s[i][0] + *(const f32x4*)(ebr + i * 512); s[i][1] = s[i][1] + *(const f32x4*)(ebr + i * 512 + 4); }
    }
    float mx = -3.0e38f;
#pragma unroll
    for (int i = 0; i < 8; ++i)
#pragma unroll
      for (int hh = 0; hh < 2; ++hh) mx = fmaxf(fmaxf(mx, fmaxf(s[i][hh][0], s[i][hh][1])), fmaxf(s[i][hh][2], s[i][hh][3]));
    mx = fmaxf(mx, __shfl_xor(mx, 16)); mx = fmaxf(mx, __shfl_xor(mx, 32));
    float sum = 0.f;
#pragma unroll
    for (int i = 0; i < 8; ++i)
#pragma unroll
      for (int hh = 0; hh < 2; ++hh)
#pragma unroll
        for (int j = 0; j < 4; ++j) { const float e = __expf(s[i][hh][j] - mx); s[i][hh][j] = e; sum += e; }
    sum += __shfl_xor(sum, 16); sum += __shfl_xor(sum, 32);
    f32x4 o0 = {0.f, 0.f, 0.f, 0.f}, o1 = {0.f, 0.f, 0.f, 0.f};
#pragma unroll
    for (int i = 0; i < 8; ++i) {
      const u32x4 pu = pack8(s[i][0], s[i][1]); const bf16x8 pf = __builtin_bit_cast(bf16x8, pu);
      const bf16_t* vb = VT + (size_t)(seq_row0 + rs + i) * 65536 + (size_t)(h * 32 + qi) * 64 + blk + g * 8;
      const bf16x8 v0 = *(const bf16x8*)vb, v1 = *(const bf16x8*)(vb + 16 * 64);
      o0 = __builtin_amdgcn_mfma_f32_16x16x32_bf16(v0, pf, o0, 0, 0, 0);
      o1 = __builtin_amdgcn_mfma_f32_16x16x32_bf16(v1, pf, o1, 0, 0, 0);
    }
    const float inv = 1.f / sum;
    bf16_t* op = O + (size_t)(R * 64 + qcol) * 1024 + h * 32 + g * 4;
    u32x2 a, b; a[0] = cvt_pk_bf16(o0[0] * inv, o0[1] * inv); a[1] = cvt_pk_bf16(o0[2] * inv, o0[3] * inv); b[0] = cvt_pk_bf16(o1[0] * inv, o1[1] * inv); b[1] = cvt_pk_bf16(o1[2] * inv, o1[3] * inv);
    *(u32x2*)op = a; *(u32x2*)(op + 16) = b;
  }
}

constexpr int SC_WD = 0, SC_AA = 2048, SC_KD = 4096, SC_BB = 6144, SC_NA = 8192, SC_RR = 10240, SC_VV = 12288, SC_YO = 14336;
__device__ __forceinline__ void scan_chain(unsigned char* ws, LAS float* L, int chain) {
  const int tid = tid_(), wid = tid >> 6, lane = tid & 63;
  int h, z, Lq; size_t tok0;
  if (chain < 64) { h = (chain & 31) >> 1; z = chain & 1; Lq = 8192; tok0 = (size_t)(chain >> 5) * 8192; }
  else { const int c2 = chain - 64; h = (c2 & 31) >> 1; z = c2 & 1; Lq = 4096; tok0 = 16384 + (size_t)(c2 >> 5) * 4096; }
  const bf16_t* RKV = (const bf16_t*)(ws + OFF_RKV); const bf16_t* LBWA = (const bf16_t*)(ws + OFF_LBWA); const bf16_t* W2T = (const bf16_t*)(ws + OFF_W2T);
  bf16_t* Y = (bf16_t*)(ws + (z ? OFF_YB : OFF_YF)); float* bonus = (float*)(ws + OFF_BONUS);
  const int tk = tid >> 4, c4 = (tid & 15) * 4;
  const int vrow = wid * 8 + (lane >> 3), ko = lane & 7;
  const int mat = wid >> 1, ntile = wid & 1;
  const int ch0 = h * 64 + c4;
  const f32x4 kk4 = *(const f32x4*)(INP(18) + ch0), ka4 = *(const f32x4*)(INP(19) + ch0), rk4 = *(const f32x4*)(INP(20) + ch0);
  bf16x8 bfrag[4]; float bias0 = 0.f;
  if (wid < 4) { const int chb = h * 64 + ntile * 32 + (lane & 31);
#pragma unroll
    for (int ks = 0; ks < 4; ++ks) bfrag[ks] = *(const bf16x8*)(W2T + ((size_t)(mat * 2 + z) * 1024 + chb) * 64 + ks * 16 + (lane >> 5) * 8);
    bias0 = (mat ? INP(13) : INP(10))[z * 1024 + chb]; }
  const int nchunk = Lq / 32;
  u32x2 rawr, rawk, rawv; bf16x8 afrag[4];
  { const size_t tb = tok0 + (size_t)(z ? nchunk - 1 : 0) * 32; const bf16_t* rp = RKV + (tb + tk) * 3072 + ch0;
    rawr = *(const u32x2*)rp; rawk = *(const u32x2*)(rp + 1024); rawv = *(const u32x2*)(rp + 2048);
    if (wid < 4) {
#pragma unroll
      for (int ks = 0; ks < 4; ++ks) afrag[ks] = *(const bf16x8*)(LBWA + (tb + (lane & 31)) * 256 + mat * 128 + z * 64 + ks * 16 + (lane >> 5) * 8); } }
  float S[8];
#pragma unroll
  for (int j = 0; j < 8; ++j) S[j] = 0.f;
  for (int ci = 0; ci < nchunk; ++ci) {
    const size_t tb = tok0 + (size_t)(z ? nchunk - 1 - ci : ci) * 32;
    if (wid < 4) {
      f32x16 acc;
#pragma unroll
      for (int j = 0; j < 16; ++j) acc[j] = 0.f;
#pragma unroll
      for (int ks = 0; ks < 4; ++ks) acc = __builtin_amdgcn_mfma_f32_32x32x16_bf16(afrag[ks], bfrag[ks], acc, 0, 0, 0);
      LAS float* dst = L + (mat ? SC_AA : SC_WD) + ntile * 32 + (lane & 31);
#pragma unroll
      for (int rg = 0; rg < 16; ++rg) { const int row = (rg & 3) + 8 * (rg >> 2) + 4 * (lane >> 5); const float sg = sigmoidf_(acc[rg] + bias0);
        dst[row * 64] = mat ? sg : __expf(-0.60653065971263342f * sg); }
    }
    __syncthreads();
    {
      const float r4[4] = {bflo(rawr[0]), bfhi(rawr[0]), bflo(rawr[1]), bfhi(rawr[1])};
      const float k4[4] = {bflo(rawk[0]), bfhi(rawk[0]), bflo(rawk[1]), bfhi(rawk[1])};
      f32x4 kx; float ss = 0.f;
#pragma unroll
      for (int j = 0; j < 4; ++j) { kx[j] = k4[j] * kk4[j]; ss += kx[j] * kx[j]; }
      ss = red16(ss); const float inv = __builtin_amdgcn_rsqf(fmaxf(ss, 1e-24f));
      const f32x4 a4 = *(const LAS f32x4*)(L + SC_AA + tk * 64 + c4);
      f32x4 kd, bb, na, rr, vv; float bon = 0.f;
#pragma unroll
      for (int j = 0; j < 4; ++j) { const float kn = kx[j] * inv; kd[j] = k4[j] * (1.f + (a4[j] - 1.f) * ka4[j]); bb[j] = kn * a4[j]; na[j] = -kn; rr[j] = r4[j]; bon += r4[j] * kd[j] * rk4[j]; }
      vv[0] = bflo(rawv[0]); vv[1] = bfhi(rawv[0]); vv[2] = bflo(rawv[1]); vv[3] = bfhi(rawv[1]);
      *(LAS f32x4*)(L + SC_KD + tk * 64 + c4) = kd; *(LAS f32x4*)(L + SC_BB + tk * 64 + c4) = bb; *(LAS f32x4*)(L + SC_NA + tk * 64 + c4) = na;
      *(LAS f32x4*)(L + SC_RR + tk * 64 + c4) = rr; *(LAS f32x4*)(L + SC_VV + tk * 64 + c4) = vv;
      bon = red16(bon); if ((tid & 15) == 0) bonus[((tb + tk) * 16 + h) * 2 + z] = bon;
    }
    __syncthreads();
    if (ci + 1 < nchunk) { const size_t tn = tok0 + (size_t)(z ? nchunk - 2 - ci : ci + 1) * 32; const bf16_t* rp = RKV + (tn + tk) * 3072 + ch0;
      rawr = *(const u32x2*)rp; rawk = *(const u32x2*)(rp + 1024); rawv = *(const u32x2*)(rp + 2048);
      if (wid < 4) {
#pragma unroll
        for (int ks = 0; ks < 4; ++ks) afrag[ks] = *(const bf16x8*)(LBWA + (tn + (lane & 31)) * 256 + mat * 128 + z * 64 + ks * 16 + (lane >> 5) * 8); } }
    {
      typedef float f32x2 __attribute__((ext_vector_type(2)));
      const LAS float* base0 = L + ko * 8; const int sstep = z ? -64 : 64; const LAS float* bp = base0 + (z ? 31 * 64 : 0);
      const LAS float* vp = L + SC_VV + vrow + (z ? 31 * 64 : 0); LAS float* yp = L + SC_YO + vrow + (z ? 31 * 64 : 0);
      f32x4 cna0 = *(const LAS f32x4*)(bp + SC_NA), cna1 = *(const LAS f32x4*)(bp + SC_NA + 4), cw0 = *(const LAS f32x4*)(bp + SC_WD), cw1 = *(const LAS f32x4*)(bp + SC_WD + 4);
      f32x4 cb0 = *(const LAS f32x4*)(bp + SC_BB), cb1 = *(const LAS f32x4*)(bp + SC_BB + 4), cd0 = *(const LAS f32x4*)(bp + SC_KD), cd1 = *(const LAS f32x4*)(bp + SC_KD + 4);
      f32x4 cr0 = *(const LAS f32x4*)(bp + SC_RR), cr1 = *(const LAS f32x4*)(bp + SC_RR + 4); float cvv = *vp;
      f32x2 S0 = {S[0], S[1]}, S1 = {S[2], S[3]}, S2 = {S[4], S[5]}, S3 = {S[6], S[7]};
#define LO2(v) __builtin_shufflevector(v, v, 0, 1)
#define HI2(v) __builtin_shufflevector(v, v, 2, 3)
#pragma unroll 4
      for (int si = 0; si < 32; ++si) {
        f32x4 nna0, nna1, nw0, nw1, nb0, nb1, nd0, nd1, nr0, nr1; float nvv;
        const LAS float* bn = bp + ((si < 31) ? sstep : 0); const LAS float* vn = vp + ((si < 31) ? sstep : 0);
        nna0 = *(const LAS f32x4*)(bn + SC_NA); nna1 = *(const LAS f32x4*)(bn + SC_NA + 4); nw0 = *(const LAS f32x4*)(bn + SC_WD); nw1 = *(const LAS f32x4*)(bn + SC_WD + 4);
        nb0 = *(const LAS f32x4*)(bn + SC_BB); nb1 = *(const LAS f32x4*)(bn + SC_BB + 4); nd0 = *(const LAS f32x4*)(bn + SC_KD); nd1 = *(const LAS f32x4*)(bn + SC_KD + 4);
        nr0 = *(const LAS f32x4*)(bn + SC_RR); nr1 = *(const LAS f32x4*)(bn + SC_RR + 4); nvv = *vn;
        f32x2 p1 = S0 * LO2(cna0), p2 = S1 * HI2(cna0); p1 = S2 * LO2(cna1) + p1; p2 = S3 * HI2(cna1) + p2; p1 = p1 + p2;
        float sa = red8(p1[0] + p1[1]);
        const f32x2 sa2 = {sa, sa}, vv2 = {cvv, cvv};
        S0 = S0 * LO2(cw0) + (sa2 * LO2(cb0) + vv2 * LO2(cd0)); S1 = S1 * HI2(cw0) + (sa2 * HI2(cb0) + vv2 * HI2(cd0));
        S2 = S2 * LO2(cw1) + (sa2 * LO2(cb1) + vv2 * LO2(cd1)); S3 = S3 * HI2(cw1) + (sa2 * HI2(cb1) + vv2 * HI2(cd1));
        f32x2 q1 = S0 * LO2(cr0), q2 = S1 * HI2(cr0); q1 = S2 * LO2(cr1) + q1; q2 = S3 * HI2(cr1) + q2; q1 = q1 + q2;
        const float y = red8(q1[0] + q1[1]);
        if (ko == 0) *yp = y;
        cna0 = nna0; cna1 = nna1; cw0 = nw0; cw1 = nw1; cb0 = nb0; cb1 = nb1; cd0 = nd0; cd1 = nd1; cr0 = nr0; cr1 = nr1; cvv = nvv;
        bp = bn; vp = vn; yp += sstep;
      }
#undef LO2
#undef HI2
      S[0] = S0[0]; S[1] = S0[1]; S[2] = S1[0]; S[3] = S1[1]; S[4] = S2[0]; S[5] = S2[1]; S[6] = S3[0]; S[7] = S3[1];
    }
    __syncthreads();
    { const f32x4 yv = *(const LAS f32x4*)(L + SC_YO + tk * 64 + c4); u32x2 o; o[0] = cvt_pk_bf16(yv[0], yv[1]); o[1] = cvt_pk_bf16(yv[2], yv[3]);
      *(u32x2*)(Y + (tb + tk) * 1024 + ch0) = o; }
  }
  __syncthreads();
}

__global__ void __launch_bounds__(512, 2) mega(Params p) {
  cg::grid_group grid = cg::this_grid();
  LAS unsigned char* lds = (LAS unsigned char*)shm;
  LAS int* TS = (LAS int*)(lds + LDS_TS);
  unsigned char* ws = p.ws;
  { const unsigned* ka = (const unsigned*)__builtin_amdgcn_kernarg_segment_ptr(); if (threadIdx.x < 66) ((LAS unsigned*)(lds + LDS_TAB))[threadIdx.x] = ka[threadIdx.x]; }
  __syncthreads();
  const int G = gridDim.x, nw = G * 8;
  const long ngt = (long)G * 512;
#define PH_VARS const int tid = tid_(), lane = tid & 63, wid = tid >> 6, gw = blockIdx.x * 8 + wid; const long gt = (long)blockIdx.x * 512 + tid; (void)lane; (void)gw; (void)gt;
  float* X = p.X;

  { PH_VARS
  {
    int rot = 0; float* tile = (float*)shm;
    const float* wqkv = INP(2);
    rot = cvt_run(mkjob(wqkv, 3072, 1024, 1024, (bf16_t*)(ws + OFF_WQKT), 1024, 0, 0, nullptr, 0.17677669529663687f, 0), tile, rot);
    rot = cvt_run(mkjob(wqkv + 1024, 3072, 1024, 1024, (bf16_t*)(ws + OFF_WQKT), 1024, 1024, 0, nullptr, 1.f, 0), tile, rot);
    rot = cvt_run(mkjob(wqkv + 2048, 3072, 1024, 1024, (bf16_t*)(ws + OFF_WVT), 1024, 0, 0, nullptr, 1.f, 0), tile, rot);
    rot = cvt_run(mkjob(INP(4), 1024, 1024, 1024, (bf16_t*)(ws + OFF_WOT), 1024, 0, 0, nullptr, 1.f, 0), tile, rot);
    rot = cvt_run(mkjob(INP(5), 2816, 1024, 2816, (bf16_t*)(ws + OFF_WGUT), 1024, 0, 0, nullptr, 1.f, 1), tile, rot);
    rot = cvt_run(mkjob(INP(6), 2816, 1024, 2816, (bf16_t*)(ws + OFF_WGUT), 1024, 128, 0, nullptr, 1.f, 1), tile, rot);
    rot = cvt_run(mkjob(INP(7), 1024, 2816, 1024, (bf16_t*)(ws + OFF_WDT), 2816, 0, 0, nullptr, 1.f, 0), tile, rot);
    bf16_t* wrt = (bf16_t*)(ws + OFF_WRT); const float* mu = INP(8);
    for (int half = 0; half < 2; ++half) {
      const int c0 = half * 1024;
      rot = cvt_run(mkjob(INP(9), 1024, 1024, 1024, wrt, 2048, 0, c0, half ? mu + 0 * 1024 : nullptr, 1.f, 0), tile, rot);
      rot = cvt_run(mkjob(INP(9) + 1048576, 1024, 1024, 1024, wrt, 2048, 1024, c0, half ? mu + 2 * 1024 : nullptr, 1.f, 0), tile, rot);
      rot = cvt_run(mkjob(INP(9) + 2097152, 1024, 1024, 1024, wrt, 2048, 2048, c0, half ? mu + 3 * 1024 : nullptr, 1.f, 0), tile, rot);
      rot = cvt_run(mkjob(INP(11), 64, 1024, 64, wrt, 2048, 3072, c0, half ? mu + 1 * 1024 : nullptr, 1.f, 0), tile, rot);
      rot = cvt_run(mkjob(INP(11) + 65536, 64, 1024, 64, wrt, 2048, 3136, c0, half ? mu + 1 * 1024 : nullptr, 1.f, 0), tile, rot);
      rot = cvt_run(mkjob(INP(14), 64, 1024, 64, wrt, 2048, 3200, c0, half ? mu + 4 * 1024 : nullptr, 1.f, 0), tile, rot);
      rot = cvt_run(mkjob(INP(14) + 65536, 64, 1024, 64, wrt, 2048, 3264, c0, half ? mu + 4 * 1024 : nullptr, 1.f, 0), tile, rot);
      rot = cvt_run(mkjob(INP(16), 160, 1024, 160, wrt, 2048, 3328, c0, half ? mu + 5 * 1024 : nullptr, 1.f, 0), tile, rot);
    }
    rot = cvt_run(mkjob(nullptr, 0, 2048, 96, wrt, 2048, 3488, 0, nullptr, 1.f, 0), tile, rot);
    bf16_t* w2t = (bf16_t*)(ws + OFF_W2T);
    rot = cvt_run(mkjob(INP(12), 1024, 64, 1024, w2t, 64, 0, 0, nullptr, 1.f, 0), tile, rot);
    rot = cvt_run(mkjob(INP(12) + 65536, 1024, 64, 1024, w2t, 64, 1024, 0, nullptr, 1.f, 0), tile, rot);
    rot = cvt_run(mkjob(INP(15), 1024, 64, 1024, w2t, 64, 2048, 0, nullptr, 1.f, 0), tile, rot);
    rot = cvt_run(mkjob(INP(15) + 65536, 1024, 64, 1024, w2t, 64, 3072, 0, nullptr, 1.f, 0), tile, rot);
    rot = cvt_run(mkjob(INP(17), 1024, 160, 1024, (bf16_t*)(ws + OFF_G2T), 256, 0, 0, nullptr, 1.f, 0), tile, rot);
    rot = cvt_run(mkjob(nullptr, 0, 96, 1024, (bf16_t*)(ws + OFF_G2T), 256, 0, 160, nullptr, 1.f, 0), tile, rot);
    rot = cvt_run(mkjob(INP(23), 1024, 1024, 1024, (bf16_t*)(ws + OFF_RWOT), 1024, 0, 0, nullptr, 1.f, 0), tile, rot);
    bf16_t* xb = (bf16_t*)(ws + OFF_XB);
    { const float* x0 = INP(0); const float* x1 = INP(1);
    for (long i0 = gt; i0 < (long)T * 256; i0 += 4 * ngt) { f32x4 v[4];
#pragma unroll
      for (int u = 0; u < 4; ++u) { const long i = i0 + u * ngt; if (i < (long)T * 256) v[u] = (i < 16384L * 256) ? *(const f32x4*)(x0 + i * 4) : *(const f32x4*)(x1 + (i - 16384L * 256) * 4); }
#pragma unroll
      for (int u = 0; u < 4; ++u) { const long i = i0 + u * ngt; if (i < (long)T * 256) { *(f32x4*)(X + i * 4) = v[u]; u32x2 o; o[0] = cvt_pk_bf16(v[u][0], v[u][1]); o[1] = cvt_pk_bf16(v[u][2], v[u][3]); *(u32x2*)(xb + i * 4) = o; } } } }
    { float* EBt = (float*)(ws + OFF_EB); const float* rpb = INP(3);
      for (long i = gt; i < 128L * 15 * 512; i += ngt) { const int e = (int)(i & 7), ln = (int)((i >> 3) & 63), dr = (int)((i >> 9) % 15), combo = (int)((i >> 9) / 15);
        const int h = combo & 31, c = combo >> 5, qi = ln & 15, g = ln >> 4; const int blk = (c == 0) ? 0 : (c == 1) ? 8 : (c == 2) ? 24 : 32;
        const int kcol = blk + g * 8 + e, qcol = 16 * c + qi; int qstart = qcol - 8; qstart = qstart < 0 ? 0 : qstart; qstart = qstart > 48 ? 48 : qstart;
        const bool valid = (kcol >= qstart) && (kcol < qstart + 16); int dc = kcol - qcol + 15; dc = dc < 0 ? 0 : dc; dc = dc > 30 ? 30 : dc;
        EBt[i] = valid ? rpb[(h * 15 + dr) * 31 + dc] : -3.0e38f; } }
    int* cnt = (int*)(ws + OFF_CNT); int* rowl = (int*)(ws + OFF_ROWL);
    if (gt < 16) cnt[gt] = 0;
    if (blockIdx.x == 0) for (int i = tid; i < XCD_BAR_WORDS; i += 512) ((unsigned*)(ws + OFF_BAR))[i] = 0u;
    if (tid < 2) ((LAS unsigned*)(lds + LDS_TS + 80))[tid] = 0u;
    for (long i = gt; i < 102400; i += ngt) rowl[i] = -1;
  }
  }
  grid.sync();
  __syncthreads();
  const XcdBarrier xb = xcd_barrier_post((unsigned*)(ws + OFF_BAR), (volatile LAS unsigned*)(lds + LDS_TS + 80));
  { PH_VARS
  { Gemm g{(const bf16_t*)(ws + OFF_XB), (const bf16_t*)(ws + OFF_WQKT), 1024}; StaticOrder S; S.init(T, 2048); EpiStore E{(bf16_t*)(ws + OFF_QK), 2048}; gemm_phase(lds, g, S, E); }
  { Gemm g{(const bf16_t*)(ws + OFF_WVT), (const bf16_t*)(ws + OFF_XB), 1024}; StaticOrder S; S.init(1024, T); EpiVT E{(bf16_t*)(ws + OFF_VT)}; gemm_phase(lds, g, S, E); }
  }
  xcd_barrier(xb);
  { PH_VARS
  attn_phase((const bf16_t*)(ws + OFF_QK), (const bf16_t*)(ws + OFF_VT), (const float*)(ws + OFF_EB), (bf16_t*)(ws + OFF_O));
  }
  xcd_barrier(xb);
  { PH_VARS
  { Gemm g{(const bf16_t*)(ws + OFF_O), (const bf16_t*)(ws + OFF_WOT), 1024}; StaticOrder S; S.init(T, 1024); EpiResid E{X}; gemm_phase(lds, g, S, E); }
  }
  xcd_barrier(xb);
  { PH_VARS
  { bf16_t* xb = (bf16_t*)(ws + OFF_XB);
    for (int row = gw; row < T; row += 2 * nw) { const int rw1 = (row + nw < T) ? row + nw : row; f32x4 oo[2][4]; ln_row2(X + (size_t)row * 1024, X + (size_t)rw1 * 1024, INP(29), INP(30), lane, oo[0], oo[1]);
#pragma unroll
      for (int h = 0; h < 2; ++h) { const int rr = h ? rw1 : row;
#pragma unroll
        for (int k = 0; k < 4; ++k) { *(f32x4*)(X + (size_t)rr * 1024 + k * 256 + lane * 4) = oo[h][k]; u32x2 q; q[0] = cvt_pk_bf16(oo[h][k][0], oo[h][k][1]); q[1] = cvt_pk_bf16(oo[h][k][2], oo[h][k][3]); *(u32x2*)(xb + (size_t)rr * 1024 + k * 256 + lane * 4) = q; } } } }
  }
  xcd_barrier(xb);
  { PH_VARS
  { Gemm g{(const bf16_t*)(ws + OFF_XB), (const bf16_t*)(ws + OFF_WGUT), 1024}; StaticOrder S; S.init(T, 5632); EpiSwiglu E{(bf16_t*)(ws + OFF_H), 2816, 1 << 20, 0}; gemm_phase(lds, g, S, E); }
  }
  xcd_barrier(xb);
  { Gemm g{(const bf16_t*)(ws + OFF_H), (const bf16_t*)(ws + OFF_WDT), 2816}; StaticOrder S; S.init(T, 1024); EpiResid E{X}; gemm_phase(lds, g, S, E); }
  xcd_barrier(xb);
  { PH_VARS
  for (int row = gw; row < T; row += 2 * nw) { const int rw1 = (row + nw < T) ? row + nw : row; f32x4 oo[2][4]; ln_row2(X + (size_t)row * 1024, X + (size_t)rw1 * 1024, INP(31), INP(32), lane, oo[0], oo[1]);
#pragma unroll
    for (int h = 0; h < 2; ++h)
#pragma unroll
      for (int k = 0; k < 4; ++k) *(f32x4*)(X + (size_t)(h ? rw1 : row) * 1024 + k * 256 + lane * 4) = oo[h][k]; }
  }
  xcd_barrier(xb);
  { PH_VARS
  { bf16_t* xb2 = (bf16_t*)(ws + OFF_XB2);
    for (int row = gw; row < T; row += nw) {
      const int s0 = row < 16384 ? (row & ~8191) : 16384 + ((row - 16384) & ~4095), len = row < 16384 ? 8192 : 4096;
      const bool hm = row > s0, hp = row < s0 + len - 1;
#pragma unroll
      for (int k = 0; k < 4; ++k) { const size_t off = (size_t)row * 1024 + k * 256 + lane * 4; const f32x4 x = *(const f32x4*)(X + off);
        const f32x4 xm = hm ? *(const f32x4*)(X + off - 1024) : (f32x4){0.f, 0.f, 0.f, 0.f}, xp = hp ? *(const f32x4*)(X + off + 1024) : (f32x4){0.f, 0.f, 0.f, 0.f};
        const f32x4 xx = (xm + xp) * 0.5f - x; u32x2 a, b; a[0] = cvt_pk_bf16(x[0], x[1]); a[1] = cvt_pk_bf16(x[2], x[3]); b[0] = cvt_pk_bf16(xx[0], xx[1]); b[1] = cvt_pk_bf16(xx[2], xx[3]);
        bf16_t* dp = xb2 + (size_t)row * 2048 + k * 256 + lane * 4; *(u32x2*)dp = a; *(u32x2*)(dp + 1024) = b; } } }
  }
  xcd_barrier(xb);
  { PH_VARS
  { Gemm g{(const bf16_t*)(ws + OFF_XB2), (const bf16_t*)(ws + OFF_WRT), 2048}; StaticOrder S; S.init(T, 3584); EpiRwkv E{(bf16_t*)(ws + OFF_RKV), (bf16_t*)(ws + OFF_LBWA), (bf16_t*)(ws + OFF_LBG)}; gemm_phase(lds, g, S, E); }
  }
  xcd_barrier(xb);
  { PH_VARS
  { LAS float* L = (LAS float*)lds; const int b = blockIdx.x;
    const int first = (G > 64 && b >= 64) ? 64 + (b - 64) : b, stride = (G > 64) ? (b < 64 ? 1000 : G - 64) : G;
    for (int ch = first; ch < 320; ch += stride) scan_chain(ws, L, ch); }
  }
  xcd_barrier(xb);
  { PH_VARS
  { bf16_t* yf = (bf16_t*)(ws + OFF_YF); const bf16_t* yb = (const bf16_t*)(ws + OFF_YB); const bf16_t* rkv = (const bf16_t*)(ws + OFF_RKV); const float* bonus = (const float*)(ws + OFF_BONUS);
    for (int row = gw; row < T; row += nw) {
      const size_t off = (size_t)row * 1024 + lane * 16; const u32x4 a0 = *(const u32x4*)(yf + off), a1 = *(const u32x4*)(yf + off + 8), b0 = *(const u32x4*)(yb + off), b1 = *(const u32x4*)(yb + off + 8);
      const u32x4 v0 = *(const u32x4*)(rkv + (size_t)row * 3072 + 2048 + lane * 16), v1 = *(const u32x4*)(rkv + (size_t)row * 3072 + 2048 + lane * 16 + 8);
      float y[16], vv[16]; float s = 0.f;
#pragma unroll
      for (int j = 0; j < 4; ++j) { y[2 * j] = bflo(a0[j]) + bflo(b0[j]); y[2 * j + 1] = bfhi(a0[j]) + bfhi(b0[j]); y[8 + 2 * j] = bflo(a1[j]) + bflo(b1[j]); y[8 + 2 * j + 1] = bfhi(a1[j]) + bfhi(b1[j]);
        vv[2 * j] = bflo(v0[j]); vv[2 * j + 1] = bfhi(v0[j]); vv[8 + 2 * j] = bflo(v1[j]); vv[8 + 2 * j + 1] = bfhi(v1[j]); }
#pragma unroll
      for (int j = 0; j < 16; ++j) s += y[j];
      const float mean = red4(s) * (1.f / 64.f); float q = 0.f;
#pragma unroll
      for (int j = 0; j < 16; ++j) { y[j] -= mean; q += y[j] * y[j]; }
      const float rstd = rsqrtf(red4(q) * (1.f / 64.f) + 64e-5f);
      const float* bp = bonus + ((size_t)row * 16 + (lane >> 2)) * 2; const float bsum = bp[0] + bp[1];
      u32x4 o0, o1;
#pragma unroll
      for (int j = 0; j < 4; ++j) { const f32x4 gg = *(const f32x4*)(INP(21) + lane * 16 + j * 4), bb = *(const f32x4*)(INP(22) + lane * 16 + j * 4); float t[4];
#pragma unroll
        for (int e = 0; e < 4; ++e) t[e] = y[j * 4 + e] * rstd * gg[e] + bb[e] + bsum * vv[j * 4 + e];
        const unsigned lo = cvt_pk_bf16(t[0], t[1]), hi = cvt_pk_bf16(t[2], t[3]);
        if (j < 2) { o0[2 * j] = lo; o0[2 * j + 1] = hi; } else { o1[2 * (j - 2)] = lo; o1[2 * (j - 2) + 1] = hi; } }
      *(u32x4*)(yf + off) = o0; *(u32x4*)(yf + off + 8) = o1; } }
  }
  xcd_barrier(xb);
  { PH_VARS
  { Gemm g{(const bf16_t*)(ws + OFF_LBG), (const bf16_t*)(ws + OFF_G2T), 256}; StaticOrder S; S.init(T, 1024); EpiMulPre E{(bf16_t*)(ws + OFF_YF)}; gemm_phase(lds, g, S, E); }
  }
  xcd_barrier(xb);
  { PH_VARS
  { Gemm g{(const bf16_t*)(ws + OFF_YF), (const bf16_t*)(ws + OFF_RWOT), 1024}; StaticOrder S; S.init(T, 1024); EpiResid E{X}; gemm_phase(lds, g, S, E); }
  }
  xcd_barrier(xb);
  { PH_VARS
  { bf16_t* xb = (bf16_t*)(ws + OFF_XBM); int* cnt = (int*)(ws + OFF_CNT); int* tokE = (int*)(ws + OFF_TOKE); float* tokG = (float*)(ws + OFF_TOKG); int* tokP = (int*)(ws + OFF_TOKP);
    const float* wr = INP(24); const float* br = INP(25);
    LAS int* lc = (LAS int*)(lds + 100000);
    if (tid < 16) lc[tid] = 0;
    __syncthreads();
    for (int row = gw; row < T; row += nw) { f32x4 o[4]; ln_row(X + (size_t)row * 1024, INP(29) + 1024, INP(30) + 1024, lane, o);
      float lg[8];
#pragma unroll
      for (int e = 0; e < 8; ++e) lg[e] = 0.f;
#pragma unroll
      for (int k = 0; k < 4; ++k) {
#pragma unroll
        for (int j = 0; j < 4; ++j) { const float* wp = wr + (size_t)(k * 256 + lane * 4 + j) * 8; const f32x4 wa = *(const f32x4*)wp, wb = *(const f32x4*)(wp + 4); const float xv = o[k][j];
          lg[0] += xv * wa[0]; lg[1] += xv * wa[1]; lg[2] += xv * wa[2]; lg[3] += xv * wa[3]; lg[4] += xv * wb[0]; lg[5] += xv * wb[1]; lg[6] += xv * wb[2]; lg[7] += xv * wb[3]; }
        *(f32x4*)(X + (size_t)row * 1024 + k * 256 + lane * 4) = o[k] * ALPHA; u32x2 q; q[0] = cvt_pk_bf16(o[k][0], o[k][1]); q[1] = cvt_pk_bf16(o[k][2], o[k][3]); *(u32x2*)(xb + (size_t)row * 1024 + k * 256 + lane * 4) = q; }
#pragma unroll
      for (int e = 0; e < 8; ++e) lg[e] = wave_sum(lg[e]) + br[e];
      int e0 = 0; float v0 = lg[0];
#pragma unroll
      for (int e = 1; e < 8; ++e) if (lg[e] > v0) { v0 = lg[e]; e0 = e; }
      int e1 = -1; float v1 = -3.0e38f;
#pragma unroll
      for (int e = 0; e < 8; ++e) if (e != e0 && lg[e] > v1) { v1 = lg[e]; e1 = e; }
      if (lane == 0) { const float ex = __expf(v1 - v0), g0 = 1.f / (1.f + ex), g1 = ex * g0;
        const int p0 = __hip_atomic_fetch_add(lc + e0, 1, __ATOMIC_RELAXED, __HIP_MEMORY_SCOPE_WORKGROUP), p1 = __hip_atomic_fetch_add(lc + 8 + e1, 1, __ATOMIC_RELAXED, __HIP_MEMORY_SCOPE_WORKGROUP);
        tokE[row * 2] = e0; tokE[row * 2 + 1] = e1; tokG[row * 2] = g0; tokG[row * 2 + 1] = g1; tokP[row * 2] = p0; tokP[row * 2 + 1] = p1; } }
    __syncthreads();
    if (tid < 16) lc[16 + tid] = atomicAdd(cnt + tid, lc[tid]);
    __syncthreads();
    if (lane < 2) for (int row = gw; row < T; row += nw) tokP[row * 2 + lane] += lc[16 + lane * 8 + tokE[row * 2 + lane]];
    __syncthreads();
    int rot = 0; float* tile = (float*)shm;
    for (int e = 0; e < 8; ++e) {
      rot = cvt_run(mkjob(INP(26) + (size_t)e * 1024 * 3584, 3584, 1024, 3584, (bf16_t*)(ws + OFF_WMGU) + (size_t)e * 7168 * 1024, 1024, 0, 0, nullptr, 1.f, 1), tile, rot);
      rot = cvt_run(mkjob(INP(27) + (size_t)e * 1024 * 3584, 3584, 1024, 3584, (bf16_t*)(ws + OFF_WMGU) + (size_t)e * 7168 * 1024, 1024, 128, 0, nullptr, 1.f, 1), tile, rot);
      rot = cvt_run(mkjob(INP(28) + (size_t)e * 3584 * 1024, 1024, 3584, 1024, (bf16_t*)(ws + OFF_WMD) + (size_t)e * 1024 * 3584, 3584, 0, 0, nullptr, 1.f, 0), tile, rot);
    }
  }
  }
  xcd_barrier(xb);
  { PH_VARS
  { const int* cnt = (const int*)(ws + OFF_CNT);
    __syncthreads();
    if (tid == 0) { int a = 0; for (int k = 0; k < 16; ++k) { TS[k] = a; a += (cnt[k] + 255) >> 8; } TS[16] = a; }
    __syncthreads();
    const int* tokE = (const int*)(ws + OFF_TOKE); const float* tokG = (const float*)(ws + OFF_TOKG); const int* tokP = (const int*)(ws + OFF_TOKP);
    int* rowl = (int*)(ws + OFF_ROWL); float* rowg = (float*)(ws + OFF_ROWG); const bf16_t* xb = (const bf16_t*)(ws + OFF_XBM); bf16_t* xs = (bf16_t*)(ws + OFF_XS);
    for (int pr0 = gw; pr0 < T * 2; pr0 += 4 * nw) { u32x4 va[4], vb[4]; int rows[4];
#pragma unroll
      for (int u = 0; u < 4; ++u) { const int pr = pr0 + u * nw; rows[u] = -1; if (pr < T * 2) { const int tok = pr >> 1, rk = pr & 1; const int e = tokE[pr]; const int row = TS[rk * 8 + e] * 256 + tokP[pr]; rows[u] = row;
        if (lane == 0) { rowl[row] = tok; rowg[row] = tokG[pr]; }
        const u32x4* sp = (const u32x4*)(xb + (size_t)tok * 1024); va[u] = sp[lane]; vb[u] = sp[lane + 64]; } }
#pragma unroll
      for (int u = 0; u < 4; ++u) if (rows[u] >= 0) { u32x4* dp = (u32x4*)(xs + (size_t)rows[u] * 1024); dp[lane] = va[u]; dp[lane + 64] = vb[u]; } }
  }
  }
  xcd_barrier(xb);
  { PH_VARS
  { const int ts8 = TS[8], ts16 = TS[16];
    for (int rk = 0; rk < 2; ++rk) { const int t0 = rk ? ts8 : 0, t1 = rk ? ts16 : ts8;
      for (int cs = t0; cs < t1; cs += MOE_CHUNK) { const int ntile = (t1 - cs) < MOE_CHUNK ? (t1 - cs) : MOE_CHUNK;
        { Gemm g{(const bf16_t*)(ws + OFF_XS), (const bf16_t*)(ws + OFF_WMGU), 1024}; MoeOrder<28> S{cs, ntile, G, (int)blockIdx.x, TS}; EpiSwiglu E{(bf16_t*)(ws + OFF_HID), 3584, 28, cs * 256}; gemm_phase(lds, g, S, E); }
        xcd_barrier(xb);
        { Gemm g{(const bf16_t*)(ws + OFF_HID), (const bf16_t*)(ws + OFF_WMD), 3584}; MoeDownOrder S{cs, ntile, G, (int)blockIdx.x, TS}; EpiMoeDown E{X, (const int*)(ws + OFF_ROWL), (const float*)(ws + OFF_ROWG), cs * 256}; gemm_phase(lds, g, S, E); }
        xcd_barrier(xb);
      } }
  }
  }
  { PH_VARS
  for (int row = gw; row < T; row += 2 * nw) { const int rw1 = (row + nw < T) ? row + nw : row; f32x4 oo[2][4]; ln_row2(X + (size_t)row * 1024, X + (size_t)rw1 * 1024, INP(31) + 1024, INP(32) + 1024, lane, oo[0], oo[1]);
#pragma unroll
    for (int h = 0; h < 2; ++h)
#pragma unroll
      for (int k = 0; k < 4; ++k) *(f32x4*)(X + (size_t)(h ? rw1 : row) * 1024 + k * 256 + lane * 4) = oo[h][k]; }
  }
}

extern "C" void kernel_launch(void* const* d_in, const int* in_sizes, int n_in, void* d_out, int out_size, void* d_ws, size_t ws_size, hipStream_t stream) {
  static int grid_blocks = 0;
  if (!grid_blocks) {
    int dev = 0, cus = 0, per_cu = 0;
    (void)hipGetDevice(&dev);
    (void)hipDeviceGetAttribute(&cus, hipDeviceAttributeMultiprocessorCount, dev);
    (void)hipFuncSetAttribute((const void*)mega, hipFuncAttributeMaxDynamicSharedMemorySize, LDS_BYTES);
    (void)hipOccupancyMaxActiveBlocksPerMultiprocessor(&per_cu, mega, 512, LDS_BYTES);
    if (per_cu > 1) per_cu = 1;
    grid_blocks = cus * per_cu;
    if (ws_size < WS_NEED) fprintf(stderr, "workspace too small: %zu < %zu\n", ws_size, (size_t)WS_NEED);
  }
  Params p{};
  for (int i = 0; i < 33; ++i) p.in[i] = (const float*)d_in[i];
  p.X = (float*)d_out; p.ws = (unsigned char*)d_ws;
  void* args[] = {&p};
  hipError_t e = hipLaunchCooperativeKernel((void*)mega, dim3(grid_blocks), dim3(512), args, LDS_BYTES, stream);
  if (e != hipSuccess) fprintf(stderr, "cooperative launch failed: %s (grid %d)\n", hipGetErrorString(e), grid_blocks);
}
```

```cpp
#include <hip/hip_runtime.h>
#include <hip/hip_cooperative_groups.h>
#include <cstdio>
namespace cg = cooperative_groups;

#define LAS __attribute__((address_space(3)))
typedef unsigned short bf16_t;
typedef short bf16x8 __attribute__((ext_vector_type(8)));
typedef float f32x4 __attribute__((ext_vector_type(4)));
typedef float f32x16 __attribute__((ext_vector_type(16)));
typedef unsigned u32x4 __attribute__((ext_vector_type(4)));
typedef unsigned u32x2 __attribute__((ext_vector_type(2)));

constexpr int T = 49152, D = 1024;
constexpr float ALPHA = 1.41421356237309515f;
constexpr size_t SZ = (size_t)T * 1024 * 2;
constexpr size_t OFF_WRT = 0;
constexpr size_t OFF_W2T = OFF_WRT + 14680064;
constexpr size_t OFF_G2T = OFF_W2T + 524288;
constexpr size_t OFF_RWOT = OFF_G2T + 524288;
constexpr size_t OFF_CNT = OFF_RWOT + 2097152;
constexpr size_t OFF_TOKE = OFF_CNT + 256;
constexpr size_t OFF_TOKG = OFF_TOKE + 393216;
constexpr size_t OFF_TOKP = OFF_TOKG + 393216;
constexpr size_t OFF_ROWL = OFF_TOKP + 393216;
constexpr size_t OFF_ROWG = OFF_ROWL + 409600;
constexpr size_t OFF_BONUS = OFF_ROWG + 409600;
constexpr size_t OFF_BAR = OFF_BONUS + 6291456;
constexpr size_t BIG = 26214400;
constexpr size_t OFF_XB = BIG, OFF_QK = BIG + SZ, OFF_VT = BIG + 3 * SZ, OFF_O = BIG + 4 * SZ;
constexpr size_t OFF_WQKT = BIG + 5 * SZ, OFF_WVT = OFF_WQKT + 4194304, OFF_WOT = OFF_WVT + 2097152, OFF_WGUT = OFF_WOT + 2097152, OFF_WDT = OFF_WGUT + 11534336;
constexpr size_t OFF_EB = OFF_WDT + 5767168;
constexpr size_t OFF_H = BIG + SZ;
constexpr size_t OFF_XB2 = BIG, OFF_RKV = BIG + 2 * SZ, OFF_LBWA = BIG + 5 * SZ, OFF_LBG = OFF_LBWA + 25165824;
constexpr size_t OFF_YF = BIG, OFF_YB = BIG + SZ;
constexpr size_t OFF_WMGU = BIG, OFF_WMD = BIG + 117440512, OFF_XS = BIG + 176160768, OFF_XBM = OFF_XS + 209715200, OFF_HID = OFF_XBM;
constexpr size_t WS_NEED = OFF_HID + 183500800;
constexpr int MOE_CHUNK = 100;
constexpr int LDS_BYTES = 131072 + 512;

struct Params { const float* in[33]; float* X; unsigned char* ws; };
extern __shared__ __attribute__((aligned(16))) unsigned char shm[];
constexpr int LDS_TS = 131072, LDS_TAB = 131072 + 128;
__device__ __forceinline__ const float* INP(int i) {
  const LAS unsigned* tab = (const LAS unsigned*)((LAS unsigned char*)shm + LDS_TAB);
  const unsigned lo = __builtin_amdgcn_readfirstlane(tab[2 * i]), hi = __builtin_amdgcn_readfirstlane(tab[2 * i + 1]);
  return (const float*)(((unsigned long long)hi << 32) | lo);
}

__device__ __forceinline__ int tid_() { int t = threadIdx.x; asm volatile("" : "+v"(t)); return t; }
__device__ __forceinline__ unsigned cvt_pk_bf16(float lo, float hi) { unsigned r; asm("v_cvt_pk_bf16_f32 %0, %1, %2" : "=v"(r) : "v"(lo), "v"(hi)); return r; }
__device__ __forceinline__ bf16_t f2bf(float f) { return (bf16_t)(cvt_pk_bf16(f, 0.f) & 0xffffu); }
__device__ __forceinline__ float bflo(unsigned u) { return __uint_as_float(u << 16); }
__device__ __forceinline__ float bfhi(unsigned u) { return __uint_as_float(u & 0xffff0000u); }
__device__ __forceinline__ float wave_sum(float v) { for (int o = 32; o; o >>= 1) v += __shfl_xor(v, o); return v; }
template <int CTRL> __device__ __forceinline__ float dppf(float v) { return __builtin_bit_cast(float, __builtin_amdgcn_mov_dpp(__builtin_bit_cast(int, v), CTRL, 0xf, 0xf, true)); }
__device__ __forceinline__ float red4(float v) { v += dppf<0xB1>(v); v += dppf<0x4E>(v); return v; }
__device__ __forceinline__ float red8(float v) { v = red4(v); v += dppf<0x141>(v); return v; }
__device__ __forceinline__ float red16(float v) { v = red8(v); v += dppf<0x140>(v); return v; }
__device__ __forceinline__ float sigmoidf_(float x) { return __builtin_amdgcn_rcpf(1.f + __expf(-x)); }


#define XB_TMO      128
#define XB_XCNT(j)  (256  + 64 * (j))
#define XB_XSUB(j)  (1280 + 64 * (j))
#define XB_XGEN(j)  (2304 + 64 * (j))
#define XB_TOP      3328
#define XB_TOPGEN   3392
#define XCD_BAR_WORDS 3456
#define XB_SPIN_CAP (1u << 18)
__device__ __forceinline__ unsigned xb_ld(unsigned* p)              { return __hip_atomic_load(p, __ATOMIC_RELAXED, __HIP_MEMORY_SCOPE_AGENT); }
__device__ __forceinline__ unsigned xb_add(unsigned* p, unsigned v) { return __hip_atomic_fetch_add(p, v, __ATOMIC_RELAXED, __HIP_MEMORY_SCOPE_AGENT); }
__device__ __forceinline__ unsigned xb_xcc_id() { return (unsigned)__builtin_amdgcn_s_getreg((3 << 11) | 20) & 0xFu; }
#define XB_SPIN(cond, bar) do { unsigned _sp = 0; while (cond) { __builtin_amdgcn_s_sleep(1); \
    if ((++_sp & 255u) == 0u) { if (xb_ld(&(bar)[XB_TMO])) break; if (_sp > XB_SPIN_CAP) { atomicAdd(&(bar)[XB_TMO], 1u); break; } } } } while (0)
struct XcdBarrier { unsigned* bar; unsigned x; volatile LAS unsigned* st; };
__device__ __forceinline__ XcdBarrier xcd_barrier_post(unsigned* bar, volatile LAS unsigned* st) {
  XcdBarrier b; b.bar = bar; b.x = xb_xcc_id(); b.st = st;
  if (threadIdx.x == 0) (void)xb_add(&bar[XB_XCNT(b.x)], 1u);
  return b;
}
__device__ __forceinline__ void xcd_barrier_complete(unsigned* bar, unsigned x, unsigned& nloc, unsigned& nx) {
  const unsigned G = gridDim.x * gridDim.y * gridDim.z;
  unsigned sum, cnt, mine, sp = 0u;
  for (;;) {
    sum = 0u; cnt = 0u; mine = 0u;
#pragma unroll
    for (unsigned j = 0; j < 16; ++j) { const unsigned c = xb_ld(&bar[XB_XCNT(j)]); sum += c; cnt += (c > 0u) ? 1u : 0u; mine = (j == x) ? c : mine; }
    if (sum == G) break;
    __builtin_amdgcn_s_sleep(1);
    if ((++sp & 255u) == 0u) { if (xb_ld(&bar[XB_TMO])) break; if (sp > XB_SPIN_CAP) { atomicAdd(&bar[XB_TMO], 1u); break; } }
  }
  nloc = mine > 0u ? mine : 1u; nx = cnt > 0u ? cnt : 1u;
}
__device__ __forceinline__ void xcd_barrier(const XcdBarrier& b) {
  asm volatile("s_waitcnt vmcnt(0)" ::: "memory");
  __syncthreads();
  if (threadIdx.x == 0) {
    unsigned* bar = b.bar;
    __builtin_amdgcn_s_waitcnt(0);
    unsigned nloc = b.st[0], nx = b.st[1];
    if (nloc == 0u) { xcd_barrier_complete(bar, b.x, nloc, nx); b.st[0] = nloc; b.st[1] = nx; }
    const unsigned old = xb_add(&bar[XB_XSUB(b.x)], 1u);
    const unsigned gen = old / nloc;
    if (old + 1u == (gen + 1u) * nloc) {
      __builtin_amdgcn_fence(__ATOMIC_RELEASE, "agent");
      asm volatile("s_waitcnt vmcnt(0)" ::: "memory");
      const unsigned og = xb_add(&bar[XB_TOP], 1u);
      const unsigned tg = og / nx;
      if (og + 1u == (tg + 1u) * nx) xb_add(&bar[XB_TOPGEN], 1u);
      else XB_SPIN(xb_ld(&bar[XB_TOPGEN]) == tg, bar);
      __builtin_amdgcn_fence(__ATOMIC_ACQUIRE, "agent");
      xb_add(&bar[XB_XGEN(b.x)], 1u);
      asm volatile("s_waitcnt vmcnt(0)" ::: "memory");
    } else {
      XB_SPIN(xb_ld(&bar[XB_XGEN(b.x)]) == gen, bar);
      __builtin_amdgcn_fence(__ATOMIC_ACQUIRE, "agent");
      asm volatile("s_waitcnt vmcnt(0)" ::: "memory");
    }
  }
  __syncthreads();
}

struct CvtJob { const float* src; int ldsrc, K, N; bf16_t* dst; int lddst, row0, col0; const float* kscale; float scale; int mode; };
__device__ __forceinline__ CvtJob mkjob(const float* src, int ldsrc, int K, int N, bf16_t* dst, int lddst, int row0, int col0, const float* kscale, float scale, int mode) {
  CvtJob j; j.src = src; j.ldsrc = ldsrc; j.K = K; j.N = N; j.dst = dst; j.lddst = lddst; j.row0 = row0; j.col0 = col0; j.kscale = kscale; j.scale = scale; j.mode = mode; return j; }
__device__ __forceinline__ int cvt_run(const CvtJob J, float* tile, int rot) {
  const int tk = (J.K + 63) >> 6, tn = (J.N + 63) >> 6, nt = tk * tn, G = gridDim.x;
  const int tx = tid_() & 63, ty = tid_() >> 6;
  int start = (int)blockIdx.x - rot; if (start < 0) start += G;
  for (int t0 = start; t0 < nt; t0 += 4 * G) {
    float v[4][8];
#pragma unroll
    for (int q = 0; q < 4; ++q) { const int t = t0 + q * G; const int k0 = (t / tn) * 64, n0 = (t % tn) * 64;
#pragma unroll
      for (int r = 0; r < 8; ++r) { const int k = k0 + r * 8 + ty, n = n0 + tx; v[q][r] = 0.f;
        if (t < nt && J.src && k < J.K && n < J.N) v[q][r] = J.src[(size_t)k * J.ldsrc + n]; } }
    __syncthreads();
#pragma unroll
    for (int q = 0; q < 4; ++q) { const int t = t0 + q * G; const int k0 = (t / tn) * 64;
#pragma unroll
      for (int r = 0; r < 8; ++r) { const int kk = r * 8 + ty; float x = v[q][r] * J.scale; if (J.kscale && t < nt && k0 + kk < J.K) x *= J.kscale[k0 + kk]; tile[q * 4160 + kk * 65 + tx] = x; } }
    __syncthreads();
#pragma unroll
    for (int q = 0; q < 4; ++q) { const int t = t0 + q * G; const int k0 = (t / tn) * 64, n0 = (t % tn) * 64;
#pragma unroll
      for (int r = 0; r < 8; ++r) { const int nn = r * 8 + ty, n = n0 + nn, k = k0 + tx;
        if (t < nt && n < J.N && k < J.K) { const int row = J.mode ? ((n >> 7) * 256 + (n & 127)) : n;
          J.dst[(size_t)(J.row0 + row) * J.lddst + J.col0 + k] = f2bf(tile[q * 4160 + tx * 65 + nn]); } } }
  }
  return (rot + nt) % G;
}

constexpr int BM = 256, BK = 64, HALF = 128, HTB = HALF * BK * 2, NXCD = 8, WGM = 8;
__device__ __forceinline__ int lds_byte(int r, int c) { const int st = (r >> 4) * 2 + (c >> 5), rr = r & 15, cc = c & 31, ob = rr * 64 + cc * 2; return st * 1024 + (ob ^ (((ob >> 9) & 1) << 5)); }
__device__ __forceinline__ void stage_rc(int b, int& R, int& C) { const int st = b / 1024, sb = b % 1024, swz = sb ^ (((sb >> 9) & 1) << 5); R = (st >> 1) * 16 + swz / 64; C = (st & 1) * 32 + (swz % 64) / 2; }
__device__ __forceinline__ int perm32(int rho) { const int n = rho >> 4, i = rho & 15; return 8 * (i >> 2) + 4 * n + (i & 3); }
struct Unit { int pm, pn; };
struct Gemm { const bf16_t* A; const bf16_t* Bt; int K; };
struct StaticOrder {
  int nM, nN, nwg, G, c;
  __device__ void init(int M, int N) { nM = M / BM; nN = N / BM; nwg = nM * nN; G = gridDim.x; c = blockIdx.x; }
  __device__ bool next(int i, Unit& u) const {
    const long L = (long)i * G + c; if (L >= nwg) return false;
    int wgid = (int)L; { const int q = nwg / NXCD, r = nwg % NXCD, xcd = wgid % NXCD, off = wgid / NXCD; wgid = (xcd < r ? xcd * (q + 1) : r * (q + 1) + (xcd - r) * q) + off; }
    const int nig = WGM * nN, gid = wgid / nig, fm = gid * WGM, gsz = (nM - fm) < WGM ? (nM - fm) : WGM;
    u.pm = fm + ((wgid % nig) % gsz); u.pn = (wgid % nig) / gsz; return true;
  }
};
template <int NC> struct MoeOrder {
  int first, ntile, G, c; const LAS int* ts;
  __device__ bool next(int i, Unit& u) const {
    const long L = (long)i * G + c; if (L >= (long)ntile * NC) return false;
    const int l = (int)L, nig = WGM * NC, gid = l / nig, fm = gid * WGM, gsz = (ntile - fm) < WGM ? (ntile - fm) : WGM;
    const int pm = first + fm + ((l % nig) % gsz), pn = (l % nig) / gsz;
    int g = 0;
#pragma unroll
    for (int k = 1; k < 16; ++k) g += (pm >= ts[k]) ? 1 : 0;
    u.pm = pm; u.pn = (g & 7) * NC + pn; return true;
  }
};

template <class Epi, class Sched>
__device__ __forceinline__ void gemm_phase(LAS unsigned char* lds, const Gemm g, const Sched& S, const Epi& E) {
  const int tid = tid_(), wid = __builtin_amdgcn_readfirstlane(tid >> 6), lane = tid & 63, wr = wid >> 2, wc = wid & 3, fr = lane & 15, fq = lane >> 4;
  const int K = g.K, nt = K / BK;
  unsigned voffA[2], voffB[2];
#pragma unroll
  for (int i = 0; i < 2; ++i) { int R, C; stage_rc(tid * 16 + i * 8192, R, C); const int Rb = Epi::PERM ? ((R & ~31) + perm32(R & 31)) : R;
    voffA[i] = (unsigned)(R * K + C) * 2u; voffB[i] = (unsigned)(Rb * K + C) * 2u; }
  const size_t kstep = (size_t)(BK * 2);
  const size_t hstep = (size_t)HALF * K * 2;
  const size_t tstep = 2 * hstep;
  const unsigned ldsw = (unsigned)wid * 1024u;
  const int aoff = lds_byte(wr * 64 + fr, fq * 8), boff = lds_byte(wc * 32 + fr, fq * 8);
#define PG8_SA(b, h) (((b) * 2 + (h)) * HTB)
#define PG8_SB(b, h) ((4 + (b) * 2 + (h)) * HTB)
#define PG8_STAGE(bufoff, gbase, voff) do { _Pragma("unroll") for (int _i = 0; _i < 2; ++_i) \
    __builtin_amdgcn_global_load_lds((const unsigned*)((const char*)(gbase) + (voff)[_i]), (LAS unsigned*)(lds + (bufoff) + ldsw + _i * 8192), 16, 0, 0); } while (0)
#define PG8_LDA(dst, b, h) do { _Pragma("unroll") for (int m = 0; m < 4; ++m) _Pragma("unroll") for (int k = 0; k < 2; ++k) dst[m][k] = *(const LAS bf16x8*)(lds + PG8_SA(b, h) + aoff + m * 2048 + k * 1024); } while (0)
#define PG8_LDB(dst, b, h) do { _Pragma("unroll") for (int n = 0; n < 2; ++n) _Pragma("unroll") for (int k = 0; k < 2; ++k) dst[n][k] = *(const LAS bf16x8*)(lds + PG8_SB(b, h) + boff + n * 2048 + k * 1024); } while (0)
#define PG8_MMA(ai, bj, At, Bt) do { __builtin_amdgcn_s_setprio(1); _Pragma("unroll") for (int m = 0; m < 4; ++m) _Pragma("unroll") for (int n = 0; n < 2; ++n) _Pragma("unroll") for (int k = 0; k < 2; ++k) \
    acc[ai][bj][m][n] = __builtin_amdgcn_mfma_f32_16x16x32_bf16(Bt[n][k], At[m][k], acc[ai][bj][m][n], 0, 0, 0); __builtin_amdgcn_s_setprio(0); } while (0)
#define PG8_WAIT_V(n) asm volatile("s_waitcnt vmcnt(" #n ")" ::: "memory")
#define PG8_WAIT_L(n) asm volatile("s_waitcnt lgkmcnt(" #n ")" ::: "memory")
#define PG8_BAR __builtin_amdgcn_s_barrier()
#define PG8_SCHED __builtin_amdgcn_sched_barrier(0)
  Unit cur, nxt; int ui = 0;
  if (!S.next(0, cur)) return;
  f32x4 acc[2][2][4][2];
#pragma unroll
  for (int a = 0; a < 2; ++a)
#pragma unroll
    for (int b = 0; b < 2; ++b)
#pragma unroll
      for (int m = 0; m < 4; ++m)
#pragma unroll
        for (int n = 0; n < 2; ++n) acc[a][b][m][n] = (f32x4){0.f, 0.f, 0.f, 0.f};
  bf16x8 At[4][2], B0[2][2], B1[2][2];
  const char* cA = (const char*)g.A + (size_t)cur.pm * tstep; const char* cB = (const char*)g.Bt + (size_t)cur.pn * tstep;
  PG8_STAGE(PG8_SB(0, 0), cB, voffB); PG8_STAGE(PG8_SA(0, 0), cA, voffA); PG8_STAGE(PG8_SB(0, 1), cB + hstep, voffB); PG8_STAGE(PG8_SA(0, 1), cA + hstep, voffA);
  if (wr == 1) PG8_BAR;
  PG8_WAIT_V(4); PG8_BAR;
  PG8_STAGE(PG8_SB(1, 0), cB + kstep, voffB); PG8_STAGE(PG8_SA(1, 0), cA + kstep, voffA); PG8_STAGE(PG8_SB(1, 1), cB + hstep + kstep, voffB);
  PG8_WAIT_V(6); PG8_BAR;
  for (;;) {
    const bool has_next = S.next(ui + 1, nxt);
    const char* nA = has_next ? (const char*)g.A + (size_t)nxt.pm * tstep : cA; const char* nB = has_next ? (const char*)g.Bt + (size_t)nxt.pn * tstep : cB;
    for (int t = 0; t < nt; t += 2) {
      const bool last = (t == nt - 2);
      const char* a1 = cA + (size_t)(t + 1) * kstep;
      const char* a2 = last ? nA : cA + (size_t)(t + 2) * kstep; const char* b2 = last ? nB : cB + (size_t)(t + 2) * kstep;
      const char* a3 = a2 + kstep; const char* b3 = b2 + kstep;
      PG8_LDB(B0, 0, 0); PG8_SCHED; PG8_LDA(At, 0, 0); PG8_STAGE(PG8_SA(1, 1), a1 + hstep, voffA);
      PG8_WAIT_L(8); PG8_BAR; PG8_WAIT_L(0); PG8_MMA(0, 0, At, B0); PG8_BAR; PG8_SCHED;
      PG8_LDB(B1, 0, 1); PG8_STAGE(PG8_SB(0, 0), b2, voffB);
      PG8_BAR; PG8_WAIT_L(0); PG8_MMA(0, 1, At, B1); PG8_BAR;
      PG8_LDA(At, 0, 1); PG8_STAGE(PG8_SA(0, 0), a2, voffA);
      PG8_BAR; PG8_WAIT_L(0); PG8_MMA(1, 0, At, B0); PG8_BAR; PG8_SCHED;
      PG8_STAGE(PG8_SB(0, 1), b2 + hstep, voffB);
      PG8_WAIT_V(6); PG8_BAR; PG8_MMA(1, 1, At, B1); PG8_BAR;
      PG8_LDB(B0, 1, 0); PG8_SCHED; PG8_LDA(At, 1, 0); PG8_STAGE(PG8_SA(0, 1), a2 + hstep, voffA);
      PG8_WAIT_L(8); PG8_BAR; PG8_WAIT_L(0); PG8_MMA(0, 0, At, B0); PG8_BAR; PG8_SCHED;
      PG8_LDB(B1, 1, 1); PG8_STAGE(PG8_SB(1, 0), b3, voffB);
      PG8_BAR; PG8_WAIT_L(0); PG8_MMA(0, 1, At, B1); PG8_BAR;
      PG8_LDA(At, 1, 1); PG8_STAGE(PG8_SA(1, 0), a3, voffA);
      PG8_BAR; PG8_WAIT_L(0); PG8_MMA(1, 0, At, B0); PG8_BAR; PG8_SCHED;
      PG8_STAGE(PG8_SB(1, 1), b3 + hstep, voffB);
      PG8_WAIT_V(6); PG8_BAR; PG8_MMA(1, 1, At, B1); PG8_BAR;
    }
    E(acc, cur, wr, wc, fr, fq);
    if (!has_next) break;
#pragma unroll
    for (int a = 0; a < 2; ++a)
#pragma unroll
      for (int b = 0; b < 2; ++b)
#pragma unroll
        for (int m = 0; m < 4; ++m)
#pragma unroll
          for (int n = 0; n < 2; ++n) acc[a][b][m][n] = (f32x4){0.f, 0.f, 0.f, 0.f};
    cur = nxt; cA = nA; cB = nB; ++ui;
  }
  PG8_WAIT_V(0);
  if (wr == 0) PG8_BAR;
  PG8_BAR;
#undef PG8_SA
#undef PG8_SB
#undef PG8_STAGE
#undef PG8_LDA
#undef PG8_LDB
#undef PG8_MMA
#undef PG8_WAIT_V
#undef PG8_WAIT_L
#undef PG8_BAR
#undef PG8_SCHED
}

typedef f32x4 Acc[2][2][4][2];
__device__ __forceinline__ u32x4 pack8(f32x4 a, f32x4 b) { u32x4 o; o[0] = cvt_pk_bf16(a[0], a[1]); o[1] = cvt_pk_bf16(a[2], a[3]); o[2] = cvt_pk_bf16(b[0], b[1]); o[3] = cvt_pk_bf16(b[2], b[3]); return o; }

struct EpiStore {
  static constexpr bool PERM = true; bf16_t* O; int ldc;
  __device__ __forceinline__ void operator()(const Acc& acc, const Unit& u, int wr, int wc, int fr, int fq) const {
    const int row0 = u.pm * BM + wr * 64 + fr, col0 = u.pn * BM + wc * 32 + 8 * fq;
#pragma unroll
    for (int ai = 0; ai < 2; ++ai)
#pragma unroll
      for (int m = 0; m < 4; ++m) { bf16_t* rp = O + (size_t)(row0 + ai * HALF + m * 16) * ldc + col0;
#pragma unroll
        for (int bj = 0; bj < 2; ++bj) *(u32x4*)(rp + bj * HALF) = pack8(acc[ai][bj][m][0], acc[ai][bj][m][1]); }
  }
};
struct EpiVT {
  static constexpr bool PERM = true; bf16_t* O;
  __device__ __forceinline__ void operator()(const Acc& acc, const Unit& u, int wr, int wc, int fr, int fq) const {
    const int row0 = u.pm * BM + wr * 64 + fr, col0 = u.pn * BM + wc * 32 + 8 * fq;
#pragma unroll
    for (int ai = 0; ai < 2; ++ai)
#pragma unroll
      for (int m = 0; m < 4; ++m) { const int ch = row0 + ai * HALF + m * 16;
#pragma unroll
        for (int bj = 0; bj < 2; ++bj) { const int tok = col0 + bj * HALF;
          *(u32x4*)(O + (size_t)(tok >> 6) * 65536 + ch * 64 + (tok & 63)) = pack8(acc[ai][bj][m][0], acc[ai][bj][m][1]); } }
  }
};
struct EpiResid {
  static constexpr bool PERM = false; float* X;
  __device__ __forceinline__ void operator()(const Acc& acc, const Unit& u, int wr, int wc, int fr, int fq) const {
    const int row0 = u.pm * BM + wr * 64 + fr, col0 = u.pn * BM + wc * 32 + 4 * fq;
#pragma unroll
    for (int ai = 0; ai < 2; ++ai)
#pragma unroll
      for (int m = 0; m < 4; ++m) { float* rp = X + (size_t)(row0 + ai * HALF + m * 16) * 1024 + col0;
#pragma unroll
        for (int bj = 0; bj < 2; ++bj)
#pragma unroll
          for (int n = 0; n < 2; ++n) { f32x4* q = (f32x4*)(rp + bj * HALF + n * 16); *q = *q * ALPHA + acc[ai][bj][m][n]; } __builtin_amdgcn_sched_barrier(0); }
  }
};
__device__ __forceinline__ f32x4 swiglu4(f32x4 g, f32x4 u) { f32x4 o;
#pragma unroll
  for (int j = 0; j < 4; ++j) o[j] = g[j] * __builtin_amdgcn_rcpf(1.f + __expf(-g[j])) * u[j];
  return o; }
struct EpiSwiglu {
  static constexpr bool PERM = true; bf16_t* H; int ldh, NC, row_base;
  __device__ __forceinline__ void operator()(const Acc& acc, const Unit& u, int wr, int wc, int fr, int fq) const {
    const int row0 = u.pm * BM - row_base + wr * 64 + fr, col0 = (u.pn % NC) * HALF + wc * 32 + 8 * fq;
#pragma unroll
    for (int ai = 0; ai < 2; ++ai)
#pragma unroll
      for (int m = 0; m < 4; ++m)
        *(u32x4*)(H + (size_t)(row0 + ai * HALF + m * 16) * ldh + col0) = pack8(swiglu4(acc[ai][0][m][0], acc[ai][1][m][0]), swiglu4(acc[ai][0][m][1], acc[ai][1][m][1]));
  }
};
struct EpiRwkv {
  static constexpr bool PERM = true; bf16_t* RKV; bf16_t* LBWA; bf16_t* LBG;
  __device__ __forceinline__ void operator()(const Acc& acc, const Unit& u, int wr, int wc, int fr, int fq) const {
    const int row0 = u.pm * BM + wr * 64 + fr;
    if (u.pn < 12) {
      const int col0 = u.pn * BM + wc * 32 + 8 * fq;
#pragma unroll
      for (int ai = 0; ai < 2; ++ai)
#pragma unroll
        for (int m = 0; m < 4; ++m) { bf16_t* rp = RKV + (size_t)(row0 + ai * HALF + m * 16) * 3072 + col0;
#pragma unroll
          for (int bj = 0; bj < 2; ++bj) *(u32x4*)(rp + bj * HALF) = pack8(acc[ai][bj][m][0], acc[ai][bj][m][1]); }
    } else {
      const bool isg = (u.pn == 13); bf16_t* O = isg ? LBG : LBWA; const int c0 = wc * 32 + 8 * fq;
#pragma unroll
      for (int ai = 0; ai < 2; ++ai)
#pragma unroll
        for (int m = 0; m < 4; ++m) { bf16_t* rp = O + (size_t)(row0 + ai * HALF + m * 16) * 256 + c0;
#pragma unroll
          for (int bj = 0; bj < 2; ++bj) { f32x4 v0 = acc[ai][bj][m][0], v1 = acc[ai][bj][m][1]; const int c = bj * HALF + c0;
            if (isg) { if (c < 160) {
#pragma unroll
                for (int j = 0; j < 4; ++j) { v0[j] = sigmoidf_(v0[j]); v1[j] = sigmoidf_(v1[j]); } } else { v0 = (f32x4){0.f, 0.f, 0.f, 0.f}; v1 = v0; } }
            else if (bj == 0) {
#pragma unroll
              for (int j = 0; j < 4; ++j) { v0[j] = 1.f - 2.f * __builtin_amdgcn_rcpf(1.f + __expf(2.f * v0[j])); v1[j] = 1.f - 2.f * __builtin_amdgcn_rcpf(1.f + __expf(2.f * v1[j])); } }
            *(u32x4*)(rp + bj * HALF) = pack8(v0, v1); } }
    }
  }
};
struct EpiMulPre {
  static constexpr bool PERM = true; bf16_t* P;
  __device__ __forceinline__ void operator()(const Acc& acc, const Unit& u, int wr, int wc, int fr, int fq) const {
    const int row0 = u.pm * BM + wr * 64 + fr, col0 = u.pn * BM + wc * 32 + 8 * fq;
#pragma unroll
    for (int ai = 0; ai < 2; ++ai)
#pragma unroll
      for (int m = 0; m < 4; ++m) { bf16_t* rp = P + (size_t)(row0 + ai * HALF + m * 16) * 1024 + col0;
#pragma unroll
        for (int bj = 0; bj < 2; ++bj) { u32x4* q = (u32x4*)(rp + bj * HALF); const u32x4 pv = *q; f32x4 a = acc[ai][bj][m][0], b = acc[ai][bj][m][1];
          a[0] *= bflo(pv[0]); a[1] *= bfhi(pv[0]); a[2] *= bflo(pv[1]); a[3] *= bfhi(pv[1]); b[0] *= bflo(pv[2]); b[1] *= bfhi(pv[2]); b[2] *= bflo(pv[3]); b[3] *= bfhi(pv[3]);
          *q = pack8(a, b); } __builtin_amdgcn_sched_barrier(0); }
  }
};
struct EpiMoeDown {
  static constexpr bool PERM = false; float* X; const int* rowl; const float* rowg; int row_base;
  __device__ __forceinline__ void operator()(const Acc& acc, const Unit& u, int wr, int wc, int fr, int fq) const {
    const int row0 = row_base + u.pm * BM + wr * 64 + fr, col0 = (u.pn & 3) * BM + wc * 32 + 4 * fq;
#pragma unroll
    for (int ai = 0; ai < 2; ++ai)
#pragma unroll
      for (int m = 0; m < 4; ++m) { const int lr = row0 + ai * HALF + m * 16; const int tok = rowl[lr];
        if (tok >= 0) { const float gt = rowg[lr]; float* rp = X + (size_t)tok * 1024 + col0;
#pragma unroll
          for (int bj = 0; bj < 2; ++bj)
#pragma unroll
            for (int n = 0; n < 2; ++n) { f32x4* q = (f32x4*)(rp + bj * HALF + n * 16); *q = *q + acc[ai][bj][m][n] * gt; } } __builtin_amdgcn_sched_barrier(0); }
  }
};
struct MoeDownOrder {
  int first, ntile, G, c; const LAS int* ts;
  __device__ bool next(int i, Unit& u) const {
    const long L = (long)i * G + c; if (L >= (long)ntile * 4) return false;
    const int l = (int)L, pm = l >> 2, pn = l & 3; int g = 0;
#pragma unroll
    for (int k = 1; k < 16; ++k) g += ((first + pm) >= ts[k]) ? 1 : 0;
    u.pm = pm; u.pn = (g & 7) * 4 + pn; return true;
  }
};

__device__ __forceinline__ void ln_row(const float* y, const float* g, const float* b, int lane, f32x4 (&o)[4]) {
  f32x4 v[4]; float s = 0.f;
#pragma unroll
  for (int k = 0; k < 4; ++k) { v[k] = *(const f32x4*)(y + k * 256 + lane * 4); s += v[k][0] + v[k][1] + v[k][2] + v[k][3]; }
  const float mean = wave_sum(s) * (1.f / 1024.f); float q = 0.f;
#pragma unroll
  for (int k = 0; k < 4; ++k) { v[k] = v[k] - mean; q += v[k][0] * v[k][0] + v[k][1] * v[k][1] + v[k][2] * v[k][2] + v[k][3] * v[k][3]; }
  const float rstd = rsqrtf(wave_sum(q) * (1.f / 1024.f) + 1e-5f);
#pragma unroll
  for (int k = 0; k < 4; ++k) { const f32x4 gg = *(const f32x4*)(g + k * 256 + lane * 4), bb = *(const f32x4*)(b + k * 256 + lane * 4); o[k] = v[k] * rstd * gg + bb; }
}

__device__ __forceinline__ void ln_row2(const float* y0, const float* y1, const float* g, const float* b, int lane, f32x4 (&o0)[4], f32x4 (&o1)[4]) {
  f32x4 v[4], u[4]; float s0 = 0.f, s1 = 0.f;
#pragma unroll
  for (int k = 0; k < 4; ++k) { v[k] = *(const f32x4*)(y0 + k * 256 + lane * 4); u[k] = *(const f32x4*)(y1 + k * 256 + lane * 4); }
#pragma unroll
  for (int k = 0; k < 4; ++k) { s0 += v[k][0] + v[k][1] + v[k][2] + v[k][3]; s1 += u[k][0] + u[k][1] + u[k][2] + u[k][3]; }
  const float m0 = wave_sum(s0) * (1.f / 1024.f), m1 = wave_sum(s1) * (1.f / 1024.f); float q0 = 0.f, q1 = 0.f;
#pragma unroll
  for (int k = 0; k < 4; ++k) { v[k] = v[k] - m0; u[k] = u[k] - m1; q0 += v[k][0] * v[k][0] + v[k][1] * v[k][1] + v[k][2] * v[k][2] + v[k][3] * v[k][3]; q1 += u[k][0] * u[k][0] + u[k][1] * u[k][1] + u[k][2] * u[k][2] + u[k][3] * u[k][3]; }
  const float r0 = rsqrtf(wave_sum(q0) * (1.f / 1024.f) + 1e-5f), r1 = rsqrtf(wave_sum(q1) * (1.f / 1024.f) + 1e-5f);
#pragma unroll
  for (int k = 0; k < 4; ++k) { const f32x4 gg = *(const f32x4*)(g + k * 256 + lane * 4), bb = *(const f32x4*)(b + k * 256 + lane * 4); o0[k] = v[k] * r0 * gg + bb; o1[k] = u[k] * r1 * gg + bb; }
}

__device__ __forceinline__ void attn_phase(const bf16_t* __restrict__ QK, const bf16_t* __restrict__ VT, const float* __restrict__ EB, bf16_t* __restrict__ O) {
  const int tid = tid_(), lane = tid & 63, qi = lane & 15, g = lane >> 4;
  const int nw = gridDim.x * 8, w0 = blockIdx.x * 8 + (tid >> 6);
  const int krho = ((qi >> 2) * 8) + (qi & 3);
  int cur_combo = -1; f32x4 bias[8][2];
  for (int u = w0; u < 768 * 4 * 32; u += nw) {
    const int combo = u & 127, h = u & 31, c = (u >> 5) & 3, R = u >> 7;
    const float* eb = EB + (size_t)combo * (15 * 512) + lane * 8;
    if (combo != cur_combo) { cur_combo = combo;
#pragma unroll
      for (int i = 0; i < 8; ++i) { bias[i][0] = *(const f32x4*)(eb + (3 + i) * 512); bias[i][1] = *(const f32x4*)(eb + (3 + i) * 512 + 4); } }
    int seq_row0, rows; if (R < 256) { seq_row0 = R & ~127; rows = 128; } else { seq_row0 = 256 + ((R - 256) & ~63); rows = 64; }
    const int r = R - seq_row0; int rs = r - 4; rs = rs < 0 ? 0 : rs; rs = rs > rows - 8 ? rows - 8 : rs;
    const int blk = (c == 0) ? 0 : (c == 1) ? 8 : (c == 2) ? 24 : 32;
    const int qcol = 16 * c + qi;
    const bf16x8 qf = *(const bf16x8*)(QK + (size_t)(R * 64 + qcol) * 2048 + h * 32 + g * 8);
    f32x4 s[8][2];
    const bf16_t* kbase = QK + ((size_t)(seq_row0 + rs) * 64 + blk + krho) * 2048 + 1024 + h * 32 + g * 8;
#pragma unroll
    for (int i = 0; i < 8; ++i)
#pragma unroll
      for (int hh = 0; hh < 2; ++hh) {
        const bf16x8 kf = *(const bf16x8*)(kbase + (size_t)(i * 64 + hh * 4) * 2048);
        s[i][hh] = __builtin_amdgcn_mfma_f32_16x16x32_bf16(kf, qf, (f32x4){0.f, 0.f, 0.f, 0.f}, 0, 0, 0);
      }
    if (rs - r == -4) {
#pragma unroll
      for (int i = 0; i < 8; ++i) { s[i][0] = s[i][0] + bias[i][0]; s[i][1] = s[i][1] + bias[i][1]; }
    } else {
      const float* ebr = eb + (rs - r + 7) * 512;
#pragma unroll
      for (int i = 0; i < 8; ++i) { s[i][0] = s[i][0] + *(const f32x4*)(ebr + i * 512); s[i][1] = s[i][1] + *(const f32x4*)(ebr + i * 512 + 4); }
    }
    float mx = -3.0e38f;
#pragma unroll
    for (int i = 0; i < 8; ++i)
#pragma unroll
      for (int hh = 0; hh < 2; ++hh) mx = fmaxf(fmaxf(mx, fmaxf(s[i][hh][0], s[i][hh][1])), fmaxf(s[i][hh][2], s[i][hh][3]));
    mx = fmaxf(mx, __shfl_xor(mx, 16)); mx = fmaxf(mx, __shfl_xor(mx, 32));
    float sum = 0.f;
#pragma unroll
    for (int i = 0; i < 8; ++i)
#pragma unroll
      for (int hh = 0; hh < 2; ++hh)
#pragma unroll
        for (int j = 0; j < 4; ++j) { const float e = __expf(s[i][hh][j] - mx); s[i][hh][j] = e; sum += e; }
    sum += __shfl_xor(sum, 16); sum += __shfl_xor(sum, 32);
    f32x4 o0 = {0.f, 0.f, 0.f, 0.f}, o1 = {0.f, 0.f, 0.f, 0.f};
#pragma unroll
    for (int i = 0; i < 8; ++i) {
      const u32x4 pu = pack8(s[i][0], s[i][1]); const bf16x8 pf = __builtin_bit_cast(bf16x8, pu);
      const bf16_t* vb = VT + (size_t)(seq_row0 + rs + i) * 65536 + (size_t)(h * 32 + qi) * 64 + blk + g * 8;
      const bf16x8 v0 = *(const bf16x8*)vb, v1 = *(const bf16x8*)(vb + 16 * 64);
      o0 = __builtin_amdgcn_mfma_f32_16x16x32_bf16(v0, pf, o0, 0, 0, 0);
      o1 = __builtin_amdgcn_mfma_f32_16x16x32_bf16(v1, pf, o1, 0, 0, 0);
    }
    const float inv = 1.f / sum;
    bf16_t* op = O + (size_t)(R * 64 + qcol) * 1024 + h * 32 + g * 4;
    u32x2 a, b; a[0] = cvt_pk_bf16(o0[0] * inv, o0[1] * inv); a[1] = cvt_pk_bf16(o0[2] * inv, o0[3] * inv); b[0] = cvt_pk_bf16(o1[0] * inv, o1[1] * inv); b[1] = cvt_pk_bf16(o1[2] * inv, o1[3] * inv);
    *(u32x2*)op = a; *(u32x2*)(op + 16) = b;
  }
}

constexpr int SC_WD = 0, SC_AA = 2048, SC_KD = 4096, SC_BB = 6144, SC_NA = 8192, SC_RR = 10240, SC_VV = 12288, SC_YO = 14336;
typedef float f32x2 __attribute__((ext_vector_type(2)));
#define LO2(v) __builtin_shufflevector(v, v, 0, 1)
#define HI2(v) __builtin_shufflevector(v, v, 2, 3)
template <int NR> __device__ __forceinline__ void scan_steps(LAS float* L, int z, int vrow, int ko, f32x2 (&St)[2][4]) {
  const int sstep = z ? -64 : 64; const LAS float* bp = L + ko * 8 + (z ? 31 * 64 : 0);
  const LAS float* vp = L + SC_VV + vrow + (z ? 31 * 64 : 0); LAS float* yp = L + SC_YO + vrow + (z ? 31 * 64 : 0);
  f32x4 c[10]; float cv[NR];
  c[0] = *(const LAS f32x4*)(bp + SC_NA); c[1] = *(const LAS f32x4*)(bp + SC_NA + 4); c[2] = *(const LAS f32x4*)(bp + SC_WD); c[3] = *(const LAS f32x4*)(bp + SC_WD + 4);
  c[4] = *(const LAS f32x4*)(bp + SC_BB); c[5] = *(const LAS f32x4*)(bp + SC_BB + 4); c[6] = *(const LAS f32x4*)(bp + SC_KD); c[7] = *(const LAS f32x4*)(bp + SC_KD + 4);
  c[8] = *(const LAS f32x4*)(bp + SC_RR); c[9] = *(const LAS f32x4*)(bp + SC_RR + 4);
#pragma unroll
  for (int r = 0; r < NR; ++r) cv[r] = vp[r];
#pragma unroll 4
  for (int si = 0; si < 32; ++si) {
    f32x4 n[10]; float nv[NR];
    const LAS float* bn = bp + ((si < 31) ? sstep : 0); const LAS float* vn = vp + ((si < 31) ? sstep : 0);
    n[0] = *(const LAS f32x4*)(bn + SC_NA); n[1] = *(const LAS f32x4*)(bn + SC_NA + 4); n[2] = *(const LAS f32x4*)(bn + SC_WD); n[3] = *(const LAS f32x4*)(bn + SC_WD + 4);
    n[4] = *(const LAS f32x4*)(bn + SC_BB); n[5] = *(const LAS f32x4*)(bn + SC_BB + 4); n[6] = *(const LAS f32x4*)(bn + SC_KD); n[7] = *(const LAS f32x4*)(bn + SC_KD + 4);
    n[8] = *(const LAS f32x4*)(bn + SC_RR); n[9] = *(const LAS f32x4*)(bn + SC_RR + 4);
#pragma unroll
    for (int r = 0; r < NR; ++r) nv[r] = vn[r];
    float sa[NR], yy[NR];
#pragma unroll
    for (int r = 0; r < NR; ++r) { f32x2 p1 = St[r][0] * LO2(c[0]), p2 = St[r][1] * HI2(c[0]); p1 = St[r][2] * LO2(c[1]) + p1; p2 = St[r][3] * HI2(c[1]) + p2; p1 = p1 + p2; sa[r] = p1[0] + p1[1]; }
#pragma unroll
    for (int r = 0; r < NR; ++r) sa[r] = red8(sa[r]);
#pragma unroll
    for (int r = 0; r < NR; ++r) { const f32x2 s2 = {sa[r], sa[r]}, v2 = {cv[r], cv[r]};
      St[r][0] = St[r][0] * LO2(c[2]) + (s2 * LO2(c[4]) + v2 * LO2(c[6])); St[r][1] = St[r][1] * HI2(c[2]) + (s2 * HI2(c[4]) + v2 * HI2(c[6]));
      St[r][2] = St[r][2] * LO2(c[3]) + (s2 * LO2(c[5]) + v2 * LO2(c[7])); St[r][3] = St[r][3] * HI2(c[3]) + (s2 * HI2(c[5]) + v2 * HI2(c[7])); }
#pragma unroll
    for (int r = 0; r < NR; ++r) { f32x2 q1 = St[r][0] * LO2(c[8]), q2 = St[r][1] * HI2(c[8]); q1 = St[r][2] * LO2(c[9]) + q1; q2 = St[r][3] * HI2(c[9]) + q2; q1 = q1 + q2; yy[r] = q1[0] + q1[1]; }
#pragma unroll
    for (int r = 0; r < NR; ++r) yy[r] = red8(yy[r]);
    if (ko == 0) {
#pragma unroll
      for (int r = 0; r < NR; ++r) yp[r] = yy[r]; }
#pragma unroll
    for (int j = 0; j < 10; ++j) c[j] = n[j];
#pragma unroll
    for (int r = 0; r < NR; ++r) cv[r] = nv[r];
    bp = bn; vp = vn; yp += sstep;
  }
}
__device__ __forceinline__ int chain_chunks(int chain) { return chain < 0 ? 0 : (chain < 64 ? 256 : 128); }
__device__ __forceinline__ void scan_block(unsigned char* ws, LAS float* Lall, int chainA, int modeA, int rbA, int chainB, int modeB, int rbB) {
  const int tid = tid_(), wid = tid >> 6, lane = tid & 63, grp = wid >> 2, gw4 = wid & 3, gtid = tid & 255;
  const int chain = grp ? chainB : chainA, mode = grp ? modeB : modeA, rowbase = grp ? rbB : rbA;
  LAS float* L = Lall + grp * 16384;
  const int nA = chain_chunks(chainA), nB = chain_chunks(chainB), nloop = nA > nB ? nA : nB;
  const int cc = chain < 0 ? 0 : chain;
  int h, z, Lq; size_t tok0;
  if (cc < 64) { h = (cc & 31) >> 1; z = cc & 1; Lq = 8192; tok0 = (size_t)(cc >> 5) * 8192; }
  else { const int c2 = cc - 64; h = (c2 & 31) >> 1; z = c2 & 1; Lq = 4096; tok0 = 16384 + (size_t)(c2 >> 5) * 4096; }
  const int nchunk = chain < 0 ? 0 : Lq / 32;
  const bf16_t* RKV = (const bf16_t*)(ws + OFF_RKV); const bf16_t* LBWA = (const bf16_t*)(ws + OFF_LBWA); const bf16_t* W2T = (const bf16_t*)(ws + OFF_W2T);
  bf16_t* Y = (bf16_t*)(ws + (z ? OFF_YB : OFF_YF)); float* bonus = (float*)(ws + OFF_BONUS);
  const int tk = gtid >> 3, c8 = (gtid & 7) * 8, ch0 = h * 64 + c8;
  const int ko = lane & 7, vl = lane >> 3, vrow = mode ? rowbase + gw4 * 8 + vl : gw4 * 16 + vl * 2;
  const int mat = gw4 >> 1, ntile = gw4 & 1;
  const f32x4 kk0 = *(const f32x4*)(INP(18) + ch0), kk1 = *(const f32x4*)(INP(18) + ch0 + 4), ka0 = *(const f32x4*)(INP(19) + ch0), ka1 = *(const f32x4*)(INP(19) + ch0 + 4);
  const f32x4 rk0 = *(const f32x4*)(INP(20) + ch0), rk1 = *(const f32x4*)(INP(20) + ch0 + 4);
  bf16x8 bfrag[4]; const int chb = h * 64 + ntile * 32 + (lane & 31);
#pragma unroll
  for (int ks = 0; ks < 4; ++ks) bfrag[ks] = *(const bf16x8*)(W2T + ((size_t)(mat * 2 + z) * 1024 + chb) * 64 + ks * 16 + (lane >> 5) * 8);
  const float bias0 = (mat ? INP(13) : INP(10))[z * 1024 + chb];
  u32x4 rawr, rawk, rawv; bf16x8 afrag[4];
  { const size_t tb = tok0 + (size_t)(z ? (nchunk > 0 ? nchunk - 1 : 0) : 0) * 32; const bf16_t* rp = RKV + (tb + tk) * 3072 + ch0;
    rawr = *(const u32x4*)rp; rawk = *(const u32x4*)(rp + 1024); rawv = *(const u32x4*)(rp + 2048);
#pragma unroll
    for (int ks = 0; ks < 4; ++ks) afrag[ks] = *(const bf16x8*)(LBWA + (tb + (lane & 31)) * 256 + mat * 128 + z * 64 + ks * 16 + (lane >> 5) * 8); }
  f32x2 St[2][4];
#pragma unroll
  for (int r = 0; r < 2; ++r)
#pragma unroll
    for (int j = 0; j < 4; ++j) St[r][j] = (f32x2){0.f, 0.f};
  for (int ci = 0; ci < nloop; ++ci) {
    const bool act = ci < nchunk;
    const size_t tb = tok0 + (size_t)(act ? (z ? nchunk - 1 - ci : ci) : 0) * 32;
    if (act) {
      f32x16 acc;
#pragma unroll
      for (int j = 0; j < 16; ++j) acc[j] = 0.f;
#pragma unroll
      for (int ks = 0; ks < 4; ++ks) acc = __builtin_amdgcn_mfma_f32_32x32x16_bf16(afrag[ks], bfrag[ks], acc, 0, 0, 0);
      LAS float* dst = L + (mat ? SC_AA : SC_WD) + ntile * 32 + (lane & 31);
#pragma unroll
      for (int rg = 0; rg < 16; ++rg) { const int row = (rg & 3) + 8 * (rg >> 2) + 4 * (lane >> 5); const float sg = sigmoidf_(acc[rg] + bias0);
        dst[row * 64] = mat ? sg : __expf(-0.60653065971263342f * sg); }
    }
    __syncthreads();
    if (act) {
      float r8[8], k8[8], kx[8]; float ss = 0.f;
#pragma unroll
      for (int j = 0; j < 4; ++j) { r8[2 * j] = bflo(rawr[j]); r8[2 * j + 1] = bfhi(rawr[j]); k8[2 * j] = bflo(rawk[j]); k8[2 * j + 1] = bfhi(rawk[j]); }
#pragma unroll
      for (int j = 0; j < 8; ++j) { kx[j] = k8[j] * (j < 4 ? kk0[j & 3] : kk1[j & 3]); ss += kx[j] * kx[j]; }
      ss = red8(ss); const float inv = __builtin_amdgcn_rsqf(fmaxf(ss, 1e-24f));
      const f32x4 a0 = *(const LAS f32x4*)(L + SC_AA + tk * 64 + c8), a1 = *(const LAS f32x4*)(L + SC_AA + tk * 64 + c8 + 4);
      f32x4 kd[2], bb[2], na[2], rr[2], vv[2]; float bon = 0.f;
#pragma unroll
      for (int j = 0; j < 8; ++j) { const float a = (j < 4 ? a0[j & 3] : a1[j & 3]), kav = (j < 4 ? ka0[j & 3] : ka1[j & 3]), rkv = (j < 4 ? rk0[j & 3] : rk1[j & 3]);
        const float kn = kx[j] * inv, kdv = k8[j] * (1.f + (a - 1.f) * kav); kd[j >> 2][j & 3] = kdv; bb[j >> 2][j & 3] = kn * a; na[j >> 2][j & 3] = -kn; rr[j >> 2][j & 3] = r8[j]; bon += r8[j] * kdv * rkv; }
#pragma unroll
      for (int j = 0; j < 4; ++j) { vv[j >> 1][(j & 1) * 2] = bflo(rawv[j]); vv[j >> 1][(j & 1) * 2 + 1] = bfhi(rawv[j]); }
      LAS float* lp = L + tk * 64 + c8;
      *(LAS f32x4*)(lp + SC_KD) = kd[0]; *(LAS f32x4*)(lp + SC_KD + 4) = kd[1]; *(LAS f32x4*)(lp + SC_BB) = bb[0]; *(LAS f32x4*)(lp + SC_BB + 4) = bb[1];
      *(LAS f32x4*)(lp + SC_NA) = na[0]; *(LAS f32x4*)(lp + SC_NA + 4) = na[1]; *(LAS f32x4*)(lp + SC_RR) = rr[0]; *(LAS f32x4*)(lp + SC_RR + 4) = rr[1];
      *(LAS f32x4*)(lp + SC_VV) = vv[0]; *(LAS f32x4*)(lp + SC_VV + 4) = vv[1];
      bon = red8(bon); if ((gtid & 7) == 0 && rowbase == 0) bonus[((tb + tk) * 16 + h) * 2 + z] = bon;
    }
    __syncthreads();
    if (act && ci + 1 < nchunk) { const size_t tn = tok0 + (size_t)(z ? nchunk - 2 - ci : ci + 1) * 32; const bf16_t* rp = RKV + (tn + tk) * 3072 + ch0;
      rawr = *(const u32x4*)rp; rawk = *(const u32x4*)(rp + 1024); rawv = *(const u32x4*)(rp + 2048);
#pragma unroll
      for (int ks = 0; ks < 4; ++ks) afrag[ks] = *(const bf16x8*)(LBWA + (tn + (lane & 31)) * 256 + mat * 128 + z * 64 + ks * 16 + (lane >> 5) * 8); }
    if (act) { if (mode) scan_steps<1>(L, z, vrow, ko, St); else scan_steps<2>(L, z, vrow, ko, St); }
    __syncthreads();
    if (act) {
      if (mode) { const int c4 = rowbase + (gtid & 7) * 4; const f32x4 yv = *(const LAS f32x4*)(L + SC_YO + tk * 64 + c4); u32x2 o; o[0] = cvt_pk_bf16(yv[0], yv[1]); o[1] = cvt_pk_bf16(yv[2], yv[3]);
        *(u32x2*)(Y + (tb + tk) * 1024 + h * 64 + c4) = o; }
      else { const f32x4 y0 = *(const LAS f32x4*)(L + SC_YO + tk * 64 + c8), y1 = *(const LAS f32x4*)(L + SC_YO + tk * 64 + c8 + 4);
        *(u32x4*)(Y + (tb + tk) * 1024 + ch0) = pack8(y0, y1); }
    }
  }
  __syncthreads();
}

__global__ void __launch_bounds__(512, 2) mega(Params p) {
  cg::grid_group grid = cg::this_grid();
  LAS unsigned char* lds = (LAS unsigned char*)shm;
  LAS int* TS = (LAS int*)(lds + LDS_TS);
  unsigned char* ws = p.ws;
  { const unsigned* ka = (const unsigned*)__builtin_amdgcn_kernarg_segment_ptr(); if (threadIdx.x < 66) ((LAS unsigned*)(lds + LDS_TAB))[threadIdx.x] = ka[threadIdx.x]; }
  __syncthreads();
  const int G = gridDim.x, nw = G * 8;
  const long ngt = (long)G * 512;
#define PH_VARS const int tid = tid_(), lane = tid & 63, wid = tid >> 6, gw = blockIdx.x * 8 + wid; const long gt = (long)blockIdx.x * 512 + tid; (void)lane; (void)gw; (void)gt;
  float* X = p.X;

  { PH_VARS
  {
    int rot = 0; float* tile = (float*)shm;
    const float* wqkv = INP(2);
    rot = cvt_run(mkjob(wqkv, 3072, 1024, 1024, (bf16_t*)(ws + OFF_WQKT), 1024, 0, 0, nullptr, 0.17677669529663687f, 0), tile, rot);
    rot = cvt_run(mkjob(wqkv + 1024, 3072, 1024, 1024, (bf16_t*)(ws + OFF_WQKT), 1024, 1024, 0, nullptr, 1.f, 0), tile, rot);
    rot = cvt_run(mkjob(wqkv + 2048, 3072, 1024, 1024, (bf16_t*)(ws + OFF_WVT), 1024, 0, 0, nullptr, 1.f, 0), tile, rot);
    rot = cvt_run(mkjob(INP(4), 1024, 1024, 1024, (bf16_t*)(ws + OFF_WOT), 1024, 0, 0, nullptr, 1.f, 0), tile, rot);
    rot = cvt_run(mkjob(INP(5), 2816, 1024, 2816, (bf16_t*)(ws + OFF_WGUT), 1024, 0, 0, nullptr, 1.f, 1), tile, rot);
    rot = cvt_run(mkjob(INP(6), 2816, 1024, 2816, (bf16_t*)(ws + OFF_WGUT), 1024, 128, 0, nullptr, 1.f, 1), tile, rot);
    rot = cvt_run(mkjob(INP(7), 1024, 2816, 1024, (bf16_t*)(ws + OFF_WDT), 2816, 0, 0, nullptr, 1.f, 0), tile, rot);
    bf16_t* wrt = (bf16_t*)(ws + OFF_WRT); const float* mu = INP(8);
    for (int half = 0; half < 2; ++half) {
      const int c0 = half * 1024;
      rot = cvt_run(mkjob(INP(9), 1024, 1024, 1024, wrt, 2048, 0, c0, half ? mu + 0 * 1024 : nullptr, 1.f, 0), tile, rot);
      rot = cvt_run(mkjob(INP(9) + 1048576, 1024, 1024, 1024, wrt, 2048, 1024, c0, half ? mu + 2 * 1024 : nullptr, 1.f, 0), tile, rot);
      rot = cvt_run(mkjob(INP(9) + 2097152, 1024, 1024, 1024, wrt, 2048, 2048, c0, half ? mu + 3 * 1024 : nullptr, 1.f, 0), tile, rot);
      rot = cvt_run(mkjob(INP(11), 64, 1024, 64, wrt, 2048, 3072, c0, half ? mu + 1 * 1024 : nullptr, 1.f, 0), tile, rot);
      rot = cvt_run(mkjob(INP(11) + 65536, 64, 1024, 64, wrt, 2048, 3136, c0, half ? mu + 1 * 1024 : nullptr, 1.f, 0), tile, rot);
      rot = cvt_run(mkjob(INP(14), 64, 1024, 64, wrt, 2048, 3200, c0, half ? mu + 4 * 1024 : nullptr, 1.f, 0), tile, rot);
      rot = cvt_run(mkjob(INP(14) + 65536, 64, 1024, 64, wrt, 2048, 3264, c0, half ? mu + 4 * 1024 : nullptr, 1.f, 0), tile, rot);
      rot = cvt_run(mkjob(INP(16), 160, 1024, 160, wrt, 2048, 3328, c0, half ? mu + 5 * 1024 : nullptr, 1.f, 0), tile, rot);
    }
    rot = cvt_run(mkjob(nullptr, 0, 2048, 96, wrt, 2048, 3488, 0, nullptr, 1.f, 0), tile, rot);
    bf16_t* w2t = (bf16_t*)(ws + OFF_W2T);
    rot = cvt_run(mkjob(INP(12), 1024, 64, 1024, w2t, 64, 0, 0, nullptr, 1.f, 0), tile, rot);
    rot = cvt_run(mkjob(INP(12) + 65536, 1024, 64, 1024, w2t, 64, 1024, 0, nullptr, 1.f, 0), tile, rot);
    rot = cvt_run(mkjob(INP(15), 1024, 64, 1024, w2t, 64, 2048, 0, nullptr, 1.f, 0), tile, rot);
    rot = cvt_run(mkjob(INP(15) + 65536, 1024, 64, 1024, w2t, 64, 3072, 0, nullptr, 1.f, 0), tile, rot);
    rot = cvt_run(mkjob(INP(17), 1024, 160, 1024, (bf16_t*)(ws + OFF_G2T), 256, 0, 0, nullptr, 1.f, 0), tile, rot);
    rot = cvt_run(mkjob(nullptr, 0, 96, 1024, (bf16_t*)(ws + OFF_G2T), 256, 0, 160, nullptr, 1.f, 0), tile, rot);
    rot = cvt_run(mkjob(INP(23), 1024, 1024, 1024, (bf16_t*)(ws + OFF_RWOT), 1024, 0, 0, nullptr, 1.f, 0), tile, rot);
    bf16_t* xb = (bf16_t*)(ws + OFF_XB);
    { const float* x0 = INP(0); const float* x1 = INP(1);
    for (long i0 = gt; i0 < (long)T * 256; i0 += 4 * ngt) { f32x4 v[4];
#pragma unroll
      for (int u = 0; u < 4; ++u) { const long i = i0 + u * ngt; if (i < (long)T * 256) v[u] = (i < 16384L * 256) ? *(const f32x4*)(x0 + i * 4) : *(const f32x4*)(x1 + (i - 16384L * 256) * 4); }
#pragma unroll
      for (int u = 0; u < 4; ++u) { const long i = i0 + u * ngt; if (i < (long)T * 256) { *(f32x4*)(X + i * 4) = v[u]; u32x2 o; o[0] = cvt_pk_bf16(v[u][0], v[u][1]); o[1] = cvt_pk_bf16(v[u][2], v[u][3]); *(u32x2*)(xb + i * 4) = o; } } } }
    { float* EBt = (float*)(ws + OFF_EB); const float* rpb = INP(3);
      for (long i = gt; i < 128L * 15 * 512; i += ngt) { const int e = (int)(i & 7), ln = (int)((i >> 3) & 63), dr = (int)((i >> 9) % 15), combo = (int)((i >> 9) / 15);
        const int h = combo & 31, c = combo >> 5, qi = ln & 15, g = ln >> 4; const int blk = (c == 0) ? 0 : (c == 1) ? 8 : (c == 2) ? 24 : 32;
        const int kcol = blk + g * 8 + e, qcol = 16 * c + qi; int qstart = qcol - 8; qstart = qstart < 0 ? 0 : qstart; qstart = qstart > 48 ? 48 : qstart;
        const bool valid = (kcol >= qstart) && (kcol < qstart + 16); int dc = kcol - qcol + 15; dc = dc < 0 ? 0 : dc; dc = dc > 30 ? 30 : dc;
        EBt[i] = valid ? rpb[(h * 15 + dr) * 31 + dc] : -3.0e38f; } }
    int* cnt = (int*)(ws + OFF_CNT); int* rowl = (int*)(ws + OFF_ROWL);
    if (gt < 16) cnt[gt] = 0;
    if (blockIdx.x == 0) for (int i = tid; i < XCD_BAR_WORDS; i += 512) ((unsigned*)(ws + OFF_BAR))[i] = 0u;
    if (tid < 2) ((LAS unsigned*)(lds + LDS_TS + 80))[tid] = 0u;
    for (long i = gt; i < 102400; i += ngt) rowl[i] = -1;
  }
  }
  grid.sync();
  __syncthreads();
  const XcdBarrier xb = xcd_barrier_post((unsigned*)(ws + OFF_BAR), (volatile LAS unsigned*)(lds + LDS_TS + 80));
  { PH_VARS
  { Gemm g{(const bf16_t*)(ws + OFF_XB), (const bf16_t*)(ws + OFF_WQKT), 1024}; StaticOrder S; S.init(T, 2048); EpiStore E{(bf16_t*)(ws + OFF_QK), 2048}; gemm_phase(lds, g, S, E); }
  { Gemm g{(const bf16_t*)(ws + OFF_WVT), (const bf16_t*)(ws + OFF_XB), 1024}; StaticOrder S; S.init(1024, T); EpiVT E{(bf16_t*)(ws + OFF_VT)}; gemm_phase(lds, g, S, E); }
  }
  xcd_barrier(xb);
  { PH_VARS
  attn_phase((const bf16_t*)(ws + OFF_QK), (const bf16_t*)(ws + OFF_VT), (const float*)(ws + OFF_EB), (bf16_t*)(ws + OFF_O));
  }
  xcd_barrier(xb);
  { PH_VARS
  { Gemm g{(const bf16_t*)(ws + OFF_O), (const bf16_t*)(ws + OFF_WOT), 1024}; StaticOrder S; S.init(T, 1024); EpiResid E{X}; gemm_phase(lds, g, S, E); }
  }
  xcd_barrier(xb);
  { PH_VARS
  { bf16_t* xb = (bf16_t*)(ws + OFF_XB);
    for (int row = gw; row < T; row += 2 * nw) { const int rw1 = (row + nw < T) ? row + nw : row; f32x4 oo[2][4]; ln_row2(X + (size_t)row * 1024, X + (size_t)rw1 * 1024, INP(29), INP(30), lane, oo[0], oo[1]);
#pragma unroll
      for (int h = 0; h < 2; ++h) { const int rr = h ? rw1 : row;
#pragma unroll
        for (int k = 0; k < 4; ++k) { *(f32x4*)(X + (size_t)rr * 1024 + k * 256 + lane * 4) = oo[h][k]; u32x2 q; q[0] = cvt_pk_bf16(oo[h][k][0], oo[h][k][1]); q[1] = cvt_pk_bf16(oo[h][k][2], oo[h][k][3]); *(u32x2*)(xb + (size_t)rr * 1024 + k * 256 + lane * 4) = q; } } } }
  }
  xcd_barrier(xb);
  { PH_VARS
  { Gemm g{(const bf16_t*)(ws + OFF_XB), (const bf16_t*)(ws + OFF_WGUT), 1024}; StaticOrder S; S.init(T, 5632); EpiSwiglu E{(bf16_t*)(ws + OFF_H), 2816, 1 << 20, 0}; gemm_phase(lds, g, S, E); }
  }
  xcd_barrier(xb);
  { Gemm g{(const bf16_t*)(ws + OFF_H), (const bf16_t*)(ws + OFF_WDT), 2816}; StaticOrder S; S.init(T, 1024); EpiResid E{X}; gemm_phase(lds, g, S, E); }
  xcd_barrier(xb);
  { PH_VARS
  for (int row = gw; row < T; row += 2 * nw) { const int rw1 = (row + nw < T) ? row + nw : row; f32x4 oo[2][4]; ln_row2(X + (size_t)row * 1024, X + (size_t)rw1 * 1024, INP(31), INP(32), lane, oo[0], oo[1]);
#pragma unroll
    for (int h = 0; h < 2; ++h)
#pragma unroll
      for (int k = 0; k < 4; ++k) *(f32x4*)(X + (size_t)(h ? rw1 : row) * 1024 + k * 256 + lane * 4) = oo[h][k]; }
  }
  xcd_barrier(xb);
  { PH_VARS
  { bf16_t* xb2 = (bf16_t*)(ws + OFF_XB2);
    for (int row = gw; row < T; row += nw) {
      const int s0 = row < 16384 ? (row & ~8191) : 16384 + ((row - 16384) & ~4095), len = row < 16384 ? 8192 : 4096;
      const bool hm = row > s0, hp = row < s0 + len - 1;
#pragma unroll
      for (int k = 0; k < 4; ++k) { const size_t off = (size_t)row * 1024 + k * 256 + lane * 4; const f32x4 x = *(const f32x4*)(X + off);
        const f32x4 xm = hm ? *(const f32x4*)(X + off - 1024) : (f32x4){0.f, 0.f, 0.f, 0.f}, xp = hp ? *(const f32x4*)(X + off + 1024) : (f32x4){0.f, 0.f, 0.f, 0.f};
        const f32x4 xx = (xm + xp) * 0.5f - x; u32x2 a, b; a[0] = cvt_pk_bf16(x[0], x[1]); a[1] = cvt_pk_bf16(x[2], x[3]); b[0] = cvt_pk_bf16(xx[0], xx[1]); b[1] = cvt_pk_bf16(xx[2], xx[3]);
        bf16_t* dp = xb2 + (size_t)row * 2048 + k * 256 + lane * 4; *(u32x2*)dp = a; *(u32x2*)(dp + 1024) = b; } } }
  }
  xcd_barrier(xb);
  { PH_VARS
  { Gemm g{(const bf16_t*)(ws + OFF_XB2), (const bf16_t*)(ws + OFF_WRT), 2048}; StaticOrder S; S.init(T, 3584); EpiRwkv E{(bf16_t*)(ws + OFF_RKV), (bf16_t*)(ws + OFF_LBWA), (bf16_t*)(ws + OFF_LBG)}; gemm_phase(lds, g, S, E); }
  }
  xcd_barrier(xb);
  { PH_VARS
  { LAS float* L = (LAS float*)lds; const int b = blockIdx.x;
    for (int round = 0; round < 320; ++round) {
      int cA, mA = 0, rA = 0, cB = -1;
      if (G == 256) { if (round > 0) break; if (b < 128) { cA = b >> 1; mA = 1; rA = (b & 1) * 32; } else { cA = 64 + (b - 128) * 2; cB = cA + 1; } }
      else { cA = b + round * G; if (cA >= 320) break; }
      scan_block(ws, L, cA, mA, rA, cB, 0, 0);
    }
  }
  }
  xcd_barrier(xb);
  { PH_VARS
  { bf16_t* yf = (bf16_t*)(ws + OFF_YF); const bf16_t* yb = (const bf16_t*)(ws + OFF_YB); const bf16_t* rkv = (const bf16_t*)(ws + OFF_RKV); const float* bonus = (const float*)(ws + OFF_BONUS);
    for (int row = gw; row < T; row += nw) {
      const size_t off = (size_t)row * 1024 + lane * 16; const u32x4 a0 = *(const u32x4*)(yf + off), a1 = *(const u32x4*)(yf + off + 8), b0 = *(const u32x4*)(yb + off), b1 = *(const u32x4*)(yb + off + 8);
      const u32x4 v0 = *(const u32x4*)(rkv + (size_t)row * 3072 + 2048 + lane * 16), v1 = *(const u32x4*)(rkv + (size_t)row * 3072 + 2048 + lane * 16 + 8);
      float y[16], vv[16]; float s = 0.f;
#pragma unroll
      for (int j = 0; j < 4; ++j) { y[2 * j] = bflo(a0[j]) + bflo(b0[j]); y[2 * j + 1] = bfhi(a0[j]) + bfhi(b0[j]); y[8 + 2 * j] = bflo(a1[j]) + bflo(b1[j]); y[8 + 2 * j + 1] = bfhi(a1[j]) + bfhi(b1[j]);
        vv[2 * j] = bflo(v0[j]); vv[2 * j + 1] = bfhi(v0[j]); vv[8 + 2 * j] = bflo(v1[j]); vv[8 + 2 * j + 1] = bfhi(v1[j]); }
#pragma unroll
      for (int j = 0; j < 16; ++j) s += y[j];
      const float mean = red4(s) * (1.f / 64.f); float q = 0.f;
#pragma unroll
      for (int j = 0; j < 16; ++j) { y[j] -= mean; q += y[j] * y[j]; }
      const float rstd = rsqrtf(red4(q) * (1.f / 64.f) + 64e-5f);
      const float* bp = bonus + ((size_t)row * 16 + (lane >> 2)) * 2; const float bsum = bp[0] + bp[1];
      u32x4 o0, o1;
#pragma unroll
      for (int j = 0; j < 4; ++j) { const f32x4 gg = *(const f32x4*)(INP(21) + lane * 16 + j * 4), bb = *(const f32x4*)(INP(22) + lane * 16 + j * 4); float t[4];
#pragma unroll
        for (int e = 0; e < 4; ++e) t[e] = y[j * 4 + e] * rstd * gg[e] + bb[e] + bsum * vv[j * 4 + e];
        const unsigned lo = cvt_pk_bf16(t[0], t[1]), hi = cvt_pk_bf16(t[2], t[3]);
        if (j < 2) { o0[2 * j] = lo; o0[2 * j + 1] = hi; } else { o1[2 * (j - 2)] = lo; o1[2 * (j - 2) + 1] = hi; } }
      *(u32x4*)(yf + off) = o0; *(u32x4*)(yf + off + 8) = o1; } }
  }
  xcd_barrier(xb);
  { PH_VARS
  { Gemm g{(const bf16_t*)(ws + OFF_LBG), (const bf16_t*)(ws + OFF_G2T), 256}; StaticOrder S; S.init(T, 1024); EpiMulPre E{(bf16_t*)(ws + OFF_YF)}; gemm_phase(lds, g, S, E); }
  }
  xcd_barrier(xb);
  { PH_VARS
  { Gemm g{(const bf16_t*)(ws + OFF_YF), (const bf16_t*)(ws + OFF_RWOT), 1024}; StaticOrder S; S.init(T, 1024); EpiResid E{X}; gemm_phase(lds, g, S, E); }
  }
  xcd_barrier(xb);
  { PH_VARS
  { bf16_t* xb = (bf16_t*)(ws + OFF_XBM); int* cnt = (int*)(ws + OFF_CNT); int* tokE = (int*)(ws + OFF_TOKE); float* tokG = (float*)(ws + OFF_TOKG); int* tokP = (int*)(ws + OFF_TOKP);
    const float* wr = INP(24); const float* br = INP(25);
    LAS int* lc = (LAS int*)(lds + 100000);
    if (tid < 16) lc[tid] = 0;
    __syncthreads();
    for (int row = gw; row < T; row += nw) { f32x4 o[4]; ln_row(X + (size_t)row * 1024, INP(29) + 1024, INP(30) + 1024, lane, o);
      float lg[8];
#pragma unroll
      for (int e = 0; e < 8; ++e) lg[e] = 0.f;
#pragma unroll
      for (int k = 0; k < 4; ++k) {
#pragma unroll
        for (int j = 0; j < 4; ++j) { const float* wp = wr + (size_t)(k * 256 + lane * 4 + j) * 8; const f32x4 wa = *(const f32x4*)wp, wb = *(const f32x4*)(wp + 4); const float xv = o[k][j];
          lg[0] += xv * wa[0]; lg[1] += xv * wa[1]; lg[2] += xv * wa[2]; lg[3] += xv * wa[3]; lg[4] += xv * wb[0]; lg[5] += xv * wb[1]; lg[6] += xv * wb[2]; lg[7] += xv * wb[3]; }
        *(f32x4*)(X + (size_t)row * 1024 + k * 256 + lane * 4) = o[k] * ALPHA; u32x2 q; q[0] = cvt_pk_bf16(o[k][0], o[k][1]); q[1] = cvt_pk_bf16(o[k][2], o[k][3]); *(u32x2*)(xb + (size_t)row * 1024 + k * 256 + lane * 4) = q; }
#pragma unroll
      for (int e = 0; e < 8; ++e) lg[e] = wave_sum(lg[e]) + br[e];
      int e0 = 0; float v0 = lg[0];
#pragma unroll
      for (int e = 1; e < 8; ++e) if (lg[e] > v0) { v0 = lg[e]; e0 = e; }
      int e1 = -1; float v1 = -3.0e38f;
#pragma unroll
      for (int e = 0; e < 8; ++e) if (e != e0 && lg[e] > v1) { v1 = lg[e]; e1 = e; }
      if (lane == 0) { const float ex = __expf(v1 - v0), g0 = 1.f / (1.f + ex), g1 = ex * g0;
        const int p0 = __hip_atomic_fetch_add(lc + e0, 1, __ATOMIC_RELAXED, __HIP_MEMORY_SCOPE_WORKGROUP), p1 = __hip_atomic_fetch_add(lc + 8 + e1, 1, __ATOMIC_RELAXED, __HIP_MEMORY_SCOPE_WORKGROUP);
        tokE[row * 2] = e0; tokE[row * 2 + 1] = e1; tokG[row * 2] = g0; tokG[row * 2 + 1] = g1; tokP[row * 2] = p0; tokP[row * 2 + 1] = p1; } }
    __syncthreads();
    if (tid < 16) lc[16 + tid] = atomicAdd(cnt + tid, lc[tid]);
    __syncthreads();
    if (lane < 2) for (int row = gw; row < T; row += nw) tokP[row * 2 + lane] += lc[16 + lane * 8 + tokE[row * 2 + lane]];
    __syncthreads();
    int rot = 0; float* tile = (float*)shm;
    for (int e = 0; e < 8; ++e) {
      rot = cvt_run(mkjob(INP(26) + (size_t)e * 1024 * 3584, 3584, 1024, 3584, (bf16_t*)(ws + OFF_WMGU) + (size_t)e * 7168 * 1024, 1024, 0, 0, nullptr, 1.f, 1), tile, rot);
      rot = cvt_run(mkjob(INP(27) + (size_t)e * 1024 * 3584, 3584, 1024, 3584, (bf16_t*)(ws + OFF_WMGU) + (size_t)e * 7168 * 1024, 1024, 128, 0, nullptr, 1.f, 1), tile, rot);
      rot = cvt_run(mkjob(INP(28) + (size_t)e * 3584 * 1024, 1024, 3584, 1024, (bf16_t*)(ws + OFF_WMD) + (size_t)e * 1024 * 3584, 3584, 0, 0, nullptr, 1.f, 0), tile, rot);
    }
  }
  }
  xcd_barrier(xb);
  { PH_VARS
  { const int* cnt = (const int*)(ws + OFF_CNT);
    __syncthreads();
    if (tid == 0) { int a = 0; for (int k = 0; k < 16; ++k) { TS[k] = a; a += (cnt[k] + 255) >> 8; } TS[16] = a; }
    __syncthreads();
    const int* tokE = (const int*)(ws + OFF_TOKE); const float* tokG = (const float*)(ws + OFF_TOKG); const int* tokP = (const int*)(ws + OFF_TOKP);
    int* rowl = (int*)(ws + OFF_ROWL); float* rowg = (float*)(ws + OFF_ROWG); const bf16_t* xb = (const bf16_t*)(ws + OFF_XBM); bf16_t* xs = (bf16_t*)(ws + OFF_XS);
    for (int pr0 = gw; pr0 < T * 2; pr0 += 4 * nw) { u32x4 va[4], vb[4]; int rows[4];
#pragma unroll
      for (int u = 0; u < 4; ++u) { const int pr = pr0 + u * nw; rows[u] = -1; if (pr < T * 2) { const int tok = pr >> 1, rk = pr & 1; const int e = tokE[pr]; const int row = TS[rk * 8 + e] * 256 + tokP[pr]; rows[u] = row;
        if (lane == 0) { rowl[row] = tok; rowg[row] = tokG[pr]; }
        const u32x4* sp = (const u32x4*)(xb + (size_t)tok * 1024); va[u] = sp[lane]; vb[u] = sp[lane + 64]; } }
#pragma unroll
      for (int u = 0; u < 4; ++u) if (rows[u] >= 0) { u32x4* dp = (u32x4*)(xs + (size_t)rows[u] * 1024); dp[lane] = va[u]; dp[lane + 64] = vb[u]; } }
  }
  }
  xcd_barrier(xb);
  { PH_VARS
  { const int ts8 = TS[8], ts16 = TS[16];
    for (int rk = 0; rk < 2; ++rk) { const int t0 = rk ? ts8 : 0, t1 = rk ? ts16 : ts8;
      for (int cs = t0; cs < t1; cs += MOE_CHUNK) { const int ntile = (t1 - cs) < MOE_CHUNK ? (t1 - cs) : MOE_CHUNK;
        { Gemm g{(const bf16_t*)(ws + OFF_XS), (const bf16_t*)(ws + OFF_WMGU), 1024}; MoeOrder<28> S{cs, ntile, G, (int)blockIdx.x, TS}; EpiSwiglu E{(bf16_t*)(ws + OFF_HID), 3584, 28, cs * 256}; gemm_phase(lds, g, S, E); }
        xcd_barrier(xb);
        { Gemm g{(const bf16_t*)(ws + OFF_HID), (const bf16_t*)(ws + OFF_WMD), 3584}; MoeDownOrder S{cs, ntile, G, (int)blockIdx.x, TS}; EpiMoeDown E{X, (const int*)(ws + OFF_ROWL), (const float*)(ws + OFF_ROWG), cs * 256}; gemm_phase(lds, g, S, E); }
        xcd_barrier(xb);
      } }
  }
  }
  { PH_VARS
  for (int row = gw; row < T; row += 2 * nw) { const int rw1 = (row + nw < T) ? row + nw : row; f32x4 oo[2][4]; ln_row2(X + (size_t)row * 1024, X + (size_t)rw1 * 1024, INP(31) + 1024, INP(32) + 1024, lane, oo[0], oo[1]);
#pragma unroll
    for (int h = 0; h < 2; ++h)
#pragma unroll
      for (int k = 0; k < 4; ++k) *(f32x4*)(X + (size_t)(h ? rw1 : row) * 1024 + k * 256 + lane * 4) = oo[h][k]; }
  }
}

extern "C" void kernel_launch(void* const* d_in, const int* in_sizes, int n_in, void* d_out, int out_size, void* d_ws, size_t ws_size, hipStream_t stream) {
  static int grid_blocks = 0;
  if (!grid_blocks) {
    int dev = 0, cus = 0, per_cu = 0;
    (void)hipGetDevice(&dev);
    (void)hipDeviceGetAttribute(&cus, hipDeviceAttributeMultiprocessorCount, dev);
    (void)hipFuncSetAttribute((const void*)mega, hipFuncAttributeMaxDynamicSharedMemorySize, LDS_BYTES);
    (void)hipOccupancyMaxActiveBlocksPerMultiprocessor(&per_cu, mega, 512, LDS_BYTES);
    if (per_cu > 1) per_cu = 1;
    grid_blocks = cus * per_cu;
    if (ws_size < WS_NEED) fprintf(stderr, "workspace too small: %zu < %zu\n", ws_size, (size_t)WS_NEED);
  }
  Params p{};
  for (int i = 0; i < 33; ++i) p.in[i] = (const float*)d_in[i];
  p.X = (float*)d_out; p.ws = (unsigned char*)d_ws;
  void* args[] = {&p};
  hipError_t e = hipLaunchCooperativeKernel((void*)mega, dim3(grid_blocks), dim3(512), args, LDS_BYTES, stream);
  if (e != hipSuccess) fprintf(stderr, "cooperative launch failed: %s (grid %d)\n", hipGetErrorString(e), grid_blocks);
}
```

```cpp
#include <hip/hip_runtime.h>
#include <hip/hip_cooperative_groups.h>
#include <cstdio>
namespace cg = cooperative_groups;

#define LAS __attribute__((address_space(3)))
typedef unsigned short bf16_t;
typedef short bf16x8 __attribute__((ext_vector_type(8)));
typedef float f32x4 __attribute__((ext_vector_type(4)));
typedef float f32x16 __attribute__((ext_vector_type(16)));
typedef unsigned u32x4 __attribute__((ext_vector_type(4)));
typedef unsigned u32x2 __attribute__((ext_vector_type(2)));

constexpr int T = 49152, D = 1024;
constexpr float ALPHA = 1.41421356237309515f;
constexpr size_t SZ = (size_t)T * 1024 * 2;
constexpr size_t OFF_WRT = 0;
constexpr size_t OFF_W2T = OFF_WRT + 14680064;
constexpr size_t OFF_G2T = OFF_W2T + 524288;
constexpr size_t OFF_RWOT = OFF_G2T + 524288;
constexpr size_t OFF_CNT = OFF_RWOT + 2097152;
constexpr size_t OFF_TOKE = OFF_CNT + 256;
constexpr size_t OFF_TOKG = OFF_TOKE + 393216;
constexpr size_t OFF_TOKP = OFF_TOKG + 393216;
constexpr size_t OFF_ROWL = OFF_TOKP + 393216;
constexpr size_t OFF_ROWG = OFF_ROWL + 409600;
constexpr size_t OFF_BONUS = OFF_ROWG + 409600;
constexpr size_t OFF_BAR = OFF_BONUS + 6291456;
constexpr size_t BIG = 26214400;
constexpr size_t OFF_XB = BIG, OFF_QK = BIG + SZ, OFF_VT = BIG + 3 * SZ, OFF_O = BIG + 4 * SZ;
constexpr size_t OFF_WQKT = BIG + 5 * SZ, OFF_WVT = OFF_WQKT + 4194304, OFF_WOT = OFF_WVT + 2097152, OFF_WGUT = OFF_WOT + 2097152, OFF_WDT = OFF_WGUT + 11534336;
constexpr size_t OFF_EB = OFF_WDT + 5767168;
constexpr size_t OFF_H = BIG + SZ;
constexpr size_t OFF_XB2 = BIG, OFF_RKV = BIG + 2 * SZ, OFF_LBWA = BIG + 5 * SZ, OFF_LBG = OFF_LBWA + 25165824;
constexpr size_t OFF_YF = BIG, OFF_YB = BIG + SZ;
constexpr size_t OFF_WMGU = BIG, OFF_WMD = BIG + 117440512, OFF_XS = BIG + 176160768, OFF_XBM = OFF_XS + 209715200, OFF_HID = OFF_XBM;
constexpr size_t WS_NEED = OFF_HID + 183500800;
constexpr int MOE_CHUNK = 100;
constexpr int LDS_BYTES = 131072 + 512;

struct Params { const float* in[33]; float* X; unsigned char* ws; };
extern __shared__ __attribute__((aligned(16))) unsigned char shm[];
constexpr int LDS_TS = 131072, LDS_TAB = 131072 + 128;
__device__ __forceinline__ const float* INP(int i) {
  const LAS unsigned* tab = (const LAS unsigned*)((LAS unsigned char*)shm + LDS_TAB);
  const unsigned lo = __builtin_amdgcn_readfirstlane(tab[2 * i]), hi = __builtin_amdgcn_readfirstlane(tab[2 * i + 1]);
  return (const float*)(((unsigned long long)hi << 32) | lo);
}

__device__ __forceinline__ int tid_() { int t = threadIdx.x; asm volatile("" : "+v"(t)); return t; }
__device__ __forceinline__ unsigned cvt_pk_bf16(float lo, float hi) { unsigned r; asm("v_cvt_pk_bf16_f32 %0, %1, %2" : "=v"(r) : "v"(lo), "v"(hi)); return r; }
__device__ __forceinline__ bf16_t f2bf(float f) { return (bf16_t)(cvt_pk_bf16(f, 0.f) & 0xffffu); }
__device__ __forceinline__ float bflo(unsigned u) { return __uint_as_float(u << 16); }
__device__ __forceinline__ float bfhi(unsigned u) { return __uint_as_float(u & 0xffff0000u); }
__device__ __forceinline__ float wave_sum(float v) { for (int o = 32; o; o >>= 1) v += __shfl_xor(v, o); return v; }
template <int CTRL> __device__ __forceinline__ float dppf(float v) { return __builtin_bit_cast(float, __builtin_amdgcn_mov_dpp(__builtin_bit_cast(int, v), CTRL, 0xf, 0xf, true)); }
__device__ __forceinline__ float red4(float v) { v += dppf<0xB1>(v); v += dppf<0x4E>(v); return v; }
__device__ __forceinline__ float red8(float v) { v = red4(v); v += dppf<0x141>(v); return v; }
__device__ __forceinline__ float red16(float v) { v = red8(v); v += dppf<0x140>(v); return v; }
__device__ __forceinline__ float sigmoidf_(float x) { return __builtin_amdgcn_rcpf(1.f + __expf(-x)); }


#define XB_TMO      128
#define XB_XCNT(j)  (256  + 64 * (j))
#define XB_XSUB(j)  (1280 + 64 * (j))
#define XB_XGEN(j)  (2304 + 64 * (j))
#define XB_TOP      3328
#define XB_TOPGEN   3392
#define XCD_BAR_WORDS 3456
#define XB_SPIN_CAP (1u << 18)
__device__ __forceinline__ unsigned xb_ld(unsigned* p)              { return __hip_atomic_load(p, __ATOMIC_RELAXED, __HIP_MEMORY_SCOPE_AGENT); }
__device__ __forceinline__ unsigned xb_add(unsigned* p, unsigned v) { return __hip_atomic_fetch_add(p, v, __ATOMIC_RELAXED, __HIP_MEMORY_SCOPE_AGENT); }
__device__ __forceinline__ unsigned xb_xcc_id() { return (unsigned)__builtin_amdgcn_s_getreg((3 << 11) | 20) & 0xFu; }
#define XB_SPIN(cond, bar) do { unsigned _sp = 0; while (cond) { __builtin_amdgcn_s_sleep(1); \
    if ((++_sp & 255u) == 0u) { if (xb_ld(&(bar)[XB_TMO])) break; if (_sp > XB_SPIN_CAP) { atomicAdd(&(bar)[XB_TMO], 1u); break; } } } } while (0)
struct XcdBarrier { unsigned* bar; unsigned x; volatile LAS unsigned* st; };
__device__ __forceinline__ XcdBarrier xcd_barrier_post(unsigned* bar, volatile LAS unsigned* st) {
  XcdBarrier b; b.bar = bar; b.x = xb_xcc_id(); b.st = st;
  if (threadIdx.x == 0) (void)xb_add(&bar[XB_XCNT(b.x)], 1u);
  return b;
}
__device__ __forceinline__ void xcd_barrier_complete(unsigned* bar, unsigned x, unsigned& nloc, unsigned& nx) {
  const unsigned G = gridDim.x * gridDim.y * gridDim.z;
  unsigned sum, cnt, mine, sp = 0u;
  for (;;) {
    sum = 0u; cnt = 0u; mine = 0u;
#pragma unroll
    for (unsigned j = 0; j < 16; ++j) { const unsigned c = xb_ld(&bar[XB_XCNT(j)]); sum += c; cnt += (c > 0u) ? 1u : 0u; mine = (j == x) ? c : mine; }
    if (sum == G) break;
    __builtin_amdgcn_s_sleep(1);
    if ((++sp & 255u) == 0u) { if (xb_ld(&bar[XB_TMO])) break; if (sp > XB_SPIN_CAP) { atomicAdd(&bar[XB_TMO], 1u); break; } }
  }
  nloc = mine > 0u ? mine : 1u; nx = cnt > 0u ? cnt : 1u;
}
__device__ __forceinline__ void xcd_barrier(const XcdBarrier& b) {
  asm volatile("s_waitcnt vmcnt(0)" ::: "memory");
  __syncthreads();
  if (threadIdx.x == 0) {
    unsigned* bar = b.bar;
    __builtin_amdgcn_s_waitcnt(0);
    unsigned nloc = b.st[0], nx = b.st[1];
    if (nloc == 0u) { xcd_barrier_complete(bar, b.x, nloc, nx); b.st[0] = nloc; b.st[1] = nx; }
    const unsigned old = xb_add(&bar[XB_XSUB(b.x)], 1u);
    const unsigned gen = old / nloc;
    if (old + 1u == (gen + 1u) * nloc) {
      __builtin_amdgcn_fence(__ATOMIC_RELEASE, "agent");
      asm volatile("s_waitcnt vmcnt(0)" ::: "memory");
      const unsigned og = xb_add(&bar[XB_TOP], 1u);
      const unsigned tg = og / nx;
      if (og + 1u == (tg + 1u) * nx) xb_add(&bar[XB_TOPGEN], 1u);
      else XB_SPIN(xb_ld(&bar[XB_TOPGEN]) == tg, bar);
      __builtin_amdgcn_fence(__ATOMIC_ACQUIRE, "agent");
      xb_add(&bar[XB_XGEN(b.x)], 1u);
      asm volatile("s_waitcnt vmcnt(0)" ::: "memory");
    } else {
      XB_SPIN(xb_ld(&bar[XB_XGEN(b.x)]) == gen, bar);
      __builtin_amdgcn_fence(__ATOMIC_ACQUIRE, "agent");
      asm volatile("s_waitcnt vmcnt(0)" ::: "memory");
    }
  }
  __syncthreads();
}

struct CvtJob { const float* src; int ldsrc, K, N; bf16_t* dst; int lddst, row0, col0; const float* kscale; float scale; int mode; };
__device__ __forceinline__ CvtJob mkjob(const float* src, int ldsrc, int K, int N, bf16_t* dst, int lddst, int row0, int col0, const float* kscale, float scale, int mode) {
  CvtJob j; j.src = src; j.ldsrc = ldsrc; j.K = K; j.N = N; j.dst = dst; j.lddst = lddst; j.row0 = row0; j.col0 = col0; j.kscale = kscale; j.scale = scale; j.mode = mode; return j; }
__device__ __forceinline__ int cvt_run(const CvtJob J, float* tile, int rot) {
  const int tk = (J.K + 63) >> 6, tn = (J.N + 63) >> 6, nt = tk * tn, G = gridDim.x;
  const int tx = tid_() & 63, ty = tid_() >> 6;
  int start = (int)blockIdx.x - rot; if (start < 0) start += G;
  for (int t0 = start; t0 < nt; t0 += 4 * G) {
    float v[4][8];
#pragma unroll
    for (int q = 0; q < 4; ++q) { const int t = t0 + q * G; const int k0 = (t / tn) * 64, n0 = (t % tn) * 64;
#pragma unroll
      for (int r = 0; r < 8; ++r) { const int k = k0 + r * 8 + ty, n = n0 + tx; v[q][r] = 0.f;
        if (t < nt && J.src && k < J.K && n < J.N) v[q][r] = J.src[(size_t)k * J.ldsrc + n]; } }
    __syncthreads();
#pragma unroll
    for (int q = 0; q < 4; ++q) { const int t = t0 + q * G; const int k0 = (t / tn) * 64;
#pragma unroll
      for (int r = 0; r < 8; ++r) { const int kk = r * 8 + ty; float x = v[q][r] * J.scale; if (J.kscale && t < nt && k0 + kk < J.K) x *= J.kscale[k0 + kk]; tile[q * 4160 + kk * 65 + tx] = x; } }
    __syncthreads();
#pragma unroll
    for (int q = 0; q < 4; ++q) { const int t = t0 + q * G; const int k0 = (t / tn) * 64, n0 = (t % tn) * 64;
#pragma unroll
      for (int r = 0; r < 8; ++r) { const int nn = r * 8 + ty, n = n0 + nn, k = k0 + tx;
        if (t < nt && n < J.N && k < J.K) { const int row = J.mode ? ((n >> 7) * 256 + (n & 127)) : n;
          J.dst[(size_t)(J.row0 + row) * J.lddst + J.col0 + k] = f2bf(tile[q * 4160 + tx * 65 + nn]); } } }
  }
  return (rot + nt) % G;
}

constexpr int BM = 256, BK = 64, HALF = 128, HTB = HALF * BK * 2, NXCD = 8, WGM = 8;
__device__ __forceinline__ int lds_byte(int r, int c) { const int st = (r >> 4) * 2 + (c >> 5), rr = r & 15, cc = c & 31, ob = rr * 64 + cc * 2; return st * 1024 + (ob ^ (((ob >> 9) & 1) << 5)); }
__device__ __forceinline__ void stage_rc(int b, int& R, int& C) { const int st = b / 1024, sb = b % 1024, swz = sb ^ (((sb >> 9) & 1) << 5); R = (st >> 1) * 16 + swz / 64; C = (st & 1) * 32 + (swz % 64) / 2; }
__device__ __forceinline__ int perm32(int rho) { const int n = rho >> 4, i = rho & 15; return 8 * (i >> 2) + 4 * n + (i & 3); }
struct Unit { int pm, pn; };
struct Gemm { const bf16_t* A; const bf16_t* Bt; int K; };
struct StaticOrder {
  int nM, nN, nwg, G, c;
  __device__ void init(int M, int N) { nM = M / BM; nN = N / BM; nwg = nM * nN; G = gridDim.x; c = blockIdx.x; }
  __device__ bool next(int i, Unit& u) const {
    const long L = (long)i * G + c; if (L >= nwg) return false;
    int wgid = (int)L; { const int q = nwg / NXCD, r = nwg % NXCD, xcd = wgid % NXCD, off = wgid / NXCD; wgid = (xcd < r ? xcd * (q + 1) : r * (q + 1) + (xcd - r) * q) + off; }
    const int nig = WGM * nN, gid = wgid / nig, fm = gid * WGM, gsz = (nM - fm) < WGM ? (nM - fm) : WGM;
    u.pm = fm + ((wgid % nig) % gsz); u.pn = (wgid % nig) / gsz; return true;
  }
};
template <int NC> struct MoeOrder {
  int first, ntile, G, c; const LAS int* ts;
  __device__ bool next(int i, Unit& u) const {
    const long L = (long)i * G + c; if (L >= (long)ntile * NC) return false;
    const int l = (int)L, nig = WGM * NC, gid = l / nig, fm = gid * WGM, gsz = (ntile - fm) < WGM ? (ntile - fm) : WGM;
    const int pm = first + fm + ((l % nig) % gsz), pn = (l % nig) / gsz;
    int g = 0;
#pragma unroll
    for (int k = 1; k < 16; ++k) g += (pm >= ts[k]) ? 1 : 0;
    u.pm = pm; u.pn = (g & 7) * NC + pn; return true;
  }
};

template <class Epi, class Sched>
__device__ __forceinline__ void gemm_phase(LAS unsigned char* lds, const Gemm g, const Sched& S, const Epi& E) {
  const int tid = tid_(), wid = __builtin_amdgcn_readfirstlane(tid >> 6), lane = tid & 63, wr = wid >> 2, wc = wid & 3, fr = lane & 15, fq = lane >> 4;
  const int K = g.K, nt = K / BK;
  unsigned voffA[2], voffB[2];
#pragma unroll
  for (int i = 0; i < 2; ++i) { int R, C; stage_rc(tid * 16 + i * 8192, R, C); const int Rb = Epi::PERM ? ((R & ~31) + perm32(R & 31)) : R;
    voffA[i] = (unsigned)(R * K + C) * 2u; voffB[i] = (unsigned)(Rb * K + C) * 2u; }
  const size_t kstep = (size_t)(BK * 2);
  const size_t hstep = (size_t)HALF * K * 2;
  const size_t tstep = 2 * hstep;
  const unsigned ldsw = (unsigned)wid * 1024u;
  const int aoff = lds_byte(wr * 64 + fr, fq * 8), boff = lds_byte(wc * 32 + fr, fq * 8);
#define PG8_SA(b, h) (((b) * 2 + (h)) * HTB)
#define PG8_SB(b, h) ((4 + (b) * 2 + (h)) * HTB)
#define PG8_STAGE(bufoff, gbase, voff) do { _Pragma("unroll") for (int _i = 0; _i < 2; ++_i) \
    __builtin_amdgcn_global_load_lds((const unsigned*)((const char*)(gbase) + (voff)[_i]), (LAS unsigned*)(lds + (bufoff) + ldsw + _i * 8192), 16, 0, 0); } while (0)
#define PG8_LDA(dst, b, h) do { _Pragma("unroll") for (int m = 0; m < 4; ++m) _Pragma("unroll") for (int k = 0; k < 2; ++k) dst[m][k] = *(const LAS bf16x8*)(lds + PG8_SA(b, h) + aoff + m * 2048 + k * 1024); } while (0)
#define PG8_LDB(dst, b, h) do { _Pragma("unroll") for (int n = 0; n < 2; ++n) _Pragma("unroll") for (int k = 0; k < 2; ++k) dst[n][k] = *(const LAS bf16x8*)(lds + PG8_SB(b, h) + boff + n * 2048 + k * 1024); } while (0)
#define PG8_MMA(ai, bj, At, Bt) do { __builtin_amdgcn_s_setprio(1); _Pragma("unroll") for (int m = 0; m < 4; ++m) _Pragma("unroll") for (int n = 0; n < 2; ++n) _Pragma("unroll") for (int k = 0; k < 2; ++k) \
    acc[ai][bj][m][n] = __builtin_amdgcn_mfma_f32_16x16x32_bf16(Bt[n][k], At[m][k], acc[ai][bj][m][n], 0, 0, 0); __builtin_amdgcn_s_setprio(0); } while (0)
#define PG8_WAIT_V(n) asm volatile("s_waitcnt vmcnt(" #n ")" ::: "memory")
#define PG8_WAIT_L(n) asm volatile("s_waitcnt lgkmcnt(" #n ")" ::: "memory")
#define PG8_BAR __builtin_amdgcn_s_barrier()
#define PG8_SCHED __builtin_amdgcn_sched_barrier(0)
  Unit cur, nxt; int ui = 0;
  if (!S.next(0, cur)) return;
  f32x4 acc[2][2][4][2];
#pragma unroll
  for (int a = 0; a < 2; ++a)
#pragma unroll
    for (int b = 0; b < 2; ++b)
#pragma unroll
      for (int m = 0; m < 4; ++m)
#pragma unroll
        for (int n = 0; n < 2; ++n) acc[a][b][m][n] = (f32x4){0.f, 0.f, 0.f, 0.f};
  bf16x8 At[4][2], B0[2][2], B1[2][2];
  const char* cA = (const char*)g.A + (size_t)cur.pm * tstep; const char* cB = (const char*)g.Bt + (size_t)cur.pn * tstep;
  PG8_STAGE(PG8_SB(0, 0), cB, voffB); PG8_STAGE(PG8_SA(0, 0), cA, voffA); PG8_STAGE(PG8_SB(0, 1), cB + hstep, voffB); PG8_STAGE(PG8_SA(0, 1), cA + hstep, voffA);
  if (wr == 1) PG8_BAR;
  PG8_WAIT_V(4); PG8_BAR;
  PG8_STAGE(PG8_SB(1, 0), cB + kstep, voffB); PG8_STAGE(PG8_SA(1, 0), cA + kstep, voffA); PG8_STAGE(PG8_SB(1, 1), cB + hstep + kstep, voffB);
  PG8_WAIT_V(6); PG8_BAR;
  for (;;) {
    const bool has_next = S.next(ui + 1, nxt);
    const char* nA = has_next ? (const char*)g.A + (size_t)nxt.pm * tstep : cA; const char* nB = has_next ? (const char*)g.Bt + (size_t)nxt.pn * tstep : cB;
    for (int t = 0; t < nt; t += 2) {
      const bool last = (t == nt - 2);
      const char* a1 = cA + (size_t)(t + 1) * kstep;
      const char* a2 = last ? nA : cA + (size_t)(t + 2) * kstep; const char* b2 = last ? nB : cB + (size_t)(t + 2) * kstep;
      const char* a3 = a2 + kstep; const char* b3 = b2 + kstep;
      PG8_LDB(B0, 0, 0); PG8_SCHED; PG8_LDA(At, 0, 0); PG8_STAGE(PG8_SA(1, 1), a1 + hstep, voffA);
      PG8_WAIT_L(8); PG8_BAR; PG8_WAIT_L(0); PG8_MMA(0, 0, At, B0); PG8_BAR; PG8_SCHED;
      PG8_LDB(B1, 0, 1); PG8_STAGE(PG8_SB(0, 0), b2, voffB);
      PG8_BAR; PG8_WAIT_L(0); PG8_MMA(0, 1, At, B1); PG8_BAR;
      PG8_LDA(At, 0, 1); PG8_STAGE(PG8_SA(0, 0), a2, voffA);
      PG8_BAR; PG8_WAIT_L(0); PG8_MMA(1, 0, At, B0); PG8_BAR; PG8_SCHED;
      PG8_STAGE(PG8_SB(0, 1), b2 + hstep, voffB);
      PG8_WAIT_V(6); PG8_BAR; PG8_MMA(1, 1, At, B1); PG8_BAR;
      PG8_LDB(B0, 1, 0); PG8_SCHED; PG8_LDA(At, 1, 0); PG8_STAGE(PG8_SA(0, 1), a2 + hstep, voffA);
      PG8_WAIT_L(8); PG8_BAR; PG8_WAIT_L(0); PG8_MMA(0, 0, At, B0); PG8_BAR; PG8_SCHED;
      PG8_LDB(B1, 1, 1); PG8_STAGE(PG8_SB(1, 0), b3, voffB);
      PG8_BAR; PG8_WAIT_L(0); PG8_MMA(0, 1, At, B1); PG8_BAR;
      PG8_LDA(At, 1, 1); PG8_STAGE(PG8_SA(1, 0), a3, voffA);
      PG8_BAR; PG8_WAIT_L(0); PG8_MMA(1, 0, At, B0); PG8_BAR; PG8_SCHED;
      PG8_STAGE(PG8_SB(1, 1), b3 + hstep, voffB);
      PG8_WAIT_V(6); PG8_BAR; PG8_MMA(1, 1, At, B1); PG8_BAR;
    }
    E(acc, cur, wr, wc, fr, fq);
    if (!has_next) break;
#pragma unroll
    for (int a = 0; a < 2; ++a)
#pragma unroll
      for (int b = 0; b < 2; ++b)
#pragma unroll
        for (int m = 0; m < 4; ++m)
#pragma unroll
          for (int n = 0; n < 2; ++n) acc[a][b][m][n] = (f32x4){0.f, 0.f, 0.f, 0.f};
    cur = nxt; cA = nA; cB = nB; ++ui;
  }
  PG8_WAIT_V(0);
  if (wr == 0) PG8_BAR;
  PG8_BAR;
#undef PG8_SA
#undef PG8_SB
#undef PG8_STAGE
#undef PG8_LDA
#undef PG8_LDB
#undef PG8_MMA
#undef PG8_WAIT_V
#undef PG8_WAIT_L
#undef PG8_BAR
#undef PG8_SCHED
}

typedef f32x4 Acc[2][2][4][2];
__device__ __forceinline__ u32x4 pack8(f32x4 a, f32x4 b) { u32x4 o; o[0] = cvt_pk_bf16(a[0], a[1]); o[1] = cvt_pk_bf16(a[2], a[3]); o[2] = cvt_pk_bf16(b[0], b[1]); o[3] = cvt_pk_bf16(b[2], b[3]); return o; }

struct EpiStore {
  static constexpr bool PERM = true; bf16_t* O; int ldc;
  __device__ __forceinline__ void operator()(const Acc& acc, const Unit& u, int wr, int wc, int fr, int fq) const {
    const int row0 = u.pm * BM + wr * 64 + fr, col0 = u.pn * BM + wc * 32 + 8 * fq;
#pragma unroll
    for (int ai = 0; ai < 2; ++ai)
#pragma unroll
      for (int m = 0; m < 4; ++m) { bf16_t* rp = O + (size_t)(row0 + ai * HALF + m * 16) * ldc + col0;
#pragma unroll
        for (int bj = 0; bj < 2; ++bj) *(u32x4*)(rp + bj * HALF) = pack8(acc[ai][bj][m][0], acc[ai][bj][m][1]); }
  }
};
struct EpiQK2 {
  static constexpr bool PERM = true; bf16_t* O;
  __device__ __forceinline__ void operator()(const Acc& acc, const Unit& u, int wr, int wc, int fr, int fq) const {
    const int row0 = u.pm * BM + wr * 64 + fr, col0 = u.pn * BM + wc * 32 + 8 * fq;
#pragma unroll
    for (int ai = 0; ai < 2; ++ai)
#pragma unroll
      for (int m = 0; m < 4; ++m) { const int tok = row0 + ai * HALF + m * 16;
#pragma unroll
        for (int bj = 0; bj < 2; ++bj) { const int n = col0 + bj * HALF; const int which = n >> 10, h = (n >> 5) & 31, d = n & 31;
          *(u32x4*)(O + (size_t)which * ((size_t)T * 1024) + ((size_t)((tok >> 6) * 32 + h) * 64 + (tok & 63)) * 32 + d) = pack8(acc[ai][bj][m][0], acc[ai][bj][m][1]); } }
  }
};
struct EpiVT {
  static constexpr bool PERM = true; bf16_t* O;
  __device__ __forceinline__ void operator()(const Acc& acc, const Unit& u, int wr, int wc, int fr, int fq) const {
    const int row0 = u.pm * BM + wr * 64 + fr, col0 = u.pn * BM + wc * 32 + 8 * fq;
#pragma unroll
    for (int ai = 0; ai < 2; ++ai)
#pragma unroll
      for (int m = 0; m < 4; ++m) { const int ch = row0 + ai * HALF + m * 16;
#pragma unroll
        for (int bj = 0; bj < 2; ++bj) { const int tok = col0 + bj * HALF;
          *(u32x4*)(O + (size_t)(tok >> 6) * 65536 + (size_t)(((ch >> 5) * 8 + ((tok & 63) >> 3)) * 32 + (ch & 31)) * 8) = pack8(acc[ai][bj][m][0], acc[ai][bj][m][1]); } }
  }
};
struct EpiResid {
  static constexpr bool PERM = false; float* X;
  __device__ __forceinline__ void operator()(const Acc& acc, const Unit& u, int wr, int wc, int fr, int fq) const {
    const int row0 = u.pm * BM + wr * 64 + fr, col0 = u.pn * BM + wc * 32 + 4 * fq;
#pragma unroll
    for (int ai = 0; ai < 2; ++ai)
#pragma unroll
      for (int m = 0; m < 4; ++m) { float* rp = X + (size_t)(row0 + ai * HALF + m * 16) * 1024 + col0;
#pragma unroll
        for (int bj = 0; bj < 2; ++bj)
#pragma unroll
          for (int n = 0; n < 2; ++n) { f32x4* q = (f32x4*)(rp + bj * HALF + n * 16); *q = *q * ALPHA + acc[ai][bj][m][n]; } __builtin_amdgcn_sched_barrier(0); }
  }
};
__device__ __forceinline__ f32x4 swiglu4(f32x4 g, f32x4 u) { f32x4 o;
#pragma unroll
  for (int j = 0; j < 4; ++j) o[j] = g[j] * __builtin_amdgcn_rcpf(1.f + __expf(-g[j])) * u[j];
  return o; }
struct EpiSwiglu {
  static constexpr bool PERM = true; bf16_t* H; int ldh, NC, row_base;
  __device__ __forceinline__ void operator()(const Acc& acc, const Unit& u, int wr, int wc, int fr, int fq) const {
    const int row0 = u.pm * BM - row_base + wr * 64 + fr, col0 = (u.pn % NC) * HALF + wc * 32 + 8 * fq;
#pragma unroll
    for (int ai = 0; ai < 2; ++ai)
#pragma unroll
      for (int m = 0; m < 4; ++m)
        *(u32x4*)(H + (size_t)(row0 + ai * HALF + m * 16) * ldh + col0) = pack8(swiglu4(acc[ai][0][m][0], acc[ai][1][m][0]), swiglu4(acc[ai][0][m][1], acc[ai][1][m][1]));
  }
};
struct EpiRwkv {
  static constexpr bool PERM = true; bf16_t* RKV; bf16_t* LBWA; bf16_t* LBG;
  __device__ __forceinline__ void operator()(const Acc& acc, const Unit& u, int wr, int wc, int fr, int fq) const {
    const int row0 = u.pm * BM + wr * 64 + fr;
    if (u.pn < 12) {
      const int col0 = u.pn * BM + wc * 32 + 8 * fq;
#pragma unroll
      for (int ai = 0; ai < 2; ++ai)
#pragma unroll
        for (int m = 0; m < 4; ++m) { bf16_t* rp = RKV + (size_t)(row0 + ai * HALF + m * 16) * 3072 + col0;
#pragma unroll
          for (int bj = 0; bj < 2; ++bj) *(u32x4*)(rp + bj * HALF) = pack8(acc[ai][bj][m][0], acc[ai][bj][m][1]); }
    } else {
      const bool isg = (u.pn == 13); bf16_t* O = isg ? LBG : LBWA; const int c0 = wc * 32 + 8 * fq;
#pragma unroll
      for (int ai = 0; ai < 2; ++ai)
#pragma unroll
        for (int m = 0; m < 4; ++m) { bf16_t* rp = O + (size_t)(row0 + ai * HALF + m * 16) * 256 + c0;
#pragma unroll
          for (int bj = 0; bj < 2; ++bj) { f32x4 v0 = acc[ai][bj][m][0], v1 = acc[ai][bj][m][1]; const int c = bj * HALF + c0;
            if (isg) { if (c < 160) {
#pragma unroll
                for (int j = 0; j < 4; ++j) { v0[j] = sigmoidf_(v0[j]); v1[j] = sigmoidf_(v1[j]); } } else { v0 = (f32x4){0.f, 0.f, 0.f, 0.f}; v1 = v0; } }
            else if (bj == 0) {
#pragma unroll
              for (int j = 0; j < 4; ++j) { v0[j] = 1.f - 2.f * __builtin_amdgcn_rcpf(1.f + __expf(2.f * v0[j])); v1[j] = 1.f - 2.f * __builtin_amdgcn_rcpf(1.f + __expf(2.f * v1[j])); } }
            *(u32x4*)(rp + bj * HALF) = pack8(v0, v1); } }
    }
  }
};
struct EpiMulPre {
  static constexpr bool PERM = true; bf16_t* P;
  __device__ __forceinline__ void operator()(const Acc& acc, const Unit& u, int wr, int wc, int fr, int fq) const {
    const int row0 = u.pm * BM + wr * 64 + fr, col0 = u.pn * BM + wc * 32 + 8 * fq;
#pragma unroll
    for (int ai = 0; ai < 2; ++ai)
#pragma unroll
      for (int m = 0; m < 4; ++m) { bf16_t* rp = P + (size_t)(row0 + ai * HALF + m * 16) * 1024 + col0;
#pragma unroll
        for (int bj = 0; bj < 2; ++bj) { u32x4* q = (u32x4*)(rp + bj * HALF); const u32x4 pv = *q; f32x4 a = acc[ai][bj][m][0], b = acc[ai][bj][m][1];
          a[0] *= bflo(pv[0]); a[1] *= bfhi(pv[0]); a[2] *= bflo(pv[1]); a[3] *= bfhi(pv[1]); b[0] *= bflo(pv[2]); b[1] *= bfhi(pv[2]); b[2] *= bflo(pv[3]); b[3] *= bfhi(pv[3]);
          *q = pack8(a, b); } __builtin_amdgcn_sched_barrier(0); }
  }
};
struct EpiMoeDown {
  static constexpr bool PERM = false; float* X; const int* rowl; const float* rowg; int row_base;
  __device__ __forceinline__ void operator()(const Acc& acc, const Unit& u, int wr, int wc, int fr, int fq) const {
    const int row0 = row_base + u.pm * BM + wr * 64 + fr, col0 = (u.pn & 3) * BM + wc * 32 + 4 * fq;
#pragma unroll
    for (int ai = 0; ai < 2; ++ai)
#pragma unroll
      for (int m = 0; m < 4; ++m) { const int lr = row0 + ai * HALF + m * 16; const int tok = rowl[lr];
        if (tok >= 0) { const float gt = rowg[lr]; float* rp = X + (size_t)tok * 1024 + col0;
#pragma unroll
          for (int bj = 0; bj < 2; ++bj)
#pragma unroll
            for (int n = 0; n < 2; ++n) { f32x4* q = (f32x4*)(rp + bj * HALF + n * 16); *q = *q + acc[ai][bj][m][n] * gt; } } __builtin_amdgcn_sched_barrier(0); }
  }
};
struct MoeDownOrder {
  int first, ntile, G, c; const LAS int* ts;
  __device__ bool next(int i, Unit& u) const {
    const long L = (long)i * G + c; if (L >= (long)ntile * 4) return false;
    const int l = (int)L, pm = l >> 2, pn = l & 3; int g = 0;
#pragma unroll
    for (int k = 1; k < 16; ++k) g += ((first + pm) >= ts[k]) ? 1 : 0;
    u.pm = pm; u.pn = (g & 7) * 4 + pn; return true;
  }
};

__device__ __forceinline__ void ln_row(const float* y, const float* g, const float* b, int lane, f32x4 (&o)[4]) {
  f32x4 v[4]; float s = 0.f;
#pragma unroll
  for (int k = 0; k < 4; ++k) { v[k] = *(const f32x4*)(y + k * 256 + lane * 4); s += v[k][0] + v[k][1] + v[k][2] + v[k][3]; }
  const float mean = wave_sum(s) * (1.f / 1024.f); float q = 0.f;
#pragma unroll
  for (int k = 0; k < 4; ++k) { v[k] = v[k] - mean; q += v[k][0] * v[k][0] + v[k][1] * v[k][1] + v[k][2] * v[k][2] + v[k][3] * v[k][3]; }
  const float rstd = rsqrtf(wave_sum(q) * (1.f / 1024.f) + 1e-5f);
#pragma unroll
  for (int k = 0; k < 4; ++k) { const f32x4 gg = *(const f32x4*)(g + k * 256 + lane * 4), bb = *(const f32x4*)(b + k * 256 + lane * 4); o[k] = v[k] * rstd * gg + bb; }
}

__device__ __forceinline__ void ln_row2(const float* y0, const float* y1, const float* g, const float* b, int lane, f32x4 (&o0)[4], f32x4 (&o1)[4]) {
  f32x4 v[4], u[4]; float s0 = 0.f, s1 = 0.f;
#pragma unroll
  for (int k = 0; k < 4; ++k) { v[k] = *(const f32x4*)(y0 + k * 256 + lane * 4); u[k] = *(const f32x4*)(y1 + k * 256 + lane * 4); }
#pragma unroll
  for (int k = 0; k < 4; ++k) { s0 += v[k][0] + v[k][1] + v[k][2] + v[k][3]; s1 += u[k][0] + u[k][1] + u[k][2] + u[k][3]; }
  const float m0 = wave_sum(s0) * (1.f / 1024.f), m1 = wave_sum(s1) * (1.f / 1024.f); float q0 = 0.f, q1 = 0.f;
#pragma unroll
  for (int k = 0; k < 4; ++k) { v[k] = v[k] - m0; u[k] = u[k] - m1; q0 += v[k][0] * v[k][0] + v[k][1] * v[k][1] + v[k][2] * v[k][2] + v[k][3] * v[k][3]; q1 += u[k][0] * u[k][0] + u[k][1] * u[k][1] + u[k][2] * u[k][2] + u[k][3] * u[k][3]; }
  const float r0 = rsqrtf(wave_sum(q0) * (1.f / 1024.f) + 1e-5f), r1 = rsqrtf(wave_sum(q1) * (1.f / 1024.f) + 1e-5f);
#pragma unroll
  for (int k = 0; k < 4; ++k) { const f32x4 gg = *(const f32x4*)(g + k * 256 + lane * 4), bb = *(const f32x4*)(b + k * 256 + lane * 4); o0[k] = v[k] * r0 * gg + bb; o1[k] = u[k] * r1 * gg + bb; }
}

__device__ __forceinline__ void attn_phase(const bf16_t* __restrict__ QK, const bf16_t* __restrict__ VT, const float* __restrict__ EB, bf16_t* __restrict__ O) {
  const int tid = tid_(), lane = tid & 63, qi = lane & 15, g = lane >> 4;
  const int nw = gridDim.x * 8, w0 = blockIdx.x * 8 + (tid >> 6);
  const int krho = ((qi >> 2) * 8) + (qi & 3);
  int cur_combo = -1; f32x4 bias[8][2];
  for (int u = w0; u < 768 * 4 * 32; u += nw) {
    const int combo = u & 127, h = u & 31, c = (u >> 5) & 3, R = u >> 7;
    const float* eb = EB + (size_t)combo * (15 * 512) + lane * 8;
    if (combo != cur_combo) { cur_combo = combo;
#pragma unroll
      for (int i = 0; i < 8; ++i) { bias[i][0] = *(const f32x4*)(eb + (3 + i) * 512); bias[i][1] = *(const f32x4*)(eb + (3 + i) * 512 + 4); } }
    int seq_row0, rows; if (R < 256) { seq_row0 = R & ~127; rows = 128; } else { seq_row0 = 256 + ((R - 256) & ~63); rows = 64; }
    const int r = R - seq_row0; int rs = r - 4; rs = rs < 0 ? 0 : rs; rs = rs > rows - 8 ? rows - 8 : rs;
    const int blk = (c == 0) ? 0 : (c == 1) ? 8 : (c == 2) ? 24 : 32;
    const int qcol = 16 * c + qi;
    const bf16x8 qf = *(const bf16x8*)(QK + ((size_t)(R * 32 + h) * 64 + qcol) * 32 + g * 8);
    f32x4 s[8][2];
    const bf16_t* kbase = QK + (size_t)T * 1024 + ((size_t)((seq_row0 + rs) * 32 + h) * 64 + blk + krho) * 32 + g * 8;
#pragma unroll
    for (int i = 0; i < 8; ++i)
#pragma unroll
      for (int hh = 0; hh < 2; ++hh) {
        const bf16x8 kf = *(const bf16x8*)(kbase + (size_t)i * 65536 + hh * 128);
        s[i][hh] = __builtin_amdgcn_mfma_f32_16x16x32_bf16(kf, qf, (f32x4){0.f, 0.f, 0.f, 0.f}, 0, 0, 0);
      }
    if (rs - r == -4) {
#pragma unroll
      for (int i = 0; i < 8; ++i) { s[i][0] = s[i][0] + bias[i][0]; s[i][1] = s[i][1] + bias[i][1]; }
    } else {
      const float* ebr = eb + (rs - r + 7) * 512;
#pragma unroll
      for (int i = 0; i < 8; ++i) { s[i][0] = s[i][0] + *(const f32x4*)(ebr + i * 512); s[i][1] = s[i][1] + *(const f32x4*)(ebr + i * 512 + 4); }
    }
    float mx = -3.0e38f;
#pragma unroll
    for (int i = 0; i < 8; ++i)
#pragma unroll
      for (int hh = 0; hh < 2; ++hh) mx = fmaxf(fmaxf(mx, fmaxf(s[i][hh][0], s[i][hh][1])), fmaxf(s[i][hh][2], s[i][hh][3]));
    mx = fmaxf(mx, __shfl_xor(mx, 16)); mx = fmaxf(mx, __shfl_xor(mx, 32));
    float sum = 0.f;
#pragma unroll
    for (int i = 0; i < 8; ++i)
#pragma unroll
      for (int hh = 0; hh < 2; ++hh)
#pragma unroll
        for (int j = 0; j < 4; ++j) { const float e = __expf(s[i][hh][j] - mx); s[i][hh][j] = e; sum += e; }
    sum += __shfl_xor(sum, 16); sum += __shfl_xor(sum, 32);
    f32x4 o0 = {0.f, 0.f, 0.f, 0.f}, o1 = {0.f, 0.f, 0.f, 0.f};
#pragma unroll
    for (int i = 0; i < 8; ++i) {
      const u32x4 pu = pack8(s[i][0], s[i][1]); const bf16x8 pf = __builtin_bit_cast(bf16x8, pu);
      const bf16_t* vb = VT + (size_t)(seq_row0 + rs + i) * 65536 + (size_t)((h * 8 + (blk >> 3) + g) * 32 + qi) * 8;
      const bf16x8 v0 = *(const bf16x8*)vb, v1 = *(const bf16x8*)(vb + 16 * 8);
      o0 = __builtin_amdgcn_mfma_f32_16x16x32_bf16(v0, pf, o0, 0, 0, 0);
      o1 = __builtin_amdgcn_mfma_f32_16x16x32_bf16(v1, pf, o1, 0, 0, 0);
    }
    const float inv = 1.f / sum;
    bf16_t* op = O + (size_t)(R * 64 + qcol) * 1024 + h * 32 + g * 4;
    u32x2 a, b; a[0] = cvt_pk_bf16(o0[0] * inv, o0[1] * inv); a[1] = cvt_pk_bf16(o0[2] * inv, o0[3] * inv); b[0] = cvt_pk_bf16(o1[0] * inv, o1[1] * inv); b[1] = cvt_pk_bf16(o1[2] * inv, o1[3] * inv);
    *(u32x2*)op = a; *(u32x2*)(op + 16) = b;
  }
}

constexpr int SC_WD = 0, SC_AA = 2048, SC_KD = 4096, SC_BB = 6144, SC_NA = 8192, SC_RR = 10240, SC_VV = 12288, SC_YO = 14336;
typedef float f32x2 __attribute__((ext_vector_type(2)));
#define LO2(v) __builtin_shufflevector(v, v, 0, 1)
#define HI2(v) __builtin_shufflevector(v, v, 2, 3)
template <int NR> __device__ __forceinline__ void scan_steps(LAS float* L, int z, int vrow, int ko, f32x2 (&St)[2][4]) {
  const int sstep = z ? -64 : 64; const LAS float* bp = L + ko * 8 + (z ? 31 * 64 : 0);
  const LAS float* vp = L + SC_VV + vrow + (z ? 31 * 64 : 0); LAS float* yp = L + SC_YO + vrow + (z ? 31 * 64 : 0);
  f32x4 c[10]; float cv[NR];
  c[0] = *(const LAS f32x4*)(bp + SC_NA); c[1] = *(const LAS f32x4*)(bp + SC_NA + 4); c[2] = *(const LAS f32x4*)(bp + SC_WD); c[3] = *(const LAS f32x4*)(bp + SC_WD + 4);
  c[4] = *(const LAS f32x4*)(bp + SC_BB); c[5] = *(const LAS f32x4*)(bp + SC_BB + 4); c[6] = *(const LAS f32x4*)(bp + SC_KD); c[7] = *(const LAS f32x4*)(bp + SC_KD + 4);
  c[8] = *(const LAS f32x4*)(bp + SC_RR); c[9] = *(const LAS f32x4*)(bp + SC_RR + 4);
#pragma unroll
  for (int r = 0; r < NR; ++r) cv[r] = vp[r];
#pragma unroll 4
  for (int si = 0; si < 32; ++si) {
    f32x4 n[10]; float nv[NR];
    const LAS float* bn = bp + ((si < 31) ? sstep : 0); const LAS float* vn = vp + ((si < 31) ? sstep : 0);
    n[0] = *(const LAS f32x4*)(bn + SC_NA); n[1] = *(const LAS f32x4*)(bn + SC_NA + 4); n[2] = *(const LAS f32x4*)(bn + SC_WD); n[3] = *(const LAS f32x4*)(bn + SC_WD + 4);
    n[4] = *(const LAS f32x4*)(bn + SC_BB); n[5] = *(const LAS f32x4*)(bn + SC_BB + 4); n[6] = *(const LAS f32x4*)(bn + SC_KD); n[7] = *(const LAS f32x4*)(bn + SC_KD + 4);
    n[8] = *(const LAS f32x4*)(bn + SC_RR); n[9] = *(const LAS f32x4*)(bn + SC_RR + 4);
#pragma unroll
    for (int r = 0; r < NR; ++r) nv[r] = vn[r];
    float sa[NR], yy[NR];
#pragma unroll
    for (int r = 0; r < NR; ++r) { f32x2 p1 = St[r][0] * LO2(c[0]), p2 = St[r][1] * HI2(c[0]); p1 = St[r][2] * LO2(c[1]) + p1; p2 = St[r][3] * HI2(c[1]) + p2; p1 = p1 + p2; sa[r] = p1[0] + p1[1]; }
#pragma unroll
    for (int r = 0; r < NR; ++r) sa[r] = red8(sa[r]);
#pragma unroll
    for (int r = 0; r < NR; ++r) { const f32x2 s2 = {sa[r], sa[r]}, v2 = {cv[r], cv[r]};
      St[r][0] = St[r][0] * LO2(c[2]) + (s2 * LO2(c[4]) + v2 * LO2(c[6])); St[r][1] = St[r][1] * HI2(c[2]) + (s2 * HI2(c[4]) + v2 * HI2(c[6]));
      St[r][2] = St[r][2] * LO2(c[3]) + (s2 * LO2(c[5]) + v2 * LO2(c[7])); St[r][3] = St[r][3] * HI2(c[3]) + (s2 * HI2(c[5]) + v2 * HI2(c[7])); }
#pragma unroll
    for (int r = 0; r < NR; ++r) { f32x2 q1 = St[r][0] * LO2(c[8]), q2 = St[r][1] * HI2(c[8]); q1 = St[r][2] * LO2(c[9]) + q1; q2 = St[r][3] * HI2(c[9]) + q2; q1 = q1 + q2; yy[r] = q1[0] + q1[1]; }
#pragma unroll
    for (int r = 0; r < NR; ++r) yy[r] = red8(yy[r]);
    if (ko == 0) {
#pragma unroll
      for (int r = 0; r < NR; ++r) yp[r] = yy[r]; }
#pragma unroll
    for (int j = 0; j < 10; ++j) c[j] = n[j];
#pragma unroll
    for (int r = 0; r < NR; ++r) cv[r] = nv[r];
    bp = bn; vp = vn; yp += sstep;
  }
}
__device__ __forceinline__ int chain_chunks(int chain) { return chain < 0 ? 0 : (chain < 64 ? 256 : 128); }
__device__ __forceinline__ void scan_block(unsigned char* ws, LAS float* Lall, int chainA, int modeA, int rbA, int chainB, int modeB, int rbB) {
  const int tid = tid_(), wid = tid >> 6, lane = tid & 63, grp = wid >> 2, gw4 = wid & 3, gtid = tid & 255;
  const int chain = grp ? chainB : chainA, mode = grp ? modeB : modeA, rowbase = grp ? rbB : rbA;
  LAS float* L = Lall + grp * 16384;
  const int nA = chain_chunks(chainA), nB = chain_chunks(chainB), nloop = nA > nB ? nA : nB;
  const int cc = chain < 0 ? 0 : chain;
  int h, z, Lq; size_t tok0;
  if (cc < 64) { h = (cc & 31) >> 1; z = cc & 1; Lq = 8192; tok0 = (size_t)(cc >> 5) * 8192; }
  else { const int c2 = cc - 64; h = (c2 & 31) >> 1; z = c2 & 1; Lq = 4096; tok0 = 16384 + (size_t)(c2 >> 5) * 4096; }
  const int nchunk = chain < 0 ? 0 : Lq / 32;
  const bf16_t* RKV = (const bf16_t*)(ws + OFF_RKV); const bf16_t* LBWA = (const bf16_t*)(ws + OFF_LBWA); const bf16_t* W2T = (const bf16_t*)(ws + OFF_W2T);
  bf16_t* Y = (bf16_t*)(ws + (z ? OFF_YB : OFF_YF)); float* bonus = (float*)(ws + OFF_BONUS);
  const int tk = gtid >> 3, c8 = (gtid & 7) * 8, ch0 = h * 64 + c8;
  const int ko = lane & 7, vl = lane >> 3, vrow = mode ? rowbase + gw4 * 8 + vl : gw4 * 16 + vl * 2;
  const int mat = gw4 >> 1, ntile = gw4 & 1;
  const f32x4 kk0 = *(const f32x4*)(INP(18) + ch0), kk1 = *(const f32x4*)(INP(18) + ch0 + 4), ka0 = *(const f32x4*)(INP(19) + ch0), ka1 = *(const f32x4*)(INP(19) + ch0 + 4);
  const f32x4 rk0 = *(const f32x4*)(INP(20) + ch0), rk1 = *(const f32x4*)(INP(20) + ch0 + 4);
  bf16x8 bfrag[4]; const int chb = h * 64 + ntile * 32 + (lane & 31);
#pragma unroll
  for (int ks = 0; ks < 4; ++ks) bfrag[ks] = *(const bf16x8*)(W2T + ((size_t)(mat * 2 + z) * 1024 + chb) * 64 + ks * 16 + (lane >> 5) * 8);
  const float bias0 = (mat ? INP(13) : INP(10))[z * 1024 + chb];
  u32x4 rawr, rawk, rawv; bf16x8 afrag[4];
  { const size_t tb = tok0 + (size_t)(z ? (nchunk > 0 ? nchunk - 1 : 0) : 0) * 32; const bf16_t* rp = RKV + (tb + tk) * 3072 + ch0;
    rawr = *(const u32x4*)rp; rawk = *(const u32x4*)(rp + 1024); rawv = *(const u32x4*)(rp + 2048);
#pragma unroll
    for (int ks = 0; ks < 4; ++ks) afrag[ks] = *(const bf16x8*)(LBWA + (tb + (lane & 31)) * 256 + mat * 128 + z * 64 + ks * 16 + (lane >> 5) * 8); }
  f32x2 St[2][4];
#pragma unroll
  for (int r = 0; r < 2; ++r)
#pragma unroll
    for (int j = 0; j < 4; ++j) St[r][j] = (f32x2){0.f, 0.f};
  for (int ci = 0; ci < nloop; ++ci) {
    const bool act = ci < nchunk;
    const size_t tb = tok0 + (size_t)(act ? (z ? nchunk - 1 - ci : ci) : 0) * 32;
    if (act) {
      f32x16 acc;
#pragma unroll
      for (int j = 0; j < 16; ++j) acc[j] = 0.f;
#pragma unroll
      for (int ks = 0; ks < 4; ++ks) acc = __builtin_amdgcn_mfma_f32_32x32x16_bf16(afrag[ks], bfrag[ks], acc, 0, 0, 0);
      LAS float* dst = L + (mat ? SC_AA : SC_WD) + ntile * 32 + (lane & 31);
#pragma unroll
      for (int rg = 0; rg < 16; ++rg) { const int row = (rg & 3) + 8 * (rg >> 2) + 4 * (lane >> 5); const float sg = sigmoidf_(acc[rg] + bias0);
        dst[row * 64] = mat ? sg : __expf(-0.60653065971263342f * sg); }
    }
    __syncthreads();
    if (act) {
      float r8[8], k8[8], kx[8]; float ss = 0.f;
#pragma unroll
      for (int j = 0; j < 4; ++j) { r8[2 * j] = bflo(rawr[j]); r8[2 * j + 1] = bfhi(rawr[j]); k8[2 * j] = bflo(rawk[j]); k8[2 * j + 1] = bfhi(rawk[j]); }
#pragma unroll
      for (int j = 0; j < 8; ++j) { kx[j] = k8[j] * (j < 4 ? kk0[j & 3] : kk1[j & 3]); ss += kx[j] * kx[j]; }
      ss = red8(ss); const float inv = __builtin_amdgcn_rsqf(fmaxf(ss, 1e-24f));
      const f32x4 a0 = *(const LAS f32x4*)(L + SC_AA + tk * 64 + c8), a1 = *(const LAS f32x4*)(L + SC_AA + tk * 64 + c8 + 4);
      f32x4 kd[2], bb[2], na[2], rr[2], vv[2]; float bon = 0.f;
#pragma unroll
      for (int j = 0; j < 8; ++j) { const float a = (j < 4 ? a0[j & 3] : a1[j & 3]), kav = (j < 4 ? ka0[j & 3] : ka1[j & 3]), rkv = (j < 4 ? rk0[j & 3] : rk1[j & 3]);
        const float kn = kx[j] * inv, kdv = k8[j] * (1.f + (a - 1.f) * kav); kd[j >> 2][j & 3] = kdv; bb[j >> 2][j & 3] = kn * a; na[j >> 2][j & 3] = -kn; rr[j >> 2][j & 3] = r8[j]; bon += r8[j] * kdv * rkv; }
#pragma unroll
      for (int j = 0; j < 4; ++j) { vv[j >> 1][(j & 1) * 2] = bflo(rawv[j]); vv[j >> 1][(j & 1) * 2 + 1] = bfhi(rawv[j]); }
      LAS float* lp = L + tk * 64 + c8;
      *(LAS f32x4*)(lp + SC_KD) = kd[0]; *(LAS f32x4*)(lp + SC_KD + 4) = kd[1]; *(LAS f32x4*)(lp + SC_BB) = bb[0]; *(LAS f32x4*)(lp + SC_BB + 4) = bb[1];
      *(LAS f32x4*)(lp + SC_NA) = na[0]; *(LAS f32x4*)(lp + SC_NA + 4) = na[1]; *(LAS f32x4*)(lp + SC_RR) = rr[0]; *(LAS f32x4*)(lp + SC_RR + 4) = rr[1];
      *(LAS f32x4*)(lp + SC_VV) = vv[0]; *(LAS f32x4*)(lp + SC_VV + 4) = vv[1];
      bon = red8(bon); if ((gtid & 7) == 0 && rowbase == 0) bonus[((tb + tk) * 16 + h) * 2 + z] = bon;
    }
    __syncthreads();
    if (act && ci + 1 < nchunk) { const size_t tn = tok0 + (size_t)(z ? nchunk - 2 - ci : ci + 1) * 32; const bf16_t* rp = RKV + (tn + tk) * 3072 + ch0;
      rawr = *(const u32x4*)rp; rawk = *(const u32x4*)(rp + 1024); rawv = *(const u32x4*)(rp + 2048);
#pragma unroll
      for (int ks = 0; ks < 4; ++ks) afrag[ks] = *(const bf16x8*)(LBWA + (tn + (lane & 31)) * 256 + mat * 128 + z * 64 + ks * 16 + (lane >> 5) * 8); }
    if (act) { if (mode) scan_steps<1>(L, z, vrow, ko, St); else scan_steps<2>(L, z, vrow, ko, St); }
    __syncthreads();
    if (act) {
      if (mode) { const int c4 = rowbase + (gtid & 7) * 4; const f32x4 yv = *(const LAS f32x4*)(L + SC_YO + tk * 64 + c4); u32x2 o; o[0] = cvt_pk_bf16(yv[0], yv[1]); o[1] = cvt_pk_bf16(yv[2], yv[3]);
        *(u32x2*)(Y + (tb + tk) * 1024 + h * 64 + c4) = o; }
      else { const f32x4 y0 = *(const LAS f32x4*)(L + SC_YO + tk * 64 + c8), y1 = *(const LAS f32x4*)(L + SC_YO + tk * 64 + c8 + 4);
        *(u32x4*)(Y + (tb + tk) * 1024 + ch0) = pack8(y0, y1); }
    }
  }
  __syncthreads();
}

__global__ void __launch_bounds__(512, 2) mega(Params p) {
  cg::grid_group grid = cg::this_grid();
  LAS unsigned char* lds = (LAS unsigned char*)shm;
  LAS int* TS = (LAS int*)(lds + LDS_TS);
  unsigned char* ws = p.ws;
  { const unsigned* ka = (const unsigned*)__builtin_amdgcn_kernarg_segment_ptr(); if (threadIdx.x < 66) ((LAS unsigned*)(lds + LDS_TAB))[threadIdx.x] = ka[threadIdx.x]; }
  __syncthreads();
  const int G = gridDim.x, nw = G * 8;
  const long ngt = (long)G * 512;
#define PH_VARS const int tid = tid_(), lane = tid & 63, wid = tid >> 6, gw = blockIdx.x * 8 + wid; const long gt = (long)blockIdx.x * 512 + tid; (void)lane; (void)gw; (void)gt;
  float* X = p.X;

  { PH_VARS
  {
    int rot = 0; float* tile = (float*)shm;
    const float* wqkv = INP(2);
    rot = cvt_run(mkjob(wqkv, 3072, 1024, 1024, (bf16_t*)(ws + OFF_WQKT), 1024, 0, 0, nullptr, 0.17677669529663687f, 0), tile, rot);
    rot = cvt_run(mkjob(wqkv + 1024, 3072, 1024, 1024, (bf16_t*)(ws + OFF_WQKT), 1024, 1024, 0, nullptr, 1.f, 0), tile, rot);
    rot = cvt_run(mkjob(wqkv + 2048, 3072, 1024, 1024, (bf16_t*)(ws + OFF_WVT), 1024, 0, 0, nullptr, 1.f, 0), tile, rot);
    rot = cvt_run(mkjob(INP(4), 1024, 1024, 1024, (bf16_t*)(ws + OFF_WOT), 1024, 0, 0, nullptr, 1.f, 0), tile, rot);
    rot = cvt_run(mkjob(INP(5), 2816, 1024, 2816, (bf16_t*)(ws + OFF_WGUT), 1024, 0, 0, nullptr, 1.f, 1), tile, rot);
    rot = cvt_run(mkjob(INP(6), 2816, 1024, 2816, (bf16_t*)(ws + OFF_WGUT), 1024, 128, 0, nullptr, 1.f, 1), tile, rot);
    rot = cvt_run(mkjob(INP(7), 1024, 2816, 1024, (bf16_t*)(ws + OFF_WDT), 2816, 0, 0, nullptr, 1.f, 0), tile, rot);
    bf16_t* wrt = (bf16_t*)(ws + OFF_WRT); const float* mu = INP(8);
    for (int half = 0; half < 2; ++half) {
      const int c0 = half * 1024;
      rot = cvt_run(mkjob(INP(9), 1024, 1024, 1024, wrt, 2048, 0, c0, half ? mu + 0 * 1024 : nullptr, 1.f, 0), tile, rot);
      rot = cvt_run(mkjob(INP(9) + 1048576, 1024, 1024, 1024, wrt, 2048, 1024, c0, half ? mu + 2 * 1024 : nullptr, 1.f, 0), tile, rot);
      rot = cvt_run(mkjob(INP(9) + 2097152, 1024, 1024, 1024, wrt, 2048, 2048, c0, half ? mu + 3 * 1024 : nullptr, 1.f, 0), tile, rot);
      rot = cvt_run(mkjob(INP(11), 64, 1024, 64, wrt, 2048, 3072, c0, half ? mu + 1 * 1024 : nullptr, 1.f, 0), tile, rot);
      rot = cvt_run(mkjob(INP(11) + 65536, 64, 1024, 64, wrt, 2048, 3136, c0, half ? mu + 1 * 1024 : nullptr, 1.f, 0), tile, rot);
      rot = cvt_run(mkjob(INP(14), 64, 1024, 64, wrt, 2048, 3200, c0, half ? mu + 4 * 1024 : nullptr, 1.f, 0), tile, rot);
      rot = cvt_run(mkjob(INP(14) + 65536, 64, 1024, 64, wrt, 2048, 3264, c0, half ? mu + 4 * 1024 : nullptr, 1.f, 0), tile, rot);
      rot = cvt_run(mkjob(INP(16), 160, 1024, 160, wrt, 2048, 3328, c0, half ? mu + 5 * 1024 : nullptr, 1.f, 0), tile, rot);
    }
    rot = cvt_run(mkjob(nullptr, 0, 2048, 96, wrt, 2048, 3488, 0, nullptr, 1.f, 0), tile, rot);
    bf16_t* w2t = (bf16_t*)(ws + OFF_W2T);
    rot = cvt_run(mkjob(INP(12), 1024, 64, 1024, w2t, 64, 0, 0, nullptr, 1.f, 0), tile, rot);
    rot = cvt_run(mkjob(INP(12) + 65536, 1024, 64, 1024, w2t, 64, 1024, 0, nullptr, 1.f, 0), tile, rot);
    rot = cvt_run(mkjob(INP(15), 1024, 64, 1024, w2t, 64, 2048, 0, nullptr, 1.f, 0), tile, rot);
    rot = cvt_run(mkjob(INP(15) + 65536, 1024, 64, 1024, w2t, 64, 3072, 0, nullptr, 1.f, 0), tile, rot);
    rot = cvt_run(mkjob(INP(17), 1024, 160, 1024, (bf16_t*)(ws + OFF_G2T), 256, 0, 0, nullptr, 1.f, 0), tile, rot);
    rot = cvt_run(mkjob(nullptr, 0, 96, 1024, (bf16_t*)(ws + OFF_G2T), 256, 0, 160, nullptr, 1.f, 0), tile, rot);
    rot = cvt_run(mkjob(INP(23), 1024, 1024, 1024, (bf16_t*)(ws + OFF_RWOT), 1024, 0, 0, nullptr, 1.f, 0), tile, rot);
    bf16_t* xb = (bf16_t*)(ws + OFF_XB);
    { const float* x0 = INP(0); const float* x1 = INP(1);
    for (long i0 = gt; i0 < (long)T * 256; i0 += 4 * ngt) { f32x4 v[4];
#pragma unroll
      for (int u = 0; u < 4; ++u) { const long i = i0 + u * ngt; if (i < (long)T * 256) v[u] = (i < 16384L * 256) ? *(const f32x4*)(x0 + i * 4) : *(const f32x4*)(x1 + (i - 16384L * 256) * 4); }
#pragma unroll
      for (int u = 0; u < 4; ++u) { const long i = i0 + u * ngt; if (i < (long)T * 256) { *(f32x4*)(X + i * 4) = v[u]; u32x2 o; o[0] = cvt_pk_bf16(v[u][0], v[u][1]); o[1] = cvt_pk_bf16(v[u][2], v[u][3]); *(u32x2*)(xb + i * 4) = o; } } } }
    { float* EBt = (float*)(ws + OFF_EB); const float* rpb = INP(3);
      for (long i = gt; i < 128L * 15 * 512; i += ngt) { const int e = (int)(i & 7), ln = (int)((i >> 3) & 63), dr = (int)((i >> 9) % 15), combo = (int)((i >> 9) / 15);
        const int h = combo & 31, c = combo >> 5, qi = ln & 15, g = ln >> 4; const int blk = (c == 0) ? 0 : (c == 1) ? 8 : (c == 2) ? 24 : 32;
        const int kcol = blk + g * 8 + e, qcol = 16 * c + qi; int qstart = qcol - 8; qstart = qstart < 0 ? 0 : qstart; qstart = qstart > 48 ? 48 : qstart;
        const bool valid = (kcol >= qstart) && (kcol < qstart + 16); int dc = kcol - qcol + 15; dc = dc < 0 ? 0 : dc; dc = dc > 30 ? 30 : dc;
        EBt[i] = valid ? rpb[(h * 15 + dr) * 31 + dc] : -3.0e38f; } }
    int* cnt = (int*)(ws + OFF_CNT); int* rowl = (int*)(ws + OFF_ROWL);
    if (gt < 16) cnt[gt] = 0;
    if (blockIdx.x == 0) for (int i = tid; i < XCD_BAR_WORDS; i += 512) ((unsigned*)(ws + OFF_BAR))[i] = 0u;
    if (tid < 2) ((LAS unsigned*)(lds + LDS_TS + 80))[tid] = 0u;
    for (long i = gt; i < 102400; i += ngt) rowl[i] = -1;
  }
  }
  grid.sync();
  __syncthreads();
  const XcdBarrier xb = xcd_barrier_post((unsigned*)(ws + OFF_BAR), (volatile LAS unsigned*)(lds + LDS_TS + 80));
  { PH_VARS
  { Gemm g{(const bf16_t*)(ws + OFF_XB), (const bf16_t*)(ws + OFF_WQKT), 1024}; StaticOrder S; S.init(T, 2048); EpiQK2 E{(bf16_t*)(ws + OFF_QK)}; gemm_phase(lds, g, S, E); }
  { Gemm g{(const bf16_t*)(ws + OFF_WVT), (const bf16_t*)(ws + OFF_XB), 1024}; StaticOrder S; S.init(1024, T); EpiVT E{(bf16_t*)(ws + OFF_VT)}; gemm_phase(lds, g, S, E); }
  }
  xcd_barrier(xb);
  { PH_VARS
  attn_phase((const bf16_t*)(ws + OFF_QK), (const bf16_t*)(ws + OFF_VT), (const float*)(ws + OFF_EB), (bf16_t*)(ws + OFF_O));
  }
  xcd_barrier(xb);
  { PH_VARS
  { Gemm g{(const bf16_t*)(ws + OFF_O), (const bf16_t*)(ws + OFF_WOT), 1024}; StaticOrder S; S.init(T, 1024); EpiResid E{X}; gemm_phase(lds, g, S, E); }
  }
  xcd_barrier(xb);
  { PH_VARS
  { bf16_t* xb = (bf16_t*)(ws + OFF_XB);
    for (int row = gw; row < T; row += 2 * nw) { const int rw1 = (row + nw < T) ? row + nw : row; f32x4 oo[2][4]; ln_row2(X + (size_t)row * 1024, X + (size_t)rw1 * 1024, INP(29), INP(30), lane, oo[0], oo[1]);
#pragma unroll
      for (int h = 0; h < 2; ++h) { const int rr = h ? rw1 : row;
#pragma unroll
        for (int k = 0; k < 4; ++k) { *(f32x4*)(X + (size_t)rr * 1024 + k * 256 + lane * 4) = oo[h][k]; u32x2 q; q[0] = cvt_pk_bf16(oo[h][k][0], oo[h][k][1]); q[1] = cvt_pk_bf16(oo[h][k][2], oo[h][k][3]); *(u32x2*)(xb + (size_t)rr * 1024 + k * 256 + lane * 4) = q; } } } }
  }
  xcd_barrier(xb);
  { PH_VARS
  { Gemm g{(const bf16_t*)(ws + OFF_XB), (const bf16_t*)(ws + OFF_WGUT), 1024}; StaticOrder S; S.init(T, 5632); EpiSwiglu E{(bf16_t*)(ws + OFF_H), 2816, 1 << 20, 0}; gemm_phase(lds, g, S, E); }
  }
  xcd_barrier(xb);
  { Gemm g{(const bf16_t*)(ws + OFF_H), (const bf16_t*)(ws + OFF_WDT), 2816}; StaticOrder S; S.init(T, 1024); EpiResid E{X}; gemm_phase(lds, g, S, E); }
  xcd_barrier(xb);
  { PH_VARS
  for (int row = gw; row < T; row += 2 * nw) { const int rw1 = (row + nw < T) ? row + nw : row; f32x4 oo[2][4]; ln_row2(X + (size_t)row * 1024, X + (size_t)rw1 * 1024, INP(31), INP(32), lane, oo[0], oo[1]);
#pragma unroll
    for (int h = 0; h < 2; ++h)
#pragma unroll
      for (int k = 0; k < 4; ++k) *(f32x4*)(X + (size_t)(h ? rw1 : row) * 1024 + k * 256 + lane * 4) = oo[h][k]; }
  }
  xcd_barrier(xb);
  { PH_VARS
  { bf16_t* xb2 = (bf16_t*)(ws + OFF_XB2);
    for (int row = gw; row < T; row += nw) {
      const int s0 = row < 16384 ? (row & ~8191) : 16384 + ((row - 16384) & ~4095), len = row < 16384 ? 8192 : 4096;
      const bool hm = row > s0, hp = row < s0 + len - 1;
#pragma unroll
      for (int k = 0; k < 4; ++k) { const size_t off = (size_t)row * 1024 + k * 256 + lane * 4; const f32x4 x = *(const f32x4*)(X + off);
        const f32x4 xm = hm ? *(const f32x4*)(X + off - 1024) : (f32x4){0.f, 0.f, 0.f, 0.f}, xp = hp ? *(const f32x4*)(X + off + 1024) : (f32x4){0.f, 0.f, 0.f, 0.f};
        const f32x4 xx = (xm + xp) * 0.5f - x; u32x2 a, b; a[0] = cvt_pk_bf16(x[0], x[1]); a[1] = cvt_pk_bf16(x[2], x[3]); b[0] = cvt_pk_bf16(xx[0], xx[1]); b[1] = cvt_pk_bf16(xx[2], xx[3]);
        bf16_t* dp = xb2 + (size_t)row * 2048 + k * 256 + lane * 4; *(u32x2*)dp = a; *(u32x2*)(dp + 1024) = b; } } }
  }
  xcd_barrier(xb);
  { PH_VARS
  { Gemm g{(const bf16_t*)(ws + OFF_XB2), (const bf16_t*)(ws + OFF_WRT), 2048}; StaticOrder S; S.init(T, 3584); EpiRwkv E{(bf16_t*)(ws + OFF_RKV), (bf16_t*)(ws + OFF_LBWA), (bf16_t*)(ws + OFF_LBG)}; gemm_phase(lds, g, S, E); }
  }
  xcd_barrier(xb);
  { PH_VARS
  { LAS float* L = (LAS float*)lds; const int b = blockIdx.x;
    for (int round = 0; round < 320; ++round) {
      int cA, mA = 0, rA = 0, cB = -1;
      if (G == 256) { if (round > 0) break; if (b < 128) { cA = b >> 1; mA = 1; rA = (b & 1) * 32; } else { cA = 64 + (b - 128) * 2; cB = cA + 1; } }
      else { cA = b + round * G; if (cA >= 320) break; }
      scan_block(ws, L, cA, mA, rA, cB, 0, 0);
    }
  }
  }
  xcd_barrier(xb);
  { PH_VARS
  { bf16_t* yf = (bf16_t*)(ws + OFF_YF); const bf16_t* yb = (const bf16_t*)(ws + OFF_YB); const bf16_t* rkv = (const bf16_t*)(ws + OFF_RKV); const float* bonus = (const float*)(ws + OFF_BONUS);
    for (int row = gw; row < T; row += nw) {
      const size_t off = (size_t)row * 1024 + lane * 16; const u32x4 a0 = *(const u32x4*)(yf + off), a1 = *(const u32x4*)(yf + off + 8), b0 = *(const u32x4*)(yb + off), b1 = *(const u32x4*)(yb + off + 8);
      const u32x4 v0 = *(const u32x4*)(rkv + (size_t)row * 3072 + 2048 + lane * 16), v1 = *(const u32x4*)(rkv + (size_t)row * 3072 + 2048 + lane * 16 + 8);
      float y[16], vv[16]; float s = 0.f;
#pragma unroll
      for (int j = 0; j < 4; ++j) { y[2 * j] = bflo(a0[j]) + bflo(b0[j]); y[2 * j + 1] = bfhi(a0[j]) + bfhi(b0[j]); y[8 + 2 * j] = bflo(a1[j]) + bflo(b1[j]); y[8 + 2 * j + 1] = bfhi(a1[j]) + bfhi(b1[j]);
        vv[2 * j] = bflo(v0[j]); vv[2 * j + 1] = bfhi(v0[j]); vv[8 + 2 * j] = bflo(v1[j]); vv[8 + 2 * j + 1] = bfhi(v1[j]); }
#pragma unroll
      for (int j = 0; j < 16; ++j) s += y[j];
      const float mean = red4(s) * (1.f / 64.f); float q = 0.f;
#pragma unroll
      for (int j = 0; j < 16; ++j) { y[j] -= mean; q += y[j] * y[j]; }
      const float rstd = rsqrtf(red4(q) * (1.f / 64.f) + 64e-5f);
      const float* bp = bonus + ((size_t)row * 16 + (lane >> 2)) * 2; const float bsum = bp[0] + bp[1];
      u32x4 o0, o1;
#pragma unroll
      for (int j = 0; j < 4; ++j) { const f32x4 gg = *(const f32x4*)(INP(21) + lane * 16 + j * 4), bb = *(const f32x4*)(INP(22) + lane * 16 + j * 4); float t[4];
#pragma unroll
        for (int e = 0; e < 4; ++e) t[e] = y[j * 4 + e] * rstd * gg[e] + bb[e] + bsum * vv[j * 4 + e];
        const unsigned lo = cvt_pk_bf16(t[0], t[1]), hi = cvt_pk_bf16(t[2], t[3]);
        if (j < 2) { o0[2 * j] = lo; o0[2 * j + 1] = hi; } else { o1[2 * (j - 2)] = lo; o1[2 * (j - 2) + 1] = hi; } }
      *(u32x4*)(yf + off) = o0; *(u32x4*)(yf + off + 8) = o1; } }
  }
  xcd_barrier(xb);
  { PH_VARS
  { Gemm g{(const bf16_t*)(ws + OFF_LBG), (const bf16_t*)(ws + OFF_G2T), 256}; StaticOrder S; S.init(T, 1024); EpiMulPre E{(bf16_t*)(ws + OFF_YF)}; gemm_phase(lds, g, S, E); }
  }
  xcd_barrier(xb);
  { PH_VARS
  { Gemm g{(const bf16_t*)(ws + OFF_YF), (const bf16_t*)(ws + OFF_RWOT), 1024}; StaticOrder S; S.init(T, 1024); EpiResid E{X}; gemm_phase(lds, g, S, E); }
  }
  xcd_barrier(xb);
  { PH_VARS
  { bf16_t* xb = (bf16_t*)(ws + OFF_XBM); int* cnt = (int*)(ws + OFF_CNT); int* tokE = (int*)(ws + OFF_TOKE); float* tokG = (float*)(ws + OFF_TOKG); int* tokP = (int*)(ws + OFF_TOKP);
    const float* wr = INP(24); const float* br = INP(25);
    LAS int* lc = (LAS int*)(lds + 100000);
    if (tid < 16) lc[tid] = 0;
    __syncthreads();
    for (int row = gw; row < T; row += nw) { f32x4 o[4]; ln_row(X + (size_t)row * 1024, INP(29) + 1024, INP(30) + 1024, lane, o);
      float lg[8];
#pragma unroll
      for (int e = 0; e < 8; ++e) lg[e] = 0.f;
#pragma unroll
      for (int k = 0; k < 4; ++k) {
#pragma unroll
        for (int j = 0; j < 4; ++j) { const float* wp = wr + (size_t)(k * 256 + lane * 4 + j) * 8; const f32x4 wa = *(const f32x4*)wp, wb = *(const f32x4*)(wp + 4); const float xv = o[k][j];
          lg[0] += xv * wa[0]; lg[1] += xv * wa[1]; lg[2] += xv * wa[2]; lg[3] += xv * wa[3]; lg[4] += xv * wb[0]; lg[5] += xv * wb[1]; lg[6] += xv * wb[2]; lg[7] += xv * wb[3]; }
        *(f32x4*)(X + (size_t)row * 1024 + k * 256 + lane * 4) = o[k] * ALPHA; u32x2 q; q[0] = cvt_pk_bf16(o[k][0], o[k][1]); q[1] = cvt_pk_bf16(o[k][2], o[k][3]); *(u32x2*)(xb + (size_t)row * 1024 + k * 256 + lane * 4) = q; }
#pragma unroll
      for (int e = 0; e < 8; ++e) lg[e] = wave_sum(lg[e]) + br[e];
      int e0 = 0; float v0 = lg[0];
#pragma unroll
      for (int e = 1; e < 8; ++e) if (lg[e] > v0) { v0 = lg[e]; e0 = e; }
      int e1 = -1; float v1 = -3.0e38f;
#pragma unroll
      for (int e = 0; e < 8; ++e) if (e != e0 && lg[e] > v1) { v1 = lg[e]; e1 = e; }
      if (lane == 0) { const float ex = __expf(v1 - v0), g0 = 1.f / (1.f + ex), g1 = ex * g0;
        const int p0 = __hip_atomic_fetch_add(lc + e0, 1, __ATOMIC_RELAXED, __HIP_MEMORY_SCOPE_WORKGROUP), p1 = __hip_atomic_fetch_add(lc + 8 + e1, 1, __ATOMIC_RELAXED, __HIP_MEMORY_SCOPE_WORKGROUP);
        tokE[row * 2] = e0; tokE[row * 2 + 1] = e1; tokG[row * 2] = g0; tokG[row * 2 + 1] = g1; tokP[row * 2] = p0; tokP[row * 2 + 1] = p1; } }
    __syncthreads();
    if (tid < 16) lc[16 + tid] = atomicAdd(cnt + tid, lc[tid]);
    __syncthreads();
    if (lane < 2) for (int row = gw; row < T; row += nw) tokP[row * 2 + lane] += lc[16 + lane * 8 + tokE[row * 2 + lane]];
    __syncthreads();
    int rot = 0; float* tile = (float*)shm;
    for (int e = 0; e < 8; ++e) {
      rot = cvt_run(mkjob(INP(26) + (size_t)e * 1024 * 3584, 3584, 1024, 3584, (bf16_t*)(ws + OFF_WMGU) + (size_t)e * 7168 * 1024, 1024, 0, 0, nullptr, 1.f, 1), tile, rot);
      rot = cvt_run(mkjob(INP(27) + (size_t)e * 1024 * 3584, 3584, 1024, 3584, (bf16_t*)(ws + OFF_WMGU) + (size_t)e * 7168 * 1024, 1024, 128, 0, nullptr, 1.f, 1), tile, rot);
      rot = cvt_run(mkjob(INP(28) + (size_t)e * 3584 * 1024, 1024, 3584, 1024, (bf16_t*)(ws + OFF_WMD) + (size_t)e * 1024 * 3584, 3584, 0, 0, nullptr, 1.f, 0), tile, rot);
    }
  }
  }
  xcd_barrier(xb);
  { PH_VARS
  { const int* cnt = (const int*)(ws + OFF_CNT);
    __syncthreads();
    if (tid == 0) { int a = 0; for (int k = 0; k < 16; ++k) { TS[k] = a; a += (cnt[k] + 255) >> 8; } TS[16] = a; }
    __syncthreads();
    const int* tokE = (const int*)(ws + OFF_TOKE); const float* tokG = (const float*)(ws + OFF_TOKG); const int* tokP = (const int*)(ws + OFF_TOKP);
    int* rowl = (int*)(ws + OFF_ROWL); float* rowg = (float*)(ws + OFF_ROWG); const bf16_t* xb = (const bf16_t*)(ws + OFF_XBM); bf16_t* xs = (bf16_t*)(ws + OFF_XS);
    for (int pr0 = gw; pr0 < T * 2; pr0 += 4 * nw) { u32x4 va[4], vb[4]; int rows[4];
#pragma unroll
      for (int u = 0; u < 4; ++u) { const int pr = pr0 + u * nw; rows[u] = -1; if (pr < T * 2) { const int tok = pr >> 1, rk = pr & 1; const int e = tokE[pr]; const int row = TS[rk * 8 + e] * 256 + tokP[pr]; rows[u] = row;
        if (lane == 0) { rowl[row] = tok; rowg[row] = tokG[pr]; }
        const u32x4* sp = (const u32x4*)(xb + (size_t)tok * 1024); va[u] = sp[lane]; vb[u] = sp[lane + 64]; } }
#pragma unroll
      for (int u = 0; u < 4; ++u) if (rows[u] >= 0) { u32x4* dp = (u32x4*)(xs + (size_t)rows[u] * 1024); dp[lane] = va[u]; dp[lane + 64] = vb[u]; } }
  }
  }
  xcd_barrier(xb);
  { PH_VARS
  { const int ts8 = TS[8], ts16 = TS[16];
    for (int rk = 0; rk < 2; ++rk) { const int t0 = rk ? ts8 : 0, t1 = rk ? ts16 : ts8;
      for (int cs = t0; cs < t1; cs += MOE_CHUNK) { const int ntile = (t1 - cs) < MOE_CHUNK ? (t1 - cs) : MOE_CHUNK;
        { Gemm g{(const bf16_t*)(ws + OFF_XS), (const bf16_t*)(ws + OFF_WMGU), 1024}; MoeOrder<28> S{cs, ntile, G, (int)blockIdx.x, TS}; EpiSwiglu E{(bf16_t*)(ws + OFF_HID), 3584, 28, cs * 256}; gemm_phase(lds, g, S, E); }
        xcd_barrier(xb);
        { Gemm g{(const bf16_t*)(ws + OFF_HID), (const bf16_t*)(ws + OFF_WMD), 3584}; MoeDownOrder S{cs, ntile, G, (int)blockIdx.x, TS}; EpiMoeDown E{X, (const int*)(ws + OFF_ROWL), (const float*)(ws + OFF_ROWG), cs * 256}; gemm_phase(lds, g, S, E); }
        xcd_barrier(xb);
      } }
  }
  }
  { PH_VARS
  for (int row = gw; row < T; row += 2 * nw) { const int rw1 = (row + nw < T) ? row + nw : row; f32x4 oo[2][4]; ln_row2(X + (size_t)row * 1024, X + (size_t)rw1 * 1024, INP(31) + 1024, INP(32) + 1024, lane, oo[0], oo[1]);
#pragma unroll
    for (int h = 0; h < 2; ++h)
#pragma unroll
      for (int k = 0; k < 4; ++k) *(f32x4*)(X + (size_t)(h ? rw1 : row) * 1024 + k * 256 + lane * 4) = oo[h][k]; }
  }
}

extern "C" void kernel_launch(void* const* d_in, const int* in_sizes, int n_in, void* d_out, int out_size, void* d_ws, size_t ws_size, hipStream_t stream) {
  static int grid_blocks = 0;
  if (!grid_blocks) {
    int dev = 0, cus = 0, per_cu = 0;
    (void)hipGetDevice(&dev);
    (void)hipDeviceGetAttribute(&cus, hipDeviceAttributeMultiprocessorCount, dev);
    (void)hipFuncSetAttribute((const void*)mega, hipFuncAttributeMaxDynamicSharedMemorySize, LDS_BYTES);
    (void)hipOccupancyMaxActiveBlocksPerMultiprocessor(&per_cu, mega, 512, LDS_BYTES);
    if (per_cu > 1) per_cu = 1;
    grid_blocks = cus * per_cu;
    if (ws_size < WS_NEED) fprintf(stderr, "workspace too small: %zu < %zu\n", ws_size, (size_t)WS_NEED);
  }
  Params p{};
  for (int i = 0; i < 33; ++i) p.in[i] = (const float*)d_in[i];
  p.X = (float*)d_out; p.ws = (unsigned char*)d_ws;
  void* args[] = {&p};
  hipError_t e = hipLaunchCooperativeKernel((void*)mega, dim3(grid_blocks), dim3(512), args, LDS_BYTES, stream);
  if (e != hipSuccess) fprintf(stderr, "cooperative launch failed: %s (grid %d)\n", hipGetErrorString(e), grid_blocks);
}
```

```cpp
#include <hip/hip_runtime.h>
#include <hip/hip_cooperative_groups.h>
#include <cstdio>
namespace cg = cooperative_groups;

#define LAS __attribute__((address_space(3)))
typedef unsigned short bf16_t;
typedef short bf16x8 __attribute__((ext_vector_type(8)));
typedef float f32x4 __attribute__((ext_vector_type(4)));
typedef float f32x16 __attribute__((ext_vector_type(16)));
typedef unsigned u32x4 __attribute__((ext_vector_type(4)));
typedef unsigned u32x2 __attribute__((ext_vector_type(2)));

constexpr int T = 49152, D = 1024;
constexpr float ALPHA = 1.41421356237309515f;
constexpr size_t SZ = (size_t)T * 1024 * 2;
constexpr size_t OFF_WRT = 0;
constexpr size_t OFF_W2T = OFF_WRT + 14680064;
constexpr size_t OFF_G2T = OFF_W2T + 524288;
constexpr size_t OFF_RWOT = OFF_G2T + 524288;
constexpr size_t OFF_CNT = OFF_RWOT + 2097152;
constexpr size_t OFF_TOKE = OFF_CNT + 256;
constexpr size_t OFF_TOKG = OFF_TOKE + 393216;
constexpr size_t OFF_TOKP = OFF_TOKG + 393216;
constexpr size_t OFF_ROWL = OFF_TOKP + 393216;
constexpr size_t OFF_ROWG = OFF_ROWL + 409600;
constexpr size_t OFF_BONUS = OFF_ROWG + 409600;
constexpr size_t OFF_BAR = OFF_BONUS + 6291456;
constexpr size_t BIG = 26214400;
constexpr size_t OFF_XB = BIG, OFF_QK = BIG + SZ, OFF_VT = BIG + 3 * SZ, OFF_O = BIG + 4 * SZ;
constexpr size_t OFF_WQKT = BIG + 5 * SZ, OFF_WVT = OFF_WQKT + 4194304, OFF_WOT = OFF_WVT + 2097152, OFF_WGUT = OFF_WOT + 2097152, OFF_WDT = OFF_WGUT + 11534336;
constexpr size_t OFF_EB = OFF_WDT + 5767168;
constexpr size_t OFF_H = BIG + SZ;
constexpr size_t OFF_XB2 = BIG, OFF_RKV = BIG + 2 * SZ, OFF_LBWA = BIG + 5 * SZ, OFF_LBG = OFF_LBWA + 25165824;
constexpr size_t OFF_YF = BIG, OFF_YB = BIG + SZ;
constexpr size_t OFF_WMGU = BIG, OFF_WMD = BIG + 117440512, OFF_XS = BIG + 176160768, OFF_XBM = OFF_XS + 209715200, OFF_HID = OFF_XBM;
constexpr size_t WS_NEED = OFF_HID + 183500800;
constexpr int MOE_CHUNK = 50;
constexpr size_t HID_BUF = (size_t)MOE_CHUNK * 256 * 7168;
constexpr int LDS_BYTES = 131072 + 512;

struct Params { const float* in[33]; float* X; unsigned char* ws; };
extern __shared__ __attribute__((aligned(16))) unsigned char shm[];
constexpr int LDS_TS = 131072, LDS_TAB = 131072 + 128;
__device__ __forceinline__ const float* INP(int i) {
  const LAS unsigned* tab = (const LAS unsigned*)((LAS unsigned char*)shm + LDS_TAB);
  const unsigned lo = __builtin_amdgcn_readfirstlane(tab[2 * i]), hi = __builtin_amdgcn_readfirstlane(tab[2 * i + 1]);
  return (const float*)(((unsigned long long)hi << 32) | lo);
}

__device__ __forceinline__ int tid_() { int t = threadIdx.x; asm volatile("" : "+v"(t)); return t; }
__device__ __forceinline__ unsigned cvt_pk_bf16(float lo, float hi) { unsigned r; asm("v_cvt_pk_bf16_f32 %0, %1, %2" : "=v"(r) : "v"(lo), "v"(hi)); return r; }
__device__ __forceinline__ bf16_t f2bf(float f) { return (bf16_t)(cvt_pk_bf16(f, 0.f) & 0xffffu); }
__device__ __forceinline__ float bflo(unsigned u) { return __uint_as_float(u << 16); }
__device__ __forceinline__ float bfhi(unsigned u) { return __uint_as_float(u & 0xffff0000u); }
__device__ __forceinline__ float wave_sum(float v) { for (int o = 32; o; o >>= 1) v += __shfl_xor(v, o); return v; }
template <int CTRL> __device__ __forceinline__ float dppf(float v) { return __builtin_bit_cast(float, __builtin_amdgcn_mov_dpp(__builtin_bit_cast(int, v), CTRL, 0xf, 0xf, true)); }
__device__ __forceinline__ float red4(float v) { v += dppf<0xB1>(v); v += dppf<0x4E>(v); return v; }
__device__ __forceinline__ float red8(float v) { v = red4(v); v += dppf<0x141>(v); return v; }
__device__ __forceinline__ float red16(float v) { v = red8(v); v += dppf<0x140>(v); return v; }
__device__ __forceinline__ float sigmoidf_(float x) { return __builtin_amdgcn_rcpf(1.f + __expf(-x)); }


#define XB_TMO      128
#define XB_XCNT(j)  (256  + 64 * (j))
#define XB_XSUB(j)  (1280 + 64 * (j))
#define XB_XGEN(j)  (2304 + 64 * (j))
#define XB_TOP      3328
#define XB_TOPGEN   3392
#define XCD_BAR_WORDS 3456
#define XB_SPIN_CAP (1u << 18)
__device__ __forceinline__ unsigned xb_ld(unsigned* p)              { return __hip_atomic_load(p, __ATOMIC_RELAXED, __HIP_MEMORY_SCOPE_AGENT); }
__device__ __forceinline__ unsigned xb_add(unsigned* p, unsigned v) { return __hip_atomic_fetch_add(p, v, __ATOMIC_RELAXED, __HIP_MEMORY_SCOPE_AGENT); }
__device__ __forceinline__ unsigned xb_xcc_id() { return (unsigned)__builtin_amdgcn_s_getreg((3 << 11) | 20) & 0xFu; }
#define XB_SPIN(cond, bar) do { unsigned _sp = 0; while (cond) { __builtin_amdgcn_s_sleep(1); \
    if ((++_sp & 255u) == 0u) { if (xb_ld(&(bar)[XB_TMO])) break; if (_sp > XB_SPIN_CAP) { atomicAdd(&(bar)[XB_TMO], 1u); break; } } } } while (0)
struct XcdBarrier { unsigned* bar; unsigned x; volatile LAS unsigned* st; };
__device__ __forceinline__ XcdBarrier xcd_barrier_post(unsigned* bar, volatile LAS unsigned* st) {
  XcdBarrier b; b.bar = bar; b.x = xb_xcc_id(); b.st = st;
  if (threadIdx.x == 0) (void)xb_add(&bar[XB_XCNT(b.x)], 1u);
  return b;
}
__device__ __forceinline__ void xcd_barrier_complete(unsigned* bar, unsigned x, unsigned& nloc, unsigned& nx) {
  const unsigned G = gridDim.x * gridDim.y * gridDim.z;
  unsigned sum, cnt, mine, sp = 0u;
  for (;;) {
    sum = 0u; cnt = 0u; mine = 0u;
#pragma unroll
    for (unsigned j = 0; j < 16; ++j) { const unsigned c = xb_ld(&bar[XB_XCNT(j)]); sum += c; cnt += (c > 0u) ? 1u : 0u; mine = (j == x) ? c : mine; }
    if (sum == G) break;
    __builtin_amdgcn_s_sleep(1);
    if ((++sp & 255u) == 0u) { if (xb_ld(&bar[XB_TMO])) break; if (sp > XB_SPIN_CAP) { atomicAdd(&bar[XB_TMO], 1u); break; } }
  }
  nloc = mine > 0u ? mine : 1u; nx = cnt > 0u ? cnt : 1u;
}
__device__ __forceinline__ void xcd_barrier(const XcdBarrier& b) {
  asm volatile("s_waitcnt vmcnt(0)" ::: "memory");
  __syncthreads();
  if (threadIdx.x == 0) {
    unsigned* bar = b.bar;
    __builtin_amdgcn_s_waitcnt(0);
    unsigned nloc = b.st[0], nx = b.st[1];
    if (nloc == 0u) { xcd_barrier_complete(bar, b.x, nloc, nx); b.st[0] = nloc; b.st[1] = nx; }
    const unsigned old = xb_add(&bar[XB_XSUB(b.x)], 1u);
    const unsigned gen = old / nloc;
    if (old + 1u == (gen + 1u) * nloc) {
      __builtin_amdgcn_fence(__ATOMIC_RELEASE, "agent");
      asm volatile("s_waitcnt vmcnt(0)" ::: "memory");
      const unsigned og = xb_add(&bar[XB_TOP], 1u);
      const unsigned tg = og / nx;
      if (og + 1u == (tg + 1u) * nx) xb_add(&bar[XB_TOPGEN], 1u);
      else XB_SPIN(xb_ld(&bar[XB_TOPGEN]) == tg, bar);
      __builtin_amdgcn_fence(__ATOMIC_ACQUIRE, "agent");
      xb_add(&bar[XB_XGEN(b.x)], 1u);
      asm volatile("s_waitcnt vmcnt(0)" ::: "memory");
    } else {
      XB_SPIN(xb_ld(&bar[XB_XGEN(b.x)]) == gen, bar);
      __builtin_amdgcn_fence(__ATOMIC_ACQUIRE, "agent");
      asm volatile("s_waitcnt vmcnt(0)" ::: "memory");
    }
  }
  __syncthreads();
}

struct CvtJob { const float* src; int ldsrc, K, N; bf16_t* dst; int lddst, row0, col0; const float* kscale; float scale; int mode; };
__device__ __forceinline__ CvtJob mkjob(const float* src, int ldsrc, int K, int N, bf16_t* dst, int lddst, int row0, int col0, const float* kscale, float scale, int mode) {
  CvtJob j; j.src = src; j.ldsrc = ldsrc; j.K = K; j.N = N; j.dst = dst; j.lddst = lddst; j.row0 = row0; j.col0 = col0; j.kscale = kscale; j.scale = scale; j.mode = mode; return j; }
__device__ __forceinline__ int cvt_run(const CvtJob J, float* tile, int rot) {
  const int tk = (J.K + 63) >> 6, tn = (J.N + 63) >> 6, nt = tk * tn, G = gridDim.x;
  const int tx = tid_() & 63, ty = tid_() >> 6;
  int start = (int)blockIdx.x - rot; if (start < 0) start += G;
  for (int t0 = start; t0 < nt; t0 += 4 * G) {
    float v[4][8];
#pragma unroll
    for (int q = 0; q < 4; ++q) { const int t = t0 + q * G; const int k0 = (t / tn) * 64, n0 = (t % tn) * 64;
#pragma unroll
      for (int r = 0; r < 8; ++r) { const int k = k0 + r * 8 + ty, n = n0 + tx; v[q][r] = 0.f;
        if (t < nt && J.src && k < J.K && n < J.N) v[q][r] = J.src[(size_t)k * J.ldsrc + n]; } }
    __syncthreads();
#pragma unroll
    for (int q = 0; q < 4; ++q) { const int t = t0 + q * G; const int k0 = (t / tn) * 64;
#pragma unroll
      for (int r = 0; r < 8; ++r) { const int kk = r * 8 + ty; float x = v[q][r] * J.scale; if (J.kscale && t < nt && k0 + kk < J.K) x *= J.kscale[k0 + kk]; tile[q * 4160 + kk * 65 + tx] = x; } }
    __syncthreads();
#pragma unroll
    for (int q = 0; q < 4; ++q) { const int t = t0 + q * G; const int k0 = (t / tn) * 64, n0 = (t % tn) * 64;
#pragma unroll
      for (int r = 0; r < 8; ++r) { const int nn = r * 8 + ty, n = n0 + nn, k = k0 + tx;
        if (t < nt && n < J.N && k < J.K) { const int row = J.mode ? ((n >> 7) * 256 + (n & 127)) : n;
          J.dst[(size_t)(J.row0 + row) * J.lddst + J.col0 + k] = f2bf(tile[q * 4160 + tx * 65 + nn]); } } }
  }
  return (rot + nt) % G;
}

constexpr int BM = 256, BK = 64, HALF = 128, HTB = HALF * BK * 2, NXCD = 8, WGM = 8;
__device__ __forceinline__ int lds_byte(int r, int c) { const int st = (r >> 4) * 2 + (c >> 5), rr = r & 15, cc = c & 31, ob = rr * 64 + cc * 2; return st * 1024 + (ob ^ (((ob >> 9) & 1) << 5)); }
__device__ __forceinline__ void stage_rc(int b, int& R, int& C) { const int st = b / 1024, sb = b % 1024, swz = sb ^ (((sb >> 9) & 1) << 5); R = (st >> 1) * 16 + swz / 64; C = (st & 1) * 32 + (swz % 64) / 2; }
__device__ __forceinline__ int perm32(int rho) { const int n = rho >> 4, i = rho & 15; return 8 * (i >> 2) + 4 * n + (i & 3); }
struct Unit { int pm, pn; };
struct Gemm { const bf16_t* A; const bf16_t* Bt; int K; };
struct StaticOrder {
  int nM, nN, nwg, G, c;
  __device__ void init(int M, int N) { nM = M / BM; nN = N / BM; nwg = nM * nN; G = gridDim.x; c = blockIdx.x; }
  __device__ bool next(int i, Unit& u) const {
    const long L = (long)i * G + c; if (L >= nwg) return false;
    int wgid = (int)L; { const int q = nwg / NXCD, r = nwg % NXCD, xcd = wgid % NXCD, off = wgid / NXCD; wgid = (xcd < r ? xcd * (q + 1) : r * (q + 1) + (xcd - r) * q) + off; }
    const int nig = WGM * nN, gid = wgid / nig, fm = gid * WGM, gsz = (nM - fm) < WGM ? (nM - fm) : WGM;
    u.pm = fm + ((wgid % nig) % gsz); u.pn = (wgid % nig) / gsz; return true;
  }
};
template <int NC> struct MoeOrder {
  int first, ntile, G, c; const LAS int* ts;
  __device__ bool next(int i, Unit& u) const {
    const long L = (long)i * G + c; if (L >= (long)ntile * NC) return false;
    const int l = (int)L, nig = WGM * NC, gid = l / nig, fm = gid * WGM, gsz = (ntile - fm) < WGM ? (ntile - fm) : WGM;
    const int pm = first + fm + ((l % nig) % gsz), pn = (l % nig) / gsz;
    int g = 0;
#pragma unroll
    for (int k = 1; k < 16; ++k) g += (pm >= ts[k]) ? 1 : 0;
    u.pm = pm; u.pn = (g & 7) * NC + pn; return true;
  }
};

struct MoeUpSkewOrder {
  int first, ntile, nd, G, c; const LAS int* ts;
  __device__ bool next(int i, Unit& u) const {
    const int r = (c >= nd) ? i : i + 3;
    const long L = (r < 3) ? (long)r * (G - nd) + (c - nd) : (long)3 * (G - nd) + (long)(r - 3) * G + c;
    if (L >= (long)ntile * 28) return false;
    const int l = (int)L, nig = WGM * 28, gid = l / nig, fm = gid * WGM, gsz = (ntile - fm) < WGM ? (ntile - fm) : WGM;
    const int pm = first + fm + ((l % nig) % gsz), pn = (l % nig) / gsz;
    int g = 0;
#pragma unroll
    for (int k = 1; k < 16; ++k) g += (pm >= ts[k]) ? 1 : 0;
    u.pm = pm; u.pn = (g & 7) * 28 + pn; return true;
  }
};

template <class Epi, class Sched>
__device__ __forceinline__ void gemm_phase(LAS unsigned char* lds, const Gemm g, const Sched& S, const Epi& E) {
  const int tid = tid_(), wid = __builtin_amdgcn_readfirstlane(tid >> 6), lane = tid & 63, wr = wid >> 2, wc = wid & 3, fr = lane & 15, fq = lane >> 4;
  const int K = g.K, nt = K / BK;
  unsigned voffA[2], voffB[2];
#pragma unroll
  for (int i = 0; i < 2; ++i) { int R, C; stage_rc(tid * 16 + i * 8192, R, C); const int Rb = Epi::PERM ? ((R & ~31) + perm32(R & 31)) : R;
    voffA[i] = (unsigned)(R * K + C) * 2u; voffB[i] = (unsigned)(Rb * K + C) * 2u; }
  const size_t kstep = (size_t)(BK * 2);
  const size_t hstep = (size_t)HALF * K * 2;
  const size_t tstep = 2 * hstep;
  const unsigned ldsw = (unsigned)wid * 1024u;
  const int aoff = lds_byte(wr * 64 + fr, fq * 8), boff = lds_byte(wc * 32 + fr, fq * 8);
#define PG8_SA(b, h) (((b) * 2 + (h)) * HTB)
#define PG8_SB(b, h) ((4 + (b) * 2 + (h)) * HTB)
#define PG8_STAGE(bufoff, gbase, voff) do { _Pragma("unroll") for (int _i = 0; _i < 2; ++_i) \
    __builtin_amdgcn_global_load_lds((const unsigned*)((const char*)(gbase) + (voff)[_i]), (LAS unsigned*)(lds + (bufoff) + ldsw + _i * 8192), 16, 0, 0); } while (0)
#define PG8_LDA(dst, b, h) do { _Pragma("unroll") for (int m = 0; m < 4; ++m) _Pragma("unroll") for (int k = 0; k < 2; ++k) dst[m][k] = *(const LAS bf16x8*)(lds + PG8_SA(b, h) + aoff + m * 2048 + k * 1024); } while (0)
#define PG8_LDB(dst, b, h) do { _Pragma("unroll") for (int n = 0; n < 2; ++n) _Pragma("unroll") for (int k = 0; k < 2; ++k) dst[n][k] = *(const LAS bf16x8*)(lds + PG8_SB(b, h) + boff + n * 2048 + k * 1024); } while (0)
#define PG8_MMA(ai, bj, At, Bt) do { __builtin_amdgcn_s_setprio(1); _Pragma("unroll") for (int m = 0; m < 4; ++m) _Pragma("unroll") for (int n = 0; n < 2; ++n) _Pragma("unroll") for (int k = 0; k < 2; ++k) \
    acc[ai][bj][m][n] = __builtin_amdgcn_mfma_f32_16x16x32_bf16(Bt[n][k], At[m][k], acc[ai][bj][m][n], 0, 0, 0); __builtin_amdgcn_s_setprio(0); } while (0)
#define PG8_WAIT_V(n) asm volatile("s_waitcnt vmcnt(" #n ")" ::: "memory")
#define PG8_WAIT_L(n) asm volatile("s_waitcnt lgkmcnt(" #n ")" ::: "memory")
#define PG8_BAR __builtin_amdgcn_s_barrier()
#define PG8_SCHED __builtin_amdgcn_sched_barrier(0)
  Unit cur, nxt; int ui = 0;
  if (!S.next(0, cur)) return;
  f32x4 acc[2][2][4][2];
#pragma unroll
  for (int a = 0; a < 2; ++a)
#pragma unroll
    for (int b = 0; b < 2; ++b)
#pragma unroll
      for (int m = 0; m < 4; ++m)
#pragma unroll
        for (int n = 0; n < 2; ++n) acc[a][b][m][n] = (f32x4){0.f, 0.f, 0.f, 0.f};
  bf16x8 At[4][2], B0[2][2], B1[2][2];
  const char* cA = (const char*)g.A + (size_t)cur.pm * tstep; const char* cB = (const char*)g.Bt + (size_t)cur.pn * tstep;
  PG8_STAGE(PG8_SB(0, 0), cB, voffB); PG8_STAGE(PG8_SA(0, 0), cA, voffA); PG8_STAGE(PG8_SB(0, 1), cB + hstep, voffB); PG8_STAGE(PG8_SA(0, 1), cA + hstep, voffA);
  if (wr == 1) PG8_BAR;
  PG8_WAIT_V(4); PG8_BAR;
  PG8_STAGE(PG8_SB(1, 0), cB + kstep, voffB); PG8_STAGE(PG8_SA(1, 0), cA + kstep, voffA); PG8_STAGE(PG8_SB(1, 1), cB + hstep + kstep, voffB);
  PG8_WAIT_V(6); PG8_BAR;
  for (;;) {
    const bool has_next = S.next(ui + 1, nxt);
    const char* nA = has_next ? (const char*)g.A + (size_t)nxt.pm * tstep : cA; const char* nB = has_next ? (const char*)g.Bt + (size_t)nxt.pn * tstep : cB;
    for (int t = 0; t < nt; t += 2) {
      const bool last = (t == nt - 2);
      const char* a1 = cA + (size_t)(t + 1) * kstep;
      const char* a2 = last ? nA : cA + (size_t)(t + 2) * kstep; const char* b2 = last ? nB : cB + (size_t)(t + 2) * kstep;
      const char* a3 = a2 + kstep; const char* b3 = b2 + kstep;
      PG8_LDB(B0, 0, 0); PG8_SCHED; PG8_LDA(At, 0, 0); PG8_STAGE(PG8_SA(1, 1), a1 + hstep, voffA);
      PG8_WAIT_L(8); PG8_BAR; PG8_WAIT_L(0); PG8_MMA(0, 0, At, B0); PG8_BAR; PG8_SCHED;
      PG8_LDB(B1, 0, 1); PG8_STAGE(PG8_SB(0, 0), b2, voffB);
      PG8_BAR; PG8_WAIT_L(0); PG8_MMA(0, 1, At, B1); PG8_BAR;
      PG8_LDA(At, 0, 1); PG8_STAGE(PG8_SA(0, 0), a2, voffA);
      PG8_BAR; PG8_WAIT_L(0); PG8_MMA(1, 0, At, B0); PG8_BAR; PG8_SCHED;
      PG8_STAGE(PG8_SB(0, 1), b2 + hstep, voffB);
      PG8_WAIT_V(6); PG8_BAR; PG8_MMA(1, 1, At, B1); PG8_BAR;
      PG8_LDB(B0, 1, 0); PG8_SCHED; PG8_LDA(At, 1, 0); PG8_STAGE(PG8_SA(0, 1), a2 + hstep, voffA);
      PG8_WAIT_L(8); PG8_BAR; PG8_WAIT_L(0); PG8_MMA(0, 0, At, B0); PG8_BAR; PG8_SCHED;
      PG8_LDB(B1, 1, 1); PG8_STAGE(PG8_SB(1, 0), b3, voffB);
      PG8_BAR; PG8_WAIT_L(0); PG8_MMA(0, 1, At, B1); PG8_BAR;
      PG8_LDA(At, 1, 1); PG8_STAGE(PG8_SA(1, 0), a3, voffA);
      PG8_BAR; PG8_WAIT_L(0); PG8_MMA(1, 0, At, B0); PG8_BAR; PG8_SCHED;
      PG8_STAGE(PG8_SB(1, 1), b3 + hstep, voffB);
      PG8_WAIT_V(6); PG8_BAR; PG8_MMA(1, 1, At, B1); PG8_BAR;
    }
    E(acc, cur, wr, wc, fr, fq);
    if (!has_next) break;
#pragma unroll
    for (int a = 0; a < 2; ++a)
#pragma unroll
      for (int b = 0; b < 2; ++b)
#pragma unroll
        for (int m = 0; m < 4; ++m)
#pragma unroll
          for (int n = 0; n < 2; ++n) acc[a][b][m][n] = (f32x4){0.f, 0.f, 0.f, 0.f};
    cur = nxt; cA = nA; cB = nB; ++ui;
  }
  PG8_WAIT_V(0);
  if (wr == 0) PG8_BAR;
  PG8_BAR;
#undef PG8_SA
#undef PG8_SB
#undef PG8_STAGE
#undef PG8_LDA
#undef PG8_LDB
#undef PG8_MMA
#undef PG8_WAIT_V
#undef PG8_WAIT_L
#undef PG8_BAR
#undef PG8_SCHED
}

typedef f32x4 Acc[2][2][4][2];
__device__ __forceinline__ u32x4 pack8(f32x4 a, f32x4 b) { u32x4 o; o[0] = cvt_pk_bf16(a[0], a[1]); o[1] = cvt_pk_bf16(a[2], a[3]); o[2] = cvt_pk_bf16(b[0], b[1]); o[3] = cvt_pk_bf16(b[2], b[3]); return o; }

struct EpiStore {
  static constexpr bool PERM = true; bf16_t* O; int ldc;
  __device__ __forceinline__ void operator()(const Acc& acc, const Unit& u, int wr, int wc, int fr, int fq) const {
    const int row0 = u.pm * BM + wr * 64 + fr, col0 = u.pn * BM + wc * 32 + 8 * fq;
#pragma unroll
    for (int ai = 0; ai < 2; ++ai)
#pragma unroll
      for (int m = 0; m < 4; ++m) { bf16_t* rp = O + (size_t)(row0 + ai * HALF + m * 16) * ldc + col0;
#pragma unroll
        for (int bj = 0; bj < 2; ++bj) *(u32x4*)(rp + bj * HALF) = pack8(acc[ai][bj][m][0], acc[ai][bj][m][1]); }
  }
};
struct EpiQK2 {
  static constexpr bool PERM = true; bf16_t* O;
  __device__ __forceinline__ void operator()(const Acc& acc, const Unit& u, int wr, int wc, int fr, int fq) const {
    const int row0 = u.pm * BM + wr * 64 + fr, col0 = u.pn * BM + wc * 32 + 8 * fq;
#pragma unroll
    for (int ai = 0; ai < 2; ++ai)
#pragma unroll
      for (int m = 0; m < 4; ++m) { const int tok = row0 + ai * HALF + m * 16;
#pragma unroll
        for (int bj = 0; bj < 2; ++bj) { const int n = col0 + bj * HALF; const int which = n >> 10, h = (n >> 5) & 31, d = n & 31;
          *(u32x4*)(O + (size_t)which * ((size_t)T * 1024) + ((size_t)((tok >> 6) * 32 + h) * 64 + (tok & 63)) * 32 + d) = pack8(acc[ai][bj][m][0], acc[ai][bj][m][1]); } }
  }
};
struct EpiVT {
  static constexpr bool PERM = true; bf16_t* O;
  __device__ __forceinline__ void operator()(const Acc& acc, const Unit& u, int wr, int wc, int fr, int fq) const {
    const int row0 = u.pm * BM + wr * 64 + fr, col0 = u.pn * BM + wc * 32 + 8 * fq;
#pragma unroll
    for (int ai = 0; ai < 2; ++ai)
#pragma unroll
      for (int m = 0; m < 4; ++m) { const int ch = row0 + ai * HALF + m * 16;
#pragma unroll
        for (int bj = 0; bj < 2; ++bj) { const int tok = col0 + bj * HALF;
          *(u32x4*)(O + (size_t)(tok >> 6) * 65536 + (size_t)(((ch >> 5) * 8 + ((tok & 63) >> 3)) * 32 + (ch & 31)) * 8) = pack8(acc[ai][bj][m][0], acc[ai][bj][m][1]); } }
  }
};
struct EpiResid {
  static constexpr bool PERM = false; float* X;
  __device__ __forceinline__ void operator()(const Acc& acc, const Unit& u, int wr, int wc, int fr, int fq) const {
    const int row0 = u.pm * BM + wr * 64 + fr, col0 = u.pn * BM + wc * 32 + 4 * fq;
#pragma unroll
    for (int ai = 0; ai < 2; ++ai)
#pragma unroll
      for (int m = 0; m < 4; ++m) { float* rp = X + (size_t)(row0 + ai * HALF + m * 16) * 1024 + col0;
#pragma unroll
        for (int bj = 0; bj < 2; ++bj)
#pragma unroll
          for (int n = 0; n < 2; ++n) { f32x4* q = (f32x4*)(rp + bj * HALF + n * 16); *q = *q * ALPHA + acc[ai][bj][m][n]; } __builtin_amdgcn_sched_barrier(0); }
  }
};
__device__ __forceinline__ f32x4 swiglu4(f32x4 g, f32x4 u) { f32x4 o;
#pragma unroll
  for (int j = 0; j < 4; ++j) o[j] = g[j] * __builtin_amdgcn_rcpf(1.f + __expf(-g[j])) * u[j];
  return o; }
struct EpiSwiglu {
  static constexpr bool PERM = true; bf16_t* H; int ldh, NC, row_base;
  __device__ __forceinline__ void operator()(const Acc& acc, const Unit& u, int wr, int wc, int fr, int fq) const {
    const int row0 = u.pm * BM - row_base + wr * 64 + fr, col0 = (u.pn % NC) * HALF + wc * 32 + 8 * fq;
#pragma unroll
    for (int ai = 0; ai < 2; ++ai)
#pragma unroll
      for (int m = 0; m < 4; ++m)
        *(u32x4*)(H + (size_t)(row0 + ai * HALF + m * 16) * ldh + col0) = pack8(swiglu4(acc[ai][0][m][0], acc[ai][1][m][0]), swiglu4(acc[ai][0][m][1], acc[ai][1][m][1]));
  }
};
struct EpiRwkv {
  static constexpr bool PERM = true; bf16_t* RKV; bf16_t* LBWA; bf16_t* LBG;
  __device__ __forceinline__ void operator()(const Acc& acc, const Unit& u, int wr, int wc, int fr, int fq) const {
    const int row0 = u.pm * BM + wr * 64 + fr;
    if (u.pn < 12) {
      const int col0 = u.pn * BM + wc * 32 + 8 * fq;
#pragma unroll
      for (int ai = 0; ai < 2; ++ai)
#pragma unroll
        for (int m = 0; m < 4; ++m) { bf16_t* rp = RKV + (size_t)(row0 + ai * HALF + m * 16) * 3072 + col0;
#pragma unroll
          for (int bj = 0; bj < 2; ++bj) *(u32x4*)(rp + bj * HALF) = pack8(acc[ai][bj][m][0], acc[ai][bj][m][1]); }
    } else {
      const bool isg = (u.pn == 13); bf16_t* O = isg ? LBG : LBWA; const int c0 = wc * 32 + 8 * fq;
#pragma unroll
      for (int ai = 0; ai < 2; ++ai)
#pragma unroll
        for (int m = 0; m < 4; ++m) { bf16_t* rp = O + (size_t)(row0 + ai * HALF + m * 16) * 256 + c0;
#pragma unroll
          for (int bj = 0; bj < 2; ++bj) { f32x4 v0 = acc[ai][bj][m][0], v1 = acc[ai][bj][m][1]; const int c = bj * HALF + c0;
            if (isg) { if (c < 160) {
#pragma unroll
                for (int j = 0; j < 4; ++j) { v0[j] = sigmoidf_(v0[j]); v1[j] = sigmoidf_(v1[j]); } } else { v0 = (f32x4){0.f, 0.f, 0.f, 0.f}; v1 = v0; } }
            else if (bj == 0) {
#pragma unroll
              for (int j = 0; j < 4; ++j) { v0[j] = 1.f - 2.f * __builtin_amdgcn_rcpf(1.f + __expf(2.f * v0[j])); v1[j] = 1.f - 2.f * __builtin_amdgcn_rcpf(1.f + __expf(2.f * v1[j])); } }
            *(u32x4*)(rp + bj * HALF) = pack8(v0, v1); } }
    }
  }
};
struct EpiMulPre {
  static constexpr bool PERM = true; bf16_t* P;
  __device__ __forceinline__ void operator()(const Acc& acc, const Unit& u, int wr, int wc, int fr, int fq) const {
    const int row0 = u.pm * BM + wr * 64 + fr, col0 = u.pn * BM + wc * 32 + 8 * fq;
#pragma unroll
    for (int ai = 0; ai < 2; ++ai)
#pragma unroll
      for (int m = 0; m < 4; ++m) { bf16_t* rp = P + (size_t)(row0 + ai * HALF + m * 16) * 1024 + col0;
#pragma unroll
        for (int bj = 0; bj < 2; ++bj) { u32x4* q = (u32x4*)(rp + bj * HALF); const u32x4 pv = *q; f32x4 a = acc[ai][bj][m][0], b = acc[ai][bj][m][1];
          a[0] *= bflo(pv[0]); a[1] *= bfhi(pv[0]); a[2] *= bflo(pv[1]); a[3] *= bfhi(pv[1]); b[0] *= bflo(pv[2]); b[1] *= bfhi(pv[2]); b[2] *= bflo(pv[3]); b[3] *= bfhi(pv[3]);
          *q = pack8(a, b); } __builtin_amdgcn_sched_barrier(0); }
  }
};
struct EpiMoeDown {
  static constexpr bool PERM = false; float* X; const int* rowl; const float* rowg; int row_base;
  __device__ __forceinline__ void operator()(const Acc& acc, const Unit& u, int wr, int wc, int fr, int fq) const {
    const int row0 = row_base + u.pm * BM + wr * 64 + fr, col0 = (u.pn & 3) * BM + wc * 32 + 4 * fq;
#pragma unroll
    for (int ai = 0; ai < 2; ++ai)
#pragma unroll
      for (int m = 0; m < 4; ++m) { const int lr = row0 + ai * HALF + m * 16; const int tok = rowl[lr];
        if (tok >= 0) { const float gt = rowg[lr]; float* rp = X + (size_t)tok * 1024 + col0;
#pragma unroll
          for (int bj = 0; bj < 2; ++bj)
#pragma unroll
            for (int n = 0; n < 2; ++n) { f32x4* q = (f32x4*)(rp + bj * HALF + n * 16); *q = *q + acc[ai][bj][m][n] * gt; } } __builtin_amdgcn_sched_barrier(0); }
  }
};
struct MoeDownOrder {
  int first, ntile, G, c; const LAS int* ts;
  __device__ bool next(int i, Unit& u) const {
    const long L = (long)i * G + c; if (L >= (long)ntile * 4) return false;
    const int l = (int)L, pm = l >> 2, pn = l & 3; int g = 0;
#pragma unroll
    for (int k = 1; k < 16; ++k) g += ((first + pm) >= ts[k]) ? 1 : 0;
    u.pm = pm; u.pn = (g & 7) * 4 + pn; return true;
  }
};

__device__ __forceinline__ void ln_row(const float* y, const float* g, const float* b, int lane, f32x4 (&o)[4]) {
  f32x4 v[4]; float s = 0.f;
#pragma unroll
  for (int k = 0; k < 4; ++k) { v[k] = *(const f32x4*)(y + k * 256 + lane * 4); s += v[k][0] + v[k][1] + v[k][2] + v[k][3]; }
  const float mean = wave_sum(s) * (1.f / 1024.f); float q = 0.f;
#pragma unroll
  for (int k = 0; k < 4; ++k) { v[k] = v[k] - mean; q += v[k][0] * v[k][0] + v[k][1] * v[k][1] + v[k][2] * v[k][2] + v[k][3] * v[k][3]; }
  const float rstd = rsqrtf(wave_sum(q) * (1.f / 1024.f) + 1e-5f);
#pragma unroll
  for (int k = 0; k < 4; ++k) { const f32x4 gg = *(const f32x4*)(g + k * 256 + lane * 4), bb = *(const f32x4*)(b + k * 256 + lane * 4); o[k] = v[k] * rstd * gg + bb; }
}

__device__ __forceinline__ void ln_row2(const float* y0, const float* y1, const float* g, const float* b, int lane, f32x4 (&o0)[4], f32x4 (&o1)[4]) {
  f32x4 v[4], u[4]; float s0 = 0.f, s1 = 0.f;
#pragma unroll
  for (int k = 0; k < 4; ++k) { v[k] = *(const f32x4*)(y0 + k * 256 + lane * 4); u[k] = *(const f32x4*)(y1 + k * 256 + lane * 4); }
#pragma unroll
  for (int k = 0; k < 4; ++k) { s0 += v[k][0] + v[k][1] + v[k][2] + v[k][3]; s1 += u[k][0] + u[k][1] + u[k][2] + u[k][3]; }
  const float m0 = wave_sum(s0) * (1.f / 1024.f), m1 = wave_sum(s1) * (1.f / 1024.f); float q0 = 0.f, q1 = 0.f;
#pragma unroll
  for (int k = 0; k < 4; ++k) { v[k] = v[k] - m0; u[k] = u[k] - m1; q0 += v[k][0] * v[k][0] + v[k][1] * v[k][1] + v[k][2] * v[k][2] + v[k][3] * v[k][3]; q1 += u[k][0] * u[k][0] + u[k][1] * u[k][1] + u[k][2] * u[k][2] + u[k][3] * u[k][3]; }
  const float r0 = rsqrtf(wave_sum(q0) * (1.f / 1024.f) + 1e-5f), r1 = rsqrtf(wave_sum(q1) * (1.f / 1024.f) + 1e-5f);
#pragma unroll
  for (int k = 0; k < 4; ++k) { const f32x4 gg = *(const f32x4*)(g + k * 256 + lane * 4), bb = *(const f32x4*)(b + k * 256 + lane * 4); o0[k] = v[k] * r0 * gg + bb; o1[k] = u[k] * r1 * gg + bb; }
}

__device__ __forceinline__ void attn_phase(const bf16_t* __restrict__ QK, const bf16_t* __restrict__ VT, const float* __restrict__ EB, bf16_t* __restrict__ O) {
  const int tid = tid_(), lane = tid & 63, qi = lane & 15, g = lane >> 4;
  const int nw = gridDim.x * 8, w0 = blockIdx.x * 8 + (tid >> 6);
  const int krho = ((qi >> 2) * 8) + (qi & 3);
  int cur_combo = -1; f32x4 bias[8][2];
  for (int u = w0; u < 768 * 4 * 32; u += nw) {
    const int combo = u & 127, h = u & 31, c = (u >> 5) & 3, R = u >> 7;
    const float* eb = EB + (size_t)combo * (15 * 512) + lane * 8;
    if (combo != cur_combo) { cur_combo = combo;
#pragma unroll
      for (int i = 0; i < 8; ++i) { bias[i][0] = *(const f32x4*)(eb + (3 + i) * 512); bias[i][1] = *(const f32x4*)(eb + (3 + i) * 512 + 4); } }
    int seq_row0, rows; if (R < 256) { seq_row0 = R & ~127; rows = 128; } else { seq_row0 = 256 + ((R - 256) & ~63); rows = 64; }
    const int r = R - seq_row0; int rs = r - 4; rs = rs < 0 ? 0 : rs; rs = rs > rows - 8 ? rows - 8 : rs;
    const int blk = (c == 0) ? 0 : (c == 1) ? 8 : (c == 2) ? 24 : 32;
    const int qcol = 16 * c + qi;
    const bf16x8 qf = *(const bf16x8*)(QK + ((size_t)(R * 32 + h) * 64 + qcol) * 32 + g * 8);
    f32x4 s[8][2];
    const bf16_t* kbase = QK + (size_t)T * 1024 + ((size_t)((seq_row0 + rs) * 32 + h) * 64 + blk + krho) * 32 + g * 8;
#pragma unroll
    for (int i = 0; i < 8; ++i)
#pragma unroll
      for (int hh = 0; hh < 2; ++hh) {
        const bf16x8 kf = *(const bf16x8*)(kbase + (size_t)i * 65536 + hh * 128);
        s[i][hh] = __builtin_amdgcn_mfma_f32_16x16x32_bf16(kf, qf, (f32x4){0.f, 0.f, 0.f, 0.f}, 0, 0, 0);
      }
    if (rs - r == -4) {
#pragma unroll
      for (int i = 0; i < 8; ++i) { s[i][0] = s[i][0] + bias[i][0]; s[i][1] = s[i][1] + bias[i][1]; }
    } else {
      const float* ebr = eb + (rs - r + 7) * 512;
#pragma unroll
      for (int i = 0; i < 8; ++i) { s[i][0] = s[i][0] + *(const f32x4*)(ebr + i * 512); s[i][1] = s[i][1] + *(const f32x4*)(ebr + i * 512 + 4); }
    }
    float mx = -3.0e38f;
#pragma unroll
    for (int i = 0; i < 8; ++i)
#pragma unroll
      for (int hh = 0; hh < 2; ++hh) mx = fmaxf(fmaxf(mx, fmaxf(s[i][hh][0], s[i][hh][1])), fmaxf(s[i][hh][2], s[i][hh][3]));
    mx = fmaxf(mx, __shfl_xor(mx, 16)); mx = fmaxf(mx, __shfl_xor(mx, 32));
    float sum = 0.f;
#pragma unroll
    for (int i = 0; i < 8; ++i)
#pragma unroll
      for (int hh = 0; hh < 2; ++hh)
#pragma unroll
        for (int j = 0; j < 4; ++j) { const float e = __expf(s[i][hh][j] - mx); s[i][hh][j] = e; sum += e; }
    sum += __shfl_xor(sum, 16); sum += __shfl_xor(sum, 32);
    f32x4 o0 = {0.f, 0.f, 0.f, 0.f}, o1 = {0.f, 0.f, 0.f, 0.f};
#pragma unroll
    for (int i = 0; i < 8; ++i) {
      const u32x4 pu = pack8(s[i][0], s[i][1]); const bf16x8 pf = __builtin_bit_cast(bf16x8, pu);
      const bf16_t* vb = VT + (size_t)(seq_row0 + rs + i) * 65536 + (size_t)((h * 8 + (blk >> 3) + g) * 32 + qi) * 8;
      const bf16x8 v0 = *(const bf16x8*)vb, v1 = *(const bf16x8*)(vb + 16 * 8);
      o0 = __builtin_amdgcn_mfma_f32_16x16x32_bf16(v0, pf, o0, 0, 0, 0);
      o1 = __builtin_amdgcn_mfma_f32_16x16x32_bf16(v1, pf, o1, 0, 0, 0);
    }
    const float inv = 1.f / sum;
    bf16_t* op = O + (size_t)(R * 64 + qcol) * 1024 + h * 32 + g * 4;
    u32x2 a, b; a[0] = cvt_pk_bf16(o0[0] * inv, o0[1] * inv); a[1] = cvt_pk_bf16(o0[2] * inv, o0[3] * inv); b[0] = cvt_pk_bf16(o1[0] * inv, o1[1] * inv); b[1] = cvt_pk_bf16(o1[2] * inv, o1[3] * inv);
    *(u32x2*)op = a; *(u32x2*)(op + 16) = b;
  }
}

constexpr int SC_WD = 0, SC_AA = 2048, SC_KD = 4096, SC_BB = 6144, SC_NA = 8192, SC_RR = 10240, SC_VV = 12288, SC_YO = 14336;
typedef float f32x2 __attribute__((ext_vector_type(2)));
#define LO2(v) __builtin_shufflevector(v, v, 0, 1)
#define HI2(v) __builtin_shufflevector(v, v, 2, 3)
template <int NR> __device__ __forceinline__ void scan_steps(LAS float* L, int z, int vrow, int ko, f32x2 (&St)[2][4]) {
  const int sstep = z ? -64 : 64; const LAS float* bp = L + ko * 8 + (z ? 31 * 64 : 0);
  const LAS float* vp = L + SC_VV + vrow + (z ? 31 * 64 : 0); LAS float* yp = L + SC_YO + vrow + (z ? 31 * 64 : 0);
  f32x4 c[10]; float cv[NR];
  c[0] = *(const LAS f32x4*)(bp + SC_NA); c[1] = *(const LAS f32x4*)(bp + SC_NA + 4); c[2] = *(const LAS f32x4*)(bp + SC_WD); c[3] = *(const LAS f32x4*)(bp + SC_WD + 4);
  c[4] = *(const LAS f32x4*)(bp + SC_BB); c[5] = *(const LAS f32x4*)(bp + SC_BB + 4); c[6] = *(const LAS f32x4*)(bp + SC_KD); c[7] = *(const LAS f32x4*)(bp + SC_KD + 4);
  c[8] = *(const LAS f32x4*)(bp + SC_RR); c[9] = *(const LAS f32x4*)(bp + SC_RR + 4);
#pragma unroll
  for (int r = 0; r < NR; ++r) cv[r] = vp[r];
#pragma unroll 4
  for (int si = 0; si < 32; ++si) {
    f32x4 n[10]; float nv[NR];
    const LAS float* bn = bp + ((si < 31) ? sstep : 0); const LAS float* vn = vp + ((si < 31) ? sstep : 0);
    n[0] = *(const LAS f32x4*)(bn + SC_NA); n[1] = *(const LAS f32x4*)(bn + SC_NA + 4); n[2] = *(const LAS f32x4*)(bn + SC_WD); n[3] = *(const LAS f32x4*)(bn + SC_WD + 4);
    n[4] = *(const LAS f32x4*)(bn + SC_BB); n[5] = *(const LAS f32x4*)(bn + SC_BB + 4); n[6] = *(const LAS f32x4*)(bn + SC_KD); n[7] = *(const LAS f32x4*)(bn + SC_KD + 4);
    n[8] = *(const LAS f32x4*)(bn + SC_RR); n[9] = *(const LAS f32x4*)(bn + SC_RR + 4);
#pragma unroll
    for (int r = 0; r < NR; ++r) nv[r] = vn[r];
    float sa[NR], yy[NR];
#pragma unroll
    for (int r = 0; r < NR; ++r) { f32x2 p1 = St[r][0] * LO2(c[0]), p2 = St[r][1] * HI2(c[0]); p1 = St[r][2] * LO2(c[1]) + p1; p2 = St[r][3] * HI2(c[1]) + p2; p1 = p1 + p2; sa[r] = p1[0] + p1[1]; }
#pragma unroll
    for (int r = 0; r < NR; ++r) sa[r] = red8(sa[r]);
#pragma unroll
    for (int r = 0; r < NR; ++r) { const f32x2 s2 = {sa[r], sa[r]}, v2 = {cv[r], cv[r]};
      St[r][0] = St[r][0] * LO2(c[2]) + (s2 * LO2(c[4]) + v2 * LO2(c[6])); St[r][1] = St[r][1] * HI2(c[2]) + (s2 * HI2(c[4]) + v2 * HI2(c[6]));
      St[r][2] = St[r][2] * LO2(c[3]) + (s2 * LO2(c[5]) + v2 * LO2(c[7])); St[r][3] = St[r][3] * HI2(c[3]) + (s2 * HI2(c[5]) + v2 * HI2(c[7])); }
#pragma unroll
    for (int r = 0; r < NR; ++r) { f32x2 q1 = St[r][0] * LO2(c[8]), q2 = St[r][1] * HI2(c[8]); q1 = St[r][2] * LO2(c[9]) + q1; q2 = St[r][3] * HI2(c[9]) + q2; q1 = q1 + q2; yy[r] = q1[0] + q1[1]; }
#pragma unroll
    for (int r = 0; r < NR; ++r) yy[r] = red8(yy[r]);
    if (ko == 0) {
#pragma unroll
      for (int r = 0; r < NR; ++r) yp[r] = yy[r]; }
#pragma unroll
    for (int j = 0; j < 10; ++j) c[j] = n[j];
#pragma unroll
    for (int r = 0; r < NR; ++r) cv[r] = nv[r];
    bp = bn; vp = vn; yp += sstep;
  }
}
__device__ __forceinline__ int chain_chunks(int chain) { return chain < 0 ? 0 : (chain < 64 ? 256 : 128); }
__device__ __forceinline__ void scan_block(unsigned char* ws, LAS float* Lall, int chainA, int modeA, int rbA, int chainB, int modeB, int rbB) {
  const int tid = tid_(), wid = tid >> 6, lane = tid & 63, grp = wid >> 2, gw4 = wid & 3, gtid = tid & 255;
  const int chain = grp ? chainB : chainA, mode = grp ? modeB : modeA, rowbase = grp ? rbB : rbA;
  LAS float* L = Lall + grp * 16384;
  const int nA = chain_chunks(chainA), nB = chain_chunks(chainB), nloop = nA > nB ? nA : nB;
  const int cc = chain < 0 ? 0 : chain;
  int h, z, Lq; size_t tok0;
  if (cc < 64) { h = (cc & 31) >> 1; z = cc & 1; Lq = 8192; tok0 = (size_t)(cc >> 5) * 8192; }
  else { const int c2 = cc - 64; h = (c2 & 31) >> 1; z = c2 & 1; Lq = 4096; tok0 = 16384 + (size_t)(c2 >> 5) * 4096; }
  const int nchunk = chain < 0 ? 0 : Lq / 32;
  const bf16_t* RKV = (const bf16_t*)(ws + OFF_RKV); const bf16_t* LBWA = (const bf16_t*)(ws + OFF_LBWA); const bf16_t* W2T = (const bf16_t*)(ws + OFF_W2T);
  bf16_t* Y = (bf16_t*)(ws + (z ? OFF_YB : OFF_YF)); float* bonus = (float*)(ws + OFF_BONUS);
  const int tk = gtid >> 3, c8 = (gtid & 7) * 8, ch0 = h * 64 + c8;
  const int ko = lane & 7, vl = lane >> 3, vrow = mode ? rowbase + gw4 * 8 + vl : gw4 * 16 + vl * 2;
  const int mat = gw4 >> 1, ntile = gw4 & 1;
  const f32x4 kk0 = *(const f32x4*)(INP(18) + ch0), kk1 = *(const f32x4*)(INP(18) + ch0 + 4), ka0 = *(const f32x4*)(INP(19) + ch0), ka1 = *(const f32x4*)(INP(19) + ch0 + 4);
  const f32x4 rk0 = *(const f32x4*)(INP(20) + ch0), rk1 = *(const f32x4*)(INP(20) + ch0 + 4);
  bf16x8 bfrag[4]; const int chb = h * 64 + ntile * 32 + (lane & 31);
#pragma unroll
  for (int ks = 0; ks < 4; ++ks) bfrag[ks] = *(const bf16x8*)(W2T + ((size_t)(mat * 2 + z) * 1024 + chb) * 64 + ks * 16 + (lane >> 5) * 8);
  const float bias0 = (mat ? INP(13) : INP(10))[z * 1024 + chb];
  u32x4 rawr, rawk, rawv; bf16x8 afrag[4];
  { const size_t tb = tok0 + (size_t)(z ? (nchunk > 0 ? nchunk - 1 : 0) : 0) * 32; const bf16_t* rp = RKV + (tb + tk) * 3072 + ch0;
    rawr = *(const u32x4*)rp; rawk = *(const u32x4*)(rp + 1024); rawv = *(const u32x4*)(rp + 2048);
#pragma unroll
    for (int ks = 0; ks < 4; ++ks) afrag[ks] = *(const bf16x8*)(LBWA + (tb + (lane & 31)) * 256 + mat * 128 + z * 64 + ks * 16 + (lane >> 5) * 8); }
  f32x2 St[2][4];
#pragma unroll
  for (int r = 0; r < 2; ++r)
#pragma unroll
    for (int j = 0; j < 4; ++j) St[r][j] = (f32x2){0.f, 0.f};
  for (int ci = 0; ci < nloop; ++ci) {
    const bool act = ci < nchunk;
    const size_t tb = tok0 + (size_t)(act ? (z ? nchunk - 1 - ci : ci) : 0) * 32;
    if (act) {
      f32x16 acc;
#pragma unroll
      for (int j = 0; j < 16; ++j) acc[j] = 0.f;
#pragma unroll
      for (int ks = 0; ks < 4; ++ks) acc = __builtin_amdgcn_mfma_f32_32x32x16_bf16(afrag[ks], bfrag[ks], acc, 0, 0, 0);
      LAS float* dst = L + (mat ? SC_AA : SC_WD) + ntile * 32 + (lane & 31);
#pragma unroll
      for (int rg = 0; rg < 16; ++rg) { const int row = (rg & 3) + 8 * (rg >> 2) + 4 * (lane >> 5); const float sg = sigmoidf_(acc[rg] + bias0);
        dst[row * 64] = mat ? sg : __expf(-0.60653065971263342f * sg); }
    }
    __syncthreads();
    if (act) {
      float r8[8], k8[8], kx[8]; float ss = 0.f;
#pragma unroll
      for (int j = 0; j < 4; ++j) { r8[2 * j] = bflo(rawr[j]); r8[2 * j + 1] = bfhi(rawr[j]); k8[2 * j] = bflo(rawk[j]); k8[2 * j + 1] = bfhi(rawk[j]); }
#pragma unroll
      for (int j = 0; j < 8; ++j) { kx[j] = k8[j] * (j < 4 ? kk0[j & 3] : kk1[j & 3]); ss += kx[j] * kx[j]; }
      ss = red8(ss); const float inv = __builtin_amdgcn_rsqf(fmaxf(ss, 1e-24f));
      const f32x4 a0 = *(const LAS f32x4*)(L + SC_AA + tk * 64 + c8), a1 = *(const LAS f32x4*)(L + SC_AA + tk * 64 + c8 + 4);
      f32x4 kd[2], bb[2], na[2], rr[2], vv[2]; float bon = 0.f;
#pragma unroll
      for (int j = 0; j < 8; ++j) { const float a = (j < 4 ? a0[j & 3] : a1[j & 3]), kav = (j < 4 ? ka0[j & 3] : ka1[j & 3]), rkv = (j < 4 ? rk0[j & 3] : rk1[j & 3]);
        const float kn = kx[j] * inv, kdv = k8[j] * (1.f + (a - 1.f) * kav); kd[j >> 2][j & 3] = kdv; bb[j >> 2][j & 3] = kn * a; na[j >> 2][j & 3] = -kn; rr[j >> 2][j & 3] = r8[j]; bon += r8[j] * kdv * rkv; }
#pragma unroll
      for (int j = 0; j < 4; ++j) { vv[j >> 1][(j & 1) * 2] = bflo(rawv[j]); vv[j >> 1][(j & 1) * 2 + 1] = bfhi(rawv[j]); }
      LAS float* lp = L + tk * 64 + c8;
      *(LAS f32x4*)(lp + SC_KD) = kd[0]; *(LAS f32x4*)(lp + SC_KD + 4) = kd[1]; *(LAS f32x4*)(lp + SC_BB) = bb[0]; *(LAS f32x4*)(lp + SC_BB + 4) = bb[1];
      *(LAS f32x4*)(lp + SC_NA) = na[0]; *(LAS f32x4*)(lp + SC_NA + 4) = na[1]; *(LAS f32x4*)(lp + SC_RR) = rr[0]; *(LAS f32x4*)(lp + SC_RR + 4) = rr[1];
      *(LAS f32x4*)(lp + SC_VV) = vv[0]; *(LAS f32x4*)(lp + SC_VV + 4) = vv[1];
      bon = red8(bon); if ((gtid & 7) == 0 && rowbase == 0) bonus[((tb + tk) * 16 + h) * 2 + z] = bon;
    }
    __syncthreads();
    if (act && ci + 1 < nchunk) { const size_t tn = tok0 + (size_t)(z ? nchunk - 2 - ci : ci + 1) * 32; const bf16_t* rp = RKV + (tn + tk) * 3072 + ch0;
      rawr = *(const u32x4*)rp; rawk = *(const u32x4*)(rp + 1024); rawv = *(const u32x4*)(rp + 2048);
#pragma unroll
      for (int ks = 0; ks < 4; ++ks) afrag[ks] = *(const bf16x8*)(LBWA + (tn + (lane & 31)) * 256 + mat * 128 + z * 64 + ks * 16 + (lane >> 5) * 8); }
    if (act) { if (mode) scan_steps<1>(L, z, vrow, ko, St); else scan_steps<2>(L, z, vrow, ko, St); }
    __syncthreads();
    if (act) {
      if (mode) { const int c4 = rowbase + (gtid & 7) * 4; const f32x4 yv = *(const LAS f32x4*)(L + SC_YO + tk * 64 + c4); u32x2 o; o[0] = cvt_pk_bf16(yv[0], yv[1]); o[1] = cvt_pk_bf16(yv[2], yv[3]);
        *(u32x2*)(Y + (tb + tk) * 1024 + h * 64 + c4) = o; }
      else { const f32x4 y0 = *(const LAS f32x4*)(L + SC_YO + tk * 64 + c8), y1 = *(const LAS f32x4*)(L + SC_YO + tk * 64 + c8 + 4);
        *(u32x4*)(Y + (tb + tk) * 1024 + ch0) = pack8(y0, y1); }
    }
  }
  __syncthreads();
}

__global__ void __launch_bounds__(512, 2) mega(Params p) {
  cg::grid_group grid = cg::this_grid();
  LAS unsigned char* lds = (LAS unsigned char*)shm;
  LAS int* TS = (LAS int*)(lds + LDS_TS);
  unsigned char* ws = p.ws;
  { const unsigned* ka = (const unsigned*)__builtin_amdgcn_kernarg_segment_ptr(); if (threadIdx.x < 66) ((LAS unsigned*)(lds + LDS_TAB))[threadIdx.x] = ka[threadIdx.x]; }
  __syncthreads();
  const int G = gridDim.x, nw = G * 8;
  const long ngt = (long)G * 512;
#define PH_VARS const int tid = tid_(), lane = tid & 63, wid = tid >> 6, gw = blockIdx.x * 8 + wid; const long gt = (long)blockIdx.x * 512 + tid; (void)lane; (void)gw; (void)gt;
  float* X = p.X;

  { PH_VARS
  {
    int rot = 0; float* tile = (float*)shm;
    const float* wqkv = INP(2);
    rot = cvt_run(mkjob(wqkv, 3072, 1024, 1024, (bf16_t*)(ws + OFF_WQKT), 1024, 0, 0, nullptr, 0.17677669529663687f, 0), tile, rot);
    rot = cvt_run(mkjob(wqkv + 1024, 3072, 1024, 1024, (bf16_t*)(ws + OFF_WQKT), 1024, 1024, 0, nullptr, 1.f, 0), tile, rot);
    rot = cvt_run(mkjob(wqkv + 2048, 3072, 1024, 1024, (bf16_t*)(ws + OFF_WVT), 1024, 0, 0, nullptr, 1.f, 0), tile, rot);
    rot = cvt_run(mkjob(INP(4), 1024, 1024, 1024, (bf16_t*)(ws + OFF_WOT), 1024, 0, 0, nullptr, 1.f, 0), tile, rot);
    rot = cvt_run(mkjob(INP(5), 2816, 1024, 2816, (bf16_t*)(ws + OFF_WGUT), 1024, 0, 0, nullptr, 1.f, 1), tile, rot);
    rot = cvt_run(mkjob(INP(6), 2816, 1024, 2816, (bf16_t*)(ws + OFF_WGUT), 1024, 128, 0, nullptr, 1.f, 1), tile, rot);
    rot = cvt_run(mkjob(INP(7), 1024, 2816, 1024, (bf16_t*)(ws + OFF_WDT), 2816, 0, 0, nullptr, 1.f, 0), tile, rot);
    bf16_t* wrt = (bf16_t*)(ws + OFF_WRT); const float* mu = INP(8);
    for (int half = 0; half < 2; ++half) {
      const int c0 = half * 1024;
      rot = cvt_run(mkjob(INP(9), 1024, 1024, 1024, wrt, 2048, 0, c0, half ? mu + 0 * 1024 : nullptr, 1.f, 0), tile, rot);
      rot = cvt_run(mkjob(INP(9) + 1048576, 1024, 1024, 1024, wrt, 2048, 1024, c0, half ? mu + 2 * 1024 : nullptr, 1.f, 0), tile, rot);
      rot = cvt_run(mkjob(INP(9) + 2097152, 1024, 1024, 1024, wrt, 2048, 2048, c0, half ? mu + 3 * 1024 : nullptr, 1.f, 0), tile, rot);
      rot = cvt_run(mkjob(INP(11), 64, 1024, 64, wrt, 2048, 3072, c0, half ? mu + 1 * 1024 : nullptr, 1.f, 0), tile, rot);
      rot = cvt_run(mkjob(INP(11) + 65536, 64, 1024, 64, wrt, 2048, 3136, c0, half ? mu + 1 * 1024 : nullptr, 1.f, 0), tile, rot);
      rot = cvt_run(mkjob(INP(14), 64, 1024, 64, wrt, 2048, 3200, c0, half ? mu + 4 * 1024 : nullptr, 1.f, 0), tile, rot);
      rot = cvt_run(mkjob(INP(14) + 65536, 64, 1024, 64, wrt, 2048, 3264, c0, half ? mu + 4 * 1024 : nullptr, 1.f, 0), tile, rot);
      rot = cvt_run(mkjob(INP(16), 160, 1024, 160, wrt, 2048, 3328, c0, half ? mu + 5 * 1024 : nullptr, 1.f, 0), tile, rot);
    }
    rot = cvt_run(mkjob(nullptr, 0, 2048, 96, wrt, 2048, 3488, 0, nullptr, 1.f, 0), tile, rot);
    bf16_t* w2t = (bf16_t*)(ws + OFF_W2T);
    rot = cvt_run(mkjob(INP(12), 1024, 64, 1024, w2t, 64, 0, 0, nullptr, 1.f, 0), tile, rot);
    rot = cvt_run(mkjob(INP(12) + 65536, 1024, 64, 1024, w2t, 64, 1024, 0, nullptr, 1.f, 0), tile, rot);
    rot = cvt_run(mkjob(INP(15), 1024, 64, 1024, w2t, 64, 2048, 0, nullptr, 1.f, 0), tile, rot);
    rot = cvt_run(mkjob(INP(15) + 65536, 1024, 64, 1024, w2t, 64, 3072, 0, nullptr, 1.f, 0), tile, rot);
    rot = cvt_run(mkjob(INP(17), 1024, 160, 1024, (bf16_t*)(ws + OFF_G2T), 256, 0, 0, nullptr, 1.f, 0), tile, rot);
    rot = cvt_run(mkjob(nullptr, 0, 96, 1024, (bf16_t*)(ws + OFF_G2T), 256, 0, 160, nullptr, 1.f, 0), tile, rot);
    rot = cvt_run(mkjob(INP(23), 1024, 1024, 1024, (bf16_t*)(ws + OFF_RWOT), 1024, 0, 0, nullptr, 1.f, 0), tile, rot);
    bf16_t* xb = (bf16_t*)(ws + OFF_XB);
    { const float* x0 = INP(0); const float* x1 = INP(1);
    for (long i0 = gt; i0 < (long)T * 256; i0 += 4 * ngt) { f32x4 v[4];
#pragma unroll
      for (int u = 0; u < 4; ++u) { const long i = i0 + u * ngt; if (i < (long)T * 256) v[u] = (i < 16384L * 256) ? *(const f32x4*)(x0 + i * 4) : *(const f32x4*)(x1 + (i - 16384L * 256) * 4); }
#pragma unroll
      for (int u = 0; u < 4; ++u) { const long i = i0 + u * ngt; if (i < (long)T * 256) { *(f32x4*)(X + i * 4) = v[u]; u32x2 o; o[0] = cvt_pk_bf16(v[u][0], v[u][1]); o[1] = cvt_pk_bf16(v[u][2], v[u][3]); *(u32x2*)(xb + i * 4) = o; } } } }
    { float* EBt = (float*)(ws + OFF_EB); const float* rpb = INP(3);
      for (long i = gt; i < 128L * 15 * 512; i += ngt) { const int e = (int)(i & 7), ln = (int)((i >> 3) & 63), dr = (int)((i >> 9) % 15), combo = (int)((i >> 9) / 15);
        const int h = combo & 31, c = combo >> 5, qi = ln & 15, g = ln >> 4; const int blk = (c == 0) ? 0 : (c == 1) ? 8 : (c == 2) ? 24 : 32;
        const int kcol = blk + g * 8 + e, qcol = 16 * c + qi; int qstart = qcol - 8; qstart = qstart < 0 ? 0 : qstart; qstart = qstart > 48 ? 48 : qstart;
        const bool valid = (kcol >= qstart) && (kcol < qstart + 16); int dc = kcol - qcol + 15; dc = dc < 0 ? 0 : dc; dc = dc > 30 ? 30 : dc;
        EBt[i] = valid ? rpb[(h * 15 + dr) * 31 + dc] : -3.0e38f; } }
    int* cnt = (int*)(ws + OFF_CNT); int* rowl = (int*)(ws + OFF_ROWL);
    if (gt < 16) cnt[gt] = 0;
    if (blockIdx.x == 0) for (int i = tid; i < XCD_BAR_WORDS; i += 512) ((unsigned*)(ws + OFF_BAR))[i] = 0u;
    if (tid < 2) ((LAS unsigned*)(lds + LDS_TS + 80))[tid] = 0u;
    for (long i = gt; i < 102400; i += ngt) rowl[i] = -1;
  }
  }
  grid.sync();
  __syncthreads();
  const XcdBarrier xb = xcd_barrier_post((unsigned*)(ws + OFF_BAR), (volatile LAS unsigned*)(lds + LDS_TS + 80));
  { PH_VARS
  { Gemm g{(const bf16_t*)(ws + OFF_XB), (const bf16_t*)(ws + OFF_WQKT), 1024}; StaticOrder S; S.init(T, 2048); EpiQK2 E{(bf16_t*)(ws + OFF_QK)}; gemm_phase(lds, g, S, E); }
  { Gemm g{(const bf16_t*)(ws + OFF_WVT), (const bf16_t*)(ws + OFF_XB), 1024}; StaticOrder S; S.init(1024, T); EpiVT E{(bf16_t*)(ws + OFF_VT)}; gemm_phase(lds, g, S, E); }
  }
  xcd_barrier(xb);
  { PH_VARS
  attn_phase((const bf16_t*)(ws + OFF_QK), (const bf16_t*)(ws + OFF_VT), (const float*)(ws + OFF_EB), (bf16_t*)(ws + OFF_O));
  }
  xcd_barrier(xb);
  { PH_VARS
  { Gemm g{(const bf16_t*)(ws + OFF_O), (const bf16_t*)(ws + OFF_WOT), 1024}; StaticOrder S; S.init(T, 1024); EpiResid E{X}; gemm_phase(lds, g, S, E); }
  }
  xcd_barrier(xb);
  { PH_VARS
  { bf16_t* xb = (bf16_t*)(ws + OFF_XB);
    for (int row = gw; row < T; row += 2 * nw) { const int rw1 = (row + nw < T) ? row + nw : row; f32x4 oo[2][4]; ln_row2(X + (size_t)row * 1024, X + (size_t)rw1 * 1024, INP(29), INP(30), lane, oo[0], oo[1]);
#pragma unroll
      for (int h = 0; h < 2; ++h) { const int rr = h ? rw1 : row;
#pragma unroll
        for (int k = 0; k < 4; ++k) { *(f32x4*)(X + (size_t)rr * 1024 + k * 256 + lane * 4) = oo[h][k]; u32x2 q; q[0] = cvt_pk_bf16(oo[h][k][0], oo[h][k][1]); q[1] = cvt_pk_bf16(oo[h][k][2], oo[h][k][3]); *(u32x2*)(xb + (size_t)rr * 1024 + k * 256 + lane * 4) = q; } } } }
  }
  xcd_barrier(xb);
  { PH_VARS
  { Gemm g{(const bf16_t*)(ws + OFF_XB), (const bf16_t*)(ws + OFF_WGUT), 1024}; StaticOrder S; S.init(T, 5632); EpiSwiglu E{(bf16_t*)(ws + OFF_H), 2816, 1 << 20, 0}; gemm_phase(lds, g, S, E); }
  }
  xcd_barrier(xb);
  { Gemm g{(const bf16_t*)(ws + OFF_H), (const bf16_t*)(ws + OFF_WDT), 2816}; StaticOrder S; S.init(T, 1024); EpiResid E{X}; gemm_phase(lds, g, S, E); }
  xcd_barrier(xb);
  { PH_VARS
  for (int row = gw; row < T; row += 2 * nw) { const int rw1 = (row + nw < T) ? row + nw : row; f32x4 oo[2][4]; ln_row2(X + (size_t)row * 1024, X + (size_t)rw1 * 1024, INP(31), INP(32), lane, oo[0], oo[1]);
#pragma unroll
    for (int h = 0; h < 2; ++h)
#pragma unroll
      for (int k = 0; k < 4; ++k) *(f32x4*)(X + (size_t)(h ? rw1 : row) * 1024 + k * 256 + lane * 4) = oo[h][k]; }
  }
  xcd_barrier(xb);
  { PH_VARS
  { bf16_t* xb2 = (bf16_t*)(ws + OFF_XB2);
    for (int row = gw; row < T; row += nw) {
      const int s0 = row < 16384 ? (row & ~8191) : 16384 + ((row - 16384) & ~4095), len = row < 16384 ? 8192 : 4096;
      const bool hm = row > s0, hp = row < s0 + len - 1;
#pragma unroll
      for (int k = 0; k < 4; ++k) { const size_t off = (size_t)row * 1024 + k * 256 + lane * 4; const f32x4 x = *(const f32x4*)(X + off);
        const f32x4 xm = hm ? *(const f32x4*)(X + off - 1024) : (f32x4){0.f, 0.f, 0.f, 0.f}, xp = hp ? *(const f32x4*)(X + off + 1024) : (f32x4){0.f, 0.f, 0.f, 0.f};
        const f32x4 xx = (xm + xp) * 0.5f - x; u32x2 a, b; a[0] = cvt_pk_bf16(x[0], x[1]); a[1] = cvt_pk_bf16(x[2], x[3]); b[0] = cvt_pk_bf16(xx[0], xx[1]); b[1] = cvt_pk_bf16(xx[2], xx[3]);
        bf16_t* dp = xb2 + (size_t)row * 2048 + k * 256 + lane * 4; *(u32x2*)dp = a; *(u32x2*)(dp + 1024) = b; } } }
  }
  xcd_barrier(xb);
  { PH_VARS
  { Gemm g{(const bf16_t*)(ws + OFF_XB2), (const bf16_t*)(ws + OFF_WRT), 2048}; StaticOrder S; S.init(T, 3584); EpiRwkv E{(bf16_t*)(ws + OFF_RKV), (bf16_t*)(ws + OFF_LBWA), (bf16_t*)(ws + OFF_LBG)}; gemm_phase(lds, g, S, E); }
  }
  xcd_barrier(xb);
  { PH_VARS
  { LAS float* L = (LAS float*)lds; const int b = blockIdx.x;
    for (int round = 0; round < 320; ++round) {
      int cA, mA = 0, rA = 0, cB = -1;
      if (G == 256) { if (round > 0) break; if (b < 128) { cA = b >> 1; mA = 1; rA = (b & 1) * 32; } else { cA = 64 + (b - 128) * 2; cB = cA + 1; } }
      else { cA = b + round * G; if (cA >= 320) break; }
      scan_block(ws, L, cA, mA, rA, cB, 0, 0);
    }
  }
  }
  xcd_barrier(xb);
  { PH_VARS
  { bf16_t* yf = (bf16_t*)(ws + OFF_YF); const bf16_t* yb = (const bf16_t*)(ws + OFF_YB); const bf16_t* rkv = (const bf16_t*)(ws + OFF_RKV); const float* bonus = (const float*)(ws + OFF_BONUS);
    for (int row = gw; row < T; row += nw) {
      const size_t off = (size_t)row * 1024 + lane * 16; const u32x4 a0 = *(const u32x4*)(yf + off), a1 = *(const u32x4*)(yf + off + 8), b0 = *(const u32x4*)(yb + off), b1 = *(const u32x4*)(yb + off + 8);
      const u32x4 v0 = *(const u32x4*)(rkv + (size_t)row * 3072 + 2048 + lane * 16), v1 = *(const u32x4*)(rkv + (size_t)row * 3072 + 2048 + lane * 16 + 8);
      float y[16], vv[16]; float s = 0.f;
#pragma unroll
      for (int j = 0; j < 4; ++j) { y[2 * j] = bflo(a0[j]) + bflo(b0[j]); y[2 * j + 1] = bfhi(a0[j]) + bfhi(b0[j]); y[8 + 2 * j] = bflo(a1[j]) + bflo(b1[j]); y[8 + 2 * j + 1] = bfhi(a1[j]) + bfhi(b1[j]);
        vv[2 * j] = bflo(v0[j]); vv[2 * j + 1] = bfhi(v0[j]); vv[8 + 2 * j] = bflo(v1[j]); vv[8 + 2 * j + 1] = bfhi(v1[j]); }
#pragma unroll
      for (int j = 0; j < 16; ++j) s += y[j];
      const float mean = red4(s) * (1.f / 64.f); float q = 0.f;
#pragma unroll
      for (int j = 0; j < 16; ++j) { y[j] -= mean; q += y[j] * y[j]; }
      const float rstd = rsqrtf(red4(q) * (1.f / 64.f) + 64e-5f);
      const float* bp = bonus + ((size_t)row * 16 + (lane >> 2)) * 2; const float bsum = bp[0] + bp[1];
      u32x4 o0, o1;
#pragma unroll
      for (int j = 0; j < 4; ++j) { const f32x4 gg = *(const f32x4*)(INP(21) + lane * 16 + j * 4), bb = *(const f32x4*)(INP(22) + lane * 16 + j * 4); float t[4];
#pragma unroll
        for (int e = 0; e < 4; ++e) t[e] = y[j * 4 + e] * rstd * gg[e] + bb[e] + bsum * vv[j * 4 + e];
        const unsigned lo = cvt_pk_bf16(t[0], t[1]), hi = cvt_pk_bf16(t[2], t[3]);
        if (j < 2) { o0[2 * j] = lo; o0[2 * j + 1] = hi; } else { o1[2 * (j - 2)] = lo; o1[2 * (j - 2) + 1] = hi; } }
      *(u32x4*)(yf + off) = o0; *(u32x4*)(yf + off + 8) = o1; } }
  }
  xcd_barrier(xb);
  { PH_VARS
  { Gemm g{(const bf16_t*)(ws + OFF_LBG), (const bf16_t*)(ws + OFF_G2T), 256}; StaticOrder S; S.init(T, 1024); EpiMulPre E{(bf16_t*)(ws + OFF_YF)}; gemm_phase(lds, g, S, E); }
  }
  xcd_barrier(xb);
  { PH_VARS
  { Gemm g{(const bf16_t*)(ws + OFF_YF), (const bf16_t*)(ws + OFF_RWOT), 1024}; StaticOrder S; S.init(T, 1024); EpiResid E{X}; gemm_phase(lds, g, S, E); }
  }
  xcd_barrier(xb);
  { PH_VARS
  { bf16_t* xb = (bf16_t*)(ws + OFF_XBM); int* cnt = (int*)(ws + OFF_CNT); int* tokE = (int*)(ws + OFF_TOKE); float* tokG = (float*)(ws + OFF_TOKG); int* tokP = (int*)(ws + OFF_TOKP);
    const float* wr = INP(24); const float* br = INP(25);
    LAS int* lc = (LAS int*)(lds + 100000);
    if (tid < 16) lc[tid] = 0;
    __syncthreads();
    for (int row = gw; row < T; row += nw) { f32x4 o[4]; ln_row(X + (size_t)row * 1024, INP(29) + 1024, INP(30) + 1024, lane, o);
      float lg[8];
#pragma unroll
      for (int e = 0; e < 8; ++e) lg[e] = 0.f;
#pragma unroll
      for (int k = 0; k < 4; ++k) {
#pragma unroll
        for (int j = 0; j < 4; ++j) { const float* wp = wr + (size_t)(k * 256 + lane * 4 + j) * 8; const f32x4 wa = *(const f32x4*)wp, wb = *(const f32x4*)(wp + 4); const float xv = o[k][j];
          lg[0] += xv * wa[0]; lg[1] += xv * wa[1]; lg[2] += xv * wa[2]; lg[3] += xv * wa[3]; lg[4] += xv * wb[0]; lg[5] += xv * wb[1]; lg[6] += xv * wb[2]; lg[7] += xv * wb[3]; }
        *(f32x4*)(X + (size_t)row * 1024 + k * 256 + lane * 4) = o[k] * ALPHA; u32x2 q; q[0] = cvt_pk_bf16(o[k][0], o[k][1]); q[1] = cvt_pk_bf16(o[k][2], o[k][3]); *(u32x2*)(xb + (size_t)row * 1024 + k * 256 + lane * 4) = q; }
#pragma unroll
      for (int e = 0; e < 8; ++e) lg[e] = wave_sum(lg[e]) + br[e];
      int e0 = 0; float v0 = lg[0];
#pragma unroll
      for (int e = 1; e < 8; ++e) if (lg[e] > v0) { v0 = lg[e]; e0 = e; }
      int e1 = -1; float v1 = -3.0e38f;
#pragma unroll
      for (int e = 0; e < 8; ++e) if (e != e0 && lg[e] > v1) { v1 = lg[e]; e1 = e; }
      if (lane == 0) { const float ex = __expf(v1 - v0), g0 = 1.f / (1.f + ex), g1 = ex * g0;
        const int p0 = __hip_atomic_fetch_add(lc + e0, 1, __ATOMIC_RELAXED, __HIP_MEMORY_SCOPE_WORKGROUP), p1 = __hip_atomic_fetch_add(lc + 8 + e1, 1, __ATOMIC_RELAXED, __HIP_MEMORY_SCOPE_WORKGROUP);
        tokE[row * 2] = e0; tokE[row * 2 + 1] = e1; tokG[row * 2] = g0; tokG[row * 2 + 1] = g1; tokP[row * 2] = p0; tokP[row * 2 + 1] = p1; } }
    __syncthreads();
    if (tid < 16) lc[16 + tid] = atomicAdd(cnt + tid, lc[tid]);
    __syncthreads();
    if (lane < 2) for (int row = gw; row < T; row += nw) tokP[row * 2 + lane] += lc[16 + lane * 8 + tokE[row * 2 + lane]];
    __syncthreads();
    int rot = 0; float* tile = (float*)shm;
    for (int e = 0; e < 8; ++e) {
      rot = cvt_run(mkjob(INP(26) + (size_t)e * 1024 * 3584, 3584, 1024, 3584, (bf16_t*)(ws + OFF_WMGU) + (size_t)e * 7168 * 1024, 1024, 0, 0, nullptr, 1.f, 1), tile, rot);
      rot = cvt_run(mkjob(INP(27) + (size_t)e * 1024 * 3584, 3584, 1024, 3584, (bf16_t*)(ws + OFF_WMGU) + (size_t)e * 7168 * 1024, 1024, 128, 0, nullptr, 1.f, 1), tile, rot);
      rot = cvt_run(mkjob(INP(28) + (size_t)e * 3584 * 1024, 1024, 3584, 1024, (bf16_t*)(ws + OFF_WMD) + (size_t)e * 1024 * 3584, 3584, 0, 0, nullptr, 1.f, 0), tile, rot);
    }
  }
  }
  xcd_barrier(xb);
  { PH_VARS
  { const int* cnt = (const int*)(ws + OFF_CNT);
    __syncthreads();
    if (tid == 0) { int a = 0; for (int k = 0; k < 16; ++k) { TS[k] = a; a += (cnt[k] + 255) >> 8; } TS[16] = a; }
    __syncthreads();
    const int* tokE = (const int*)(ws + OFF_TOKE); const float* tokG = (const float*)(ws + OFF_TOKG); const int* tokP = (const int*)(ws + OFF_TOKP);
    int* rowl = (int*)(ws + OFF_ROWL); float* rowg = (float*)(ws + OFF_ROWG); const bf16_t* xb = (const bf16_t*)(ws + OFF_XBM); bf16_t* xs = (bf16_t*)(ws + OFF_XS);
    for (int pr0 = gw; pr0 < T * 2; pr0 += 4 * nw) { u32x4 va[4], vb[4]; int rows[4];
#pragma unroll
      for (int u = 0; u < 4; ++u) { const int pr = pr0 + u * nw; rows[u] = -1; if (pr < T * 2) { const int tok = pr >> 1, rk = pr & 1; const int e = tokE[pr]; const int row = TS[rk * 8 + e] * 256 + tokP[pr]; rows[u] = row;
        if (lane == 0) { rowl[row] = tok; rowg[row] = tokG[pr]; }
        const u32x4* sp = (const u32x4*)(xb + (size_t)tok * 1024); va[u] = sp[lane]; vb[u] = sp[lane + 64]; } }
#pragma unroll
      for (int u = 0; u < 4; ++u) if (rows[u] >= 0) { u32x4* dp = (u32x4*)(xs + (size_t)rows[u] * 1024); dp[lane] = va[u]; dp[lane + 64] = vb[u]; } }
  }
  }
  xcd_barrier(xb);
  { PH_VARS
  { const int ts8 = TS[8], ts16 = TS[16]; const int b = blockIdx.x;
    int pcs = -1, pnt = 0, pbuf = 0, buf = 0;
    for (int rk = 0; rk < 2; ++rk) { const int t0 = rk ? ts16 * 0 + ts8 : 0, t1 = rk ? ts16 : ts8;
      for (int cs = t0; cs < t1; cs += MOE_CHUNK) { const int ntile = (t1 - cs) < MOE_CHUNK ? (t1 - cs) : MOE_CHUNK;
        int nd = 0;
        if (pcs >= 0) { nd = pnt * 4; nd = nd > G ? G : nd;
          Gemm g{(const bf16_t*)(ws + OFF_HID + (size_t)pbuf * HID_BUF), (const bf16_t*)(ws + OFF_WMD), 3584}; MoeDownOrder S{pcs, pnt, G, b, TS}; EpiMoeDown E{X, (const int*)(ws + OFF_ROWL), (const float*)(ws + OFF_ROWG), pcs * 256}; gemm_phase(lds, g, S, E); }
        { Gemm g{(const bf16_t*)(ws + OFF_XS), (const bf16_t*)(ws + OFF_WMGU), 1024}; MoeUpSkewOrder S{cs, ntile, nd, G, b, TS}; EpiSwiglu E{(bf16_t*)(ws + OFF_HID + (size_t)buf * HID_BUF), 3584, 28, cs * 256}; gemm_phase(lds, g, S, E); }
        xcd_barrier(xb);
        pcs = cs; pnt = ntile; pbuf = buf; buf ^= 1;
      } }
    if (pcs >= 0) { Gemm g{(const bf16_t*)(ws + OFF_HID + (size_t)pbuf * HID_BUF), (const bf16_t*)(ws + OFF_WMD), 3584}; MoeDownOrder S{pcs, pnt, G, b, TS}; EpiMoeDown E{X, (const int*)(ws + OFF_ROWL), (const float*)(ws + OFF_ROWG), pcs * 256}; gemm_phase(lds, g, S, E); }
    xcd_barrier(xb);
  }
  }
  { PH_VARS
  for (int row = gw; row < T; row += 2 * nw) { const int rw1 = (row + nw < T) ? row + nw : row; f32x4 oo[2][4]; ln_row2(X + (size_t)row * 1024, X + (size_t)rw1 * 1024, INP(31) + 1024, INP(32) + 1024, lane, oo[0], oo[1]);
#pragma unroll
    for (int h = 0; h < 2; ++h)
#pragma unroll
      for (int k = 0; k < 4; ++k) *(f32x4*)(X + (size_t)(h ? rw1 : row) * 1024 + k * 256 + lane * 4) = oo[h][k]; }
  }
}

extern "C" void kernel_launch(void* const* d_in, const int* in_sizes, int n_in, void* d_out, int out_size, void* d_ws, size_t ws_size, hipStream_t stream) {
  static int grid_blocks = 0;
  if (!grid_blocks) {
    int dev = 0, cus = 0, per_cu = 0;
    (void)hipGetDevice(&dev);
    (void)hipDeviceGetAttribute(&cus, hipDeviceAttributeMultiprocessorCount, dev);
    (void)hipFuncSetAttribute((const void*)mega, hipFuncAttributeMaxDynamicSharedMemorySize, LDS_BYTES);
    (void)hipOccupancyMaxActiveBlocksPerMultiprocessor(&per_cu, mega, 512, LDS_BYTES);
    if (per_cu > 1) per_cu = 1;
    grid_blocks = cus * per_cu;
    if (ws_size < WS_NEED) fprintf(stderr, "workspace too small: %zu < %zu\n", ws_size, (size_t)WS_NEED);
  }
  Params p{};
  for (int i = 0; i < 33; ++i) p.in[i] = (const float*)d_in[i];
  p.X = (float*)d_out; p.ws = (unsigned char*)d_ws;
  void* args[] = {&p};
  hipError_t e = hipLaunchCooperativeKernel((void*)mega, dim3(grid_blocks), dim3(512), args, LDS_BYTES, stream);
  if (e != hipSuccess) fprintf(stderr, "cooperative launch failed: %s (grid %d)\n", hipGetErrorString(e), grid_blocks);
}
```

```cpp
#include <hip/hip_runtime.h>
#include <hip/hip_cooperative_groups.h>
#include <cstdio>
namespace cg = cooperative_groups;

#define LAS __attribute__((address_space(3)))
typedef unsigned short bf16_t;
typedef short bf16x8 __attribute__((ext_vector_type(8)));
typedef float f32x4 __attribute__((ext_vector_type(4)));
typedef float f32x16 __attribute__((ext_vector_type(16)));
typedef unsigned u32x4 __attribute__((ext_vector_type(4)));
typedef unsigned u32x2 __attribute__((ext_vector_type(2)));

constexpr int T = 49152, D = 1024;
constexpr float ALPHA = 1.41421356237309515f;
constexpr size_t SZ = (size_t)T * 1024 * 2;
constexpr size_t OFF_WRT = 0;
constexpr size_t OFF_W2T = OFF_WRT + 14680064;
constexpr size_t OFF_G2T = OFF_W2T + 524288;
constexpr size_t OFF_RWOT = OFF_G2T + 524288;
constexpr size_t OFF_CNT = OFF_RWOT + 2097152;
constexpr size_t OFF_TOKE = OFF_CNT + 256;
constexpr size_t OFF_TOKG = OFF_TOKE + 393216;
constexpr size_t OFF_TOKP = OFF_TOKG + 393216;
constexpr size_t OFF_ROWL = OFF_TOKP + 393216;
constexpr size_t OFF_ROWG = OFF_ROWL + 409600;
constexpr size_t OFF_BONUS = OFF_ROWG + 409600;
constexpr size_t OFF_BAR = OFF_BONUS + 6291456;
constexpr size_t BIG = 26214400;
constexpr size_t OFF_XB = BIG, OFF_QK = BIG + SZ, OFF_VT = BIG + 3 * SZ, OFF_O = BIG + 4 * SZ;
constexpr size_t OFF_WQKT = BIG + 5 * SZ, OFF_WVT = OFF_WQKT + 4194304, OFF_WOT = OFF_WVT + 2097152, OFF_WGUT = OFF_WOT + 2097152, OFF_WDT = OFF_WGUT + 11534336;
constexpr size_t OFF_EB = OFF_WDT + 5767168;
constexpr size_t OFF_H = BIG + SZ;
constexpr size_t OFF_XB2 = BIG, OFF_RKV = BIG + 2 * SZ, OFF_LBWA = BIG + 5 * SZ, OFF_LBG = OFF_LBWA + 25165824;
constexpr size_t OFF_YF = BIG, OFF_YB = BIG + SZ;
constexpr size_t OFF_WMGU = BIG, OFF_WMD = BIG + 117440512, OFF_XS = BIG + 176160768, OFF_XBM = OFF_XS + 209715200, OFF_HID = OFF_XBM;
constexpr size_t WS_NEED = OFF_HID + 183500800;
constexpr int MOE_CHUNK = 50;
constexpr size_t HID_BUF = (size_t)MOE_CHUNK * 256 * 7168;
constexpr int LDS_BYTES = 131072 + 512;

struct Params { const float* in[33]; float* X; unsigned char* ws; };
extern __shared__ __attribute__((aligned(16))) unsigned char shm[];
constexpr int LDS_TS = 131072, LDS_TAB = 131072 + 128;
__device__ __forceinline__ const float* INP(int i) {
  const LAS unsigned* tab = (const LAS unsigned*)((LAS unsigned char*)shm + LDS_TAB);
  const unsigned lo = __builtin_amdgcn_readfirstlane(tab[2 * i]), hi = __builtin_amdgcn_readfirstlane(tab[2 * i + 1]);
  return (const float*)(((unsigned long long)hi << 32) | lo);
}

__device__ __forceinline__ int tid_() { int t = threadIdx.x; asm volatile("" : "+v"(t)); return t; }
__device__ __forceinline__ unsigned cvt_pk_bf16(float lo, float hi) { unsigned r; asm("v_cvt_pk_bf16_f32 %0, %1, %2" : "=v"(r) : "v"(lo), "v"(hi)); return r; }
__device__ __forceinline__ bf16_t f2bf(float f) { return (bf16_t)(cvt_pk_bf16(f, 0.f) & 0xffffu); }
__device__ __forceinline__ float bflo(unsigned u) { return __uint_as_float(u << 16); }
__device__ __forceinline__ float bfhi(unsigned u) { return __uint_as_float(u & 0xffff0000u); }
__device__ __forceinline__ float wave_sum(float v) { for (int o = 32; o; o >>= 1) v += __shfl_xor(v, o); return v; }
template <int CTRL> __device__ __forceinline__ float dppf(float v) { return __builtin_bit_cast(float, __builtin_amdgcn_mov_dpp(__builtin_bit_cast(int, v), CTRL, 0xf, 0xf, true)); }
__device__ __forceinline__ float red4(float v) { v += dppf<0xB1>(v); v += dppf<0x4E>(v); return v; }
__device__ __forceinline__ float red8(float v) { v = red4(v); v += dppf<0x141>(v); return v; }
__device__ __forceinline__ float red16(float v) { v = red8(v); v += dppf<0x140>(v); return v; }
__device__ __forceinline__ float sigmoidf_(float x) { return __builtin_amdgcn_rcpf(1.f + __expf(-x)); }


#define XB_TMO      128
#define XB_XCNT(j)  (256  + 64 * (j))
#define XB_XSUB(j)  (1280 + 64 * (j))
#define XB_XGEN(j)  (2304 + 64 * (j))
#define XB_TOP      3328
#define XB_TOPGEN   3392
#define XCD_BAR_WORDS 3456
#define XB_SPIN_CAP (1u << 18)
__device__ __forceinline__ unsigned xb_ld(unsigned* p)              { return __hip_atomic_load(p, __ATOMIC_RELAXED, __HIP_MEMORY_SCOPE_AGENT); }
__device__ __forceinline__ unsigned xb_add(unsigned* p, unsigned v) { return __hip_atomic_fetch_add(p, v, __ATOMIC_RELAXED, __HIP_MEMORY_SCOPE_AGENT); }
__device__ __forceinline__ unsigned xb_xcc_id() { return (unsigned)__builtin_amdgcn_s_getreg((3 << 11) | 20) & 0xFu; }
#define XB_SPIN(cond, bar) do { unsigned _sp = 0; while (cond) { __builtin_amdgcn_s_sleep(1); \
    if ((++_sp & 255u) == 0u) { if (xb_ld(&(bar)[XB_TMO])) break; if (_sp > XB_SPIN_CAP) { atomicAdd(&(bar)[XB_TMO], 1u); break; } } } } while (0)
struct XcdBarrier { unsigned* bar; unsigned x; volatile LAS unsigned* st; };
__device__ __forceinline__ XcdBarrier xcd_barrier_post(unsigned* bar, volatile LAS unsigned* st) {
  XcdBarrier b; b.bar = bar; b.x = xb_xcc_id(); b.st = st;
  if (threadIdx.x == 0) (void)xb_add(&bar[XB_XCNT(b.x)], 1u);
  return b;
}
__device__ __forceinline__ void xcd_barrier_complete(unsigned* bar, unsigned x, unsigned& nloc, unsigned& nx) {
  const unsigned G = gridDim.x * gridDim.y * gridDim.z;
  unsigned sum, cnt, mine, sp = 0u;
  for (;;) {
    sum = 0u; cnt = 0u; mine = 0u;
#pragma unroll
    for (unsigned j = 0; j < 16; ++j) { const unsigned c = xb_ld(&bar[XB_XCNT(j)]); sum += c; cnt += (c > 0u) ? 1u : 0u; mine = (j == x) ? c : mine; }
    if (sum == G) break;
    __builtin_amdgcn_s_sleep(1);
    if ((++sp & 255u) == 0u) { if (xb_ld(&bar[XB_TMO])) break; if (sp > XB_SPIN_CAP) { atomicAdd(&bar[XB_TMO], 1u); break; } }
  }
  nloc = mine > 0u ? mine : 1u; nx = cnt > 0u ? cnt : 1u;
}
__device__ __forceinline__ void xcd_barrier(const XcdBarrier& b) {
  asm volatile("s_waitcnt vmcnt(0)" ::: "memory");
  __syncthreads();
  if (threadIdx.x == 0) {
    unsigned* bar = b.bar;
    __builtin_amdgcn_s_waitcnt(0);
    unsigned nloc = b.st[0], nx = b.st[1];
    if (nloc == 0u) { xcd_barrier_complete(bar, b.x, nloc, nx); b.st[0] = nloc; b.st[1] = nx; }
    const unsigned old = xb_add(&bar[XB_XSUB(b.x)], 1u);
    const unsigned gen = old / nloc;
    if (old + 1u == (gen + 1u) * nloc) {
      __builtin_amdgcn_fence(__ATOMIC_RELEASE, "agent");
      asm volatile("s_waitcnt vmcnt(0)" ::: "memory");
      const unsigned og = xb_add(&bar[XB_TOP], 1u);
      const unsigned tg = og / nx;
      if (og + 1u == (tg + 1u) * nx) xb_add(&bar[XB_TOPGEN], 1u);
      else XB_SPIN(xb_ld(&bar[XB_TOPGEN]) == tg, bar);
      __builtin_amdgcn_fence(__ATOMIC_ACQUIRE, "agent");
      xb_add(&bar[XB_XGEN(b.x)], 1u);
      asm volatile("s_waitcnt vmcnt(0)" ::: "memory");
    } else {
      XB_SPIN(xb_ld(&bar[XB_XGEN(b.x)]) == gen, bar);
      __builtin_amdgcn_fence(__ATOMIC_ACQUIRE, "agent");
      asm volatile("s_waitcnt vmcnt(0)" ::: "memory");
    }
  }
  __syncthreads();
}

struct CvtJob { const float* src; int ldsrc, K, N; bf16_t* dst; int lddst, row0, col0; const float* kscale; float scale; int mode; };
__device__ __forceinline__ CvtJob mkjob(const float* src, int ldsrc, int K, int N, bf16_t* dst, int lddst, int row0, int col0, const float* kscale, float scale, int mode) {
  CvtJob j; j.src = src; j.ldsrc = ldsrc; j.K = K; j.N = N; j.dst = dst; j.lddst = lddst; j.row0 = row0; j.col0 = col0; j.kscale = kscale; j.scale = scale; j.mode = mode; return j; }
__device__ __forceinline__ int cvt_run(const CvtJob J, float* tile, int rot) {
  const int tk = (J.K + 63) >> 6, tn = (J.N + 63) >> 6, nt = tk * tn, G = gridDim.x;
  const int tx = tid_() & 63, ty = tid_() >> 6;
  int start = (int)blockIdx.x - rot; if (start < 0) start += G;
  for (int t0 = start; t0 < nt; t0 += 4 * G) {
    float v[4][8];
#pragma unroll
    for (int q = 0; q < 4; ++q) { const int t = t0 + q * G; const int k0 = (t / tn) * 64, n0 = (t % tn) * 64;
#pragma unroll
      for (int r = 0; r < 8; ++r) { const int k = k0 + r * 8 + ty, n = n0 + tx; v[q][r] = 0.f;
        if (t < nt && J.src && k < J.K && n < J.N) v[q][r] = J.src[(size_t)k * J.ldsrc + n]; } }
    __syncthreads();
#pragma unroll
    for (int q = 0; q < 4; ++q) { const int t = t0 + q * G; const int k0 = (t / tn) * 64;
#pragma unroll
      for (int r = 0; r < 8; ++r) { const int kk = r * 8 + ty; float x = v[q][r] * J.scale; if (J.kscale && t < nt && k0 + kk < J.K) x *= J.kscale[k0 + kk]; tile[q * 4160 + kk * 65 + tx] = x; } }
    __syncthreads();
#pragma unroll
    for (int q = 0; q < 4; ++q) { const int t = t0 + q * G; const int k0 = (t / tn) * 64, n0 = (t % tn) * 64;
#pragma unroll
      for (int r = 0; r < 8; ++r) { const int nn = r * 8 + ty, n = n0 + nn, k = k0 + tx;
        if (t < nt && n < J.N && k < J.K) { const int row = J.mode ? ((n >> 7) * 256 + (n & 127)) : n;
          J.dst[(size_t)(J.row0 + row) * J.lddst + J.col0 + k] = f2bf(tile[q * 4160 + tx * 65 + nn]); } } }
  }
  return (rot + nt) % G;
}

constexpr int BM = 256, BK = 64, HALF = 128, HTB = HALF * BK * 2, NXCD = 8, WGM = 8;
__device__ __forceinline__ int lds_byte(int r, int c) { const int st = (r >> 4) * 2 + (c >> 5), rr = r & 15, cc = c & 31, ob = rr * 64 + cc * 2; return st * 1024 + (ob ^ (((ob >> 9) & 1) << 5)); }
__device__ __forceinline__ void stage_rc(int b, int& R, int& C) { const int st = b / 1024, sb = b % 1024, swz = sb ^ (((sb >> 9) & 1) << 5); R = (st >> 1) * 16 + swz / 64; C = (st & 1) * 32 + (swz % 64) / 2; }
__device__ __forceinline__ int perm32(int rho) { const int n = rho >> 4, i = rho & 15; return 8 * (i >> 2) + 4 * n + (i & 3); }
struct Unit { int pm, pn; };
struct Gemm { const bf16_t* A; const bf16_t* Bt; int K; };
struct StaticOrder {
  int nM, nN, nwg, G, c;
  __device__ void init(int M, int N) { nM = M / BM; nN = N / BM; nwg = nM * nN; G = gridDim.x; c = blockIdx.x; }
  __device__ bool next(int i, Unit& u) const {
    const long L = (long)i * G + c; if (L >= nwg) return false;
    int wgid = (int)L; { const int q = nwg / NXCD, r = nwg % NXCD, xcd = wgid % NXCD, off = wgid / NXCD; wgid = (xcd < r ? xcd * (q + 1) : r * (q + 1) + (xcd - r) * q) + off; }
    const int nig = WGM * nN, gid = wgid / nig, fm = gid * WGM, gsz = (nM - fm) < WGM ? (nM - fm) : WGM;
    u.pm = fm + ((wgid % nig) % gsz); u.pn = (wgid % nig) / gsz; return true;
  }
};
template <int NC> struct MoeOrder {
  int first, ntile, G, c; const LAS int* ts;
  __device__ bool next(int i, Unit& u) const {
    const long L = (long)i * G + c; if (L >= (long)ntile * NC) return false;
    const int l = (int)L, nig = WGM * NC, gid = l / nig, fm = gid * WGM, gsz = (ntile - fm) < WGM ? (ntile - fm) : WGM;
    const int pm = first + fm + ((l % nig) % gsz), pn = (l % nig) / gsz;
    int g = 0;
#pragma unroll
    for (int k = 1; k < 16; ++k) g += (pm >= ts[k]) ? 1 : 0;
    u.pm = pm; u.pn = (g & 7) * NC + pn; return true;
  }
};

struct MoeUpSkewOrder {
  int first, ntile, nd, G, c; const LAS int* ts;
  __device__ bool next(int i, Unit& u) const {
    const int r = (c >= nd) ? i : i + 3;
    const long L = (r < 3) ? (long)r * (G - nd) + (c - nd) : (long)3 * (G - nd) + (long)(r - 3) * G + c;
    if (L >= (long)ntile * 28) return false;
    const int l = (int)L, nig = WGM * 28, gid = l / nig, fm = gid * WGM, gsz = (ntile - fm) < WGM ? (ntile - fm) : WGM;
    const int pm = first + fm + ((l % nig) % gsz), pn = (l % nig) / gsz;
    int g = 0;
#pragma unroll
    for (int k = 1; k < 16; ++k) g += (pm >= ts[k]) ? 1 : 0;
    u.pm = pm; u.pn = (g & 7) * 28 + pn; return true;
  }
};

template <class Epi, class Sched>
__device__ __forceinline__ void gemm_phase(LAS unsigned char* lds, const Gemm g, const Sched& S, const Epi& E) {
  const int tid = tid_(), wid = __builtin_amdgcn_readfirstlane(tid >> 6), lane = tid & 63, wr = wid >> 2, wc = wid & 3, fr = lane & 15, fq = lane >> 4;
  const int K = g.K, nt = K / BK;
  unsigned voffA[2], voffB[2];
#pragma unroll
  for (int i = 0; i < 2; ++i) { int R, C; stage_rc(tid * 16 + i * 8192, R, C); const int Rb = Epi::PERM ? ((R & ~31) + perm32(R & 31)) : R;
    voffA[i] = (unsigned)(R * K + C) * 2u; voffB[i] = (unsigned)(Rb * K + C) * 2u; }
  const size_t kstep = (size_t)(BK * 2);
  const size_t hstep = (size_t)HALF * K * 2;
  const size_t tstep = 2 * hstep;
  const unsigned ldsw = (unsigned)wid * 1024u;
  const int aoff = lds_byte(wr * 64 + fr, fq * 8), boff = lds_byte(wc * 32 + fr, fq * 8);
#define PG8_SA(b, h) (((b) * 2 + (h)) * HTB)
#define PG8_SB(b, h) ((4 + (b) * 2 + (h)) * HTB)
#define PG8_STAGE(bufoff, gbase, voff) do { _Pragma("unroll") for (int _i = 0; _i < 2; ++_i) \
    __builtin_amdgcn_global_load_lds((const unsigned*)((const char*)(gbase) + (voff)[_i]), (LAS unsigned*)(lds + (bufoff) + ldsw + _i * 8192), 16, 0, 0); } while (0)
#define PG8_LDA(dst, b, h) do { _Pragma("unroll") for (int m = 0; m < 4; ++m) _Pragma("unroll") for (int k = 0; k < 2; ++k) dst[m][k] = *(const LAS bf16x8*)(lds + PG8_SA(b, h) + aoff + m * 2048 + k * 1024); } while (0)
#define PG8_LDB(dst, b, h) do { _Pragma("unroll") for (int n = 0; n < 2; ++n) _Pragma("unroll") for (int k = 0; k < 2; ++k) dst[n][k] = *(const LAS bf16x8*)(lds + PG8_SB(b, h) + boff + n * 2048 + k * 1024); } while (0)
#define PG8_MMA(ai, bj, At, Bt) do { __builtin_amdgcn_s_setprio(1); _Pragma("unroll") for (int m = 0; m < 4; ++m) _Pragma("unroll") for (int n = 0; n < 2; ++n) _Pragma("unroll") for (int k = 0; k < 2; ++k) \
    acc[ai][bj][m][n] = __builtin_amdgcn_mfma_f32_16x16x32_bf16(Bt[n][k], At[m][k], acc[ai][bj][m][n], 0, 0, 0); __builtin_amdgcn_s_setprio(0); } while (0)
#define PG8_WAIT_V(n) asm volatile("s_waitcnt vmcnt(" #n ")" ::: "memory")
#define PG8_WAIT_L(n) asm volatile("s_waitcnt lgkmcnt(" #n ")" ::: "memory")
#define PG8_BAR __builtin_amdgcn_s_barrier()
#define PG8_SCHED __builtin_amdgcn_sched_barrier(0)
  Unit cur, nxt; int ui = 0;
  if (!S.next(0, cur)) return;
  f32x4 acc[2][2][4][2];
#pragma unroll
  for (int a = 0; a < 2; ++a)
#pragma unroll
    for (int b = 0; b < 2; ++b)
#pragma unroll
      for (int m = 0; m < 4; ++m)
#pragma unroll
        for (int n = 0; n < 2; ++n) acc[a][b][m][n] = (f32x4){0.f, 0.f, 0.f, 0.f};
  bf16x8 At[4][2], B0[2][2], B1[2][2];
  const char* cA = (const char*)g.A + (size_t)cur.pm * tstep; const char* cB = (const char*)g.Bt + (size_t)cur.pn * tstep;
  PG8_STAGE(PG8_SB(0, 0), cB, voffB); PG8_STAGE(PG8_SA(0, 0), cA, voffA); PG8_STAGE(PG8_SB(0, 1), cB + hstep, voffB); PG8_STAGE(PG8_SA(0, 1), cA + hstep, voffA);
  if (wr == 1) PG8_BAR;
  PG8_WAIT_V(4); PG8_BAR;
  PG8_STAGE(PG8_SB(1, 0), cB + kstep, voffB); PG8_STAGE(PG8_SA(1, 0), cA + kstep, voffA); PG8_STAGE(PG8_SB(1, 1), cB + hstep + kstep, voffB);
  PG8_WAIT_V(6); PG8_BAR;
  for (;;) {
    const bool has_next = S.next(ui + 1, nxt);
    const char* nA = has_next ? (const char*)g.A + (size_t)nxt.pm * tstep : cA; const char* nB = has_next ? (const char*)g.Bt + (size_t)nxt.pn * tstep : cB;
    for (int t = 0; t < nt; t += 2) {
      const bool last = (t == nt - 2);
      const char* a1 = cA + (size_t)(t + 1) * kstep;
      const char* a2 = last ? nA : cA + (size_t)(t + 2) * kstep; const char* b2 = last ? nB : cB + (size_t)(t + 2) * kstep;
      const char* a3 = a2 + kstep; const char* b3 = b2 + kstep;
      PG8_LDB(B0, 0, 0); PG8_SCHED; PG8_LDA(At, 0, 0); PG8_STAGE(PG8_SA(1, 1), a1 + hstep, voffA);
      PG8_WAIT_L(8); PG8_BAR; PG8_WAIT_L(0); PG8_MMA(0, 0, At, B0); PG8_BAR; PG8_SCHED;
      PG8_LDB(B1, 0, 1); PG8_STAGE(PG8_SB(0, 0), b2, voffB);
      PG8_BAR; PG8_WAIT_L(0); PG8_MMA(0, 1, At, B1); PG8_BAR;
      PG8_LDA(At, 0, 1); PG8_STAGE(PG8_SA(0, 0), a2, voffA);
      PG8_BAR; PG8_WAIT_L(0); PG8_MMA(1, 0, At, B0); PG8_BAR; PG8_SCHED;
      PG8_STAGE(PG8_SB(0, 1), b2 + hstep, voffB);
      PG8_WAIT_V(6); PG8_BAR; PG8_MMA(1, 1, At, B1); PG8_BAR;
      PG8_LDB(B0, 1, 0); PG8_SCHED; PG8_LDA(At, 1, 0); PG8_STAGE(PG8_SA(0, 1), a2 + hstep, voffA);
      PG8_WAIT_L(8); PG8_BAR; PG8_WAIT_L(0); PG8_MMA(0, 0, At, B0); PG8_BAR; PG8_SCHED;
      PG8_LDB(B1, 1, 1); PG8_STAGE(PG8_SB(1, 0), b3, voffB);
      PG8_BAR; PG8_WAIT_L(0); PG8_MMA(0, 1, At, B1); PG8_BAR;
      PG8_LDA(At, 1, 1); PG8_STAGE(PG8_SA(1, 0), a3, voffA);
      PG8_BAR; PG8_WAIT_L(0); PG8_MMA(1, 0, At, B0); PG8_BAR; PG8_SCHED;
      PG8_STAGE(PG8_SB(1, 1), b3 + hstep, voffB);
      PG8_WAIT_V(6); PG8_BAR; PG8_MMA(1, 1, At, B1); PG8_BAR;
    }
    E(acc, cur, wr, wc, fr, fq);
    if (!has_next) break;
#pragma unroll
    for (int a = 0; a < 2; ++a)
#pragma unroll
      for (int b = 0; b < 2; ++b)
#pragma unroll
        for (int m = 0; m < 4; ++m)
#pragma unroll
          for (int n = 0; n < 2; ++n) acc[a][b][m][n] = (f32x4){0.f, 0.f, 0.f, 0.f};
    cur = nxt; cA = nA; cB = nB; ++ui;
  }
  PG8_WAIT_V(0);
  if (wr == 0) PG8_BAR;
  PG8_BAR;
#undef PG8_SA
#undef PG8_SB
#undef PG8_STAGE
#undef PG8_LDA
#undef PG8_LDB
#undef PG8_MMA
#undef PG8_WAIT_V
#undef PG8_WAIT_L
#undef PG8_BAR
#undef PG8_SCHED
}

typedef f32x4 Acc[2][2][4][2];
__device__ __forceinline__ u32x4 pack8(f32x4 a, f32x4 b) { u32x4 o; o[0] = cvt_pk_bf16(a[0], a[1]); o[1] = cvt_pk_bf16(a[2], a[3]); o[2] = cvt_pk_bf16(b[0], b[1]); o[3] = cvt_pk_bf16(b[2], b[3]); return o; }

struct EpiStore {
  static constexpr bool PERM = true; bf16_t* O; int ldc;
  __device__ __forceinline__ void operator()(const Acc& acc, const Unit& u, int wr, int wc, int fr, int fq) const {
    const int row0 = u.pm * BM + wr * 64 + fr, col0 = u.pn * BM + wc * 32 + 8 * fq;
#pragma unroll
    for (int ai = 0; ai < 2; ++ai)
#pragma unroll
      for (int m = 0; m < 4; ++m) { bf16_t* rp = O + (size_t)(row0 + ai * HALF + m * 16) * ldc + col0;
#pragma unroll
        for (int bj = 0; bj < 2; ++bj) *(u32x4*)(rp + bj * HALF) = pack8(acc[ai][bj][m][0], acc[ai][bj][m][1]); }
  }
};
struct EpiQK2 {
  static constexpr bool PERM = true; bf16_t* O;
  __device__ __forceinline__ void operator()(const Acc& acc, const Unit& u, int wr, int wc, int fr, int fq) const {
    const int row0 = u.pm * BM + wr * 64 + fr, col0 = u.pn * BM + wc * 32 + 8 * fq;
#pragma unroll
    for (int ai = 0; ai < 2; ++ai)
#pragma unroll
      for (int m = 0; m < 4; ++m) { const int tok = row0 + ai * HALF + m * 16;
#pragma unroll
        for (int bj = 0; bj < 2; ++bj) { const int n = col0 + bj * HALF; const int which = n >> 10, h = (n >> 5) & 31, d = n & 31;
          *(u32x4*)(O + (size_t)which * ((size_t)T * 1024) + ((size_t)((tok >> 6) * 32 + h) * 64 + (tok & 63)) * 32 + d) = pack8(acc[ai][bj][m][0], acc[ai][bj][m][1]); } }
  }
};
struct EpiVT {
  static constexpr bool PERM = true; bf16_t* O;
  __device__ __forceinline__ void operator()(const Acc& acc, const Unit& u, int wr, int wc, int fr, int fq) const {
    const int row0 = u.pm * BM + wr * 64 + fr, col0 = u.pn * BM + wc * 32 + 8 * fq;
#pragma unroll
    for (int ai = 0; ai < 2; ++ai)
#pragma unroll
      for (int m = 0; m < 4; ++m) { const int ch = row0 + ai * HALF + m * 16;
#pragma unroll
        for (int bj = 0; bj < 2; ++bj) { const int tok = col0 + bj * HALF;
          *(u32x4*)(O + (size_t)(tok >> 6) * 65536 + (size_t)(((ch >> 5) * 8 + ((tok & 63) >> 3)) * 32 + (ch & 31)) * 8) = pack8(acc[ai][bj][m][0], acc[ai][bj][m][1]); } }
  }
};
struct EpiResid {
  static constexpr bool PERM = false; float* X;
  __device__ __forceinline__ void operator()(const Acc& acc, const Unit& u, int wr, int wc, int fr, int fq) const {
    const int row0 = u.pm * BM + wr * 64 + fr, col0 = u.pn * BM + wc * 32 + 4 * fq;
#pragma unroll
    for (int ai = 0; ai < 2; ++ai)
#pragma unroll
      for (int m = 0; m < 4; ++m) { float* rp = X + (size_t)(row0 + ai * HALF + m * 16) * 1024 + col0;
#pragma unroll
        for (int bj = 0; bj < 2; ++bj)
#pragma unroll
          for (int n = 0; n < 2; ++n) { f32x4* q = (f32x4*)(rp + bj * HALF + n * 16); *q = *q * ALPHA + acc[ai][bj][m][n]; } __builtin_amdgcn_sched_barrier(0); }
  }
};
__device__ __forceinline__ f32x4 swiglu4(f32x4 g, f32x4 u) { f32x4 o;
#pragma unroll
  for (int j = 0; j < 4; ++j) o[j] = g[j] * __builtin_amdgcn_rcpf(1.f + __expf(-g[j])) * u[j];
  return o; }
struct EpiSwiglu {
  static constexpr bool PERM = true; bf16_t* H; int ldh, NC, row_base;
  __device__ __forceinline__ void operator()(const Acc& acc, const Unit& u, int wr, int wc, int fr, int fq) const {
    const int row0 = u.pm * BM - row_base + wr * 64 + fr, col0 = (u.pn % NC) * HALF + wc * 32 + 8 * fq;
#pragma unroll
    for (int ai = 0; ai < 2; ++ai)
#pragma unroll
      for (int m = 0; m < 4; ++m)
        *(u32x4*)(H + (size_t)(row0 + ai * HALF + m * 16) * ldh + col0) = pack8(swiglu4(acc[ai][0][m][0], acc[ai][1][m][0]), swiglu4(acc[ai][0][m][1], acc[ai][1][m][1]));
  }
};
struct EpiRwkv {
  static constexpr bool PERM = true; bf16_t* RKV; bf16_t* LBWA; bf16_t* LBG;
  __device__ __forceinline__ void operator()(const Acc& acc, const Unit& u, int wr, int wc, int fr, int fq) const {
    const int row0 = u.pm * BM + wr * 64 + fr;
    if (u.pn < 12) {
      const int col0 = u.pn * BM + wc * 32 + 8 * fq;
#pragma unroll
      for (int ai = 0; ai < 2; ++ai)
#pragma unroll
        for (int m = 0; m < 4; ++m) { bf16_t* rp = RKV + (size_t)(row0 + ai * HALF + m * 16) * 3072 + col0;
#pragma unroll
          for (int bj = 0; bj < 2; ++bj) *(u32x4*)(rp + bj * HALF) = pack8(acc[ai][bj][m][0], acc[ai][bj][m][1]); }
    } else {
      const bool isg = (u.pn == 13); bf16_t* O = isg ? LBG : LBWA; const int c0 = wc * 32 + 8 * fq;
#pragma unroll
      for (int ai = 0; ai < 2; ++ai)
#pragma unroll
        for (int m = 0; m < 4; ++m) { bf16_t* rp = O + (size_t)(row0 + ai * HALF + m * 16) * 256 + c0;
#pragma unroll
          for (int bj = 0; bj < 2; ++bj) { f32x4 v0 = acc[ai][bj][m][0], v1 = acc[ai][bj][m][1]; const int c = bj * HALF + c0;
            if (isg) { if (c < 160) {
#pragma unroll
                for (int j = 0; j < 4; ++j) { v0[j] = sigmoidf_(v0[j]); v1[j] = sigmoidf_(v1[j]); } } else { v0 = (f32x4){0.f, 0.f, 0.f, 0.f}; v1 = v0; } }
            else if (bj == 0) {
#pragma unroll
              for (int j = 0; j < 4; ++j) { v0[j] = 1.f - 2.f * __builtin_amdgcn_rcpf(1.f + __expf(2.f * v0[j])); v1[j] = 1.f - 2.f * __builtin_amdgcn_rcpf(1.f + __expf(2.f * v1[j])); } }
            *(u32x4*)(rp + bj * HALF) = pack8(v0, v1); } }
    }
  }
};
struct EpiMulPre {
  static constexpr bool PERM = true; bf16_t* P;
  __device__ __forceinline__ void operator()(const Acc& acc, const Unit& u, int wr, int wc, int fr, int fq) const {
    const int row0 = u.pm * BM + wr * 64 + fr, col0 = u.pn * BM + wc * 32 + 8 * fq;
#pragma unroll
    for (int ai = 0; ai < 2; ++ai)
#pragma unroll
      for (int m = 0; m < 4; ++m) { bf16_t* rp = P + (size_t)(row0 + ai * HALF + m * 16) * 1024 + col0;
#pragma unroll
        for (int bj = 0; bj < 2; ++bj) { u32x4* q = (u32x4*)(rp + bj * HALF); const u32x4 pv = *q; f32x4 a = acc[ai][bj][m][0], b = acc[ai][bj][m][1];
          a[0] *= bflo(pv[0]); a[1] *= bfhi(pv[0]); a[2] *= bflo(pv[1]); a[3] *= bfhi(pv[1]); b[0] *= bflo(pv[2]); b[1] *= bfhi(pv[2]); b[2] *= bflo(pv[3]); b[3] *= bfhi(pv[3]);
          *q = pack8(a, b); } __builtin_amdgcn_sched_barrier(0); }
  }
};
struct EpiMoeDown {
  static constexpr bool PERM = false; float* X; const int* rowl; const float* rowg; int row_base;
  __device__ __forceinline__ void operator()(const Acc& acc, const Unit& u, int wr, int wc, int fr, int fq) const {
    const int row0 = row_base + u.pm * BM + wr * 64 + fr, col0 = (u.pn & 3) * BM + wc * 32 + 4 * fq;
#pragma unroll
    for (int ai = 0; ai < 2; ++ai)
#pragma unroll
      for (int m = 0; m < 4; ++m) { const int lr = row0 + ai * HALF + m * 16; const int tok = rowl[lr];
        if (tok >= 0) { const float gt = rowg[lr]; float* rp = X + (size_t)tok * 1024 + col0;
#pragma unroll
          for (int bj = 0; bj < 2; ++bj)
#pragma unroll
            for (int n = 0; n < 2; ++n) { f32x4* q = (f32x4*)(rp + bj * HALF + n * 16); *q = *q + acc[ai][bj][m][n] * gt; } } __builtin_amdgcn_sched_barrier(0); }
  }
};
struct MoeDownOrder {
  int first, ntile, G, c; const LAS int* ts;
  __device__ bool next(int i, Unit& u) const {
    const long L = (long)i * G + c; if (L >= (long)ntile * 4) return false;
    const int l = (int)L, pm = l >> 2, pn = l & 3; int g = 0;
#pragma unroll
    for (int k = 1; k < 16; ++k) g += ((first + pm) >= ts[k]) ? 1 : 0;
    u.pm = pm; u.pn = (g & 7) * 4 + pn; return true;
  }
};

__device__ __forceinline__ void ln_row(const float* y, const float* g, const float* b, int lane, f32x4 (&o)[4]) {
  f32x4 v[4]; float s = 0.f;
#pragma unroll
  for (int k = 0; k < 4; ++k) { v[k] = *(const f32x4*)(y + k * 256 + lane * 4); s += v[k][0] + v[k][1] + v[k][2] + v[k][3]; }
  const float mean = wave_sum(s) * (1.f / 1024.f); float q = 0.f;
#pragma unroll
  for (int k = 0; k < 4; ++k) { v[k] = v[k] - mean; q += v[k][0] * v[k][0] + v[k][1] * v[k][1] + v[k][2] * v[k][2] + v[k][3] * v[k][3]; }
  const float rstd = rsqrtf(wave_sum(q) * (1.f / 1024.f) + 1e-5f);
#pragma unroll
  for (int k = 0; k < 4; ++k) { const f32x4 gg = *(const f32x4*)(g + k * 256 + lane * 4), bb = *(const f32x4*)(b + k * 256 + lane * 4); o[k] = v[k] * rstd * gg + bb; }
}

__device__ __forceinline__ void ln_row2(const float* y0, const float* y1, const float* g, const float* b, int lane, f32x4 (&o0)[4], f32x4 (&o1)[4]) {
  f32x4 v[4], u[4]; float s0 = 0.f, s1 = 0.f;
#pragma unroll
  for (int k = 0; k < 4; ++k) { v[k] = *(const f32x4*)(y0 + k * 256 + lane * 4); u[k] = *(const f32x4*)(y1 + k * 256 + lane * 4); }
#pragma unroll
  for (int k = 0; k < 4; ++k) { s0 += v[k][0] + v[k][1] + v[k][2] + v[k][3]; s1 += u[k][0] + u[k][1] + u[k][2] + u[k][3]; }
  const float m0 = wave_sum(s0) * (1.f / 1024.f), m1 = wave_sum(s1) * (1.f / 1024.f); float q0 = 0.f, q1 = 0.f;
#pragma unroll
  for (int k = 0; k < 4; ++k) { v[k] = v[k] - m0; u[k] = u[k] - m1; q0 += v[k][0] * v[k][0] + v[k][1] * v[k][1] + v[k][2] * v[k][2] + v[k][3] * v[k][3]; q1 += u[k][0] * u[k][0] + u[k][1] * u[k][1] + u[k][2] * u[k][2] + u[k][3] * u[k][3]; }
  const float r0 = rsqrtf(wave_sum(q0) * (1.f / 1024.f) + 1e-5f), r1 = rsqrtf(wave_sum(q1) * (1.f / 1024.f) + 1e-5f);
#pragma unroll
  for (int k = 0; k < 4; ++k) { const f32x4 gg = *(const f32x4*)(g + k * 256 + lane * 4), bb = *(const f32x4*)(b + k * 256 + lane * 4); o0[k] = v[k] * r0 * gg + bb; o1[k] = u[k] * r1 * gg + bb; }
}

__device__ __forceinline__ void attn_phase(const bf16_t* __restrict__ QK, const bf16_t* __restrict__ VT, const float* __restrict__ EB, bf16_t* __restrict__ O) {
  const int tid = tid_(), lane = tid & 63, qi = lane & 15, g = lane >> 4;
  const int nw = gridDim.x * 8, w0 = blockIdx.x * 8 + (tid >> 6);
  const int krho = ((qi >> 2) * 8) + (qi & 3);
  int cur_combo = -1; f32x4 bias[8][2];
  for (int u = w0; u < 768 * 4 * 32; u += nw) {
    const int combo = u & 127, h = u & 31, c = (u >> 5) & 3, R = u >> 7;
    const float* eb = EB + (size_t)combo * (15 * 512) + lane * 8;
    if (combo != cur_combo) { cur_combo = combo;
#pragma unroll
      for (int i = 0; i < 8; ++i) { bias[i][0] = *(const f32x4*)(eb + (3 + i) * 512); bias[i][1] = *(const f32x4*)(eb + (3 + i) * 512 + 4); } }
    int seq_row0, rows; if (R < 256) { seq_row0 = R & ~127; rows = 128; } else { seq_row0 = 256 + ((R - 256) & ~63); rows = 64; }
    const int r = R - seq_row0; int rs = r - 4; rs = rs < 0 ? 0 : rs; rs = rs > rows - 8 ? rows - 8 : rs;
    const int blk = (c == 0) ? 0 : (c == 1) ? 8 : (c == 2) ? 24 : 32;
    const int qcol = 16 * c + qi;
    const bf16x8 qf = *(const bf16x8*)(QK + ((size_t)(R * 32 + h) * 64 + qcol) * 32 + g * 8);
    f32x4 s[8][2];
    const bf16_t* kbase = QK + (size_t)T * 1024 + ((size_t)((seq_row0 + rs) * 32 + h) * 64 + blk + krho) * 32 + g * 8;
#pragma unroll
    for (int i = 0; i < 8; ++i)
#pragma unroll
      for (int hh = 0; hh < 2; ++hh) {
        const bf16x8 kf = *(const bf16x8*)(kbase + (size_t)i * 65536 + hh * 128);
        s[i][hh] = __builtin_amdgcn_mfma_f32_16x16x32_bf16(kf, qf, (f32x4){0.f, 0.f, 0.f, 0.f}, 0, 0, 0);
      }
    if (rs - r == -4) {
#pragma unroll
      for (int i = 0; i < 8; ++i) { s[i][0] = s[i][0] + bias[i][0]; s[i][1] = s[i][1] + bias[i][1]; }
    } else {
      const float* ebr = eb + (rs - r + 7) * 512;
#pragma unroll
      for (int i = 0; i < 8; ++i) { s[i][0] = s[i][0] + *(const f32x4*)(ebr + i * 512); s[i][1] = s[i][1] + *(const f32x4*)(ebr + i * 512 + 4); }
    }
    float mx = -3.0e38f;
#pragma unroll
    for (int i = 0; i < 8; ++i)
#pragma unroll
      for (int hh = 0; hh < 2; ++hh) mx = fmaxf(fmaxf(mx, fmaxf(s[i][hh][0], s[i][hh][1])), fmaxf(s[i][hh][2], s[i][hh][3]));
    mx = fmaxf(mx, __shfl_xor(mx, 16)); mx = fmaxf(mx, __shfl_xor(mx, 32));
    float sum = 0.f;
#pragma unroll
    for (int i = 0; i < 8; ++i)
#pragma unroll
      for (int hh = 0; hh < 2; ++hh)
#pragma unroll
        for (int j = 0; j < 4; ++j) { const float e = __expf(s[i][hh][j] - mx); s[i][hh][j] = e; sum += e; }
    sum += __shfl_xor(sum, 16); sum += __shfl_xor(sum, 32);
    f32x4 o0 = {0.f, 0.f, 0.f, 0.f}, o1 = {0.f, 0.f, 0.f, 0.f};
#pragma unroll
    for (int i = 0; i < 8; ++i) {
      const u32x4 pu = pack8(s[i][0], s[i][1]); const bf16x8 pf = __builtin_bit_cast(bf16x8, pu);
      const bf16_t* vb = VT + (size_t)(seq_row0 + rs + i) * 65536 + (size_t)((h * 8 + (blk >> 3) + g) * 32 + qi) * 8;
      const bf16x8 v0 = *(const bf16x8*)vb, v1 = *(const bf16x8*)(vb + 16 * 8);
      o0 = __builtin_amdgcn_mfma_f32_16x16x32_bf16(v0, pf, o0, 0, 0, 0);
      o1 = __builtin_amdgcn_mfma_f32_16x16x32_bf16(v1, pf, o1, 0, 0, 0);
    }
    const float inv = 1.f / sum;
    bf16_t* op = O + (size_t)(R * 64 + qcol) * 1024 + h * 32 + g * 4;
    u32x2 a, b; a[0] = cvt_pk_bf16(o0[0] * inv, o0[1] * inv); a[1] = cvt_pk_bf16(o0[2] * inv, o0[3] * inv); b[0] = cvt_pk_bf16(o1[0] * inv, o1[1] * inv); b[1] = cvt_pk_bf16(o1[2] * inv, o1[3] * inv);
    *(u32x2*)op = a; *(u32x2*)(op + 16) = b;
  }
}

constexpr int SC_WD = 0, SC_AA = 2048, SC_KD = 4096, SC_BB = 6144, SC_NA = 8192, SC_RR = 10240, SC_VV = 12288, SC_YO = 14336;
typedef float f32x2 __attribute__((ext_vector_type(2)));
#define LO2(v) __builtin_shufflevector(v, v, 0, 1)
#define HI2(v) __builtin_shufflevector(v, v, 2, 3)
template <int NR, int z> __device__ __forceinline__ void scan_steps(LAS float* L, int wdo, int vrow, int ko, f32x2 (&St)[2][4]) {
  constexpr int sstep = z ? -64 : 64; const LAS float* bp = L + ko * 8 + (z ? 31 * 64 : 0);
  const LAS float* vp = L + SC_VV + vrow + (z ? 31 * 64 : 0); LAS float* yp = L + SC_YO + vrow + (z ? 31 * 64 : 0);
  f32x4 c[10]; float cv[NR];
  c[0] = *(const LAS f32x4*)(bp + SC_NA); c[1] = *(const LAS f32x4*)(bp + SC_NA + 4); c[2] = *(const LAS f32x4*)(bp + SC_WD + wdo); c[3] = *(const LAS f32x4*)(bp + SC_WD + wdo + 4);
  c[4] = *(const LAS f32x4*)(bp + SC_BB); c[5] = *(const LAS f32x4*)(bp + SC_BB + 4); c[6] = *(const LAS f32x4*)(bp + SC_KD); c[7] = *(const LAS f32x4*)(bp + SC_KD + 4);
  c[8] = *(const LAS f32x4*)(bp + SC_RR); c[9] = *(const LAS f32x4*)(bp + SC_RR + 4);
#pragma unroll
  for (int r = 0; r < NR; ++r) cv[r] = vp[r];
#pragma unroll 8
  for (int si = 0; si < 32; ++si) {
    f32x4 n[10]; float nv[NR];
    const LAS float* bn = bp + ((si < 31) ? sstep : 0); const LAS float* vn = vp + ((si < 31) ? sstep : 0);
    n[0] = *(const LAS f32x4*)(bn + SC_NA); n[1] = *(const LAS f32x4*)(bn + SC_NA + 4); n[2] = *(const LAS f32x4*)(bn + SC_WD + wdo); n[3] = *(const LAS f32x4*)(bn + SC_WD + wdo + 4);
    n[4] = *(const LAS f32x4*)(bn + SC_BB); n[5] = *(const LAS f32x4*)(bn + SC_BB + 4); n[6] = *(const LAS f32x4*)(bn + SC_KD); n[7] = *(const LAS f32x4*)(bn + SC_KD + 4);
    n[8] = *(const LAS f32x4*)(bn + SC_RR); n[9] = *(const LAS f32x4*)(bn + SC_RR + 4);
#pragma unroll
    for (int r = 0; r < NR; ++r) nv[r] = vn[r];
    float sa[NR], yy[NR];
#pragma unroll
    for (int r = 0; r < NR; ++r) { f32x2 p1 = St[r][0] * LO2(c[0]); p1 = St[r][1] * HI2(c[0]) + p1; p1 = St[r][2] * LO2(c[1]) + p1; p1 = St[r][3] * HI2(c[1]) + p1; sa[r] = p1[0] + p1[1]; }
#pragma unroll
    for (int r = 0; r < NR; ++r) sa[r] = red8(sa[r]);
#pragma unroll
    for (int r = 0; r < NR; ++r) { const f32x2 s2 = {sa[r], sa[r]}, v2 = {cv[r], cv[r]};
      St[r][0] = St[r][0] * LO2(c[2]) + (s2 * LO2(c[4]) + v2 * LO2(c[6])); St[r][1] = St[r][1] * HI2(c[2]) + (s2 * HI2(c[4]) + v2 * HI2(c[6]));
      St[r][2] = St[r][2] * LO2(c[3]) + (s2 * LO2(c[5]) + v2 * LO2(c[7])); St[r][3] = St[r][3] * HI2(c[3]) + (s2 * HI2(c[5]) + v2 * HI2(c[7])); }
#pragma unroll
    for (int r = 0; r < NR; ++r) { f32x2 q1 = St[r][0] * LO2(c[8]); q1 = St[r][1] * HI2(c[8]) + q1; q1 = St[r][2] * LO2(c[9]) + q1; q1 = St[r][3] * HI2(c[9]) + q1; yy[r] = q1[0] + q1[1]; }
#pragma unroll
    for (int r = 0; r < NR; ++r) yy[r] = red8(yy[r]);
#pragma unroll
    for (int r = 0; r < NR; ++r) yp[r] = yy[r];
#pragma unroll
    for (int j = 0; j < 10; ++j) c[j] = n[j];
#pragma unroll
    for (int r = 0; r < NR; ++r) cv[r] = nv[r];
    bp = bn; vp = vn; yp += sstep;
  }
}
__device__ __forceinline__ int chain_chunks(int chain) { return chain < 0 ? 0 : (chain < 64 ? 256 : 128); }
__device__ __forceinline__ void scan_block(unsigned char* ws, LAS float* Lall, int chainA, int modeA, int rbA, int chainB, int modeB, int rbB) {
  const int tid = tid_(), wid = tid >> 6, lane = tid & 63, grp = wid >> 2, gw4 = wid & 3, gtid = tid & 255;
  const int chain = grp ? chainB : chainA, mode = grp ? modeB : modeA, rowbase = grp ? rbB : rbA;
  LAS float* L = Lall + grp * 16384;
  const bool helper = (mode == 2), helped = (grp == 0) && (modeB == 2);
  const int nA = chain_chunks(chainA), nB = chain_chunks(chainB), nloop = nA > nB ? nA : nB;
  const int cc = chain < 0 ? 0 : chain;
  int h, z, Lq; size_t tok0;
  if (cc < 64) { h = (cc & 31) >> 1; z = cc & 1; Lq = 8192; tok0 = (size_t)(cc >> 5) * 8192; }
  else { const int c2 = cc - 64; h = (c2 & 31) >> 1; z = c2 & 1; Lq = 4096; tok0 = 16384 + (size_t)(c2 >> 5) * 4096; }
  const int nchunk = chain < 0 ? 0 : Lq / 32;
  const bf16_t* RKV = (const bf16_t*)(ws + OFF_RKV); const bf16_t* LBWA = (const bf16_t*)(ws + OFF_LBWA); const bf16_t* W2T = (const bf16_t*)(ws + OFF_W2T);
  bf16_t* Y = (bf16_t*)(ws + (z ? OFF_YB : OFF_YF)); float* bonus = (float*)(ws + OFF_BONUS);
  const int tk = gtid >> 3, c8 = (gtid & 7) * 8, ch0 = h * 64 + c8;
  const int ko = lane & 7, vl = lane >> 3, vrow = mode ? rowbase + gw4 * 8 + vl : gw4 * 16 + vl * 2;
  const int mat = gw4 >> 1, ntile = gw4 & 1;
  const f32x4 kk0 = *(const f32x4*)(INP(18) + ch0), kk1 = *(const f32x4*)(INP(18) + ch0 + 4), ka0 = *(const f32x4*)(INP(19) + ch0), ka1 = *(const f32x4*)(INP(19) + ch0 + 4);
  const f32x4 rk0 = *(const f32x4*)(INP(20) + ch0), rk1 = *(const f32x4*)(INP(20) + ch0 + 4);
  bf16x8 bfrag[4]; const int chb = h * 64 + ntile * 32 + (lane & 31);
#pragma unroll
  for (int ks = 0; ks < 4; ++ks) bfrag[ks] = *(const bf16x8*)(W2T + ((size_t)(mat * 2 + z) * 1024 + chb) * 64 + ks * 16 + (lane >> 5) * 8);
  const float bias0 = (mat ? INP(13) : INP(10))[z * 1024 + chb];
  u32x4 rawr, rawk, rawv; bf16x8 afrag[4];
  { const size_t tb = tok0 + (size_t)(z ? (nchunk > 0 ? nchunk - 1 : 0) : 0) * 32; const bf16_t* rp = RKV + (tb + tk) * 3072 + ch0;
    rawr = *(const u32x4*)rp; rawk = *(const u32x4*)(rp + 1024); rawv = *(const u32x4*)(rp + 2048);
#pragma unroll
    for (int ks = 0; ks < 4; ++ks) afrag[ks] = *(const bf16x8*)(LBWA + (tb + (lane & 31)) * 256 + mat * 128 + z * 64 + ks * 16 + (lane >> 5) * 8); }
  f32x2 St[2][4];
#pragma unroll
  for (int r = 0; r < 2; ++r)
#pragma unroll
    for (int j = 0; j < 4; ++j) St[r][j] = (f32x2){0.f, 0.f};
#define LORA_TILE(BASE) do { f32x16 acc; \
      _Pragma("unroll") for (int j = 0; j < 16; ++j) acc[j] = 0.f; \
      _Pragma("unroll") for (int ks = 0; ks < 4; ++ks) acc = __builtin_amdgcn_mfma_f32_32x32x16_bf16(afrag[ks], bfrag[ks], acc, 0, 0, 0); \
      LAS float* dst = (BASE) + (mat ? SC_AA : SC_WD) + ntile * 32 + (lane & 31); \
      _Pragma("unroll") for (int rg = 0; rg < 16; ++rg) { const int row = (rg & 3) + 8 * (rg >> 2) + 4 * (lane >> 5); const float sg = sigmoidf_(acc[rg] + bias0); \
        dst[row * 64] = mat ? sg : __expf(-0.60653065971263342f * sg); } } while (0)
  if (helper && nchunk > 0) { LORA_TILE(Lall); }
  for (int ci = 0; ci < nloop; ++ci) {
    const bool act = ci < nchunk; const int wdo = helped ? ((ci & 1) ? 16384 : 0) : 0;
    const size_t tb = tok0 + (size_t)(act ? (z ? nchunk - 1 - ci : ci) : 0) * 32;
    if (act && !helped && !helper) { LORA_TILE(L); }
    __syncthreads();
    if (act && !helper) {
      float r8[8], k8[8], kx[8]; float ss = 0.f;
#pragma unroll
      for (int j = 0; j < 4; ++j) { r8[2 * j] = bflo(rawr[j]); r8[2 * j + 1] = bfhi(rawr[j]); k8[2 * j] = bflo(rawk[j]); k8[2 * j + 1] = bfhi(rawk[j]); }
#pragma unroll
      for (int j = 0; j < 8; ++j) { kx[j] = k8[j] * (j < 4 ? kk0[j & 3] : kk1[j & 3]); ss += kx[j] * kx[j]; }
      ss = red8(ss); const float inv = __builtin_amdgcn_rsqf(fmaxf(ss, 1e-24f));
      const f32x4 a0 = *(const LAS f32x4*)(L + wdo + SC_AA + tk * 64 + c8), a1 = *(const LAS f32x4*)(L + wdo + SC_AA + tk * 64 + c8 + 4);
      f32x4 kd[2], bb[2], na[2], rr[2], vv[2]; float bon = 0.f;
#pragma unroll
      for (int j = 0; j < 8; ++j) { const float a = (j < 4 ? a0[j & 3] : a1[j & 3]), kav = (j < 4 ? ka0[j & 3] : ka1[j & 3]), rkv = (j < 4 ? rk0[j & 3] : rk1[j & 3]);
        const float kn = kx[j] * inv, kdv = k8[j] * (1.f + (a - 1.f) * kav); kd[j >> 2][j & 3] = kdv; bb[j >> 2][j & 3] = kn * a; na[j >> 2][j & 3] = -kn; rr[j >> 2][j & 3] = r8[j]; bon += r8[j] * kdv * rkv; }
#pragma unroll
      for (int j = 0; j < 4; ++j) { vv[j >> 1][(j & 1) * 2] = bflo(rawv[j]); vv[j >> 1][(j & 1) * 2 + 1] = bfhi(rawv[j]); }
      LAS float* lp = L + tk * 64 + c8;
      *(LAS f32x4*)(lp + SC_KD) = kd[0]; *(LAS f32x4*)(lp + SC_KD + 4) = kd[1]; *(LAS f32x4*)(lp + SC_BB) = bb[0]; *(LAS f32x4*)(lp + SC_BB + 4) = bb[1];
      *(LAS f32x4*)(lp + SC_NA) = na[0]; *(LAS f32x4*)(lp + SC_NA + 4) = na[1]; *(LAS f32x4*)(lp + SC_RR) = rr[0]; *(LAS f32x4*)(lp + SC_RR + 4) = rr[1];
      *(LAS f32x4*)(lp + SC_VV) = vv[0]; *(LAS f32x4*)(lp + SC_VV + 4) = vv[1];
      bon = red8(bon); if ((gtid & 7) == 0 && rowbase == 0) bonus[((tb + tk) * 16 + h) * 2 + z] = bon;
    }
    __syncthreads();
    if (act && ci + 1 < nchunk) { const size_t tn = tok0 + (size_t)(z ? nchunk - 2 - ci : ci + 1) * 32; const bf16_t* rp = RKV + (tn + tk) * 3072 + ch0;
      if (!helper) { rawr = *(const u32x4*)rp; rawk = *(const u32x4*)(rp + 1024); rawv = *(const u32x4*)(rp + 2048); }
#pragma unroll
      for (int ks = 0; ks < 4; ++ks) afrag[ks] = *(const bf16x8*)(LBWA + (tn + (lane & 31)) * 256 + mat * 128 + z * 64 + ks * 16 + (lane >> 5) * 8);
      if (helper) { LORA_TILE(Lall + (((ci + 1) & 1) ? 16384 : 0)); } }
    if (act && !helper) { if (mode) { if (z) scan_steps<1, 1>(L, wdo, vrow, ko, St); else scan_steps<1, 0>(L, wdo, vrow, ko, St); } else { if (z) scan_steps<2, 1>(L, wdo, vrow, ko, St); else scan_steps<2, 0>(L, wdo, vrow, ko, St); } }
    __syncthreads();
    if (act && !helper) {
      if (mode) { const int c4 = rowbase + (gtid & 7) * 4; const f32x4 yv = *(const LAS f32x4*)(L + SC_YO + tk * 64 + c4); u32x2 o; o[0] = cvt_pk_bf16(yv[0], yv[1]); o[1] = cvt_pk_bf16(yv[2], yv[3]);
        *(u32x2*)(Y + (tb + tk) * 1024 + h * 64 + c4) = o; }
      else { const f32x4 y0 = *(const LAS f32x4*)(L + SC_YO + tk * 64 + c8), y1 = *(const LAS f32x4*)(L + SC_YO + tk * 64 + c8 + 4);
        *(u32x4*)(Y + (tb + tk) * 1024 + ch0) = pack8(y0, y1); }
    }
  }
  __syncthreads();
#undef LORA_TILE
}

__global__ void __launch_bounds__(512, 2) mega(Params p) {
  cg::grid_group grid = cg::this_grid();
  LAS unsigned char* lds = (LAS unsigned char*)shm;
  LAS int* TS = (LAS int*)(lds + LDS_TS);
  unsigned char* ws = p.ws;
  { const unsigned* ka = (const unsigned*)__builtin_amdgcn_kernarg_segment_ptr(); if (threadIdx.x < 66) ((LAS unsigned*)(lds + LDS_TAB))[threadIdx.x] = ka[threadIdx.x]; }
  __syncthreads();
  const int G = gridDim.x, nw = G * 8;
  const long ngt = (long)G * 512;
#define PH_VARS const int tid = tid_(), lane = tid & 63, wid = tid >> 6, gw = blockIdx.x * 8 + wid; const long gt = (long)blockIdx.x * 512 + tid; (void)lane; (void)gw; (void)gt;
  float* X = p.X;

  { PH_VARS
  {
    int rot = 0; float* tile = (float*)shm;
    const float* wqkv = INP(2);
    rot = cvt_run(mkjob(wqkv, 3072, 1024, 1024, (bf16_t*)(ws + OFF_WQKT), 1024, 0, 0, nullptr, 0.17677669529663687f, 0), tile, rot);
    rot = cvt_run(mkjob(wqkv + 1024, 3072, 1024, 1024, (bf16_t*)(ws + OFF_WQKT), 1024, 1024, 0, nullptr, 1.f, 0), tile, rot);
    rot = cvt_run(mkjob(wqkv + 2048, 3072, 1024, 1024, (bf16_t*)(ws + OFF_WVT), 1024, 0, 0, nullptr, 1.f, 0), tile, rot);
    rot = cvt_run(mkjob(INP(4), 1024, 1024, 1024, (bf16_t*)(ws + OFF_WOT), 1024, 0, 0, nullptr, 1.f, 0), tile, rot);
    rot = cvt_run(mkjob(INP(5), 2816, 1024, 2816, (bf16_t*)(ws + OFF_WGUT), 1024, 0, 0, nullptr, 1.f, 1), tile, rot);
    rot = cvt_run(mkjob(INP(6), 2816, 1024, 2816, (bf16_t*)(ws + OFF_WGUT), 1024, 128, 0, nullptr, 1.f, 1), tile, rot);
    rot = cvt_run(mkjob(INP(7), 1024, 2816, 1024, (bf16_t*)(ws + OFF_WDT), 2816, 0, 0, nullptr, 1.f, 0), tile, rot);
    bf16_t* wrt = (bf16_t*)(ws + OFF_WRT); const float* mu = INP(8);
    for (int half = 0; half < 2; ++half) {
      const int c0 = half * 1024;
      rot = cvt_run(mkjob(INP(9), 1024, 1024, 1024, wrt, 2048, 0, c0, half ? mu + 0 * 1024 : nullptr, 1.f, 0), tile, rot);
      rot = cvt_run(mkjob(INP(9) + 1048576, 1024, 1024, 1024, wrt, 2048, 1024, c0, half ? mu + 2 * 1024 : nullptr, 1.f, 0), tile, rot);
      rot = cvt_run(mkjob(INP(9) + 2097152, 1024, 1024, 1024, wrt, 2048, 2048, c0, half ? mu + 3 * 1024 : nullptr, 1.f, 0), tile, rot);
      rot = cvt_run(mkjob(INP(11), 64, 1024, 64, wrt, 2048, 3072, c0, half ? mu + 1 * 1024 : nullptr, 1.f, 0), tile, rot);
      rot = cvt_run(mkjob(INP(11) + 65536, 64, 1024, 64, wrt, 2048, 3136, c0, half ? mu + 1 * 1024 : nullptr, 1.f, 0), tile, rot);
      rot = cvt_run(mkjob(INP(14), 64, 1024, 64, wrt, 2048, 3200, c0, half ? mu + 4 * 1024 : nullptr, 1.f, 0), tile, rot);
      rot = cvt_run(mkjob(INP(14) + 65536, 64, 1024, 64, wrt, 2048, 3264, c0, half ? mu + 4 * 1024 : nullptr, 1.f, 0), tile, rot);
      rot = cvt_run(mkjob(INP(16), 160, 1024, 160, wrt, 2048, 3328, c0, half ? mu + 5 * 1024 : nullptr, 1.f, 0), tile, rot);
    }
    rot = cvt_run(mkjob(nullptr, 0, 2048, 96, wrt, 2048, 3488, 0, nullptr, 1.f, 0), tile, rot);
    bf16_t* w2t = (bf16_t*)(ws + OFF_W2T);
    rot = cvt_run(mkjob(INP(12), 1024, 64, 1024, w2t, 64, 0, 0, nullptr, 1.f, 0), tile, rot);
    rot = cvt_run(mkjob(INP(12) + 65536, 1024, 64, 1024, w2t, 64, 1024, 0, nullptr, 1.f, 0), tile, rot);
    rot = cvt_run(mkjob(INP(15), 1024, 64, 1024, w2t, 64, 2048, 0, nullptr, 1.f, 0), tile, rot);
    rot = cvt_run(mkjob(INP(15) + 65536, 1024, 64, 1024, w2t, 64, 3072, 0, nullptr, 1.f, 0), tile, rot);
    rot = cvt_run(mkjob(INP(17), 1024, 160, 1024, (bf16_t*)(ws + OFF_G2T), 256, 0, 0, nullptr, 1.f, 0), tile, rot);
    rot = cvt_run(mkjob(nullptr, 0, 96, 1024, (bf16_t*)(ws + OFF_G2T), 256, 0, 160, nullptr, 1.f, 0), tile, rot);
    rot = cvt_run(mkjob(INP(23), 1024, 1024, 1024, (bf16_t*)(ws + OFF_RWOT), 1024, 0, 0, nullptr, 1.f, 0), tile, rot);
    bf16_t* xb = (bf16_t*)(ws + OFF_XB);
    { const float* x0 = INP(0); const float* x1 = INP(1);
    for (long i0 = gt; i0 < (long)T * 256; i0 += 4 * ngt) { f32x4 v[4];
#pragma unroll
      for (int u = 0; u < 4; ++u) { const long i = i0 + u * ngt; if (i < (long)T * 256) v[u] = (i < 16384L * 256) ? *(const f32x4*)(x0 + i * 4) : *(const f32x4*)(x1 + (i - 16384L * 256) * 4); }
#pragma unroll
      for (int u = 0; u < 4; ++u) { const long i = i0 + u * ngt; if (i < (long)T * 256) { *(f32x4*)(X + i * 4) = v[u]; u32x2 o; o[0] = cvt_pk_bf16(v[u][0], v[u][1]); o[1] = cvt_pk_bf16(v[u][2], v[u][3]); *(u32x2*)(xb + i * 4) = o; } } } }
    { float* EBt = (float*)(ws + OFF_EB); const float* rpb = INP(3);
      for (long i = gt; i < 128L * 15 * 512; i += ngt) { const int e = (int)(i & 7), ln = (int)((i >> 3) & 63), dr = (int)((i >> 9) % 15), combo = (int)((i >> 9) / 15);
        const int h = combo & 31, c = combo >> 5, qi = ln & 15, g = ln >> 4; const int blk = (c == 0) ? 0 : (c == 1) ? 8 : (c == 2) ? 24 : 32;
        const int kcol = blk + g * 8 + e, qcol = 16 * c + qi; int qstart = qcol - 8; qstart = qstart < 0 ? 0 : qstart; qstart = qstart > 48 ? 48 : qstart;
        const bool valid = (kcol >= qstart) && (kcol < qstart + 16); int dc = kcol - qcol + 15; dc = dc < 0 ? 0 : dc; dc = dc > 30 ? 30 : dc;
        EBt[i] = valid ? rpb[(h * 15 + dr) * 31 + dc] : -3.0e38f; } }
    int* cnt = (int*)(ws + OFF_CNT); int* rowl = (int*)(ws + OFF_ROWL);
    if (gt < 16) cnt[gt] = 0;
    if (blockIdx.x == 0) for (int i = tid; i < XCD_BAR_WORDS; i += 512) ((unsigned*)(ws + OFF_BAR))[i] = 0u;
    if (tid < 2) ((LAS unsigned*)(lds + LDS_TS + 80))[tid] = 0u;
    for (long i = gt; i < 102400; i += ngt) rowl[i] = -1;
  }
  }
  grid.sync();
  __syncthreads();
  const XcdBarrier xb = xcd_barrier_post((unsigned*)(ws + OFF_BAR), (volatile LAS unsigned*)(lds + LDS_TS + 80));
  { PH_VARS
  { Gemm g{(const bf16_t*)(ws + OFF_XB), (const bf16_t*)(ws + OFF_WQKT), 1024}; StaticOrder S; S.init(T, 2048); EpiQK2 E{(bf16_t*)(ws + OFF_QK)}; gemm_phase(lds, g, S, E); }
  { Gemm g{(const bf16_t*)(ws + OFF_WVT), (const bf16_t*)(ws + OFF_XB), 1024}; StaticOrder S; S.init(1024, T); EpiVT E{(bf16_t*)(ws + OFF_VT)}; gemm_phase(lds, g, S, E); }
  }
  xcd_barrier(xb);
  { PH_VARS
  attn_phase((const bf16_t*)(ws + OFF_QK), (const bf16_t*)(ws + OFF_VT), (const float*)(ws + OFF_EB), (bf16_t*)(ws + OFF_O));
  }
  xcd_barrier(xb);
  { PH_VARS
  { Gemm g{(const bf16_t*)(ws + OFF_O), (const bf16_t*)(ws + OFF_WOT), 1024}; StaticOrder S; S.init(T, 1024); EpiResid E{X}; gemm_phase(lds, g, S, E); }
  }
  xcd_barrier(xb);
  { PH_VARS
  { bf16_t* xb = (bf16_t*)(ws + OFF_XB);
    for (int row = gw; row < T; row += 2 * nw) { const int rw1 = (row + nw < T) ? row + nw : row; f32x4 oo[2][4]; ln_row2(X + (size_t)row * 1024, X + (size_t)rw1 * 1024, INP(29), INP(30), lane, oo[0], oo[1]);
#pragma unroll
      for (int h = 0; h < 2; ++h) { const int rr = h ? rw1 : row;
#pragma unroll
        for (int k = 0; k < 4; ++k) { *(f32x4*)(X + (size_t)rr * 1024 + k * 256 + lane * 4) = oo[h][k]; u32x2 q; q[0] = cvt_pk_bf16(oo[h][k][0], oo[h][k][1]); q[1] = cvt_pk_bf16(oo[h][k][2], oo[h][k][3]); *(u32x2*)(xb + (size_t)rr * 1024 + k * 256 + lane * 4) = q; } } } }
  }
  xcd_barrier(xb);
  { PH_VARS
  { Gemm g{(const bf16_t*)(ws + OFF_XB), (const bf16_t*)(ws + OFF_WGUT), 1024}; StaticOrder S; S.init(T, 5632); EpiSwiglu E{(bf16_t*)(ws + OFF_H), 2816, 1 << 20, 0}; gemm_phase(lds, g, S, E); }
  }
  xcd_barrier(xb);
  { Gemm g{(const bf16_t*)(ws + OFF_H), (const bf16_t*)(ws + OFF_WDT), 2816}; StaticOrder S; S.init(T, 1024); EpiResid E{X}; gemm_phase(lds, g, S, E); }
  xcd_barrier(xb);
  { PH_VARS
  for (int row = gw; row < T; row += 2 * nw) { const int rw1 = (row + nw < T) ? row + nw : row; f32x4 oo[2][4]; ln_row2(X + (size_t)row * 1024, X + (size_t)rw1 * 1024, INP(31), INP(32), lane, oo[0], oo[1]);
#pragma unroll
    for (int h = 0; h < 2; ++h)
#pragma unroll
      for (int k = 0; k < 4; ++k) *(f32x4*)(X + (size_t)(h ? rw1 : row) * 1024 + k * 256 + lane * 4) = oo[h][k]; }
  }
  xcd_barrier(xb);
  { PH_VARS
  { bf16_t* xb2 = (bf16_t*)(ws + OFF_XB2);
    for (int row = gw; row < T; row += nw) {
      const int s0 = row < 16384 ? (row & ~8191) : 16384 + ((row - 16384) & ~4095), len = row < 16384 ? 8192 : 4096;
      const bool hm = row > s0, hp = row < s0 + len - 1;
#pragma unroll
      for (int k = 0; k < 4; ++k) { const size_t off = (size_t)row * 1024 + k * 256 + lane * 4; const f32x4 x = *(const f32x4*)(X + off);
        const f32x4 xm = hm ? *(const f32x4*)(X + off - 1024) : (f32x4){0.f, 0.f, 0.f, 0.f}, xp = hp ? *(const f32x4*)(X + off + 1024) : (f32x4){0.f, 0.f, 0.f, 0.f};
        const f32x4 xx = (xm + xp) * 0.5f - x; u32x2 a, b; a[0] = cvt_pk_bf16(x[0], x[1]); a[1] = cvt_pk_bf16(x[2], x[3]); b[0] = cvt_pk_bf16(xx[0], xx[1]); b[1] = cvt_pk_bf16(xx[2], xx[3]);
        bf16_t* dp = xb2 + (size_t)row * 2048 + k * 256 + lane * 4; *(u32x2*)dp = a; *(u32x2*)(dp + 1024) = b; } } }
  }
  xcd_barrier(xb);
  { PH_VARS
  { Gemm g{(const bf16_t*)(ws + OFF_XB2), (const bf16_t*)(ws + OFF_WRT), 2048}; StaticOrder S; S.init(T, 3584); EpiRwkv E{(bf16_t*)(ws + OFF_RKV), (bf16_t*)(ws + OFF_LBWA), (bf16_t*)(ws + OFF_LBG)}; gemm_phase(lds, g, S, E); }
  }
  xcd_barrier(xb);
  { PH_VARS
  { LAS float* L = (LAS float*)lds; const int b = blockIdx.x;
    for (int round = 0; round < 320; ++round) {
      int cA, mA = 0, rA = 0, cB = -1, mB = 0;
      if (G == 256) { if (round > 0) break; if (b < 128) { cA = b >> 1; mA = 1; rA = (b & 1) * 32; cB = cA; mB = 2; } else { cA = 64 + (b - 128) * 2; cB = cA + 1; } }
      else { cA = b + round * G; if (cA >= 320) break; }
      scan_block(ws, L, cA, mA, rA, cB, mB, 0);
    }
  }
  }
  xcd_barrier(xb);
  { PH_VARS
  { bf16_t* yf = (bf16_t*)(ws + OFF_YF); const bf16_t* yb = (const bf16_t*)(ws + OFF_YB); const bf16_t* rkv = (const bf16_t*)(ws + OFF_RKV); const float* bonus = (const float*)(ws + OFF_BONUS);
    for (int row = gw; row < T; row += nw) {
      const size_t off = (size_t)row * 1024 + lane * 16; const u32x4 a0 = *(const u32x4*)(yf + off), a1 = *(const u32x4*)(yf + off + 8), b0 = *(const u32x4*)(yb + off), b1 = *(const u32x4*)(yb + off + 8);
      const u32x4 v0 = *(const u32x4*)(rkv + (size_t)row * 3072 + 2048 + lane * 16), v1 = *(const u32x4*)(rkv + (size_t)row * 3072 + 2048 + lane * 16 + 8);
      float y[16], vv[16]; float s = 0.f;
#pragma unroll
      for (int j = 0; j < 4; ++j) { y[2 * j] = bflo(a0[j]) + bflo(b0[j]); y[2 * j + 1] = bfhi(a0[j]) + bfhi(b0[j]); y[8 + 2 * j] = bflo(a1[j]) + bflo(b1[j]); y[8 + 2 * j + 1] = bfhi(a1[j]) + bfhi(b1[j]);
        vv[2 * j] = bflo(v0[j]); vv[2 * j + 1] = bfhi(v0[j]); vv[8 + 2 * j] = bflo(v1[j]); vv[8 + 2 * j + 1] = bfhi(v1[j]); }
#pragma unroll
      for (int j = 0; j < 16; ++j) s += y[j];
      const float mean = red4(s) * (1.f / 64.f); float q = 0.f;
#pragma unroll
      for (int j = 0; j < 16; ++j) { y[j] -= mean; q += y[j] * y[j]; }
      const float rstd = rsqrtf(red4(q) * (1.f / 64.f) + 64e-5f);
      const float* bp = bonus + ((size_t)row * 16 + (lane >> 2)) * 2; const float bsum = bp[0] + bp[1];
      u32x4 o0, o1;
#pragma unroll
      for (int j = 0; j < 4; ++j) { const f32x4 gg = *(const f32x4*)(INP(21) + lane * 16 + j * 4), bb = *(const f32x4*)(INP(22) + lane * 16 + j * 4); float t[4];
#pragma unroll
        for (int e = 0; e < 4; ++e) t[e] = y[j * 4 + e] * rstd * gg[e] + bb[e] + bsum * vv[j * 4 + e];
        const unsigned lo = cvt_pk_bf16(t[0], t[1]), hi = cvt_pk_bf16(t[2], t[3]);
        if (j < 2) { o0[2 * j] = lo; o0[2 * j + 1] = hi; } else { o1[2 * (j - 2)] = lo; o1[2 * (j - 2) + 1] = hi; } }
      *(u32x4*)(yf + off) = o0; *(u32x4*)(yf + off + 8) = o1; } }
  }
  xcd_barrier(xb);
  { PH_VARS
  { Gemm g{(const bf16_t*)(ws + OFF_LBG), (const bf16_t*)(ws + OFF_G2T), 256}; StaticOrder S; S.init(T, 1024); EpiMulPre E{(bf16_t*)(ws + OFF_YF)}; gemm_phase(lds, g, S, E); }
  }
  xcd_barrier(xb);
  { PH_VARS
  { Gemm g{(const bf16_t*)(ws + OFF_YF), (const bf16_t*)(ws + OFF_RWOT), 1024}; StaticOrder S; S.init(T, 1024); EpiResid E{X}; gemm_phase(lds, g, S, E); }
  }
  xcd_barrier(xb);
  { PH_VARS
  { bf16_t* xb = (bf16_t*)(ws + OFF_XBM); int* cnt = (int*)(ws + OFF_CNT); int* tokE = (int*)(ws + OFF_TOKE); float* tokG = (float*)(ws + OFF_TOKG); int* tokP = (int*)(ws + OFF_TOKP);
    const float* wr = INP(24); const float* br = INP(25);
    LAS int* lc = (LAS int*)(lds + 100000);
    if (tid < 16) lc[tid] = 0;
    __syncthreads();
    for (int row = gw; row < T; row += nw) { f32x4 o[4]; ln_row(X + (size_t)row * 1024, INP(29) + 1024, INP(30) + 1024, lane, o);
      float lg[8];
#pragma unroll
      for (int e = 0; e < 8; ++e) lg[e] = 0.f;
#pragma unroll
      for (int k = 0; k < 4; ++k) {
#pragma unroll
        for (int j = 0; j < 4; ++j) { const float* wp = wr + (size_t)(k * 256 + lane * 4 + j) * 8; const f32x4 wa = *(const f32x4*)wp, wb = *(const f32x4*)(wp + 4); const float xv = o[k][j];
          lg[0] += xv * wa[0]; lg[1] += xv * wa[1]; lg[2] += xv * wa[2]; lg[3] += xv * wa[3]; lg[4] += xv * wb[0]; lg[5] += xv * wb[1]; lg[6] += xv * wb[2]; lg[7] += xv * wb[3]; }
        *(f32x4*)(X + (size_t)row * 1024 + k * 256 + lane * 4) = o[k] * ALPHA; u32x2 q; q[0] = cvt_pk_bf16(o[k][0], o[k][1]); q[1] = cvt_pk_bf16(o[k][2], o[k][3]); *(u32x2*)(xb + (size_t)row * 1024 + k * 256 + lane * 4) = q; }
#pragma unroll
      for (int e = 0; e < 8; ++e) lg[e] = wave_sum(lg[e]) + br[e];
      int e0 = 0; float v0 = lg[0];
#pragma unroll
      for (int e = 1; e < 8; ++e) if (lg[e] > v0) { v0 = lg[e]; e0 = e; }
      int e1 = -1; float v1 = -3.0e38f;
#pragma unroll
      for (int e = 0; e < 8; ++e) if (e != e0 && lg[e] > v1) { v1 = lg[e]; e1 = e; }
      if (lane == 0) { const float ex = __expf(v1 - v0), g0 = 1.f / (1.f + ex), g1 = ex * g0;
        const int p0 = __hip_atomic_fetch_add(lc + e0, 1, __ATOMIC_RELAXED, __HIP_MEMORY_SCOPE_WORKGROUP), p1 = __hip_atomic_fetch_add(lc + 8 + e1, 1, __ATOMIC_RELAXED, __HIP_MEMORY_SCOPE_WORKGROUP);
        tokE[row * 2] = e0; tokE[row * 2 + 1] = e1; tokG[row * 2] = g0; tokG[row * 2 + 1] = g1; tokP[row * 2] = p0; tokP[row * 2 + 1] = p1; } }
    __syncthreads();
    if (tid < 16) lc[16 + tid] = atomicAdd(cnt + tid, lc[tid]);
    __syncthreads();
    if (lane < 2) for (int row = gw; row < T; row += nw) tokP[row * 2 + lane] += lc[16 + lane * 8 + tokE[row * 2 + lane]];
    __syncthreads();
    int rot = 0; float* tile = (float*)shm;
    for (int e = 0; e < 8; ++e) {
      rot = cvt_run(mkjob(INP(26) + (size_t)e * 1024 * 3584, 3584, 1024, 3584, (bf16_t*)(ws + OFF_WMGU) + (size_t)e * 7168 * 1024, 1024, 0, 0, nullptr, 1.f, 1), tile, rot);
      rot = cvt_run(mkjob(INP(27) + (size_t)e * 1024 * 3584, 3584, 1024, 3584, (bf16_t*)(ws + OFF_WMGU) + (size_t)e * 7168 * 1024, 1024, 128, 0, nullptr, 1.f, 1), tile, rot);
      rot = cvt_run(mkjob(INP(28) + (size_t)e * 3584 * 1024, 1024, 3584, 1024, (bf16_t*)(ws + OFF_WMD) + (size_t)e * 1024 * 3584, 3584, 0, 0, nullptr, 1.f, 0), tile, rot);
    }
  }
  }
  xcd_barrier(xb);
  { PH_VARS
  { const int* cnt = (const int*)(ws + OFF_CNT);
    __syncthreads();
    if (tid == 0) { int a = 0; for (int k = 0; k < 16; ++k) { TS[k] = a; a += (cnt[k] + 255) >> 8; } TS[16] = a; }
    __syncthreads();
    const int* tokE = (const int*)(ws + OFF_TOKE); const float* tokG = (const float*)(ws + OFF_TOKG); const int* tokP = (const int*)(ws + OFF_TOKP);
    int* rowl = (int*)(ws + OFF_ROWL); float* rowg = (float*)(ws + OFF_ROWG); const bf16_t* xb = (const bf16_t*)(ws + OFF_XBM); bf16_t* xs = (bf16_t*)(ws + OFF_XS);
    for (int pr0 = gw; pr0 < T * 2; pr0 += 4 * nw) { u32x4 va[4], vb[4]; int rows[4];
#pragma unroll
      for (int u = 0; u < 4; ++u) { const int pr = pr0 + u * nw; rows[u] = -1; if (pr < T * 2) { const int tok = pr >> 1, rk = pr & 1; const int e = tokE[pr]; const int row = TS[rk * 8 + e] * 256 + tokP[pr]; rows[u] = row;
        if (lane == 0) { rowl[row] = tok; rowg[row] = tokG[pr]; }
        const u32x4* sp = (const u32x4*)(xb + (size_t)tok * 1024); va[u] = sp[lane]; vb[u] = sp[lane + 64]; } }
#pragma unroll
      for (int u = 0; u < 4; ++u) if (rows[u] >= 0) { u32x4* dp = (u32x4*)(xs + (size_t)rows[u] * 1024); dp[lane] = va[u]; dp[lane + 64] = vb[u]; } }
  }
  }
  xcd_barrier(xb);
  { PH_VARS
  { const int ts8 = TS[8], ts16 = TS[16]; const int b = blockIdx.x;
    int pcs = -1, pnt = 0, pbuf = 0, buf = 0;
    for (int rk = 0; rk < 2; ++rk) { const int t0 = rk ? ts16 * 0 + ts8 : 0, t1 = rk ? ts16 : ts8;
      for (int cs = t0; cs < t1; cs += MOE_CHUNK) { const int ntile = (t1 - cs) < MOE_CHUNK ? (t1 - cs) : MOE_CHUNK;
        int nd = 0;
        if (pcs >= 0) { nd = pnt * 4; nd = nd > G ? G : nd;
          Gemm g{(const bf16_t*)(ws + OFF_HID + (size_t)pbuf * HID_BUF), (const bf16_t*)(ws + OFF_WMD), 3584}; MoeDownOrder S{pcs, pnt, G, b, TS}; EpiMoeDown E{X, (const int*)(ws + OFF_ROWL), (const float*)(ws + OFF_ROWG), pcs * 256}; gemm_phase(lds, g, S, E); }
        { Gemm g{(const bf16_t*)(ws + OFF_XS), (const bf16_t*)(ws + OFF_WMGU), 1024}; MoeUpSkewOrder S{cs, ntile, nd, G, b, TS}; EpiSwiglu E{(bf16_t*)(ws + OFF_HID + (size_t)buf * HID_BUF), 3584, 28, cs * 256}; gemm_phase(lds, g, S, E); }
        xcd_barrier(xb);
        pcs = cs; pnt = ntile; pbuf = buf; buf ^= 1;
      } }
    if (pcs >= 0) { Gemm g{(const bf16_t*)(ws + OFF_HID + (size_t)pbuf * HID_BUF), (const bf16_t*)(ws + OFF_WMD), 3584}; MoeDownOrder S{pcs, pnt, G, b, TS}; EpiMoeDown E{X, (const int*)(ws + OFF_ROWL), (const float*)(ws + OFF_ROWG), pcs * 256}; gemm_phase(lds, g, S, E); }
    xcd_barrier(xb);
  }
  }
  { PH_VARS
  for (int row = gw; row < T; row += 2 * nw) { const int rw1 = (row + nw < T) ? row + nw : row; f32x4 oo[2][4]; ln_row2(X + (size_t)row * 1024, X + (size_t)rw1 * 1024, INP(31) + 1024, INP(32) + 1024, lane, oo[0], oo[1]);
#pragma unroll
    for (int h = 0; h < 2; ++h)
#pragma unroll
      for (int k = 0; k < 4; ++k) *(f32x4*)(X + (size_t)(h ? rw1 : row) * 1024 + k * 256 + lane * 4) = oo[h][k]; }
  }
}

extern "C" void kernel_launch(void* const* d_in, const int* in_sizes, int n_in, void* d_out, int out_size, void* d_ws, size_t ws_size, hipStream_t stream) {
  static int grid_blocks = 0;
  if (!grid_blocks) {
    int dev = 0, cus = 0, per_cu = 0;
    (void)hipGetDevice(&dev);
    (void)hipDeviceGetAttribute(&cus, hipDeviceAttributeMultiprocessorCount, dev);
    (void)hipFuncSetAttribute((const void*)mega, hipFuncAttributeMaxDynamicSharedMemorySize, LDS_BYTES);
    (void)hipOccupancyMaxActiveBlocksPerMultiprocessor(&per_cu, mega, 512, LDS_BYTES);
    if (per_cu > 1) per_cu = 1;
    grid_blocks = cus * per_cu;
    if (ws_size < WS_NEED) fprintf(stderr, "workspace too small: %zu < %zu\n", ws_size, (size_t)WS_NEED);
  }
  Params p{};
  for (int i = 0; i < 33; ++i) p.in[i] = (const float*)d_in[i];
  p.X = (float*)d_out; p.ws = (unsigned char*)d_ws;
  void* args[] = {&p};
  hipError_t e = hipLaunchCooperativeKernel((void*)mega, dim3(grid_blocks), dim3(512), args, LDS_BYTES, stream);
  if (e != hipSuccess) fprintf(stderr, "cooperative launch failed: %s (grid %d)\n", hipGetErrorString(e), grid_blocks);
}
```

```cpp
#include <hip/hip_runtime.h>
#include <hip/hip_cooperative_groups.h>
#include <cstdio>
namespace cg = cooperative_groups;

#define LAS __attribute__((address_space(3)))
typedef unsigned short bf16_t;
typedef short bf16x8 __attribute__((ext_vector_type(8)));
typedef float f32x4 __attribute__((ext_vector_type(4)));
typedef float f32x16 __attribute__((ext_vector_type(16)));
typedef unsigned u32x4 __attribute__((ext_vector_type(4)));
typedef unsigned u32x2 __attribute__((ext_vector_type(2)));

constexpr int T = 49152, D = 1024;
constexpr float ALPHA = 1.41421356237309515f;
constexpr size_t SZ = (size_t)T * 1024 * 2;
constexpr size_t OFF_WRT = 0;
constexpr size_t OFF_W2T = OFF_WRT + 14680064;
constexpr size_t OFF_G2T = OFF_W2T + 524288;
constexpr size_t OFF_RWOT = OFF_G2T + 524288;
constexpr size_t OFF_CNT = OFF_RWOT + 2097152;
constexpr size_t OFF_TOKE = OFF_CNT + 256;
constexpr size_t OFF_TOKG = OFF_TOKE + 393216;
constexpr size_t OFF_TOKP = OFF_TOKG + 393216;
constexpr size_t OFF_ROWL = OFF_TOKP + 393216;
constexpr size_t OFF_ROWG = OFF_ROWL + 409600;
constexpr size_t OFF_BONUS = OFF_ROWG + 409600;
constexpr size_t OFF_BAR = OFF_BONUS + 6291456;
constexpr size_t BIG = 26214400;
constexpr size_t OFF_XB = BIG, OFF_QK = BIG + SZ, OFF_VT = BIG + 3 * SZ, OFF_O = BIG + 4 * SZ;
constexpr size_t OFF_WQKT = BIG + 5 * SZ, OFF_WVT = OFF_WQKT + 4194304, OFF_WOT = OFF_WVT + 2097152, OFF_WGUT = OFF_WOT + 2097152, OFF_WDT = OFF_WGUT + 11534336;
constexpr size_t OFF_EB = OFF_WDT + 5767168;
constexpr size_t OFF_H = BIG + SZ;
constexpr size_t OFF_XB2 = BIG, OFF_RKV = BIG + 2 * SZ, OFF_LBWA = BIG + 5 * SZ, OFF_LBG = OFF_LBWA + 25165824;
constexpr size_t OFF_YF = BIG, OFF_YB = BIG + SZ;
constexpr size_t OFF_WMGU = BIG, OFF_WMD = BIG + 117440512, OFF_XS = BIG + 176160768, OFF_XBM = OFF_XS + 209715200, OFF_HID = OFF_XBM;
constexpr size_t WS_NEED = OFF_HID + 183500800;
constexpr int MOE_CHUNK = 50;
constexpr size_t HID_BUF = (size_t)MOE_CHUNK * 256 * 7168;
constexpr int LDS_BYTES = 131072 + 512 + 1024;

struct Params { const float* in[33]; float* X; unsigned char* ws; };
extern __shared__ __attribute__((aligned(16))) unsigned char shm[];
constexpr int LDS_TS = 131072, LDS_TAB = 131072 + 128;
__device__ __forceinline__ const float* INP(int i) {
  const LAS unsigned* tab = (const LAS unsigned*)((LAS unsigned char*)shm + LDS_TAB);
  const unsigned lo = __builtin_amdgcn_readfirstlane(tab[2 * i]), hi = __builtin_amdgcn_readfirstlane(tab[2 * i + 1]);
  return (const float*)(((unsigned long long)hi << 32) | lo);
}

__device__ __forceinline__ int tid_() { int t = threadIdx.x; asm volatile("" : "+v"(t)); return t; }
__device__ __forceinline__ unsigned cvt_pk_bf16(float lo, float hi) { unsigned r; asm("v_cvt_pk_bf16_f32 %0, %1, %2" : "=v"(r) : "v"(lo), "v"(hi)); return r; }
__device__ __forceinline__ bf16_t f2bf(float f) { return (bf16_t)(cvt_pk_bf16(f, 0.f) & 0xffffu); }
__device__ __forceinline__ float bflo(unsigned u) { return __uint_as_float(u << 16); }
__device__ __forceinline__ float bfhi(unsigned u) { return __uint_as_float(u & 0xffff0000u); }
__device__ __forceinline__ float wave_sum(float v) { for (int o = 32; o; o >>= 1) v += __shfl_xor(v, o); return v; }
template <int CTRL> __device__ __forceinline__ float dppf(float v) { return __builtin_bit_cast(float, __builtin_amdgcn_mov_dpp(__builtin_bit_cast(int, v), CTRL, 0xf, 0xf, true)); }
__device__ __forceinline__ float red4(float v) { v += dppf<0xB1>(v); v += dppf<0x4E>(v); return v; }
__device__ __forceinline__ float red8(float v) { v = red4(v); v += dppf<0x141>(v); return v; }
__device__ __forceinline__ float red16(float v) { v = red8(v); v += dppf<0x140>(v); return v; }
__device__ __forceinline__ float sigmoidf_(float x) { return __builtin_amdgcn_rcpf(1.f + __expf(-x)); }


#define XB_TMO      128
#define XB_XCNT(j)  (256  + 64 * (j))
#define XB_XSUB(j)  (1280 + 64 * (j))
#define XB_XGEN(j)  (2304 + 64 * (j))
#define XB_TOP      3328
#define XB_TOPGEN   3392
#define XCD_BAR_WORDS 3456
#define XB_SPIN_CAP (1u << 18)
__device__ __forceinline__ unsigned xb_ld(unsigned* p)              { return __hip_atomic_load(p, __ATOMIC_RELAXED, __HIP_MEMORY_SCOPE_AGENT); }
__device__ __forceinline__ unsigned xb_add(unsigned* p, unsigned v) { return __hip_atomic_fetch_add(p, v, __ATOMIC_RELAXED, __HIP_MEMORY_SCOPE_AGENT); }
__device__ __forceinline__ unsigned xb_xcc_id() { return (unsigned)__builtin_amdgcn_s_getreg((3 << 11) | 20) & 0xFu; }
#define XB_SPIN(cond, bar) do { unsigned _sp = 0; while (cond) { __builtin_amdgcn_s_sleep(1); \
    if ((++_sp & 255u) == 0u) { if (xb_ld(&(bar)[XB_TMO])) break; if (_sp > XB_SPIN_CAP) { atomicAdd(&(bar)[XB_TMO], 1u); break; } } } } while (0)
struct XcdBarrier { unsigned* bar; unsigned x; volatile LAS unsigned* st; };
__device__ __forceinline__ XcdBarrier xcd_barrier_post(unsigned* bar, volatile LAS unsigned* st) {
  XcdBarrier b; b.bar = bar; b.x = xb_xcc_id(); b.st = st;
  if (threadIdx.x == 0) (void)xb_add(&bar[XB_XCNT(b.x)], 1u);
  return b;
}
__device__ __forceinline__ void xcd_barrier_complete(unsigned* bar, unsigned x, unsigned& nloc, unsigned& nx) {
  const unsigned G = gridDim.x * gridDim.y * gridDim.z;
  unsigned sum, cnt, mine, sp = 0u;
  for (;;) {
    sum = 0u; cnt = 0u; mine = 0u;
#pragma unroll
    for (unsigned j = 0; j < 16; ++j) { const unsigned c = xb_ld(&bar[XB_XCNT(j)]); sum += c; cnt += (c > 0u) ? 1u : 0u; mine = (j == x) ? c : mine; }
    if (sum == G) break;
    __builtin_amdgcn_s_sleep(1);
    if ((++sp & 255u) == 0u) { if (xb_ld(&bar[XB_TMO])) break; if (sp > XB_SPIN_CAP) { atomicAdd(&bar[XB_TMO], 1u); break; } }
  }
  nloc = mine > 0u ? mine : 1u; nx = cnt > 0u ? cnt : 1u;
}
__device__ __forceinline__ void xcd_barrier(const XcdBarrier& b) {
  asm volatile("s_waitcnt vmcnt(0)" ::: "memory");
  __syncthreads();
  if (threadIdx.x == 0) {
    unsigned* bar = b.bar;
    __builtin_amdgcn_s_waitcnt(0);
    unsigned nloc = b.st[0], nx = b.st[1];
    if (nloc == 0u) { xcd_barrier_complete(bar, b.x, nloc, nx); b.st[0] = nloc; b.st[1] = nx; }
    const unsigned old = xb_add(&bar[XB_XSUB(b.x)], 1u);
    const unsigned gen = old / nloc;
    if (old + 1u == (gen + 1u) * nloc) {
      __builtin_amdgcn_fence(__ATOMIC_RELEASE, "agent");
      asm volatile("s_waitcnt vmcnt(0)" ::: "memory");
      const unsigned og = xb_add(&bar[XB_TOP], 1u);
      const unsigned tg = og / nx;
      if (og + 1u == (tg + 1u) * nx) xb_add(&bar[XB_TOPGEN], 1u);
      else XB_SPIN(xb_ld(&bar[XB_TOPGEN]) == tg, bar);
      __builtin_amdgcn_fence(__ATOMIC_ACQUIRE, "agent");
      xb_add(&bar[XB_XGEN(b.x)], 1u);
      asm volatile("s_waitcnt vmcnt(0)" ::: "memory");
    } else {
      XB_SPIN(xb_ld(&bar[XB_XGEN(b.x)]) == gen, bar);
      __builtin_amdgcn_fence(__ATOMIC_ACQUIRE, "agent");
      asm volatile("s_waitcnt vmcnt(0)" ::: "memory");
    }
  }
  __syncthreads();
}

struct CvtJob { const float* src; int ldsrc, K, N; bf16_t* dst; int lddst, row0, col0; const float* kscale; float scale; int mode; };
__device__ __forceinline__ CvtJob mkjob(const float* src, int ldsrc, int K, int N, bf16_t* dst, int lddst, int row0, int col0, const float* kscale, float scale, int mode) {
  CvtJob j; j.src = src; j.ldsrc = ldsrc; j.K = K; j.N = N; j.dst = dst; j.lddst = lddst; j.row0 = row0; j.col0 = col0; j.kscale = kscale; j.scale = scale; j.mode = mode; return j; }
__device__ __forceinline__ int cvt_run(const CvtJob J, float* tile, int rot) {
  const int tk = (J.K + 63) >> 6, tn = (J.N + 63) >> 6, nt = tk * tn, G = gridDim.x;
  const int tx = tid_() & 63, ty = tid_() >> 6;
  int start = (int)blockIdx.x - rot; if (start < 0) start += G;
  for (int t0 = start; t0 < nt; t0 += 4 * G) {
    float v[4][8];
#pragma unroll
    for (int q = 0; q < 4; ++q) { const int t = t0 + q * G; const int k0 = (t / tn) * 64, n0 = (t % tn) * 64;
#pragma unroll
      for (int r = 0; r < 8; ++r) { const int k = k0 + r * 8 + ty, n = n0 + tx; v[q][r] = 0.f;
        if (t < nt && J.src && k < J.K && n < J.N) v[q][r] = J.src[(size_t)k * J.ldsrc + n]; } }
    __syncthreads();
#pragma unroll
    for (int q = 0; q < 4; ++q) { const int t = t0 + q * G; const int k0 = (t / tn) * 64;
#pragma unroll
      for (int r = 0; r < 8; ++r) { const int kk = r * 8 + ty; float x = v[q][r] * J.scale; if (J.kscale && t < nt && k0 + kk < J.K) x *= J.kscale[k0 + kk]; tile[q * 4160 + kk * 65 + tx] = x; } }
    __syncthreads();
#pragma unroll
    for (int q = 0; q < 4; ++q) { const int t = t0 + q * G; const int k0 = (t / tn) * 64, n0 = (t % tn) * 64;
#pragma unroll
      for (int r = 0; r < 8; ++r) { const int nn = r * 8 + ty, n = n0 + nn, k = k0 + tx;
        if (t < nt && n < J.N && k < J.K) { const int row = J.mode ? ((n >> 7) * 256 + (n & 127)) : n;
          J.dst[(size_t)(J.row0 + row) * J.lddst + J.col0 + k] = f2bf(tile[q * 4160 + tx * 65 + nn]); } } }
  }
  return (rot + nt) % G;
}

constexpr int BM = 256, BK = 64, HALF = 128, HTB = HALF * BK * 2, NXCD = 8, WGM = 8;
__device__ __forceinline__ int lds_byte(int r, int c) { const int st = (r >> 4) * 2 + (c >> 5), rr = r & 15, cc = c & 31, ob = rr * 64 + cc * 2; return st * 1024 + (ob ^ (((ob >> 9) & 1) << 5)); }
__device__ __forceinline__ void stage_rc(int b, int& R, int& C) { const int st = b / 1024, sb = b % 1024, swz = sb ^ (((sb >> 9) & 1) << 5); R = (st >> 1) * 16 + swz / 64; C = (st & 1) * 32 + (swz % 64) / 2; }
__device__ __forceinline__ int perm32(int rho) { const int n = rho >> 4, i = rho & 15; return 8 * (i >> 2) + 4 * n + (i & 3); }
struct Unit { int pm, pn; };
struct Gemm { const bf16_t* A; const bf16_t* Bt; int K; };
struct StaticOrder {
  int nM, nN, nwg, G, c;
  __device__ void init(int M, int N) { nM = M / BM; nN = N / BM; nwg = nM * nN; G = gridDim.x; c = blockIdx.x; }
  __device__ bool next(int i, Unit& u) const {
    const long L = (long)i * G + c; if (L >= nwg) return false;
    int wgid = (int)L; { const int q = nwg / NXCD, r = nwg % NXCD, xcd = wgid % NXCD, off = wgid / NXCD; wgid = (xcd < r ? xcd * (q + 1) : r * (q + 1) + (xcd - r) * q) + off; }
    const int nig = WGM * nN, gid = wgid / nig, fm = gid * WGM, gsz = (nM - fm) < WGM ? (nM - fm) : WGM;
    u.pm = fm + ((wgid % nig) % gsz); u.pn = (wgid % nig) / gsz; return true;
  }
};
template <int NC> struct MoeOrder {
  int first, ntile, G, c; const LAS int* ts;
  __device__ bool next(int i, Unit& u) const {
    const long L = (long)i * G + c; if (L >= (long)ntile * NC) return false;
    const int l = (int)L, nig = WGM * NC, gid = l / nig, fm = gid * WGM, gsz = (ntile - fm) < WGM ? (ntile - fm) : WGM;
    const int pm = first + fm + ((l % nig) % gsz), pn = (l % nig) / gsz;
    int g = 0;
#pragma unroll
    for (int k = 1; k < 16; ++k) g += (pm >= ts[k]) ? 1 : 0;
    u.pm = pm; u.pn = (g & 7) * NC + pn; return true;
  }
};

struct MoeUpSkewOrder {
  int first, ntile, nd, G, c; const LAS int* ts;
  __device__ bool next(int i, Unit& u) const {
    const int r = (c >= nd) ? i : i + 3;
    const long L = (r < 3) ? (long)r * (G - nd) + (c - nd) : (long)3 * (G - nd) + (long)(r - 3) * G + c;
    if (L >= (long)ntile * 28) return false;
    const int l = (int)L, nig = WGM * 28, gid = l / nig, fm = gid * WGM, gsz = (ntile - fm) < WGM ? (ntile - fm) : WGM;
    const int pm = first + fm + ((l % nig) % gsz), pn = (l % nig) / gsz;
    int g = 0;
#pragma unroll
    for (int k = 1; k < 16; ++k) g += (pm >= ts[k]) ? 1 : 0;
    u.pm = pm; u.pn = (g & 7) * 28 + pn; return true;
  }
};

template <class Epi, class Sched>
__device__ __forceinline__ void gemm_phase(LAS unsigned char* lds, const Gemm g, const Sched& S, const Epi& E) {
  const int tid = tid_(), wid = __builtin_amdgcn_readfirstlane(tid >> 6), lane = tid & 63, wr = wid >> 2, wc = wid & 3, fr = lane & 15, fq = lane >> 4;
  const int K = g.K, nt = K / BK;
  unsigned voffA[2], voffB[2];
#pragma unroll
  for (int i = 0; i < 2; ++i) { int R, C; stage_rc(tid * 16 + i * 8192, R, C); const int Rb = Epi::PERM ? ((R & ~31) + perm32(R & 31)) : R;
    voffA[i] = (unsigned)(R * K + C) * 2u; voffB[i] = (unsigned)(Rb * K + C) * 2u; }
  const size_t kstep = (size_t)(BK * 2);
  const size_t hstep = (size_t)HALF * K * 2;
  const size_t tstep = 2 * hstep;
  const unsigned ldsw = (unsigned)wid * 1024u;
  const int aoff = lds_byte(wr * 64 + fr, fq * 8), boff = lds_byte(wc * 32 + fr, fq * 8);
#define PG8_SA(b, h) (((b) * 2 + (h)) * HTB)
#define PG8_SB(b, h) ((4 + (b) * 2 + (h)) * HTB)
#define PG8_STAGE(bufoff, gbase, voff) do { _Pragma("unroll") for (int _i = 0; _i < 2; ++_i) \
    __builtin_amdgcn_global_load_lds((const unsigned*)((const char*)(gbase) + (voff)[_i]), (LAS unsigned*)(lds + (bufoff) + ldsw + _i * 8192), 16, 0, 0); } while (0)
#define PG8_LDA(dst, b, h) do { _Pragma("unroll") for (int m = 0; m < 4; ++m) _Pragma("unroll") for (int k = 0; k < 2; ++k) dst[m][k] = *(const LAS bf16x8*)(lds + PG8_SA(b, h) + aoff + m * 2048 + k * 1024); } while (0)
#define PG8_LDB(dst, b, h) do { _Pragma("unroll") for (int n = 0; n < 2; ++n) _Pragma("unroll") for (int k = 0; k < 2; ++k) dst[n][k] = *(const LAS bf16x8*)(lds + PG8_SB(b, h) + boff + n * 2048 + k * 1024); } while (0)
#define PG8_MMA(ai, bj, At, Bt) do { __builtin_amdgcn_s_setprio(1); _Pragma("unroll") for (int m = 0; m < 4; ++m) _Pragma("unroll") for (int n = 0; n < 2; ++n) _Pragma("unroll") for (int k = 0; k < 2; ++k) \
    acc[ai][bj][m][n] = __builtin_amdgcn_mfma_f32_16x16x32_bf16(Bt[n][k], At[m][k], acc[ai][bj][m][n], 0, 0, 0); __builtin_amdgcn_s_setprio(0); } while (0)
#define PG8_WAIT_V(n) asm volatile("s_waitcnt vmcnt(" #n ")" ::: "memory")
#define PG8_WAIT_L(n) asm volatile("s_waitcnt lgkmcnt(" #n ")" ::: "memory")
#define PG8_BAR __builtin_amdgcn_s_barrier()
#define PG8_SCHED __builtin_amdgcn_sched_barrier(0)
  Unit cur, nxt; int ui = 0;
  if (!S.next(0, cur)) return;
  f32x4 acc[2][2][4][2];
#pragma unroll
  for (int a = 0; a < 2; ++a)
#pragma unroll
    for (int b = 0; b < 2; ++b)
#pragma unroll
      for (int m = 0; m < 4; ++m)
#pragma unroll
        for (int n = 0; n < 2; ++n) acc[a][b][m][n] = (f32x4){0.f, 0.f, 0.f, 0.f};
  bf16x8 At[4][2], B0[2][2], B1[2][2];
  const char* cA = (const char*)g.A + (size_t)cur.pm * tstep; const char* cB = (const char*)g.Bt + (size_t)cur.pn * tstep;
  PG8_STAGE(PG8_SB(0, 0), cB, voffB); PG8_STAGE(PG8_SA(0, 0), cA, voffA); PG8_STAGE(PG8_SB(0, 1), cB + hstep, voffB); PG8_STAGE(PG8_SA(0, 1), cA + hstep, voffA);
  if (wr == 1) PG8_BAR;
  PG8_WAIT_V(4); PG8_BAR;
  PG8_STAGE(PG8_SB(1, 0), cB + kstep, voffB); PG8_STAGE(PG8_SA(1, 0), cA + kstep, voffA); PG8_STAGE(PG8_SB(1, 1), cB + hstep + kstep, voffB);
  PG8_WAIT_V(6); PG8_BAR;
  for (;;) {
    const bool has_next = S.next(ui + 1, nxt);
    const char* nA = has_next ? (const char*)g.A + (size_t)nxt.pm * tstep : cA; const char* nB = has_next ? (const char*)g.Bt + (size_t)nxt.pn * tstep : cB;
    for (int t = 0; t < nt; t += 2) {
      const bool last = (t == nt - 2);
      const char* a1 = cA + (size_t)(t + 1) * kstep;
      const char* a2 = last ? nA : cA + (size_t)(t + 2) * kstep; const char* b2 = last ? nB : cB + (size_t)(t + 2) * kstep;
      const char* a3 = a2 + kstep; const char* b3 = b2 + kstep;
      PG8_LDB(B0, 0, 0); PG8_SCHED; PG8_LDA(At, 0, 0); PG8_STAGE(PG8_SA(1, 1), a1 + hstep, voffA);
      PG8_WAIT_L(8); PG8_BAR; PG8_WAIT_L(0); PG8_MMA(0, 0, At, B0); PG8_BAR; PG8_SCHED;
      PG8_LDB(B1, 0, 1); PG8_STAGE(PG8_SB(0, 0), b2, voffB);
      PG8_BAR; PG8_WAIT_L(0); PG8_MMA(0, 1, At, B1); PG8_BAR;
      PG8_LDA(At, 0, 1); PG8_STAGE(PG8_SA(0, 0), a2, voffA);
      PG8_BAR; PG8_WAIT_L(0); PG8_MMA(1, 0, At, B0); PG8_BAR; PG8_SCHED;
      PG8_STAGE(PG8_SB(0, 1), b2 + hstep, voffB);
      PG8_WAIT_V(6); PG8_BAR; PG8_MMA(1, 1, At, B1); PG8_BAR;
      PG8_LDB(B0, 1, 0); PG8_SCHED; PG8_LDA(At, 1, 0); PG8_STAGE(PG8_SA(0, 1), a2 + hstep, voffA);
      PG8_WAIT_L(8); PG8_BAR; PG8_WAIT_L(0); PG8_MMA(0, 0, At, B0); PG8_BAR; PG8_SCHED;
      PG8_LDB(B1, 1, 1); PG8_STAGE(PG8_SB(1, 0), b3, voffB);
      PG8_BAR; PG8_WAIT_L(0); PG8_MMA(0, 1, At, B1); PG8_BAR;
      PG8_LDA(At, 1, 1); PG8_STAGE(PG8_SA(1, 0), a3, voffA);
      PG8_BAR; PG8_WAIT_L(0); PG8_MMA(1, 0, At, B0); PG8_BAR; PG8_SCHED;
      PG8_STAGE(PG8_SB(1, 1), b3 + hstep, voffB);
      PG8_WAIT_V(6); PG8_BAR; PG8_MMA(1, 1, At, B1); PG8_BAR;
    }
    E(acc, cur, wr, wc, fr, fq);
    if (!has_next) break;
#pragma unroll
    for (int a = 0; a < 2; ++a)
#pragma unroll
      for (int b = 0; b < 2; ++b)
#pragma unroll
        for (int m = 0; m < 4; ++m)
#pragma unroll
          for (int n = 0; n < 2; ++n) acc[a][b][m][n] = (f32x4){0.f, 0.f, 0.f, 0.f};
    cur = nxt; cA = nA; cB = nB; ++ui;
  }
  PG8_WAIT_V(0);
  if (wr == 0) PG8_BAR;
  PG8_BAR;
#undef PG8_SA
#undef PG8_SB
#undef PG8_STAGE
#undef PG8_LDA
#undef PG8_LDB
#undef PG8_MMA
#undef PG8_WAIT_V
#undef PG8_WAIT_L
#undef PG8_BAR
#undef PG8_SCHED
}

typedef f32x4 Acc[2][2][4][2];
__device__ __forceinline__ u32x4 pack8(f32x4 a, f32x4 b) { u32x4 o; o[0] = cvt_pk_bf16(a[0], a[1]); o[1] = cvt_pk_bf16(a[2], a[3]); o[2] = cvt_pk_bf16(b[0], b[1]); o[3] = cvt_pk_bf16(b[2], b[3]); return o; }

struct EpiStore {
  static constexpr bool PERM = true; bf16_t* O; int ldc;
  __device__ __forceinline__ void operator()(const Acc& acc, const Unit& u, int wr, int wc, int fr, int fq) const {
    const int row0 = u.pm * BM + wr * 64 + fr, col0 = u.pn * BM + wc * 32 + 8 * fq;
#pragma unroll
    for (int ai = 0; ai < 2; ++ai)
#pragma unroll
      for (int m = 0; m < 4; ++m) { bf16_t* rp = O + (size_t)(row0 + ai * HALF + m * 16) * ldc + col0;
#pragma unroll
        for (int bj = 0; bj < 2; ++bj) *(u32x4*)(rp + bj * HALF) = pack8(acc[ai][bj][m][0], acc[ai][bj][m][1]); }
  }
};
struct EpiQK2 {
  static constexpr bool PERM = true; bf16_t* O;
  __device__ __forceinline__ void operator()(const Acc& acc, const Unit& u, int wr, int wc, int fr, int fq) const {
    const int row0 = u.pm * BM + wr * 64 + fr, col0 = u.pn * BM + wc * 32 + 8 * fq;
#pragma unroll
    for (int ai = 0; ai < 2; ++ai)
#pragma unroll
      for (int m = 0; m < 4; ++m) { const int tok = row0 + ai * HALF + m * 16;
#pragma unroll
        for (int bj = 0; bj < 2; ++bj) { const int n = col0 + bj * HALF; const int which = n >> 10, h = (n >> 5) & 31, d = n & 31;
          *(u32x4*)(O + (size_t)which * ((size_t)T * 1024) + ((size_t)((tok >> 6) * 32 + h) * 64 + (tok & 63)) * 32 + d) = pack8(acc[ai][bj][m][0], acc[ai][bj][m][1]); } }
  }
};
struct EpiVT {
  static constexpr bool PERM = true; bf16_t* O;
  __device__ __forceinline__ void operator()(const Acc& acc, const Unit& u, int wr, int wc, int fr, int fq) const {
    const int row0 = u.pm * BM + wr * 64 + fr, col0 = u.pn * BM + wc * 32 + 8 * fq;
#pragma unroll
    for (int ai = 0; ai < 2; ++ai)
#pragma unroll
      for (int m = 0; m < 4; ++m) { const int ch = row0 + ai * HALF + m * 16;
#pragma unroll
        for (int bj = 0; bj < 2; ++bj) { const int tok = col0 + bj * HALF;
          *(u32x4*)(O + (size_t)(tok >> 6) * 65536 + (size_t)(((ch >> 5) * 8 + ((tok & 63) >> 3)) * 32 + (ch & 31)) * 8) = pack8(acc[ai][bj][m][0], acc[ai][bj][m][1]); } }
  }
};
struct EpiResid {
  static constexpr bool PERM = false; float* X;
  __device__ __forceinline__ void operator()(const Acc& acc, const Unit& u, int wr, int wc, int fr, int fq) const {
    const int row0 = u.pm * BM + wr * 64 + fr, col0 = u.pn * BM + wc * 32 + 4 * fq;
#pragma unroll
    for (int ai = 0; ai < 2; ++ai)
#pragma unroll
      for (int m = 0; m < 4; ++m) { float* rp = X + (size_t)(row0 + ai * HALF + m * 16) * 1024 + col0;
#pragma unroll
        for (int bj = 0; bj < 2; ++bj)
#pragma unroll
          for (int n = 0; n < 2; ++n) { f32x4* q = (f32x4*)(rp + bj * HALF + n * 16); *q = *q * ALPHA + acc[ai][bj][m][n]; } __builtin_amdgcn_sched_barrier(0); }
  }
};
__device__ __forceinline__ f32x4 swiglu4(f32x4 g, f32x4 u) { f32x4 o;
#pragma unroll
  for (int j = 0; j < 4; ++j) o[j] = g[j] * __builtin_amdgcn_rcpf(1.f + __expf(-g[j])) * u[j];
  return o; }
struct EpiSwiglu {
  static constexpr bool PERM = true; bf16_t* H; int ldh, NC, row_base;
  __device__ __forceinline__ void operator()(const Acc& acc, const Unit& u, int wr, int wc, int fr, int fq) const {
    const int row0 = u.pm * BM - row_base + wr * 64 + fr, col0 = (u.pn % NC) * HALF + wc * 32 + 8 * fq;
#pragma unroll
    for (int ai = 0; ai < 2; ++ai)
#pragma unroll
      for (int m = 0; m < 4; ++m)
        *(u32x4*)(H + (size_t)(row0 + ai * HALF + m * 16) * ldh + col0) = pack8(swiglu4(acc[ai][0][m][0], acc[ai][1][m][0]), swiglu4(acc[ai][0][m][1], acc[ai][1][m][1]));
  }
};
struct EpiRwkv {
  static constexpr bool PERM = true; bf16_t* RKV; bf16_t* LBWA; bf16_t* LBG;
  __device__ __forceinline__ void operator()(const Acc& acc, const Unit& u, int wr, int wc, int fr, int fq) const {
    const int row0 = u.pm * BM + wr * 64 + fr;
    if (u.pn < 12) {
      const int col0 = u.pn * BM + wc * 32 + 8 * fq;
#pragma unroll
      for (int ai = 0; ai < 2; ++ai)
#pragma unroll
        for (int m = 0; m < 4; ++m) { bf16_t* rp = RKV + (size_t)(row0 + ai * HALF + m * 16) * 3072 + col0;
#pragma unroll
          for (int bj = 0; bj < 2; ++bj) *(u32x4*)(rp + bj * HALF) = pack8(acc[ai][bj][m][0], acc[ai][bj][m][1]); }
    } else {
      const bool isg = (u.pn == 13); bf16_t* O = isg ? LBG : LBWA; const int c0 = wc * 32 + 8 * fq;
#pragma unroll
      for (int ai = 0; ai < 2; ++ai)
#pragma unroll
        for (int m = 0; m < 4; ++m) { bf16_t* rp = O + (size_t)(row0 + ai * HALF + m * 16) * 256 + c0;
#pragma unroll
          for (int bj = 0; bj < 2; ++bj) { f32x4 v0 = acc[ai][bj][m][0], v1 = acc[ai][bj][m][1]; const int c = bj * HALF + c0;
            if (isg) { if (c < 160) {
#pragma unroll
                for (int j = 0; j < 4; ++j) { v0[j] = sigmoidf_(v0[j]); v1[j] = sigmoidf_(v1[j]); } } else { v0 = (f32x4){0.f, 0.f, 0.f, 0.f}; v1 = v0; } }
            else if (bj == 0) {
#pragma unroll
              for (int j = 0; j < 4; ++j) { v0[j] = 1.f - 2.f * __builtin_amdgcn_rcpf(1.f + __expf(2.f * v0[j])); v1[j] = 1.f - 2.f * __builtin_amdgcn_rcpf(1.f + __expf(2.f * v1[j])); } }
            *(u32x4*)(rp + bj * HALF) = pack8(v0, v1); } }
    }
  }
};
struct EpiMulPre {
  static constexpr bool PERM = true; bf16_t* P;
  __device__ __forceinline__ void operator()(const Acc& acc, const Unit& u, int wr, int wc, int fr, int fq) const {
    const int row0 = u.pm * BM + wr * 64 + fr, col0 = u.pn * BM + wc * 32 + 8 * fq;
#pragma unroll
    for (int ai = 0; ai < 2; ++ai)
#pragma unroll
      for (int m = 0; m < 4; ++m) { bf16_t* rp = P + (size_t)(row0 + ai * HALF + m * 16) * 1024 + col0;
#pragma unroll
        for (int bj = 0; bj < 2; ++bj) { u32x4* q = (u32x4*)(rp + bj * HALF); const u32x4 pv = *q; f32x4 a = acc[ai][bj][m][0], b = acc[ai][bj][m][1];
          a[0] *= bflo(pv[0]); a[1] *= bfhi(pv[0]); a[2] *= bflo(pv[1]); a[3] *= bfhi(pv[1]); b[0] *= bflo(pv[2]); b[1] *= bfhi(pv[2]); b[2] *= bflo(pv[3]); b[3] *= bfhi(pv[3]);
          *q = pack8(a, b); } __builtin_amdgcn_sched_barrier(0); }
  }
};
struct EpiMoeDown {
  static constexpr bool PERM = false; float* X; const int* rowl; const float* rowg; int row_base;
  __device__ __forceinline__ void operator()(const Acc& acc, const Unit& u, int wr, int wc, int fr, int fq) const {
    const int row0 = row_base + u.pm * BM + wr * 64 + fr, col0 = (u.pn & 3) * BM + wc * 32 + 4 * fq;
#pragma unroll
    for (int ai = 0; ai < 2; ++ai)
#pragma unroll
      for (int m = 0; m < 4; ++m) { const int lr = row0 + ai * HALF + m * 16; const int tok = rowl[lr];
        if (tok >= 0) { const float gt = rowg[lr]; float* rp = X + (size_t)tok * 1024 + col0;
#pragma unroll
          for (int bj = 0; bj < 2; ++bj)
#pragma unroll
            for (int n = 0; n < 2; ++n) { f32x4* q = (f32x4*)(rp + bj * HALF + n * 16); *q = *q + acc[ai][bj][m][n] * gt; } } __builtin_amdgcn_sched_barrier(0); }
  }
};
struct MoeDownOrder {
  int first, ntile, G, c; const LAS int* ts;
  __device__ bool next(int i, Unit& u) const {
    const long L = (long)i * G + c; if (L >= (long)ntile * 4) return false;
    const int l = (int)L, pm = l >> 2, pn = l & 3; int g = 0;
#pragma unroll
    for (int k = 1; k < 16; ++k) g += ((first + pm) >= ts[k]) ? 1 : 0;
    u.pm = pm; u.pn = (g & 7) * 4 + pn; return true;
  }
};

__device__ __forceinline__ void ln_row(const float* y, const float* g, const float* b, int lane, f32x4 (&o)[4]) {
  f32x4 v[4]; float s = 0.f;
#pragma unroll
  for (int k = 0; k < 4; ++k) { v[k] = *(const f32x4*)(y + k * 256 + lane * 4); s += v[k][0] + v[k][1] + v[k][2] + v[k][3]; }
  const float mean = wave_sum(s) * (1.f / 1024.f); float q = 0.f;
#pragma unroll
  for (int k = 0; k < 4; ++k) { v[k] = v[k] - mean; q += v[k][0] * v[k][0] + v[k][1] * v[k][1] + v[k][2] * v[k][2] + v[k][3] * v[k][3]; }
  const float rstd = rsqrtf(wave_sum(q) * (1.f / 1024.f) + 1e-5f);
#pragma unroll
  for (int k = 0; k < 4; ++k) { const f32x4 gg = *(const f32x4*)(g + k * 256 + lane * 4), bb = *(const f32x4*)(b + k * 256 + lane * 4); o[k] = v[k] * rstd * gg + bb; }
}

__device__ __forceinline__ void ln_row2(const float* y0, const float* y1, const float* g, const float* b, int lane, f32x4 (&o0)[4], f32x4 (&o1)[4]) {
  f32x4 v[4], u[4]; float s0 = 0.f, s1 = 0.f;
#pragma unroll
  for (int k = 0; k < 4; ++k) { v[k] = *(const f32x4*)(y0 + k * 256 + lane * 4); u[k] = *(const f32x4*)(y1 + k * 256 + lane * 4); }
#pragma unroll
  for (int k = 0; k < 4; ++k) { s0 += v[k][0] + v[k][1] + v[k][2] + v[k][3]; s1 += u[k][0] + u[k][1] + u[k][2] + u[k][3]; }
  const float m0 = wave_sum(s0) * (1.f / 1024.f), m1 = wave_sum(s1) * (1.f / 1024.f); float q0 = 0.f, q1 = 0.f;
#pragma unroll
  for (int k = 0; k < 4; ++k) { v[k] = v[k] - m0; u[k] = u[k] - m1; q0 += v[k][0] * v[k][0] + v[k][1] * v[k][1] + v[k][2] * v[k][2] + v[k][3] * v[k][3]; q1 += u[k][0] * u[k][0] + u[k][1] * u[k][1] + u[k][2] * u[k][2] + u[k][3] * u[k][3]; }
  const float r0 = rsqrtf(wave_sum(q0) * (1.f / 1024.f) + 1e-5f), r1 = rsqrtf(wave_sum(q1) * (1.f / 1024.f) + 1e-5f);
#pragma unroll
  for (int k = 0; k < 4; ++k) { const f32x4 gg = *(const f32x4*)(g + k * 256 + lane * 4), bb = *(const f32x4*)(b + k * 256 + lane * 4); o0[k] = v[k] * r0 * gg + bb; o1[k] = u[k] * r1 * gg + bb; }
}

__device__ __forceinline__ void attn_phase(const bf16_t* __restrict__ QK, const bf16_t* __restrict__ VT, const float* __restrict__ EB, bf16_t* __restrict__ O) {
  const int tid = tid_(), lane = tid & 63, qi = lane & 15, g = lane >> 4;
  const int nw = gridDim.x * 8, w0 = blockIdx.x * 8 + (tid >> 6);
  const int krho = ((qi >> 2) * 8) + (qi & 3);
  int cur_combo = -1; f32x4 bias[8][2];
  for (int u = w0; u < 768 * 4 * 32; u += nw) {
    const int combo = u & 127, h = u & 31, c = (u >> 5) & 3, R = u >> 7;
    const float* eb = EB + (size_t)combo * (15 * 512) + lane * 8;
    if (combo != cur_combo) { cur_combo = combo;
#pragma unroll
      for (int i = 0; i < 8; ++i) { bias[i][0] = *(const f32x4*)(eb + (3 + i) * 512); bias[i][1] = *(const f32x4*)(eb + (3 + i) * 512 + 4); } }
    int seq_row0, rows; if (R < 256) { seq_row0 = R & ~127; rows = 128; } else { seq_row0 = 256 + ((R - 256) & ~63); rows = 64; }
    const int r = R - seq_row0; int rs = r - 4; rs = rs < 0 ? 0 : rs; rs = rs > rows - 8 ? rows - 8 : rs;
    const int blk = (c == 0) ? 0 : (c == 1) ? 8 : (c == 2) ? 24 : 32;
    const int qcol = 16 * c + qi;
    const bf16x8 qf = *(const bf16x8*)(QK + ((size_t)(R * 32 + h) * 64 + qcol) * 32 + g * 8);
    f32x4 s[8][2];
    const bf16_t* kbase = QK + (size_t)T * 1024 + ((size_t)((seq_row0 + rs) * 32 + h) * 64 + blk + krho) * 32 + g * 8;
#pragma unroll
    for (int i = 0; i < 8; ++i)
#pragma unroll
      for (int hh = 0; hh < 2; ++hh) {
        const bf16x8 kf = *(const bf16x8*)(kbase + (size_t)i * 65536 + hh * 128);
        s[i][hh] = __builtin_amdgcn_mfma_f32_16x16x32_bf16(kf, qf, (f32x4){0.f, 0.f, 0.f, 0.f}, 0, 0, 0);
      }
    if (rs - r == -4) {
#pragma unroll
      for (int i = 0; i < 8; ++i) { s[i][0] = s[i][0] + bias[i][0]; s[i][1] = s[i][1] + bias[i][1]; }
    } else {
      const float* ebr = eb + (rs - r + 7) * 512;
#pragma unroll
      for (int i = 0; i < 8; ++i) { s[i][0] = s[i][0] + *(const f32x4*)(ebr + i * 512); s[i][1] = s[i][1] + *(const f32x4*)(ebr + i * 512 + 4); }
    }
    float mx = -3.0e38f;
#pragma unroll
    for (int i = 0; i < 8; ++i)
#pragma unroll
      for (int hh = 0; hh < 2; ++hh) mx = fmaxf(fmaxf(mx, fmaxf(s[i][hh][0], s[i][hh][1])), fmaxf(s[i][hh][2], s[i][hh][3]));
    mx = fmaxf(mx, __shfl_xor(mx, 16)); mx = fmaxf(mx, __shfl_xor(mx, 32));
    float sum = 0.f;
#pragma unroll
    for (int i = 0; i < 8; ++i)
#pragma unroll
      for (int hh = 0; hh < 2; ++hh)
#pragma unroll
        for (int j = 0; j < 4; ++j) { const float e = __expf(s[i][hh][j] - mx); s[i][hh][j] = e; sum += e; }
    sum += __shfl_xor(sum, 16); sum += __shfl_xor(sum, 32);
    f32x4 o0 = {0.f, 0.f, 0.f, 0.f}, o1 = {0.f, 0.f, 0.f, 0.f};
#pragma unroll
    for (int i = 0; i < 8; ++i) {
      const u32x4 pu = pack8(s[i][0], s[i][1]); const bf16x8 pf = __builtin_bit_cast(bf16x8, pu);
      const bf16_t* vb = VT + (size_t)(seq_row0 + rs + i) * 65536 + (size_t)((h * 8 + (blk >> 3) + g) * 32 + qi) * 8;
      const bf16x8 v0 = *(const bf16x8*)vb, v1 = *(const bf16x8*)(vb + 16 * 8);
      o0 = __builtin_amdgcn_mfma_f32_16x16x32_bf16(v0, pf, o0, 0, 0, 0);
      o1 = __builtin_amdgcn_mfma_f32_16x16x32_bf16(v1, pf, o1, 0, 0, 0);
    }
    const float inv = 1.f / sum;
    bf16_t* op = O + (size_t)(R * 64 + qcol) * 1024 + h * 32 + g * 4;
    u32x2 a, b; a[0] = cvt_pk_bf16(o0[0] * inv, o0[1] * inv); a[1] = cvt_pk_bf16(o0[2] * inv, o0[3] * inv); b[0] = cvt_pk_bf16(o1[0] * inv, o1[1] * inv); b[1] = cvt_pk_bf16(o1[2] * inv, o1[3] * inv);
    *(u32x2*)op = a; *(u32x2*)(op + 16) = b;
  }
}

constexpr int SC_WD = 0, SC_AA = 2048, SC_KD = 4096, SC_BB = 6144, SC_NA = 8192, SC_RR = 10240, SC_VV = 12288, SC_YO = 14336;
typedef float f32x2 __attribute__((ext_vector_type(2)));
#define LO2(v) __builtin_shufflevector(v, v, 0, 1)
#define HI2(v) __builtin_shufflevector(v, v, 2, 3)
template <int NR, int z> __device__ __forceinline__ void scan_steps(LAS float* L, const LAS float* GT, int vrow, int ko, f32x2 (&St)[2][4]) {
  constexpr int sstep = z ? -64 : 64; const LAS float* bp = L + ko * 8 + (z ? 31 * 64 : 0);
  const LAS float* vp = L + SC_VV + vrow + (z ? 31 * 64 : 0); LAS float* yp = L + SC_YO + vrow + (z ? 31 * 64 : 0);
  f32x4 c[8]; float cv[NR];
  c[0] = *(const LAS f32x4*)(bp + SC_NA); c[1] = *(const LAS f32x4*)(bp + SC_NA + 4); c[2] = *(const LAS f32x4*)(bp + SC_BB); c[3] = *(const LAS f32x4*)(bp + SC_BB + 4);
  c[4] = *(const LAS f32x4*)(bp + SC_KD); c[5] = *(const LAS f32x4*)(bp + SC_KD + 4); c[6] = *(const LAS f32x4*)(bp + SC_RR); c[7] = *(const LAS f32x4*)(bp + SC_RR + 4);
#pragma unroll
  for (int r = 0; r < NR; ++r) cv[r] = vp[r];
#pragma unroll 8
  for (int si = 0; si < 32; ++si) {
    f32x4 n[8]; float nv[NR];
    const LAS float* bn = bp + ((si < 31) ? sstep : 0); const LAS float* vn = vp + ((si < 31) ? sstep : 0);
    n[0] = *(const LAS f32x4*)(bn + SC_NA); n[1] = *(const LAS f32x4*)(bn + SC_NA + 4); n[2] = *(const LAS f32x4*)(bn + SC_BB); n[3] = *(const LAS f32x4*)(bn + SC_BB + 4);
    n[4] = *(const LAS f32x4*)(bn + SC_KD); n[5] = *(const LAS f32x4*)(bn + SC_KD + 4); n[6] = *(const LAS f32x4*)(bn + SC_RR); n[7] = *(const LAS f32x4*)(bn + SC_RR + 4);
#pragma unroll
    for (int r = 0; r < NR; ++r) nv[r] = vn[r];
    float sa[NR], yy[NR];
#pragma unroll
    for (int r = 0; r < NR; ++r) { f32x2 p1 = St[r][0] * LO2(c[0]); p1 = St[r][1] * HI2(c[0]) + p1; p1 = St[r][2] * LO2(c[1]) + p1; p1 = St[r][3] * HI2(c[1]) + p1; sa[r] = p1[0] + p1[1]; }
#pragma unroll
    for (int r = 0; r < NR; ++r) sa[r] = red8(sa[r]);
#pragma unroll
    for (int r = 0; r < NR; ++r) { const f32x2 s2 = {sa[r], sa[r]}, v2 = {cv[r], cv[r]};
      St[r][0] = s2 * LO2(c[2]) + (v2 * LO2(c[4]) + St[r][0]); St[r][1] = s2 * HI2(c[2]) + (v2 * HI2(c[4]) + St[r][1]);
      St[r][2] = s2 * LO2(c[3]) + (v2 * LO2(c[5]) + St[r][2]); St[r][3] = s2 * HI2(c[3]) + (v2 * HI2(c[5]) + St[r][3]); }
#pragma unroll
    for (int r = 0; r < NR; ++r) { f32x2 q1 = St[r][0] * LO2(c[6]); q1 = St[r][1] * HI2(c[6]) + q1; q1 = St[r][2] * LO2(c[7]) + q1; q1 = St[r][3] * HI2(c[7]) + q1; yy[r] = q1[0] + q1[1]; }
#pragma unroll
    for (int r = 0; r < NR; ++r) yy[r] = red8(yy[r]);
#pragma unroll
    for (int r = 0; r < NR; ++r) yp[r] = yy[r];
#pragma unroll
    for (int j = 0; j < 8; ++j) c[j] = n[j];
#pragma unroll
    for (int r = 0; r < NR; ++r) cv[r] = nv[r];
    bp = bn; vp = vn; yp += sstep;
  }
  { const f32x4 t0 = *(const LAS f32x4*)(GT + ko * 8), t1 = *(const LAS f32x4*)(GT + ko * 8 + 4);
#pragma unroll
    for (int r = 0; r < NR; ++r) { St[r][0] = St[r][0] * LO2(t0); St[r][1] = St[r][1] * HI2(t0); St[r][2] = St[r][2] * LO2(t1); St[r][3] = St[r][3] * HI2(t1); } }
}
__device__ __forceinline__ int chain_chunks(int chain) { return chain < 0 ? 0 : (chain < 64 ? 256 : 128); }
__device__ __forceinline__ void scan_block(unsigned char* ws, LAS float* Lall, int chainA, int modeA, int rbA, int chainB, int modeB, int rbB) {
  const int tid = tid_(), wid = tid >> 6, lane = tid & 63, grp = wid >> 2, gw4 = wid & 3, gtid = tid & 255;
  const int chain = grp ? chainB : chainA, mode = grp ? modeB : modeA, rowbase = grp ? rbB : rbA;
  LAS float* L = Lall + grp * 16384;
  LAS float* GTB = (LAS float*)((LAS unsigned char*)Lall + 131072 + 512);
  const bool helper = (mode == 2), helped = (grp == 0) && (modeB == 2);
  const int nA = chain_chunks(chainA), nB = chain_chunks(chainB), nloop = nA > nB ? nA : nB;
  const int cc = chain < 0 ? 0 : chain;
  int h, z, Lq; size_t tok0;
  if (cc < 64) { h = (cc & 31) >> 1; z = cc & 1; Lq = 8192; tok0 = (size_t)(cc >> 5) * 8192; }
  else { const int c2 = cc - 64; h = (c2 & 31) >> 1; z = c2 & 1; Lq = 4096; tok0 = 16384 + (size_t)(c2 >> 5) * 4096; }
  const int nchunk = chain < 0 ? 0 : Lq / 32;
  const bf16_t* RKV = (const bf16_t*)(ws + OFF_RKV); const bf16_t* LBWA = (const bf16_t*)(ws + OFF_LBWA); const bf16_t* W2T = (const bf16_t*)(ws + OFF_W2T);
  bf16_t* Y = (bf16_t*)(ws + (z ? OFF_YB : OFF_YF)); float* bonus = (float*)(ws + OFF_BONUS);
  const int tk = gtid >> 3, c8 = (gtid & 7) * 8, ch0 = h * 64 + c8;
  const int ko = lane & 7, vl = lane >> 3, vrow = mode ? rowbase + gw4 * 8 + vl : gw4 * 16 + vl * 2;
  const int mat = gw4 >> 1, ntile = gw4 & 1;
  const f32x4 kk0 = *(const f32x4*)(INP(18) + ch0), kk1 = *(const f32x4*)(INP(18) + ch0 + 4), ka0 = *(const f32x4*)(INP(19) + ch0), ka1 = *(const f32x4*)(INP(19) + ch0 + 4);
  const f32x4 rk0 = *(const f32x4*)(INP(20) + ch0), rk1 = *(const f32x4*)(INP(20) + ch0 + 4);
  bf16x8 bfrag[4]; const int chb = h * 64 + ntile * 32 + (lane & 31);
#pragma unroll
  for (int ks = 0; ks < 4; ++ks) bfrag[ks] = *(const bf16x8*)(W2T + ((size_t)(mat * 2 + z) * 1024 + chb) * 64 + ks * 16 + (lane >> 5) * 8);
  const float bias0 = (mat ? INP(13) : INP(10))[z * 1024 + chb];
  u32x4 rawr, rawk, rawv; bf16x8 afrag[4];
  { const size_t tb = tok0 + (size_t)(z ? (nchunk > 0 ? nchunk - 1 : 0) : 0) * 32; const bf16_t* rp = RKV + (tb + tk) * 3072 + ch0;
    rawr = *(const u32x4*)rp; rawk = *(const u32x4*)(rp + 1024); rawv = *(const u32x4*)(rp + 2048);
#pragma unroll
    for (int ks = 0; ks < 4; ++ks) afrag[ks] = *(const bf16x8*)(LBWA + (tb + (lane & 31)) * 256 + mat * 128 + z * 64 + ks * 16 + (lane >> 5) * 8); }
  f32x2 St[2][4];
#pragma unroll
  for (int r = 0; r < 2; ++r)
#pragma unroll
    for (int j = 0; j < 4; ++j) St[r][j] = (f32x2){0.f, 0.f};
#define LORA_TILE(BASE, GTP) do { f32x16 acc; \
      _Pragma("unroll") for (int j = 0; j < 16; ++j) acc[j] = 0.f; \
      _Pragma("unroll") for (int ks = 0; ks < 4; ++ks) acc = __builtin_amdgcn_mfma_f32_32x32x16_bf16(afrag[ks], bfrag[ks], acc, 0, 0, 0); \
      const int half_ = lane >> 5; \
      if (mat) { LAS float* dst = (BASE) + SC_AA + ntile * 32 + (lane & 31); \
        _Pragma("unroll") for (int rg = 0; rg < 16; ++rg) { const int row = (rg & 3) + 8 * (rg >> 2) + 4 * half_; dst[row * 64] = sigmoidf_(acc[rg] + bias0); } } \
      else { float w_[16], G_[4], O_[4], E_[4];   \
        _Pragma("unroll") for (int rg = 0; rg < 16; ++rg) w_[rg] = __expf(-0.60653065971263342f * sigmoidf_(acc[rg] + bias0)); \
        if (!z) { _Pragma("unroll") for (int m = 0; m < 4; ++m) { w_[4 * m + 1] *= w_[4 * m]; w_[4 * m + 2] *= w_[4 * m + 1]; w_[4 * m + 3] *= w_[4 * m + 2]; G_[m] = w_[4 * m + 3]; } } \
        else    { _Pragma("unroll") for (int m = 0; m < 4; ++m) { w_[4 * m + 2] *= w_[4 * m + 3]; w_[4 * m + 1] *= w_[4 * m + 2]; w_[4 * m] *= w_[4 * m + 1]; G_[m] = w_[4 * m]; } } \
        _Pragma("unroll") for (int m = 0; m < 4; ++m) O_[m] = __shfl_xor(G_[m], 32); \
        float R_ = 1.f; \
        if (!z) { _Pragma("unroll") for (int m = 0; m < 4; ++m) { E_[m] = half_ ? R_ * O_[m] : R_; R_ *= G_[m] * O_[m]; } } \
        else    { _Pragma("unroll") for (int m = 3; m >= 0; --m) { E_[m] = half_ ? R_ : R_ * O_[m]; R_ *= G_[m] * O_[m]; } } \
        LAS float* dst = (BASE) + SC_WD + ntile * 32 + (lane & 31); \
        _Pragma("unroll") for (int rg = 0; rg < 16; ++rg) { const int row = (rg & 3) + 8 * (rg >> 2) + 4 * half_; dst[row * 64] = w_[rg] * E_[rg >> 2]; } \
        if (half_ == 0) (GTP)[ntile * 32 + (lane & 31)] = R_; } } while (0)
  if (helper && nchunk > 0) { LORA_TILE(Lall, GTB); }
  for (int ci = 0; ci < nloop; ++ci) {
    const bool act = ci < nchunk; const int wdo = helped ? ((ci & 1) ? 16384 : 0) : 0;
    const size_t tb = tok0 + (size_t)(act ? (z ? nchunk - 1 - ci : ci) : 0) * 32;
    LAS float* GT = GTB + (grp * 2 + (helped ? (ci & 1) : 0)) * 64;
    if (act && !helped && !helper) { LORA_TILE(L, GT); }
    __syncthreads();
    if (act && !helper) {
      float r8[8], k8[8], kx[8]; float ss = 0.f;
#pragma unroll
      for (int j = 0; j < 4; ++j) { r8[2 * j] = bflo(rawr[j]); r8[2 * j + 1] = bfhi(rawr[j]); k8[2 * j] = bflo(rawk[j]); k8[2 * j + 1] = bfhi(rawk[j]); }
#pragma unroll
      for (int j = 0; j < 8; ++j) { kx[j] = k8[j] * (j < 4 ? kk0[j & 3] : kk1[j & 3]); ss += kx[j] * kx[j]; }
      ss = red8(ss); const float inv = __builtin_amdgcn_rsqf(fmaxf(ss, 1e-24f));
      const f32x4 a0 = *(const LAS f32x4*)(L + wdo + SC_AA + tk * 64 + c8), a1 = *(const LAS f32x4*)(L + wdo + SC_AA + tk * 64 + c8 + 4);
      f32x4 kd[2], bb[2], na[2], rr[2], vv[2]; float bon = 0.f;
#pragma unroll
      for (int j = 0; j < 8; ++j) { const float a = (j < 4 ? a0[j & 3] : a1[j & 3]), kav = (j < 4 ? ka0[j & 3] : ka1[j & 3]), rkv = (j < 4 ? rk0[j & 3] : rk1[j & 3]);
        const float kn = kx[j] * inv, kdv = k8[j] * (1.f + (a - 1.f) * kav); kd[j >> 2][j & 3] = kdv; bb[j >> 2][j & 3] = kn * a; na[j >> 2][j & 3] = -kn; rr[j >> 2][j & 3] = r8[j]; bon += r8[j] * kdv * rkv; }
#pragma unroll
      for (int j = 0; j < 4; ++j) { vv[j >> 1][(j & 1) * 2] = bflo(rawv[j]); vv[j >> 1][(j & 1) * 2 + 1] = bfhi(rawv[j]); }
      { const LAS float* gp = L + wdo + SC_WD + c8; const int tkp = z ? tk + 1 : tk - 1; const bool hv = (tkp >= 0) && (tkp < 32); const int tkc = hv ? tkp : tk;
        const f32x4 g0 = *(const LAS f32x4*)(gp + tk * 64), g1 = *(const LAS f32x4*)(gp + tk * 64 + 4);
        f32x4 p0 = *(const LAS f32x4*)(gp + tkc * 64), p1 = *(const LAS f32x4*)(gp + tkc * 64 + 4);
        if (!hv) { p0 = (f32x4){1.f, 1.f, 1.f, 1.f}; p1 = p0; }
        f32x4 i0, i1;
#pragma unroll
        for (int j = 0; j < 4; ++j) { i0[j] = __builtin_amdgcn_rcpf(g0[j]); i1[j] = __builtin_amdgcn_rcpf(g1[j]); }
        kd[0] = kd[0] * i0; kd[1] = kd[1] * i1; bb[0] = bb[0] * i0; bb[1] = bb[1] * i1; na[0] = na[0] * p0; na[1] = na[1] * p1; rr[0] = rr[0] * g0; rr[1] = rr[1] * g1; }
      LAS float* lp = L + tk * 64 + c8;
      *(LAS f32x4*)(lp + SC_KD) = kd[0]; *(LAS f32x4*)(lp + SC_KD + 4) = kd[1]; *(LAS f32x4*)(lp + SC_BB) = bb[0]; *(LAS f32x4*)(lp + SC_BB + 4) = bb[1];
      *(LAS f32x4*)(lp + SC_NA) = na[0]; *(LAS f32x4*)(lp + SC_NA + 4) = na[1]; *(LAS f32x4*)(lp + SC_RR) = rr[0]; *(LAS f32x4*)(lp + SC_RR + 4) = rr[1];
      *(LAS f32x4*)(lp + SC_VV) = vv[0]; *(LAS f32x4*)(lp + SC_VV + 4) = vv[1];
      bon = red8(bon); if ((gtid & 7) == 0 && rowbase == 0) bonus[((tb + tk) * 16 + h) * 2 + z] = bon;
    }
    __syncthreads();
    if (act && ci + 1 < nchunk) { const size_t tn = tok0 + (size_t)(z ? nchunk - 2 - ci : ci + 1) * 32; const bf16_t* rp = RKV + (tn + tk) * 3072 + ch0;
      if (!helper) { rawr = *(const u32x4*)rp; rawk = *(const u32x4*)(rp + 1024); rawv = *(const u32x4*)(rp + 2048); }
#pragma unroll
      for (int ks = 0; ks < 4; ++ks) afrag[ks] = *(const bf16x8*)(LBWA + (tn + (lane & 31)) * 256 + mat * 128 + z * 64 + ks * 16 + (lane >> 5) * 8);
      if (helper) { LORA_TILE(Lall + (((ci + 1) & 1) ? 16384 : 0), GTB + ((ci + 1) & 1) * 64); } }
    if (act && !helper) { if (mode) { if (z) scan_steps<1, 1>(L, GT, vrow, ko, St); else scan_steps<1, 0>(L, GT, vrow, ko, St); } else { if (z) scan_steps<2, 1>(L, GT, vrow, ko, St); else scan_steps<2, 0>(L, GT, vrow, ko, St); } }
    __syncthreads();
    if (act && !helper) {
      if (mode) { const int c4 = rowbase + (gtid & 7) * 4; const f32x4 yv = *(const LAS f32x4*)(L + SC_YO + tk * 64 + c4); u32x2 o; o[0] = cvt_pk_bf16(yv[0], yv[1]); o[1] = cvt_pk_bf16(yv[2], yv[3]);
        *(u32x2*)(Y + (tb + tk) * 1024 + h * 64 + c4) = o; }
      else { const f32x4 y0 = *(const LAS f32x4*)(L + SC_YO + tk * 64 + c8), y1 = *(const LAS f32x4*)(L + SC_YO + tk * 64 + c8 + 4);
        *(u32x4*)(Y + (tb + tk) * 1024 + ch0) = pack8(y0, y1); }
    }
  }
  __syncthreads();
#undef LORA_TILE
}

__global__ void __launch_bounds__(512, 2) mega(Params p) {
  cg::grid_group grid = cg::this_grid();
  LAS unsigned char* lds = (LAS unsigned char*)shm;
  LAS int* TS = (LAS int*)(lds + LDS_TS);
  unsigned char* ws = p.ws;
  { const unsigned* ka = (const unsigned*)__builtin_amdgcn_kernarg_segment_ptr(); if (threadIdx.x < 66) ((LAS unsigned*)(lds + LDS_TAB))[threadIdx.x] = ka[threadIdx.x]; }
  __syncthreads();
  const int G = gridDim.x, nw = G * 8;
  const long ngt = (long)G * 512;
#define PH_VARS const int tid = tid_(), lane = tid & 63, wid = tid >> 6, gw = blockIdx.x * 8 + wid; const long gt = (long)blockIdx.x * 512 + tid; (void)lane; (void)gw; (void)gt;
  float* X = p.X;

  { PH_VARS
  {
    int rot = 0; float* tile = (float*)shm;
    const float* wqkv = INP(2);
    rot = cvt_run(mkjob(wqkv, 3072, 1024, 1024, (bf16_t*)(ws + OFF_WQKT), 1024, 0, 0, nullptr, 0.17677669529663687f, 0), tile, rot);
    rot = cvt_run(mkjob(wqkv + 1024, 3072, 1024, 1024, (bf16_t*)(ws + OFF_WQKT), 1024, 1024, 0, nullptr, 1.f, 0), tile, rot);
    rot = cvt_run(mkjob(wqkv + 2048, 3072, 1024, 1024, (bf16_t*)(ws + OFF_WVT), 1024, 0, 0, nullptr, 1.f, 0), tile, rot);
    rot = cvt_run(mkjob(INP(4), 1024, 1024, 1024, (bf16_t*)(ws + OFF_WOT), 1024, 0, 0, nullptr, 1.f, 0), tile, rot);
    rot = cvt_run(mkjob(INP(5), 2816, 1024, 2816, (bf16_t*)(ws + OFF_WGUT), 1024, 0, 0, nullptr, 1.f, 1), tile, rot);
    rot = cvt_run(mkjob(INP(6), 2816, 1024, 2816, (bf16_t*)(ws + OFF_WGUT), 1024, 128, 0, nullptr, 1.f, 1), tile, rot);
    rot = cvt_run(mkjob(INP(7), 1024, 2816, 1024, (bf16_t*)(ws + OFF_WDT), 2816, 0, 0, nullptr, 1.f, 0), tile, rot);
    bf16_t* wrt = (bf16_t*)(ws + OFF_WRT); const float* mu = INP(8);
    for (int half = 0; half < 2; ++half) {
      const int c0 = half * 1024;
      rot = cvt_run(mkjob(INP(9), 1024, 1024, 1024, wrt, 2048, 0, c0, half ? mu + 0 * 1024 : nullptr, 1.f, 0), tile, rot);
      rot = cvt_run(mkjob(INP(9) + 1048576, 1024, 1024, 1024, wrt, 2048, 1024, c0, half ? mu + 2 * 1024 : nullptr, 1.f, 0), tile, rot);
      rot = cvt_run(mkjob(INP(9) + 2097152, 1024, 1024, 1024, wrt, 2048, 2048, c0, half ? mu + 3 * 1024 : nullptr, 1.f, 0), tile, rot);
      rot = cvt_run(mkjob(INP(11), 64, 1024, 64, wrt, 2048, 3072, c0, half ? mu + 1 * 1024 : nullptr, 1.f, 0), tile, rot);
      rot = cvt_run(mkjob(INP(11) + 65536, 64, 1024, 64, wrt, 2048, 3136, c0, half ? mu + 1 * 1024 : nullptr, 1.f, 0), tile, rot);
      rot = cvt_run(mkjob(INP(14), 64, 1024, 64, wrt, 2048, 3200, c0, half ? mu + 4 * 1024 : nullptr, 1.f, 0), tile, rot);
      rot = cvt_run(mkjob(INP(14) + 65536, 64, 1024, 64, wrt, 2048, 3264, c0, half ? mu + 4 * 1024 : nullptr, 1.f, 0), tile, rot);
      rot = cvt_run(mkjob(INP(16), 160, 1024, 160, wrt, 2048, 3328, c0, half ? mu + 5 * 1024 : nullptr, 1.f, 0), tile, rot);
    }
    rot = cvt_run(mkjob(nullptr, 0, 2048, 96, wrt, 2048, 3488, 0, nullptr, 1.f, 0), tile, rot);
    bf16_t* w2t = (bf16_t*)(ws + OFF_W2T);
    rot = cvt_run(mkjob(INP(12), 1024, 64, 1024, w2t, 64, 0, 0, nullptr, 1.f, 0), tile, rot);
    rot = cvt_run(mkjob(INP(12) + 65536, 1024, 64, 1024, w2t, 64, 1024, 0, nullptr, 1.f, 0), tile, rot);
    rot = cvt_run(mkjob(INP(15), 1024, 64, 1024, w2t, 64, 2048, 0, nullptr, 1.f, 0), tile, rot);
    rot = cvt_run(mkjob(INP(15) + 65536, 1024, 64, 1024, w2t, 64, 3072, 0, nullptr, 1.f, 0), tile, rot);
    rot = cvt_run(mkjob(INP(17), 1024, 160, 1024, (bf16_t*)(ws + OFF_G2T), 256, 0, 0, nullptr, 1.f, 0), tile, rot);
    rot = cvt_run(mkjob(nullptr, 0, 96, 1024, (bf16_t*)(ws + OFF_G2T), 256, 0, 160, nullptr, 1.f, 0), tile, rot);
    rot = cvt_run(mkjob(INP(23), 1024, 1024, 1024, (bf16_t*)(ws + OFF_RWOT), 1024, 0, 0, nullptr, 1.f, 0), tile, rot);
    bf16_t* xb = (bf16_t*)(ws + OFF_XB);
    { const float* x0 = INP(0); const float* x1 = INP(1);
    for (long i0 = gt; i0 < (long)T * 256; i0 += 4 * ngt) { f32x4 v[4];
#pragma unroll
      for (int u = 0; u < 4; ++u) { const long i = i0 + u * ngt; if (i < (long)T * 256) v[u] = (i < 16384L * 256) ? *(const f32x4*)(x0 + i * 4) : *(const f32x4*)(x1 + (i - 16384L * 256) * 4); }
#pragma unroll
      for (int u = 0; u < 4; ++u) { const long i = i0 + u * ngt; if (i < (long)T * 256) { *(f32x4*)(X + i * 4) = v[u]; u32x2 o; o[0] = cvt_pk_bf16(v[u][0], v[u][1]); o[1] = cvt_pk_bf16(v[u][2], v[u][3]); *(u32x2*)(xb + i * 4) = o; } } } }
    { float* EBt = (float*)(ws + OFF_EB); const float* rpb = INP(3);
      for (long i = gt; i < 128L * 15 * 512; i += ngt) { const int e = (int)(i & 7), ln = (int)((i >> 3) & 63), dr = (int)((i >> 9) % 15), combo = (int)((i >> 9) / 15);
        const int h = combo & 31, c = combo >> 5, qi = ln & 15, g = ln >> 4; const int blk = (c == 0) ? 0 : (c == 1) ? 8 : (c == 2) ? 24 : 32;
        const int kcol = blk + g * 8 + e, qcol = 16 * c + qi; int qstart = qcol - 8; qstart = qstart < 0 ? 0 : qstart; qstart = qstart > 48 ? 48 : qstart;
        const bool valid = (kcol >= qstart) && (kcol < qstart + 16); int dc = kcol - qcol + 15; dc = dc < 0 ? 0 : dc; dc = dc > 30 ? 30 : dc;
        EBt[i] = valid ? rpb[(h * 15 + dr) * 31 + dc] : -3.0e38f; } }
    int* cnt = (int*)(ws + OFF_CNT); int* rowl = (int*)(ws + OFF_ROWL);
    if (gt < 16) cnt[gt] = 0;
    if (blockIdx.x == 0) for (int i = tid; i < XCD_BAR_WORDS; i += 512) ((unsigned*)(ws + OFF_BAR))[i] = 0u;
    if (tid < 2) ((LAS unsigned*)(lds + LDS_TS + 80))[tid] = 0u;
    for (long i = gt; i < 102400; i += ngt) rowl[i] = -1;
  }
  }
  grid.sync();
  __syncthreads();
  const XcdBarrier xb = xcd_barrier_post((unsigned*)(ws + OFF_BAR), (volatile LAS unsigned*)(lds + LDS_TS + 80));
  { PH_VARS
  { Gemm g{(const bf16_t*)(ws + OFF_XB), (const bf16_t*)(ws + OFF_WQKT), 1024}; StaticOrder S; S.init(T, 2048); EpiQK2 E{(bf16_t*)(ws + OFF_QK)}; gemm_phase(lds, g, S, E); }
  { Gemm g{(const bf16_t*)(ws + OFF_WVT), (const bf16_t*)(ws + OFF_XB), 1024}; StaticOrder S; S.init(1024, T); EpiVT E{(bf16_t*)(ws + OFF_VT)}; gemm_phase(lds, g, S, E); }
  }
  xcd_barrier(xb);
  { PH_VARS
  attn_phase((const bf16_t*)(ws + OFF_QK), (const bf16_t*)(ws + OFF_VT), (const float*)(ws + OFF_EB), (bf16_t*)(ws + OFF_O));
  }
  xcd_barrier(xb);
  { PH_VARS
  { Gemm g{(const bf16_t*)(ws + OFF_O), (const bf16_t*)(ws + OFF_WOT), 1024}; StaticOrder S; S.init(T, 1024); EpiResid E{X}; gemm_phase(lds, g, S, E); }
  }
  xcd_barrier(xb);
  { PH_VARS
  { bf16_t* xb = (bf16_t*)(ws + OFF_XB);
    for (int row = gw; row < T; row += 2 * nw) { const int rw1 = (row + nw < T) ? row + nw : row; f32x4 oo[2][4]; ln_row2(X + (size_t)row * 1024, X + (size_t)rw1 * 1024, INP(29), INP(30), lane, oo[0], oo[1]);
#pragma unroll
      for (int h = 0; h < 2; ++h) { const int rr = h ? rw1 : row;
#pragma unroll
        for (int k = 0; k < 4; ++k) { *(f32x4*)(X + (size_t)rr * 1024 + k * 256 + lane * 4) = oo[h][k]; u32x2 q; q[0] = cvt_pk_bf16(oo[h][k][0], oo[h][k][1]); q[1] = cvt_pk_bf16(oo[h][k][2], oo[h][k][3]); *(u32x2*)(xb + (size_t)rr * 1024 + k * 256 + lane * 4) = q; } } } }
  }
  xcd_barrier(xb);
  { PH_VARS
  { Gemm g{(const bf16_t*)(ws + OFF_XB), (const bf16_t*)(ws + OFF_WGUT), 1024}; StaticOrder S; S.init(T, 5632); EpiSwiglu E{(bf16_t*)(ws + OFF_H), 2816, 1 << 20, 0}; gemm_phase(lds, g, S, E); }
  }
  xcd_barrier(xb);
  { Gemm g{(const bf16_t*)(ws + OFF_H), (const bf16_t*)(ws + OFF_WDT), 2816}; StaticOrder S; S.init(T, 1024); EpiResid E{X}; gemm_phase(lds, g, S, E); }
  xcd_barrier(xb);
  { PH_VARS
  for (int row = gw; row < T; row += 2 * nw) { const int rw1 = (row + nw < T) ? row + nw : row; f32x4 oo[2][4]; ln_row2(X + (size_t)row * 1024, X + (size_t)rw1 * 1024, INP(31), INP(32), lane, oo[0], oo[1]);
#pragma unroll
    for (int h = 0; h < 2; ++h)
#pragma unroll
      for (int k = 0; k < 4; ++k) *(f32x4*)(X + (size_t)(h ? rw1 : row) * 1024 + k * 256 + lane * 4) = oo[h][k]; }
  }
  xcd_barrier(xb);
  { PH_VARS
  { bf16_t* xb2 = (bf16_t*)(ws + OFF_XB2);
    for (int row = gw; row < T; row += nw) {
      const int s0 = row < 16384 ? (row & ~8191) : 16384 + ((row - 16384) & ~4095), len = row < 16384 ? 8192 : 4096;
      const bool hm = row > s0, hp = row < s0 + len - 1;
#pragma unroll
      for (int k = 0; k < 4; ++k) { const size_t off = (size_t)row * 1024 + k * 256 + lane * 4; const f32x4 x = *(const f32x4*)(X + off);
        const f32x4 xm = hm ? *(const f32x4*)(X + off - 1024) : (f32x4){0.f, 0.f, 0.f, 0.f}, xp = hp ? *(const f32x4*)(X + off + 1024) : (f32x4){0.f, 0.f, 0.f, 0.f};
        const f32x4 xx = (xm + xp) * 0.5f - x; u32x2 a, b; a[0] = cvt_pk_bf16(x[0], x[1]); a[1] = cvt_pk_bf16(x[2], x[3]); b[0] = cvt_pk_bf16(xx[0], xx[1]); b[1] = cvt_pk_bf16(xx[2], xx[3]);
        bf16_t* dp = xb2 + (size_t)row * 2048 + k * 256 + lane * 4; *(u32x2*)dp = a; *(u32x2*)(dp + 1024) = b; } } }
  }
  xcd_barrier(xb);
  { PH_VARS
  { Gemm g{(const bf16_t*)(ws + OFF_XB2), (const bf16_t*)(ws + OFF_WRT), 2048}; StaticOrder S; S.init(T, 3584); EpiRwkv E{(bf16_t*)(ws + OFF_RKV), (bf16_t*)(ws + OFF_LBWA), (bf16_t*)(ws + OFF_LBG)}; gemm_phase(lds, g, S, E); }
  }
  xcd_barrier(xb);
  { PH_VARS
  { LAS float* L = (LAS float*)lds; const int b = blockIdx.x;
    for (int round = 0; round < 320; ++round) {
      int cA, mA = 0, rA = 0, cB = -1, mB = 0;
      if (G == 256) { if (round > 0) break; if (b < 128) { cA = b >> 1; mA = 1; rA = (b & 1) * 32; cB = cA; mB = 2; } else { cA = 64 + (b - 128) * 2; cB = cA + 1; } }
      else { cA = b + round * G; if (cA >= 320) break; }
      scan_block(ws, L, cA, mA, rA, cB, mB, 0);
    }
  }
  }
  xcd_barrier(xb);
  { PH_VARS
  { bf16_t* yf = (bf16_t*)(ws + OFF_YF); const bf16_t* yb = (const bf16_t*)(ws + OFF_YB); const bf16_t* rkv = (const bf16_t*)(ws + OFF_RKV); const float* bonus = (const float*)(ws + OFF_BONUS);
    for (int row = gw; row < T; row += nw) {
      const size_t off = (size_t)row * 1024 + lane * 16; const u32x4 a0 = *(const u32x4*)(yf + off), a1 = *(const u32x4*)(yf + off + 8), b0 = *(const u32x4*)(yb + off), b1 = *(const u32x4*)(yb + off + 8);
      const u32x4 v0 = *(const u32x4*)(rkv + (size_t)row * 3072 + 2048 + lane * 16), v1 = *(const u32x4*)(rkv + (size_t)row * 3072 + 2048 + lane * 16 + 8);
      float y[16], vv[16]; float s = 0.f;
#pragma unroll
      for (int j = 0; j < 4; ++j) { y[2 * j] = bflo(a0[j]) + bflo(b0[j]); y[2 * j + 1] = bfhi(a0[j]) + bfhi(b0[j]); y[8 + 2 * j] = bflo(a1[j]) + bflo(b1[j]); y[8 + 2 * j + 1] = bfhi(a1[j]) + bfhi(b1[j]);
        vv[2 * j] = bflo(v0[j]); vv[2 * j + 1] = bfhi(v0[j]); vv[8 + 2 * j] = bflo(v1[j]); vv[8 + 2 * j + 1] = bfhi(v1[j]); }
#pragma unroll
      for (int j = 0; j < 16; ++j) s += y[j];
      const float mean = red4(s) * (1.f / 64.f); float q = 0.f;
#pragma unroll
      for (int j = 0; j < 16; ++j) { y[j] -= mean; q += y[j] * y[j]; }
      const float rstd = rsqrtf(red4(q) * (1.f / 64.f) + 64e-5f);
      const float* bp = bonus + ((size_t)row * 16 + (lane >> 2)) * 2; const float bsum = bp[0] + bp[1];
      u32x4 o0, o1;
#pragma unroll
      for (int j = 0; j < 4; ++j) { const f32x4 gg = *(const f32x4*)(INP(21) + lane * 16 + j * 4), bb = *(const f32x4*)(INP(22) + lane * 16 + j * 4); float t[4];
#pragma unroll
        for (int e = 0; e < 4; ++e) t[e] = y[j * 4 + e] * rstd * gg[e] + bb[e] + bsum * vv[j * 4 + e];
        const unsigned lo = cvt_pk_bf16(t[0], t[1]), hi = cvt_pk_bf16(t[2], t[3]);
        if (j < 2) { o0[2 * j] = lo; o0[2 * j + 1] = hi; } else { o1[2 * (j - 2)] = lo; o1[2 * (j - 2) + 1] = hi; } }
      *(u32x4*)(yf + off) = o0; *(u32x4*)(yf + off + 8) = o1; } }
  }
  xcd_barrier(xb);
  { PH_VARS
  { Gemm g{(const bf16_t*)(ws + OFF_LBG), (const bf16_t*)(ws + OFF_G2T), 256}; StaticOrder S; S.init(T, 1024); EpiMulPre E{(bf16_t*)(ws + OFF_YF)}; gemm_phase(lds, g, S, E); }
  }
  xcd_barrier(xb);
  { PH_VARS
  { Gemm g{(const bf16_t*)(ws + OFF_YF), (const bf16_t*)(ws + OFF_RWOT), 1024}; StaticOrder S; S.init(T, 1024); EpiResid E{X}; gemm_phase(lds, g, S, E); }
  }
  xcd_barrier(xb);
  { PH_VARS
  { bf16_t* xb = (bf16_t*)(ws + OFF_XBM); int* cnt = (int*)(ws + OFF_CNT); int* tokE = (int*)(ws + OFF_TOKE); float* tokG = (float*)(ws + OFF_TOKG); int* tokP = (int*)(ws + OFF_TOKP);
    const float* wr = INP(24); const float* br = INP(25);
    LAS int* lc = (LAS int*)(lds + 100000);
    if (tid < 16) lc[tid] = 0;
    __syncthreads();
    for (int row = gw; row < T; row += nw) { f32x4 o[4]; ln_row(X + (size_t)row * 1024, INP(29) + 1024, INP(30) + 1024, lane, o);
      float lg[8];
#pragma unroll
      for (int e = 0; e < 8; ++e) lg[e] = 0.f;
#pragma unroll
      for (int k = 0; k < 4; ++k) {
#pragma unroll
        for (int j = 0; j < 4; ++j) { const float* wp = wr + (size_t)(k * 256 + lane * 4 + j) * 8; const f32x4 wa = *(const f32x4*)wp, wb = *(const f32x4*)(wp + 4); const float xv = o[k][j];
          lg[0] += xv * wa[0]; lg[1] += xv * wa[1]; lg[2] += xv * wa[2]; lg[3] += xv * wa[3]; lg[4] += xv * wb[0]; lg[5] += xv * wb[1]; lg[6] += xv * wb[2]; lg[7] += xv * wb[3]; }
        *(f32x4*)(X + (size_t)row * 1024 + k * 256 + lane * 4) = o[k] * ALPHA; u32x2 q; q[0] = cvt_pk_bf16(o[k][0], o[k][1]); q[1] = cvt_pk_bf16(o[k][2], o[k][3]); *(u32x2*)(xb + (size_t)row * 1024 + k * 256 + lane * 4) = q; }
#pragma unroll
      for (int e = 0; e < 8; ++e) lg[e] = wave_sum(lg[e]) + br[e];
      int e0 = 0; float v0 = lg[0];
#pragma unroll
      for (int e = 1; e < 8; ++e) if (lg[e] > v0) { v0 = lg[e]; e0 = e; }
      int e1 = -1; float v1 = -3.0e38f;
#pragma unroll
      for (int e = 0; e < 8; ++e) if (e != e0 && lg[e] > v1) { v1 = lg[e]; e1 = e; }
      if (lane == 0) { const float ex = __expf(v1 - v0), g0 = 1.f / (1.f + ex), g1 = ex * g0;
        const int p0 = __hip_atomic_fetch_add(lc + e0, 1, __ATOMIC_RELAXED, __HIP_MEMORY_SCOPE_WORKGROUP), p1 = __hip_atomic_fetch_add(lc + 8 + e1, 1, __ATOMIC_RELAXED, __HIP_MEMORY_SCOPE_WORKGROUP);
        tokE[row * 2] = e0; tokE[row * 2 + 1] = e1; tokG[row * 2] = g0; tokG[row * 2 + 1] = g1; tokP[row * 2] = p0; tokP[row * 2 + 1] = p1; } }
    __syncthreads();
    if (tid < 16) lc[16 + tid] = atomicAdd(cnt + tid, lc[tid]);
    __syncthreads();
    if (lane < 2) for (int row = gw; row < T; row += nw) tokP[row * 2 + lane] += lc[16 + lane * 8 + tokE[row * 2 + lane]];
    __syncthreads();
    int rot = 0; float* tile = (float*)shm;
    for (int e = 0; e < 8; ++e) {
      rot = cvt_run(mkjob(INP(26) + (size_t)e * 1024 * 3584, 3584, 1024, 3584, (bf16_t*)(ws + OFF_WMGU) + (size_t)e * 7168 * 1024, 1024, 0, 0, nullptr, 1.f, 1), tile, rot);
      rot = cvt_run(mkjob(INP(27) + (size_t)e * 1024 * 3584, 3584, 1024, 3584, (bf16_t*)(ws + OFF_WMGU) + (size_t)e * 7168 * 1024, 1024, 128, 0, nullptr, 1.f, 1), tile, rot);
      rot = cvt_run(mkjob(INP(28) + (size_t)e * 3584 * 1024, 1024, 3584, 1024, (bf16_t*)(ws + OFF_WMD) + (size_t)e * 1024 * 3584, 3584, 0, 0, nullptr, 1.f, 0), tile, rot);
    }
  }
  }
  xcd_barrier(xb);
  { PH_VARS
  { const int* cnt = (const int*)(ws + OFF_CNT);
    __syncthreads();
    if (tid == 0) { int a = 0; for (int k = 0; k < 16; ++k) { TS[k] = a; a += (cnt[k] + 255) >> 8; } TS[16] = a; }
    __syncthreads();
    const int* tokE = (const int*)(ws + OFF_TOKE); const float* tokG = (const float*)(ws + OFF_TOKG); const int* tokP = (const int*)(ws + OFF_TOKP);
    int* rowl = (int*)(ws + OFF_ROWL); float* rowg = (float*)(ws + OFF_ROWG); const bf16_t* xb = (const bf16_t*)(ws + OFF_XBM); bf16_t* xs = (bf16_t*)(ws + OFF_XS);
    for (int pr0 = gw; pr0 < T * 2; pr0 += 4 * nw) { u32x4 va[4], vb[4]; int rows[4];
#pragma unroll
      for (int u = 0; u < 4; ++u) { const int pr = pr0 + u * nw; rows[u] = -1; if (pr < T * 2) { const int tok = pr >> 1, rk = pr & 1; const int e = tokE[pr]; const int row = TS[rk * 8 + e] * 256 + tokP[pr]; rows[u] = row;
        if (lane == 0) { rowl[row] = tok; rowg[row] = tokG[pr]; }
        const u32x4* sp = (const u32x4*)(xb + (size_t)tok * 1024); va[u] = sp[lane]; vb[u] = sp[lane + 64]; } }
#pragma unroll
      for (int u = 0; u < 4; ++u) if (rows[u] >= 0) { u32x4* dp = (u32x4*)(xs + (size_t)rows[u] * 1024); dp[lane] = va[u]; dp[lane + 64] = vb[u]; } }
  }
  }
  xcd_barrier(xb);
  { PH_VARS
  { const int ts8 = TS[8], ts16 = TS[16]; const int b = blockIdx.x;
    int pcs = -1, pnt = 0, pbuf = 0, buf = 0;
    for (int rk = 0; rk < 2; ++rk) { const int t0 = rk ? ts16 * 0 + ts8 : 0, t1 = rk ? ts16 : ts8;
      for (int cs = t0; cs < t1; cs += MOE_CHUNK) { const int ntile = (t1 - cs) < MOE_CHUNK ? (t1 - cs) : MOE_CHUNK;
        int nd = 0;
        if (pcs >= 0) { nd = pnt * 4; nd = nd > G ? G : nd;
          Gemm g{(const bf16_t*)(ws + OFF_HID + (size_t)pbuf * HID_BUF), (const bf16_t*)(ws + OFF_WMD), 3584}; MoeDownOrder S{pcs, pnt, G, b, TS}; EpiMoeDown E{X, (const int*)(ws + OFF_ROWL), (const float*)(ws + OFF_ROWG), pcs * 256}; gemm_phase(lds, g, S, E); }
        { Gemm g{(const bf16_t*)(ws + OFF_XS), (const bf16_t*)(ws + OFF_WMGU), 1024}; MoeUpSkewOrder S{cs, ntile, nd, G, b, TS}; EpiSwiglu E{(bf16_t*)(ws + OFF_HID + (size_t)buf * HID_BUF), 3584, 28, cs * 256}; gemm_phase(lds, g, S, E); }
        xcd_barrier(xb);
        pcs = cs; pnt = ntile; pbuf = buf; buf ^= 1;
      } }
    if (pcs >= 0) { Gemm g{(const bf16_t*)(ws + OFF_HID + (size_t)pbuf * HID_BUF), (const bf16_t*)(ws + OFF_WMD), 3584}; MoeDownOrder S{pcs, pnt, G, b, TS}; EpiMoeDown E{X, (const int*)(ws + OFF_ROWL), (const float*)(ws + OFF_ROWG), pcs * 256}; gemm_phase(lds, g, S, E); }
    xcd_barrier(xb);
  }
  }
  { PH_VARS
  for (int row = gw; row < T; row += 2 * nw) { const int rw1 = (row + nw < T) ? row + nw : row; f32x4 oo[2][4]; ln_row2(X + (size_t)row * 1024, X + (size_t)rw1 * 1024, INP(31) + 1024, INP(32) + 1024, lane, oo[0], oo[1]);
#pragma unroll
    for (int h = 0; h < 2; ++h)
#pragma unroll
      for (int k = 0; k < 4; ++k) *(f32x4*)(X + (size_t)(h ? rw1 : row) * 1024 + k * 256 + lane * 4) = oo[h][k]; }
  }
}

extern "C" void kernel_launch(void* const* d_in, const int* in_sizes, int n_in, void* d_out, int out_size, void* d_ws, size_t ws_size, hipStream_t stream) {
  static int grid_blocks = 0;
  if (!grid_blocks) {
    int dev = 0, cus = 0, per_cu = 0;
    (void)hipGetDevice(&dev);
    (void)hipDeviceGetAttribute(&cus, hipDeviceAttributeMultiprocessorCount, dev);
    (void)hipFuncSetAttribute((const void*)mega, hipFuncAttributeMaxDynamicSharedMemorySize, LDS_BYTES);
    (void)hipOccupancyMaxActiveBlocksPerMultiprocessor(&per_cu, mega, 512, LDS_BYTES);
    if (per_cu > 1) per_cu = 1;
    grid_blocks = cus * per_cu;
    if (ws_size < WS_NEED) fprintf(stderr, "workspace too small: %zu < %zu\n", ws_size, (size_t)WS_NEED);
  }
  Params p{};
  for (int i = 0; i < 33; ++i) p.in[i] = (const float*)d_in[i];
  p.X = (float*)d_out; p.ws = (unsigned char*)d_ws;
  void* args[] = {&p};
  hipError_t e = hipLaunchCooperativeKernel((void*)mega, dim3(grid_blocks), dim3(512), args, LDS_BYTES, stream);
  if (e != hipSuccess) fprintf(stderr, "cooperative launch failed: %s (grid %d)\n", hipGetErrorString(e), grid_blocks);
}
```

```cpp
#include <hip/hip_runtime.h>
#include <hip/hip_cooperative_groups.h>
#include <cstdio>
namespace cg = cooperative_groups;

#define LAS __attribute__((address_space(3)))
typedef unsigned short bf16_t;
typedef short bf16x8 __attribute__((ext_vector_type(8)));
typedef float f32x4 __attribute__((ext_vector_type(4)));
typedef float f32x16 __attribute__((ext_vector_type(16)));
typedef unsigned u32x4 __attribute__((ext_vector_type(4)));
typedef unsigned u32x2 __attribute__((ext_vector_type(2)));

constexpr int T = 49152, D = 1024;
constexpr float ALPHA = 1.41421356237309515f;
constexpr size_t SZ = (size_t)T * 1024 * 2;
constexpr size_t OFF_WRT = 0;
constexpr size_t OFF_W2T = OFF_WRT + 14680064;
constexpr size_t OFF_G2T = OFF_W2T + 524288;
constexpr size_t OFF_RWOT = OFF_G2T + 524288;
constexpr size_t OFF_CNT = OFF_RWOT + 2097152;
constexpr size_t OFF_TOKE = OFF_CNT + 256;
constexpr size_t OFF_TOKG = OFF_TOKE + 393216;
constexpr size_t OFF_TOKP = OFF_TOKG + 393216;
constexpr size_t OFF_ROWL = OFF_TOKP + 393216;
constexpr size_t OFF_ROWG = OFF_ROWL + 409600;
constexpr size_t OFF_BONUS = OFF_ROWG + 409600;
constexpr size_t OFF_BAR = OFF_BONUS + 6291456;
constexpr size_t BIG = 26214400;
constexpr size_t OFF_XB = BIG, OFF_QK = BIG + SZ, OFF_VT = BIG + 3 * SZ, OFF_O = BIG + 4 * SZ;
constexpr size_t OFF_WQKT = BIG + 5 * SZ, OFF_WVT = OFF_WQKT + 4194304, OFF_WOT = OFF_WVT + 2097152, OFF_WGUT = OFF_WOT + 2097152, OFF_WDT = OFF_WGUT + 11534336;
constexpr size_t OFF_EB = OFF_WDT + 5767168;
constexpr size_t OFF_H = BIG + SZ;
constexpr size_t OFF_XB2 = BIG, OFF_RKV = BIG + 2 * SZ, OFF_LBWA = BIG + 5 * SZ, OFF_LBG = OFF_LBWA + 25165824;
constexpr size_t OFF_YF = BIG, OFF_YB = BIG + SZ;
constexpr size_t OFF_WMGU = BIG, OFF_WMD = BIG + 117440512, OFF_XS = BIG + 176160768, OFF_XBM = OFF_XS + 209715200, OFF_HID = OFF_XBM;
constexpr size_t WS_NEED = OFF_HID + 183500800;
constexpr int MOE_CHUNK = 50;
constexpr size_t HID_BUF = (size_t)MOE_CHUNK * 256 * 7168;
constexpr int LDS_BYTES = 131072 + 512 + 1024;

struct Params { const float* in[33]; float* X; unsigned char* ws; };
extern __shared__ __attribute__((aligned(16))) unsigned char shm[];
constexpr int LDS_TS = 131072, LDS_TAB = 131072 + 128;
__device__ __forceinline__ const float* INP(int i) {
  const LAS unsigned* tab = (const LAS unsigned*)((LAS unsigned char*)shm + LDS_TAB);
  const unsigned lo = __builtin_amdgcn_readfirstlane(tab[2 * i]), hi = __builtin_amdgcn_readfirstlane(tab[2 * i + 1]);
  return (const float*)(((unsigned long long)hi << 32) | lo);
}

__device__ __forceinline__ int tid_() { int t = threadIdx.x; asm volatile("" : "+v"(t)); return t; }
__device__ __forceinline__ unsigned cvt_pk_bf16(float lo, float hi) { unsigned r; asm("v_cvt_pk_bf16_f32 %0, %1, %2" : "=v"(r) : "v"(lo), "v"(hi)); return r; }
__device__ __forceinline__ bf16_t f2bf(float f) { return (bf16_t)(cvt_pk_bf16(f, 0.f) & 0xffffu); }
__device__ __forceinline__ float bflo(unsigned u) { return __uint_as_float(u << 16); }
__device__ __forceinline__ float bfhi(unsigned u) { return __uint_as_float(u & 0xffff0000u); }
__device__ __forceinline__ float wave_sum(float v) { for (int o = 32; o; o >>= 1) v += __shfl_xor(v, o); return v; }
template <int CTRL> __device__ __forceinline__ float dppf(float v) { return __builtin_bit_cast(float, __builtin_amdgcn_mov_dpp(__builtin_bit_cast(int, v), CTRL, 0xf, 0xf, true)); }
__device__ __forceinline__ float red4(float v) { v += dppf<0xB1>(v); v += dppf<0x4E>(v); return v; }
__device__ __forceinline__ float red8(float v) { v = red4(v); v += dppf<0x141>(v); return v; }
__device__ __forceinline__ float red16(float v) { v = red8(v); v += dppf<0x140>(v); return v; }
__device__ __forceinline__ float sigmoidf_(float x) { return __builtin_amdgcn_rcpf(1.f + __expf(-x)); }


#define XB_TMO      128
#define XB_XCNT(j)  (256  + 64 * (j))
#define XB_XSUB(j)  (1280 + 64 * (j))
#define XB_XGEN(j)  (2304 + 64 * (j))
#define XB_TOP      3328
#define XB_TOPGEN   3392
#define XCD_BAR_WORDS 3456
#define XB_SPIN_CAP (1u << 18)
__device__ __forceinline__ unsigned xb_ld(unsigned* p)              { return __hip_atomic_load(p, __ATOMIC_RELAXED, __HIP_MEMORY_SCOPE_AGENT); }
__device__ __forceinline__ unsigned xb_add(unsigned* p, unsigned v) { return __hip_atomic_fetch_add(p, v, __ATOMIC_RELAXED, __HIP_MEMORY_SCOPE_AGENT); }
__device__ __forceinline__ unsigned xb_xcc_id() { return (unsigned)__builtin_amdgcn_s_getreg((3 << 11) | 20) & 0xFu; }
#define XB_SPIN(cond, bar) do { unsigned _sp = 0; while (cond) { __builtin_amdgcn_s_sleep(1); \
    if ((++_sp & 255u) == 0u) { if (xb_ld(&(bar)[XB_TMO])) break; if (_sp > XB_SPIN_CAP) { atomicAdd(&(bar)[XB_TMO], 1u); break; } } } } while (0)
struct XcdBarrier { unsigned* bar; unsigned x; volatile LAS unsigned* st; };
__device__ __forceinline__ XcdBarrier xcd_barrier_post(unsigned* bar, volatile LAS unsigned* st) {
  XcdBarrier b; b.bar = bar; b.x = xb_xcc_id(); b.st = st;
  if (threadIdx.x == 0) (void)xb_add(&bar[XB_XCNT(b.x)], 1u);
  return b;
}
__device__ __forceinline__ void xcd_barrier_complete(unsigned* bar, unsigned x, unsigned& nloc, unsigned& nx) {
  const unsigned G = gridDim.x * gridDim.y * gridDim.z;
  unsigned sum, cnt, mine, sp = 0u;
  for (;;) {
    sum = 0u; cnt = 0u; mine = 0u;
#pragma unroll
    for (unsigned j = 0; j < 16; ++j) { const unsigned c = xb_ld(&bar[XB_XCNT(j)]); sum += c; cnt += (c > 0u) ? 1u : 0u; mine = (j == x) ? c : mine; }
    if (sum == G) break;
    __builtin_amdgcn_s_sleep(1);
    if ((++sp & 255u) == 0u) { if (xb_ld(&bar[XB_TMO])) break; if (sp > XB_SPIN_CAP) { atomicAdd(&bar[XB_TMO], 1u); break; } }
  }
  nloc = mine > 0u ? mine : 1u; nx = cnt > 0u ? cnt : 1u;
}
__device__ __forceinline__ void xcd_barrier(const XcdBarrier& b) {
  asm volatile("s_waitcnt vmcnt(0)" ::: "memory");
  __syncthreads();
  if (threadIdx.x == 0) {
    unsigned* bar = b.bar;
    __builtin_amdgcn_s_waitcnt(0);
    unsigned nloc = b.st[0], nx = b.st[1];
    if (nloc == 0u) { xcd_barrier_complete(bar, b.x, nloc, nx); b.st[0] = nloc; b.st[1] = nx; }
    const unsigned old = xb_add(&bar[XB_XSUB(b.x)], 1u);
    const unsigned gen = old / nloc;
    if (old + 1u == (gen + 1u) * nloc) {
      __builtin_amdgcn_fence(__ATOMIC_RELEASE, "agent");
      asm volatile("s_waitcnt vmcnt(0)" ::: "memory");
      const unsigned og = xb_add(&bar[XB_TOP], 1u);
      const unsigned tg = og / nx;
      if (og + 1u == (tg + 1u) * nx) xb_add(&bar[XB_TOPGEN], 1u);
      else XB_SPIN(xb_ld(&bar[XB_TOPGEN]) == tg, bar);
      __builtin_amdgcn_fence(__ATOMIC_ACQUIRE, "agent");
      xb_add(&bar[XB_XGEN(b.x)], 1u);
      asm volatile("s_waitcnt vmcnt(0)" ::: "memory");
    } else {
      XB_SPIN(xb_ld(&bar[XB_XGEN(b.x)]) == gen, bar);
      __builtin_amdgcn_fence(__ATOMIC_ACQUIRE, "agent");
      asm volatile("s_waitcnt vmcnt(0)" ::: "memory");
    }
  }
  __syncthreads();
}

struct CvtJob { const float* src; int ldsrc, K, N; bf16_t* dst; int lddst, row0, col0; const float* kscale; float scale; int mode; };
__device__ __forceinline__ CvtJob mkjob(const float* src, int ldsrc, int K, int N, bf16_t* dst, int lddst, int row0, int col0, const float* kscale, float scale, int mode) {
  CvtJob j; j.src = src; j.ldsrc = ldsrc; j.K = K; j.N = N; j.dst = dst; j.lddst = lddst; j.row0 = row0; j.col0 = col0; j.kscale = kscale; j.scale = scale; j.mode = mode; return j; }
__device__ __forceinline__ int cvt_run(const CvtJob J, float* tile, int rot) {
  const int tk = (J.K + 63) >> 6, tn = (J.N + 63) >> 6, nt = tk * tn, G = gridDim.x;
  const int tx = tid_() & 63, ty = tid_() >> 6;
  int start = (int)blockIdx.x - rot; if (start < 0) start += G;
  for (int t0 = start; t0 < nt; t0 += 4 * G) {
    float v[4][8];
#pragma unroll
    for (int q = 0; q < 4; ++q) { const int t = t0 + q * G; const int k0 = (t / tn) * 64, n0 = (t % tn) * 64;
#pragma unroll
      for (int r = 0; r < 8; ++r) { const int k = k0 + r * 8 + ty, n = n0 + tx; v[q][r] = 0.f;
        if (t < nt && J.src && k < J.K && n < J.N) v[q][r] = __builtin_nontemporal_load(J.src + (size_t)k * J.ldsrc + n); } }
    __syncthreads();
#pragma unroll
    for (int q = 0; q < 4; ++q) { const int t = t0 + q * G; const int k0 = (t / tn) * 64;
#pragma unroll
      for (int r = 0; r < 8; ++r) { const int kk = r * 8 + ty; float x = v[q][r] * J.scale; if (J.kscale && t < nt && k0 + kk < J.K) x *= J.kscale[k0 + kk]; tile[q * 4160 + kk * 65 + tx] = x; } }
    __syncthreads();
#pragma unroll
    for (int q = 0; q < 4; ++q) { const int t = t0 + q * G; const int k0 = (t / tn) * 64, n0 = (t % tn) * 64;
#pragma unroll
      for (int r = 0; r < 8; ++r) { const int nn = r * 8 + ty, n = n0 + nn, k = k0 + tx;
        if (t < nt && n < J.N && k < J.K) { const int row = J.mode ? ((n >> 7) * 256 + (n & 127)) : n;
          J.dst[(size_t)(J.row0 + row) * J.lddst + J.col0 + k] = f2bf(tile[q * 4160 + tx * 65 + nn]); } } }
  }
  return (rot + nt) % G;
}

constexpr int BM = 256, BK = 64, HALF = 128, HTB = HALF * BK * 2, NXCD = 8, WGM = 8;
__device__ __forceinline__ int lds_byte(int r, int c) { const int st = (r >> 4) * 2 + (c >> 5), rr = r & 15, cc = c & 31, ob = rr * 64 + cc * 2; return st * 1024 + (ob ^ (((ob >> 9) & 1) << 5)); }
__device__ __forceinline__ void stage_rc(int b, int& R, int& C) { const int st = b / 1024, sb = b % 1024, swz = sb ^ (((sb >> 9) & 1) << 5); R = (st >> 1) * 16 + swz / 64; C = (st & 1) * 32 + (swz % 64) / 2; }
__device__ __forceinline__ int perm32(int rho) { const int n = rho >> 4, i = rho & 15; return 8 * (i >> 2) + 4 * n + (i & 3); }
struct Unit { int pm, pn; };
struct Gemm { const bf16_t* A; const bf16_t* Bt; int K; };
struct StaticOrder {
  int nM, nN, nwg, G, c;
  __device__ void init(int M, int N) { nM = M / BM; nN = N / BM; nwg = nM * nN; G = gridDim.x; c = blockIdx.x; }
  __device__ bool next(int i, Unit& u) const {
    const long L = (long)i * G + c; if (L >= nwg) return false;
    int wgid = (int)L; { const int q = nwg / NXCD, r = nwg % NXCD, xcd = wgid % NXCD, off = wgid / NXCD; wgid = (xcd < r ? xcd * (q + 1) : r * (q + 1) + (xcd - r) * q) + off; }
    const int nig = WGM * nN, gid = wgid / nig, fm = gid * WGM, gsz = (nM - fm) < WGM ? (nM - fm) : WGM;
    u.pm = fm + ((wgid % nig) % gsz); u.pn = (wgid % nig) / gsz; return true;
  }
};
template <int NC> struct MoeOrder {
  int first, ntile, G, c; const LAS int* ts;
  __device__ bool next(int i, Unit& u) const {
    const long L = (long)i * G + c; if (L >= (long)ntile * NC) return false;
    const int l = (int)L, nig = WGM * NC, gid = l / nig, fm = gid * WGM, gsz = (ntile - fm) < WGM ? (ntile - fm) : WGM;
    const int pm = first + fm + ((l % nig) % gsz), pn = (l % nig) / gsz;
    int g = 0;
#pragma unroll
    for (int k = 1; k < 16; ++k) g += (pm >= ts[k]) ? 1 : 0;
    u.pm = pm; u.pn = (g & 7) * NC + pn; return true;
  }
};

struct MoeUpSkewOrder {
  int first, ntile, nd, G, c; const LAS int* ts;
  __device__ bool next(int i, Unit& u) const {
    const int r = (c >= nd) ? i : i + 3;
    const long L = (r < 3) ? (long)r * (G - nd) + (c - nd) : (long)3 * (G - nd) + (long)(r - 3) * G + c;
    if (L >= (long)ntile * 28) return false;
    const int l = (int)L, nig = WGM * 28, gid = l / nig, fm = gid * WGM, gsz = (ntile - fm) < WGM ? (ntile - fm) : WGM;
    const int pm = first + fm + ((l % nig) % gsz), pn = (l % nig) / gsz;
    int g = 0;
#pragma unroll
    for (int k = 1; k < 16; ++k) g += (pm >= ts[k]) ? 1 : 0;
    u.pm = pm; u.pn = (g & 7) * 28 + pn; return true;
  }
};

template <class Epi, class Sched>
__device__ __forceinline__ void gemm_phase(LAS unsigned char* lds, const Gemm g, const Sched& S, const Epi& E) {
  const int tid = tid_(), wid = __builtin_amdgcn_readfirstlane(tid >> 6), lane = tid & 63, wr = wid >> 2, wc = wid & 3, fr = lane & 15, fq = lane >> 4;
  const int K = g.K, nt = K / BK;
  unsigned voffA[2], voffB[2];
#pragma unroll
  for (int i = 0; i < 2; ++i) { int R, C; stage_rc(tid * 16 + i * 8192, R, C); const int Rb = Epi::PERM ? ((R & ~31) + perm32(R & 31)) : R;
    voffA[i] = (unsigned)(R * K + C) * 2u; voffB[i] = (unsigned)(Rb * K + C) * 2u; }
  const size_t kstep = (size_t)(BK * 2);
  const size_t hstep = (size_t)HALF * K * 2;
  const size_t tstep = 2 * hstep;
  const unsigned ldsw = (unsigned)wid * 1024u;
  const int aoff = lds_byte(wr * 64 + fr, fq * 8), boff = lds_byte(wc * 32 + fr, fq * 8);
#define PG8_SA(b, h) (((b) * 2 + (h)) * HTB)
#define PG8_SB(b, h) ((4 + (b) * 2 + (h)) * HTB)
#define PG8_STAGE(bufoff, gbase, voff) do { _Pragma("unroll") for (int _i = 0; _i < 2; ++_i) \
    __builtin_amdgcn_global_load_lds((const unsigned*)((const char*)(gbase) + (voff)[_i]), (LAS unsigned*)(lds + (bufoff) + ldsw + _i * 8192), 16, 0, 0); } while (0)
#define PG8_LDA(dst, b, h) do { _Pragma("unroll") for (int m = 0; m < 4; ++m) _Pragma("unroll") for (int k = 0; k < 2; ++k) dst[m][k] = *(const LAS bf16x8*)(lds + PG8_SA(b, h) + aoff + m * 2048 + k * 1024); } while (0)
#define PG8_LDB(dst, b, h) do { _Pragma("unroll") for (int n = 0; n < 2; ++n) _Pragma("unroll") for (int k = 0; k < 2; ++k) dst[n][k] = *(const LAS bf16x8*)(lds + PG8_SB(b, h) + boff + n * 2048 + k * 1024); } while (0)
#define PG8_MMA(ai, bj, At, Bt) do { __builtin_amdgcn_s_setprio(1); _Pragma("unroll") for (int m = 0; m < 4; ++m) _Pragma("unroll") for (int n = 0; n < 2; ++n) _Pragma("unroll") for (int k = 0; k < 2; ++k) \
    acc[ai][bj][m][n] = __builtin_amdgcn_mfma_f32_16x16x32_bf16(Bt[n][k], At[m][k], acc[ai][bj][m][n], 0, 0, 0); __builtin_amdgcn_s_setprio(0); } while (0)
#define PG8_WAIT_V(n) asm volatile("s_waitcnt vmcnt(" #n ")" ::: "memory")
#define PG8_WAIT_L(n) asm volatile("s_waitcnt lgkmcnt(" #n ")" ::: "memory")
#define PG8_BAR __builtin_amdgcn_s_barrier()
#define PG8_SCHED __builtin_amdgcn_sched_barrier(0)
  Unit cur, nxt; int ui = 0;
  if (!S.next(0, cur)) return;
  f32x4 acc[2][2][4][2];
#pragma unroll
  for (int a = 0; a < 2; ++a)
#pragma unroll
    for (int b = 0; b < 2; ++b)
#pragma unroll
      for (int m = 0; m < 4; ++m)
#pragma unroll
        for (int n = 0; n < 2; ++n) acc[a][b][m][n] = (f32x4){0.f, 0.f, 0.f, 0.f};
  bf16x8 At[4][2], B0[2][2], B1[2][2];
  const char* cA = (const char*)g.A + (size_t)cur.pm * tstep; const char* cB = (const char*)g.Bt + (size_t)cur.pn * tstep;
  PG8_STAGE(PG8_SB(0, 0), cB, voffB); PG8_STAGE(PG8_SA(0, 0), cA, voffA); PG8_STAGE(PG8_SB(0, 1), cB + hstep, voffB); PG8_STAGE(PG8_SA(0, 1), cA + hstep, voffA);
  if (wr == 1) PG8_BAR;
  PG8_WAIT_V(4); PG8_BAR;
  PG8_STAGE(PG8_SB(1, 0), cB + kstep, voffB); PG8_STAGE(PG8_SA(1, 0), cA + kstep, voffA); PG8_STAGE(PG8_SB(1, 1), cB + hstep + kstep, voffB);
  PG8_WAIT_V(6); PG8_BAR;
  for (;;) {
    const bool has_next = S.next(ui + 1, nxt);
    const char* nA = has_next ? (const char*)g.A + (size_t)nxt.pm * tstep : cA; const char* nB = has_next ? (const char*)g.Bt + (size_t)nxt.pn * tstep : cB;
    for (int t = 0; t < nt; t += 2) {
      const bool last = (t == nt - 2);
      const char* a1 = cA + (size_t)(t + 1) * kstep;
      const char* a2 = last ? nA : cA + (size_t)(t + 2) * kstep; const char* b2 = last ? nB : cB + (size_t)(t + 2) * kstep;
      const char* a3 = a2 + kstep; const char* b3 = b2 + kstep;
      PG8_LDB(B0, 0, 0); PG8_SCHED; PG8_LDA(At, 0, 0); PG8_STAGE(PG8_SA(1, 1), a1 + hstep, voffA);
      PG8_WAIT_L(8); PG8_BAR; PG8_WAIT_L(0); PG8_MMA(0, 0, At, B0); PG8_BAR; PG8_SCHED;
      PG8_LDB(B1, 0, 1); PG8_STAGE(PG8_SB(0, 0), b2, voffB);
      PG8_BAR; PG8_WAIT_L(0); PG8_MMA(0, 1, At, B1); PG8_BAR;
      PG8_LDA(At, 0, 1); PG8_STAGE(PG8_SA(0, 0), a2, voffA);
      PG8_BAR; PG8_WAIT_L(0); PG8_MMA(1, 0, At, B0); PG8_BAR; PG8_SCHED;
      PG8_STAGE(PG8_SB(0, 1), b2 + hstep, voffB);
      PG8_WAIT_V(6); PG8_BAR; PG8_MMA(1, 1, At, B1); PG8_BAR;
      PG8_LDB(B0, 1, 0); PG8_SCHED; PG8_LDA(At, 1, 0); PG8_STAGE(PG8_SA(0, 1), a2 + hstep, voffA);
      PG8_WAIT_L(8); PG8_BAR; PG8_WAIT_L(0); PG8_MMA(0, 0, At, B0); PG8_BAR; PG8_SCHED;
      PG8_LDB(B1, 1, 1); PG8_STAGE(PG8_SB(1, 0), b3, voffB);
      PG8_BAR; PG8_WAIT_L(0); PG8_MMA(0, 1, At, B1); PG8_BAR;
      PG8_LDA(At, 1, 1); PG8_STAGE(PG8_SA(1, 0), a3, voffA);
      PG8_BAR; PG8_WAIT_L(0); PG8_MMA(1, 0, At, B0); PG8_BAR; PG8_SCHED;
      PG8_STAGE(PG8_SB(1, 1), b3 + hstep, voffB);
      PG8_WAIT_V(6); PG8_BAR; PG8_MMA(1, 1, At, B1); PG8_BAR;
    }
    E(acc, cur, wr, wc, fr, fq);
    if (!has_next) break;
#pragma unroll
    for (int a = 0; a < 2; ++a)
#pragma unroll
      for (int b = 0; b < 2; ++b)
#pragma unroll
        for (int m = 0; m < 4; ++m)
#pragma unroll
          for (int n = 0; n < 2; ++n) acc[a][b][m][n] = (f32x4){0.f, 0.f, 0.f, 0.f};
    cur = nxt; cA = nA; cB = nB; ++ui;
  }
  PG8_WAIT_V(0);
  if (wr == 0) PG8_BAR;
  PG8_BAR;
#undef PG8_SA
#undef PG8_SB
#undef PG8_STAGE
#undef PG8_LDA
#undef PG8_LDB
#undef PG8_MMA
#undef PG8_WAIT_V
#undef PG8_WAIT_L
#undef PG8_BAR
#undef PG8_SCHED
}

typedef f32x4 Acc[2][2][4][2];
__device__ __forceinline__ u32x4 pack8(f32x4 a, f32x4 b) { u32x4 o; o[0] = cvt_pk_bf16(a[0], a[1]); o[1] = cvt_pk_bf16(a[2], a[3]); o[2] = cvt_pk_bf16(b[0], b[1]); o[3] = cvt_pk_bf16(b[2], b[3]); return o; }

struct EpiStore {
  static constexpr bool PERM = true; bf16_t* O; int ldc;
  __device__ __forceinline__ void operator()(const Acc& acc, const Unit& u, int wr, int wc, int fr, int fq) const {
    const int row0 = u.pm * BM + wr * 64 + fr, col0 = u.pn * BM + wc * 32 + 8 * fq;
#pragma unroll
    for (int ai = 0; ai < 2; ++ai)
#pragma unroll
      for (int m = 0; m < 4; ++m) { bf16_t* rp = O + (size_t)(row0 + ai * HALF + m * 16) * ldc + col0;
#pragma unroll
        for (int bj = 0; bj < 2; ++bj) *(u32x4*)(rp + bj * HALF) = pack8(acc[ai][bj][m][0], acc[ai][bj][m][1]); }
  }
};
struct EpiQK2 {
  static constexpr bool PERM = true; bf16_t* O;
  __device__ __forceinline__ void operator()(const Acc& acc, const Unit& u, int wr, int wc, int fr, int fq) const {
    const int row0 = u.pm * BM + wr * 64 + fr, col0 = u.pn * BM + wc * 32 + 8 * fq;
#pragma unroll
    for (int ai = 0; ai < 2; ++ai)
#pragma unroll
      for (int m = 0; m < 4; ++m) { const int tok = row0 + ai * HALF + m * 16;
#pragma unroll
        for (int bj = 0; bj < 2; ++bj) { const int n = col0 + bj * HALF; const int which = n >> 10, h = (n >> 5) & 31, d = n & 31;
          *(u32x4*)(O + (size_t)which * ((size_t)T * 1024) + ((size_t)((tok >> 6) * 32 + h) * 64 + (tok & 63)) * 32 + d) = pack8(acc[ai][bj][m][0], acc[ai][bj][m][1]); } }
  }
};
struct EpiVT {
  static constexpr bool PERM = true; bf16_t* O;
  __device__ __forceinline__ void operator()(const Acc& acc, const Unit& u, int wr, int wc, int fr, int fq) const {
    const int row0 = u.pm * BM + wr * 64 + fr, col0 = u.pn * BM + wc * 32 + 8 * fq;
#pragma unroll
    for (int ai = 0; ai < 2; ++ai)
#pragma unroll
      for (int m = 0; m < 4; ++m) { const int ch = row0 + ai * HALF + m * 16;
#pragma unroll
        for (int bj = 0; bj < 2; ++bj) { const int tok = col0 + bj * HALF;
          *(u32x4*)(O + (size_t)(tok >> 6) * 65536 + (size_t)(((ch >> 5) * 8 + ((tok & 63) >> 3)) * 32 + (ch & 31)) * 8) = pack8(acc[ai][bj][m][0], acc[ai][bj][m][1]); } }
  }
};
struct EpiResid {
  static constexpr bool PERM = false; float* X;
  __device__ __forceinline__ void operator()(const Acc& acc, const Unit& u, int wr, int wc, int fr, int fq) const {
    const int row0 = u.pm * BM + wr * 64 + fr, col0 = u.pn * BM + wc * 32 + 4 * fq;
#pragma unroll
    for (int ai = 0; ai < 2; ++ai)
#pragma unroll
      for (int m = 0; m < 4; ++m) { float* rp = X + (size_t)(row0 + ai * HALF + m * 16) * 1024 + col0;
#pragma unroll
        for (int bj = 0; bj < 2; ++bj)
#pragma unroll
          for (int n = 0; n < 2; ++n) { f32x4* q = (f32x4*)(rp + bj * HALF + n * 16); *q = *q * ALPHA + acc[ai][bj][m][n]; } __builtin_amdgcn_sched_barrier(0); }
  }
};
__device__ __forceinline__ f32x4 swiglu4(f32x4 g, f32x4 u) { f32x4 o;
#pragma unroll
  for (int j = 0; j < 4; ++j) o[j] = g[j] * __builtin_amdgcn_rcpf(1.f + __expf(-g[j])) * u[j];
  return o; }
struct EpiSwiglu {
  static constexpr bool PERM = true; bf16_t* H; int ldh, NC, row_base;
  __device__ __forceinline__ void operator()(const Acc& acc, const Unit& u, int wr, int wc, int fr, int fq) const {
    const int row0 = u.pm * BM - row_base + wr * 64 + fr, col0 = (u.pn % NC) * HALF + wc * 32 + 8 * fq;
#pragma unroll
    for (int ai = 0; ai < 2; ++ai)
#pragma unroll
      for (int m = 0; m < 4; ++m)
        *(u32x4*)(H + (size_t)(row0 + ai * HALF + m * 16) * ldh + col0) = pack8(swiglu4(acc[ai][0][m][0], acc[ai][1][m][0]), swiglu4(acc[ai][0][m][1], acc[ai][1][m][1]));
  }
};
struct EpiRwkv {
  static constexpr bool PERM = true; bf16_t* RKV; bf16_t* LBWA; bf16_t* LBG;
  __device__ __forceinline__ void operator()(const Acc& acc, const Unit& u, int wr, int wc, int fr, int fq) const {
    const int row0 = u.pm * BM + wr * 64 + fr;
    if (u.pn < 12) {
      const int col0 = u.pn * BM + wc * 32 + 8 * fq;
#pragma unroll
      for (int ai = 0; ai < 2; ++ai)
#pragma unroll
        for (int m = 0; m < 4; ++m) { bf16_t* rp = RKV + (size_t)(row0 + ai * HALF + m * 16) * 3072 + col0;
#pragma unroll
          for (int bj = 0; bj < 2; ++bj) *(u32x4*)(rp + bj * HALF) = pack8(acc[ai][bj][m][0], acc[ai][bj][m][1]); }
    } else {
      const bool isg = (u.pn == 13); bf16_t* O = isg ? LBG : LBWA; const int c0 = wc * 32 + 8 * fq;
#pragma unroll
      for (int ai = 0; ai < 2; ++ai)
#pragma unroll
        for (int m = 0; m < 4; ++m) { bf16_t* rp = O + (size_t)(row0 + ai * HALF + m * 16) * 256 + c0;
#pragma unroll
          for (int bj = 0; bj < 2; ++bj) { f32x4 v0 = acc[ai][bj][m][0], v1 = acc[ai][bj][m][1]; const int c = bj * HALF + c0;
            if (isg) { if (c < 160) {
#pragma unroll
                for (int j = 0; j < 4; ++j) { v0[j] = sigmoidf_(v0[j]); v1[j] = sigmoidf_(v1[j]); } } else { v0 = (f32x4){0.f, 0.f, 0.f, 0.f}; v1 = v0; } }
            else if (bj == 0) {
#pragma unroll
              for (int j = 0; j < 4; ++j) { v0[j] = 1.f - 2.f * __builtin_amdgcn_rcpf(1.f + __expf(2.f * v0[j])); v1[j] = 1.f - 2.f * __builtin_amdgcn_rcpf(1.f + __expf(2.f * v1[j])); } }
            *(u32x4*)(rp + bj * HALF) = pack8(v0, v1); } }
    }
  }
};
struct EpiMulPre {
  static constexpr bool PERM = true; bf16_t* P;
  __device__ __forceinline__ void operator()(const Acc& acc, const Unit& u, int wr, int wc, int fr, int fq) const {
    const int row0 = u.pm * BM + wr * 64 + fr, col0 = u.pn * BM + wc * 32 + 8 * fq;
#pragma unroll
    for (int ai = 0; ai < 2; ++ai)
#pragma unroll
      for (int m = 0; m < 4; ++m) { bf16_t* rp = P + (size_t)(row0 + ai * HALF + m * 16) * 1024 + col0;
#pragma unroll
        for (int bj = 0; bj < 2; ++bj) { u32x4* q = (u32x4*)(rp + bj * HALF); const u32x4 pv = *q; f32x4 a = acc[ai][bj][m][0], b = acc[ai][bj][m][1];
          a[0] *= bflo(pv[0]); a[1] *= bfhi(pv[0]); a[2] *= bflo(pv[1]); a[3] *= bfhi(pv[1]); b[0] *= bflo(pv[2]); b[1] *= bfhi(pv[2]); b[2] *= bflo(pv[3]); b[3] *= bfhi(pv[3]);
          *q = pack8(a, b); } __builtin_amdgcn_sched_barrier(0); }
  }
};
struct EpiMoeDown {
  static constexpr bool PERM = false; float* X; const int* rowl; const float* rowg; int row_base;
  __device__ __forceinline__ void operator()(const Acc& acc, const Unit& u, int wr, int wc, int fr, int fq) const {
    const int row0 = row_base + u.pm * BM + wr * 64 + fr, col0 = (u.pn & 3) * BM + wc * 32 + 4 * fq;
#pragma unroll
    for (int ai = 0; ai < 2; ++ai)
#pragma unroll
      for (int m = 0; m < 4; ++m) { const int lr = row0 + ai * HALF + m * 16; const int tok = rowl[lr];
        if (tok >= 0) { const float gt = rowg[lr]; float* rp = X + (size_t)tok * 1024 + col0;
#pragma unroll
          for (int bj = 0; bj < 2; ++bj)
#pragma unroll
            for (int n = 0; n < 2; ++n) { f32x4* q = (f32x4*)(rp + bj * HALF + n * 16); *q = *q + acc[ai][bj][m][n] * gt; } } __builtin_amdgcn_sched_barrier(0); }
  }
};
struct MoeDownOrder {
  int first, ntile, G, c; const LAS int* ts;
  __device__ bool next(int i, Unit& u) const {
    const long L = (long)i * G + c; if (L >= (long)ntile * 4) return false;
    const int l = (int)L, pm = l >> 2, pn = l & 3; int g = 0;
#pragma unroll
    for (int k = 1; k < 16; ++k) g += ((first + pm) >= ts[k]) ? 1 : 0;
    u.pm = pm; u.pn = (g & 7) * 4 + pn; return true;
  }
};

__device__ __forceinline__ void ln_row(const float* y, const float* g, const float* b, int lane, f32x4 (&o)[4]) {
  f32x4 v[4]; float s = 0.f;
#pragma unroll
  for (int k = 0; k < 4; ++k) { v[k] = *(const f32x4*)(y + k * 256 + lane * 4); s += v[k][0] + v[k][1] + v[k][2] + v[k][3]; }
  const float mean = wave_sum(s) * (1.f / 1024.f); float q = 0.f;
#pragma unroll
  for (int k = 0; k < 4; ++k) { v[k] = v[k] - mean; q += v[k][0] * v[k][0] + v[k][1] * v[k][1] + v[k][2] * v[k][2] + v[k][3] * v[k][3]; }
  const float rstd = rsqrtf(wave_sum(q) * (1.f / 1024.f) + 1e-5f);
#pragma unroll
  for (int k = 0; k < 4; ++k) { const f32x4 gg = *(const f32x4*)(g + k * 256 + lane * 4), bb = *(const f32x4*)(b + k * 256 + lane * 4); o[k] = v[k] * rstd * gg + bb; }
}

__device__ __forceinline__ void ln_row2(const float* y0, const float* y1, const float* g, const float* b, int lane, f32x4 (&o0)[4], f32x4 (&o1)[4]) {
  f32x4 v[4], u[4]; float s0 = 0.f, s1 = 0.f;
#pragma unroll
  for (int k = 0; k < 4; ++k) { v[k] = *(const f32x4*)(y0 + k * 256 + lane * 4); u[k] = *(const f32x4*)(y1 + k * 256 + lane * 4); }
#pragma unroll
  for (int k = 0; k < 4; ++k) { s0 += v[k][0] + v[k][1] + v[k][2] + v[k][3]; s1 += u[k][0] + u[k][1] + u[k][2] + u[k][3]; }
  const float m0 = wave_sum(s0) * (1.f / 1024.f), m1 = wave_sum(s1) * (1.f / 1024.f); float q0 = 0.f, q1 = 0.f;
#pragma unroll
  for (int k = 0; k < 4; ++k) { v[k] = v[k] - m0; u[k] = u[k] - m1; q0 += v[k][0] * v[k][0] + v[k][1] * v[k][1] + v[k][2] * v[k][2] + v[k][3] * v[k][3]; q1 += u[k][0] * u[k][0] + u[k][1] * u[k][1] + u[k][2] * u[k][2] + u[k][3] * u[k][3]; }
  const float r0 = rsqrtf(wave_sum(q0) * (1.f / 1024.f) + 1e-5f), r1 = rsqrtf(wave_sum(q1) * (1.f / 1024.f) + 1e-5f);
#pragma unroll
  for (int k = 0; k < 4; ++k) { const f32x4 gg = *(const f32x4*)(g + k * 256 + lane * 4), bb = *(const f32x4*)(b + k * 256 + lane * 4); o0[k] = v[k] * r0 * gg + bb; o1[k] = u[k] * r1 * gg + bb; }
}

__device__ __forceinline__ void attn_phase(const bf16_t* __restrict__ QK, const bf16_t* __restrict__ VT, const float* __restrict__ EB, bf16_t* __restrict__ O) {
  const int tid = tid_(), lane = tid & 63, qi = lane & 15, g = lane >> 4;
  const int nw = gridDim.x * 8, w0 = blockIdx.x * 8 + (tid >> 6);
  const int krho = ((qi >> 2) * 8) + (qi & 3);
  int cur_combo = -1; f32x4 bias[8][2];
  for (int u = w0; u < 768 * 4 * 32; u += nw) {
    const int combo = u & 127, h = u & 31, c = (u >> 5) & 3, R = u >> 7;
    const float* eb = EB + (size_t)combo * (15 * 512) + lane * 8;
    if (combo != cur_combo) { cur_combo = combo;
#pragma unroll
      for (int i = 0; i < 8; ++i) { bias[i][0] = *(const f32x4*)(eb + (3 + i) * 512); bias[i][1] = *(const f32x4*)(eb + (3 + i) * 512 + 4); } }
    int seq_row0, rows; if (R < 256) { seq_row0 = R & ~127; rows = 128; } else { seq_row0 = 256 + ((R - 256) & ~63); rows = 64; }
    const int r = R - seq_row0; int rs = r - 4; rs = rs < 0 ? 0 : rs; rs = rs > rows - 8 ? rows - 8 : rs;
    const int blk = (c == 0) ? 0 : (c == 1) ? 8 : (c == 2) ? 24 : 32;
    const int qcol = 16 * c + qi;
    const bf16x8 qf = *(const bf16x8*)(QK + ((size_t)(R * 32 + h) * 64 + qcol) * 32 + g * 8);
    f32x4 s[8][2];
    const bf16_t* kbase = QK + (size_t)T * 1024 + ((size_t)((seq_row0 + rs) * 32 + h) * 64 + blk + krho) * 32 + g * 8;
#pragma unroll
    for (int i = 0; i < 8; ++i)
#pragma unroll
      for (int hh = 0; hh < 2; ++hh) {
        const bf16x8 kf = *(const bf16x8*)(kbase + (size_t)i * 65536 + hh * 128);
        s[i][hh] = __builtin_amdgcn_mfma_f32_16x16x32_bf16(kf, qf, (f32x4){0.f, 0.f, 0.f, 0.f}, 0, 0, 0);
      }
    if (rs - r == -4) {
#pragma unroll
      for (int i = 0; i < 8; ++i) { s[i][0] = s[i][0] + bias[i][0]; s[i][1] = s[i][1] + bias[i][1]; }
    } else {
      const float* ebr = eb + (rs - r + 7) * 512;
#pragma unroll
      for (int i = 0; i < 8; ++i) { s[i][0] = s[i][0] + *(const f32x4*)(ebr + i * 512); s[i][1] = s[i][1] + *(const f32x4*)(ebr + i * 512 + 4); }
    }
    float mx = -3.0e38f;
#pragma unroll
    for (int i = 0; i < 8; ++i)
#pragma unroll
      for (int hh = 0; hh < 2; ++hh) mx = fmaxf(fmaxf(mx, fmaxf(s[i][hh][0], s[i][hh][1])), fmaxf(s[i][hh][2], s[i][hh][3]));
    mx = fmaxf(mx, __shfl_xor(mx, 16)); mx = fmaxf(mx, __shfl_xor(mx, 32));
    float sum = 0.f;
#pragma unroll
    for (int i = 0; i < 8; ++i)
#pragma unroll
      for (int hh = 0; hh < 2; ++hh)
#pragma unroll
        for (int j = 0; j < 4; ++j) { const float e = __expf(s[i][hh][j] - mx); s[i][hh][j] = e; sum += e; }
    sum += __shfl_xor(sum, 16); sum += __shfl_xor(sum, 32);
    f32x4 o0 = {0.f, 0.f, 0.f, 0.f}, o1 = {0.f, 0.f, 0.f, 0.f};
#pragma unroll
    for (int i = 0; i < 8; ++i) {
      const u32x4 pu = pack8(s[i][0], s[i][1]); const bf16x8 pf = __builtin_bit_cast(bf16x8, pu);
      const bf16_t* vb = VT + (size_t)(seq_row0 + rs + i) * 65536 + (size_t)((h * 8 + (blk >> 3) + g) * 32 + qi) * 8;
      const bf16x8 v0 = *(const bf16x8*)vb, v1 = *(const bf16x8*)(vb + 16 * 8);
      o0 = __builtin_amdgcn_mfma_f32_16x16x32_bf16(v0, pf, o0, 0, 0, 0);
      o1 = __builtin_amdgcn_mfma_f32_16x16x32_bf16(v1, pf, o1, 0, 0, 0);
    }
    const float inv = 1.f / sum;
    bf16_t* op = O + (size_t)(R * 64 + qcol) * 1024 + h * 32 + g * 4;
    u32x2 a, b; a[0] = cvt_pk_bf16(o0[0] * inv, o0[1] * inv); a[1] = cvt_pk_bf16(o0[2] * inv, o0[3] * inv); b[0] = cvt_pk_bf16(o1[0] * inv, o1[1] * inv); b[1] = cvt_pk_bf16(o1[2] * inv, o1[3] * inv);
    *(u32x2*)op = a; *(u32x2*)(op + 16) = b;
  }
}

constexpr int SC_WD = 0, SC_AA = 2048, SC_KD = 4096, SC_BB = 6144, SC_NA = 8192, SC_RR = 10240, SC_VV = 12288, SC_YO = 14336;
typedef float f32x2 __attribute__((ext_vector_type(2)));
#define LO2(v) __builtin_shufflevector(v, v, 0, 1)
#define HI2(v) __builtin_shufflevector(v, v, 2, 3)
template <int NR, int z> __device__ __forceinline__ void scan_steps(LAS float* L, const LAS float* GT, int vrow, int ko, f32x2 (&St)[2][4]) {
  constexpr int sstep = z ? -64 : 64; const LAS float* bp = L + ko * 8 + (z ? 31 * 64 : 0);
  const LAS float* vp = L + SC_VV + vrow + (z ? 31 * 64 : 0); LAS float* yp = L + SC_YO + vrow + (z ? 31 * 64 : 0);
  f32x4 c[8]; float cv[NR];
  c[0] = *(const LAS f32x4*)(bp + SC_NA); c[1] = *(const LAS f32x4*)(bp + SC_NA + 4); c[2] = *(const LAS f32x4*)(bp + SC_BB); c[3] = *(const LAS f32x4*)(bp + SC_BB + 4);
  c[4] = *(const LAS f32x4*)(bp + SC_KD); c[5] = *(const LAS f32x4*)(bp + SC_KD + 4); c[6] = *(const LAS f32x4*)(bp + SC_RR); c[7] = *(const LAS f32x4*)(bp + SC_RR + 4);
#pragma unroll
  for (int r = 0; r < NR; ++r) cv[r] = vp[r];
#pragma unroll 8
  for (int si = 0; si < 32; ++si) {
    f32x4 n[8]; float nv[NR];
    const LAS float* bn = bp + ((si < 31) ? sstep : 0); const LAS float* vn = vp + ((si < 31) ? sstep : 0);
    n[0] = *(const LAS f32x4*)(bn + SC_NA); n[1] = *(const LAS f32x4*)(bn + SC_NA + 4); n[2] = *(const LAS f32x4*)(bn + SC_BB); n[3] = *(const LAS f32x4*)(bn + SC_BB + 4);
    n[4] = *(const LAS f32x4*)(bn + SC_KD); n[5] = *(const LAS f32x4*)(bn + SC_KD + 4); n[6] = *(const LAS f32x4*)(bn + SC_RR); n[7] = *(const LAS f32x4*)(bn + SC_RR + 4);
#pragma unroll
    for (int r = 0; r < NR; ++r) nv[r] = vn[r];
    float sa[NR], yy[NR];
#pragma unroll
    for (int r = 0; r < NR; ++r) { f32x2 p1 = St[r][0] * LO2(c[0]); p1 = St[r][1] * HI2(c[0]) + p1; p1 = St[r][2] * LO2(c[1]) + p1; p1 = St[r][3] * HI2(c[1]) + p1; sa[r] = p1[0] + p1[1]; }
#pragma unroll
    for (int r = 0; r < NR; ++r) sa[r] = red8(sa[r]);
#pragma unroll
    for (int r = 0; r < NR; ++r) { const f32x2 s2 = {sa[r], sa[r]}, v2 = {cv[r], cv[r]};
      St[r][0] = s2 * LO2(c[2]) + (v2 * LO2(c[4]) + St[r][0]); St[r][1] = s2 * HI2(c[2]) + (v2 * HI2(c[4]) + St[r][1]);
      St[r][2] = s2 * LO2(c[3]) + (v2 * LO2(c[5]) + St[r][2]); St[r][3] = s2 * HI2(c[3]) + (v2 * HI2(c[5]) + St[r][3]); }
#pragma unroll
    for (int r = 0; r < NR; ++r) { f32x2 q1 = St[r][0] * LO2(c[6]); q1 = St[r][1] * HI2(c[6]) + q1; q1 = St[r][2] * LO2(c[7]) + q1; q1 = St[r][3] * HI2(c[7]) + q1; yy[r] = q1[0] + q1[1]; }
#pragma unroll
    for (int r = 0; r < NR; ++r) yy[r] = red8(yy[r]);
#pragma unroll
    for (int r = 0; r < NR; ++r) yp[r] = yy[r];
#pragma unroll
    for (int j = 0; j < 8; ++j) c[j] = n[j];
#pragma unroll
    for (int r = 0; r < NR; ++r) cv[r] = nv[r];
    bp = bn; vp = vn; yp += sstep;
  }
  { const f32x4 t0 = *(const LAS f32x4*)(GT + ko * 8), t1 = *(const LAS f32x4*)(GT + ko * 8 + 4);
#pragma unroll
    for (int r = 0; r < NR; ++r) { St[r][0] = St[r][0] * LO2(t0); St[r][1] = St[r][1] * HI2(t0); St[r][2] = St[r][2] * LO2(t1); St[r][3] = St[r][3] * HI2(t1); } }
}
__device__ __forceinline__ int chain_chunks(int chain) { return chain < 0 ? 0 : (chain < 64 ? 256 : 128); }
__device__ __forceinline__ void scan_block(unsigned char* ws, LAS float* Lall, int chainA, int modeA, int rbA, int chainB, int modeB, int rbB) {
  const int tid = tid_(), wid = tid >> 6, lane = tid & 63, grp = wid >> 2, gw4 = wid & 3, gtid = tid & 255;
  const int chain = grp ? chainB : chainA, mode = grp ? modeB : modeA, rowbase = grp ? rbB : rbA;
  LAS float* L = Lall + grp * 16384;
  LAS float* GTB = (LAS float*)((LAS unsigned char*)Lall + 131072 + 512);
  const bool helper = (mode == 2), helped = (grp == 0) && (modeB == 2);
  const int nA = chain_chunks(chainA), nB = chain_chunks(chainB), nloop = nA > nB ? nA : nB;
  const int cc = chain < 0 ? 0 : chain;
  int h, z, Lq; size_t tok0;
  if (cc < 64) { h = (cc & 31) >> 1; z = cc & 1; Lq = 8192; tok0 = (size_t)(cc >> 5) * 8192; }
  else { const int c2 = cc - 64; h = (c2 & 31) >> 1; z = c2 & 1; Lq = 4096; tok0 = 16384 + (size_t)(c2 >> 5) * 4096; }
  const int nchunk = chain < 0 ? 0 : Lq / 32;
  const bf16_t* RKV = (const bf16_t*)(ws + OFF_RKV); const bf16_t* LBWA = (const bf16_t*)(ws + OFF_LBWA); const bf16_t* W2T = (const bf16_t*)(ws + OFF_W2T);
  bf16_t* Y = (bf16_t*)(ws + (z ? OFF_YB : OFF_YF)); float* bonus = (float*)(ws + OFF_BONUS);
  const int tk = gtid >> 3, c8 = (gtid & 7) * 8, ch0 = h * 64 + c8;
  const int ko = lane & 7, vl = lane >> 3, vrow = mode ? rowbase + gw4 * 8 + vl : gw4 * 16 + vl * 2;
  const int mat = gw4 >> 1, ntile = gw4 & 1;
  const f32x4 kk0 = *(const f32x4*)(INP(18) + ch0), kk1 = *(const f32x4*)(INP(18) + ch0 + 4), ka0 = *(const f32x4*)(INP(19) + ch0), ka1 = *(const f32x4*)(INP(19) + ch0 + 4);
  const f32x4 rk0 = *(const f32x4*)(INP(20) + ch0), rk1 = *(const f32x4*)(INP(20) + ch0 + 4);
  bf16x8 bfrag[4]; const int chb = h * 64 + ntile * 32 + (lane & 31);
#pragma unroll
  for (int ks = 0; ks < 4; ++ks) bfrag[ks] = *(const bf16x8*)(W2T + ((size_t)(mat * 2 + z) * 1024 + chb) * 64 + ks * 16 + (lane >> 5) * 8);
  const float bias0 = (mat ? INP(13) : INP(10))[z * 1024 + chb];
  u32x4 rawr, rawk, rawv; bf16x8 afrag[4];
  { const size_t tb = tok0 + (size_t)(z ? (nchunk > 0 ? nchunk - 1 : 0) : 0) * 32; const bf16_t* rp = RKV + (tb + tk) * 3072 + ch0;
    rawr = *(const u32x4*)rp; rawk = *(const u32x4*)(rp + 1024); rawv = *(const u32x4*)(rp + 2048);
#pragma unroll
    for (int ks = 0; ks < 4; ++ks) afrag[ks] = *(const bf16x8*)(LBWA + (tb + (lane & 31)) * 256 + mat * 128 + z * 64 + ks * 16 + (lane >> 5) * 8); }
  f32x2 St[2][4];
#pragma unroll
  for (int r = 0; r < 2; ++r)
#pragma unroll
    for (int j = 0; j < 4; ++j) St[r][j] = (f32x2){0.f, 0.f};
#define LORA_TILE(BASE, GTP) do { f32x16 acc; \
      _Pragma("unroll") for (int j = 0; j < 16; ++j) acc[j] = 0.f; \
      _Pragma("unroll") for (int ks = 0; ks < 4; ++ks) acc = __builtin_amdgcn_mfma_f32_32x32x16_bf16(afrag[ks], bfrag[ks], acc, 0, 0, 0); \
      const int half_ = lane >> 5; \
      if (mat) { LAS float* dst = (BASE) + SC_AA + ntile * 32 + (lane & 31); \
        _Pragma("unroll") for (int rg = 0; rg < 16; ++rg) { const int row = (rg & 3) + 8 * (rg >> 2) + 4 * half_; dst[row * 64] = sigmoidf_(acc[rg] + bias0); } } \
      else { float w_[16], G_[4], O_[4], E_[4];   \
        _Pragma("unroll") for (int rg = 0; rg < 16; ++rg) w_[rg] = __expf(-0.60653065971263342f * sigmoidf_(acc[rg] + bias0)); \
        if (!z) { _Pragma("unroll") for (int m = 0; m < 4; ++m) { w_[4 * m + 1] *= w_[4 * m]; w_[4 * m + 2] *= w_[4 * m + 1]; w_[4 * m + 3] *= w_[4 * m + 2]; G_[m] = w_[4 * m + 3]; } } \
        else    { _Pragma("unroll") for (int m = 0; m < 4; ++m) { w_[4 * m + 2] *= w_[4 * m + 3]; w_[4 * m + 1] *= w_[4 * m + 2]; w_[4 * m] *= w_[4 * m + 1]; G_[m] = w_[4 * m]; } } \
        _Pragma("unroll") for (int m = 0; m < 4; ++m) O_[m] = __shfl_xor(G_[m], 32); \
        float R_ = 1.f; \
        if (!z) { _Pragma("unroll") for (int m = 0; m < 4; ++m) { E_[m] = half_ ? R_ * O_[m] : R_; R_ *= G_[m] * O_[m]; } } \
        else    { _Pragma("unroll") for (int m = 3; m >= 0; --m) { E_[m] = half_ ? R_ : R_ * O_[m]; R_ *= G_[m] * O_[m]; } } \
        LAS float* dst = (BASE) + SC_WD + ntile * 32 + (lane & 31); \
        _Pragma("unroll") for (int rg = 0; rg < 16; ++rg) { const int row = (rg & 3) + 8 * (rg >> 2) + 4 * half_; dst[row * 64] = w_[rg] * E_[rg >> 2]; } \
        if (half_ == 0) (GTP)[ntile * 32 + (lane & 31)] = R_; } } while (0)
  if (helper && nchunk > 0) { LORA_TILE(Lall, GTB); }
  for (int ci = 0; ci < nloop; ++ci) {
    const bool act = ci < nchunk; const int wdo = helped ? ((ci & 1) ? 16384 : 0) : 0;
    const size_t tb = tok0 + (size_t)(act ? (z ? nchunk - 1 - ci : ci) : 0) * 32;
    LAS float* GT = GTB + (grp * 2 + (helped ? (ci & 1) : 0)) * 64;
    if (act && !helped && !helper) { LORA_TILE(L, GT); }
    __syncthreads();
    if (act && !helper) {
      float r8[8], k8[8], kx[8]; float ss = 0.f;
#pragma unroll
      for (int j = 0; j < 4; ++j) { r8[2 * j] = bflo(rawr[j]); r8[2 * j + 1] = bfhi(rawr[j]); k8[2 * j] = bflo(rawk[j]); k8[2 * j + 1] = bfhi(rawk[j]); }
#pragma unroll
      for (int j = 0; j < 8; ++j) { kx[j] = k8[j] * (j < 4 ? kk0[j & 3] : kk1[j & 3]); ss += kx[j] * kx[j]; }
      ss = red8(ss); const float inv = __builtin_amdgcn_rsqf(fmaxf(ss, 1e-24f));
      const f32x4 a0 = *(const LAS f32x4*)(L + wdo + SC_AA + tk * 64 + c8), a1 = *(const LAS f32x4*)(L + wdo + SC_AA + tk * 64 + c8 + 4);
      f32x4 kd[2], bb[2], na[2], rr[2], vv[2]; float bon = 0.f;
#pragma unroll
      for (int j = 0; j < 8; ++j) { const float a = (j < 4 ? a0[j & 3] : a1[j & 3]), kav = (j < 4 ? ka0[j & 3] : ka1[j & 3]), rkv = (j < 4 ? rk0[j & 3] : rk1[j & 3]);
        const float kn = kx[j] * inv, kdv = k8[j] * (1.f + (a - 1.f) * kav); kd[j >> 2][j & 3] = kdv; bb[j >> 2][j & 3] = kn * a; na[j >> 2][j & 3] = -kn; rr[j >> 2][j & 3] = r8[j]; bon += r8[j] * kdv * rkv; }
#pragma unroll
      for (int j = 0; j < 4; ++j) { vv[j >> 1][(j & 1) * 2] = bflo(rawv[j]); vv[j >> 1][(j & 1) * 2 + 1] = bfhi(rawv[j]); }
      { const LAS float* gp = L + wdo + SC_WD + c8; const int tkp = z ? tk + 1 : tk - 1; const bool hv = (tkp >= 0) && (tkp < 32); const int tkc = hv ? tkp : tk;
        const f32x4 g0 = *(const LAS f32x4*)(gp + tk * 64), g1 = *(const LAS f32x4*)(gp + tk * 64 + 4);
        f32x4 p0 = *(const LAS f32x4*)(gp + tkc * 64), p1 = *(const LAS f32x4*)(gp + tkc * 64 + 4);
        if (!hv) { p0 = (f32x4){1.f, 1.f, 1.f, 1.f}; p1 = p0; }
        f32x4 i0, i1;
#pragma unroll
        for (int j = 0; j < 4; ++j) { i0[j] = __builtin_amdgcn_rcpf(g0[j]); i1[j] = __builtin_amdgcn_rcpf(g1[j]); }
        kd[0] = kd[0] * i0; kd[1] = kd[1] * i1; bb[0] = bb[0] * i0; bb[1] = bb[1] * i1; na[0] = na[0] * p0; na[1] = na[1] * p1; rr[0] = rr[0] * g0; rr[1] = rr[1] * g1; }
      LAS float* lp = L + tk * 64 + c8;
      *(LAS f32x4*)(lp + SC_KD) = kd[0]; *(LAS f32x4*)(lp + SC_KD + 4) = kd[1]; *(LAS f32x4*)(lp + SC_BB) = bb[0]; *(LAS f32x4*)(lp + SC_BB + 4) = bb[1];
      *(LAS f32x4*)(lp + SC_NA) = na[0]; *(LAS f32x4*)(lp + SC_NA + 4) = na[1]; *(LAS f32x4*)(lp + SC_RR) = rr[0]; *(LAS f32x4*)(lp + SC_RR + 4) = rr[1];
      *(LAS f32x4*)(lp + SC_VV) = vv[0]; *(LAS f32x4*)(lp + SC_VV + 4) = vv[1];
      bon = red8(bon); if ((gtid & 7) == 0 && rowbase == 0) bonus[((tb + tk) * 16 + h) * 2 + z] = bon;
    }
    __syncthreads();
    if (act && ci + 1 < nchunk) { const size_t tn = tok0 + (size_t)(z ? nchunk - 2 - ci : ci + 1) * 32; const bf16_t* rp = RKV + (tn + tk) * 3072 + ch0;
      if (!helper) { rawr = *(const u32x4*)rp; rawk = *(const u32x4*)(rp + 1024); rawv = *(const u32x4*)(rp + 2048); }
#pragma unroll
      for (int ks = 0; ks < 4; ++ks) afrag[ks] = *(const bf16x8*)(LBWA + (tn + (lane & 31)) * 256 + mat * 128 + z * 64 + ks * 16 + (lane >> 5) * 8);
      if (helper) { LORA_TILE(Lall + (((ci + 1) & 1) ? 16384 : 0), GTB + ((ci + 1) & 1) * 64); } }
    if (act && !helper) { if (mode) { if (z) scan_steps<1, 1>(L, GT, vrow, ko, St); else scan_steps<1, 0>(L, GT, vrow, ko, St); } else { if (z) scan_steps<2, 1>(L, GT, vrow, ko, St); else scan_steps<2, 0>(L, GT, vrow, ko, St); } }
    __syncthreads();
    if (act && !helper) {
      if (mode) { const int c4 = rowbase + (gtid & 7) * 4; const f32x4 yv = *(const LAS f32x4*)(L + SC_YO + tk * 64 + c4); u32x2 o; o[0] = cvt_pk_bf16(yv[0], yv[1]); o[1] = cvt_pk_bf16(yv[2], yv[3]);
        *(u32x2*)(Y + (tb + tk) * 1024 + h * 64 + c4) = o; }
      else { const f32x4 y0 = *(const LAS f32x4*)(L + SC_YO + tk * 64 + c8), y1 = *(const LAS f32x4*)(L + SC_YO + tk * 64 + c8 + 4);
        *(u32x4*)(Y + (tb + tk) * 1024 + ch0) = pack8(y0, y1); }
    }
  }
  __syncthreads();
#undef LORA_TILE
}

__global__ void __launch_bounds__(512, 2) mega(Params p) {
  cg::grid_group grid = cg::this_grid();
  LAS unsigned char* lds = (LAS unsigned char*)shm;
  LAS int* TS = (LAS int*)(lds + LDS_TS);
  unsigned char* ws = p.ws;
  { const unsigned* ka = (const unsigned*)__builtin_amdgcn_kernarg_segment_ptr(); if (threadIdx.x < 66) ((LAS unsigned*)(lds + LDS_TAB))[threadIdx.x] = ka[threadIdx.x]; }
  __syncthreads();
  const int G = gridDim.x, nw = G * 8;
  const long ngt = (long)G * 512;
#define PH_VARS const int tid = tid_(), lane = tid & 63, wid = tid >> 6, gw = blockIdx.x * 8 + wid; const long gt = (long)blockIdx.x * 512 + tid; (void)lane; (void)gw; (void)gt;
  float* X = p.X;

  { PH_VARS
  {
    int rot = 0; float* tile = (float*)shm;
    const float* wqkv = INP(2);
    rot = cvt_run(mkjob(wqkv, 3072, 1024, 1024, (bf16_t*)(ws + OFF_WQKT), 1024, 0, 0, nullptr, 0.17677669529663687f, 0), tile, rot);
    rot = cvt_run(mkjob(wqkv + 1024, 3072, 1024, 1024, (bf16_t*)(ws + OFF_WQKT), 1024, 1024, 0, nullptr, 1.f, 0), tile, rot);
    rot = cvt_run(mkjob(wqkv + 2048, 3072, 1024, 1024, (bf16_t*)(ws + OFF_WVT), 1024, 0, 0, nullptr, 1.f, 0), tile, rot);
    rot = cvt_run(mkjob(INP(4), 1024, 1024, 1024, (bf16_t*)(ws + OFF_WOT), 1024, 0, 0, nullptr, 1.f, 0), tile, rot);
    rot = cvt_run(mkjob(INP(5), 2816, 1024, 2816, (bf16_t*)(ws + OFF_WGUT), 1024, 0, 0, nullptr, 1.f, 1), tile, rot);
    rot = cvt_run(mkjob(INP(6), 2816, 1024, 2816, (bf16_t*)(ws + OFF_WGUT), 1024, 128, 0, nullptr, 1.f, 1), tile, rot);
    rot = cvt_run(mkjob(INP(7), 1024, 2816, 1024, (bf16_t*)(ws + OFF_WDT), 2816, 0, 0, nullptr, 1.f, 0), tile, rot);
    bf16_t* wrt = (bf16_t*)(ws + OFF_WRT); const float* mu = INP(8);
    for (int half = 0; half < 2; ++half) {
      const int c0 = half * 1024;
      rot = cvt_run(mkjob(INP(9), 1024, 1024, 1024, wrt, 2048, 0, c0, half ? mu + 0 * 1024 : nullptr, 1.f, 0), tile, rot);
      rot = cvt_run(mkjob(INP(9) + 1048576, 1024, 1024, 1024, wrt, 2048, 1024, c0, half ? mu + 2 * 1024 : nullptr, 1.f, 0), tile, rot);
      rot = cvt_run(mkjob(INP(9) + 2097152, 1024, 1024, 1024, wrt, 2048, 2048, c0, half ? mu + 3 * 1024 : nullptr, 1.f, 0), tile, rot);
      rot = cvt_run(mkjob(INP(11), 64, 1024, 64, wrt, 2048, 3072, c0, half ? mu + 1 * 1024 : nullptr, 1.f, 0), tile, rot);
      rot = cvt_run(mkjob(INP(11) + 65536, 64, 1024, 64, wrt, 2048, 3136, c0, half ? mu + 1 * 1024 : nullptr, 1.f, 0), tile, rot);
      rot = cvt_run(mkjob(INP(14), 64, 1024, 64, wrt, 2048, 3200, c0, half ? mu + 4 * 1024 : nullptr, 1.f, 0), tile, rot);
      rot = cvt_run(mkjob(INP(14) + 65536, 64, 1024, 64, wrt, 2048, 3264, c0, half ? mu + 4 * 1024 : nullptr, 1.f, 0), tile, rot);
      rot = cvt_run(mkjob(INP(16), 160, 1024, 160, wrt, 2048, 3328, c0, half ? mu + 5 * 1024 : nullptr, 1.f, 0), tile, rot);
    }
    rot = cvt_run(mkjob(nullptr, 0, 2048, 96, wrt, 2048, 3488, 0, nullptr, 1.f, 0), tile, rot);
    bf16_t* w2t = (bf16_t*)(ws + OFF_W2T);
    rot = cvt_run(mkjob(INP(12), 1024, 64, 1024, w2t, 64, 0, 0, nullptr, 1.f, 0), tile, rot);
    rot = cvt_run(mkjob(INP(12) + 65536, 1024, 64, 1024, w2t, 64, 1024, 0, nullptr, 1.f, 0), tile, rot);
    rot = cvt_run(mkjob(INP(15), 1024, 64, 1024, w2t, 64, 2048, 0, nullptr, 1.f, 0), tile, rot);
    rot = cvt_run(mkjob(INP(15) + 65536, 1024, 64, 1024, w2t, 64, 3072, 0, nullptr, 1.f, 0), tile, rot);
    rot = cvt_run(mkjob(INP(17), 1024, 160, 1024, (bf16_t*)(ws + OFF_G2T), 256, 0, 0, nullptr, 1.f, 0), tile, rot);
    rot = cvt_run(mkjob(nullptr, 0, 96, 1024, (bf16_t*)(ws + OFF_G2T), 256, 0, 160, nullptr, 1.f, 0), tile, rot);
    rot = cvt_run(mkjob(INP(23), 1024, 1024, 1024, (bf16_t*)(ws + OFF_RWOT), 1024, 0, 0, nullptr, 1.f, 0), tile, rot);
    bf16_t* xb = (bf16_t*)(ws + OFF_XB);
    { const float* x0 = INP(0); const float* x1 = INP(1);
    for (long i0 = gt; i0 < (long)T * 256; i0 += 4 * ngt) { f32x4 v[4];
#pragma unroll
      for (int u = 0; u < 4; ++u) { const long i = i0 + u * ngt; if (i < (long)T * 256) v[u] = (i < 16384L * 256) ? *(const f32x4*)(x0 + i * 4) : *(const f32x4*)(x1 + (i - 16384L * 256) * 4); }
#pragma unroll
      for (int u = 0; u < 4; ++u) { const long i = i0 + u * ngt; if (i < (long)T * 256) { *(f32x4*)(X + i * 4) = v[u]; u32x2 o; o[0] = cvt_pk_bf16(v[u][0], v[u][1]); o[1] = cvt_pk_bf16(v[u][2], v[u][3]); *(u32x2*)(xb + i * 4) = o; } } } }
    { float* EBt = (float*)(ws + OFF_EB); const float* rpb = INP(3);
      for (long i = gt; i < 128L * 15 * 512; i += ngt) { const int e = (int)(i & 7), ln = (int)((i >> 3) & 63), dr = (int)((i >> 9) % 15), combo = (int)((i >> 9) / 15);
        const int h = combo & 31, c = combo >> 5, qi = ln & 15, g = ln >> 4; const int blk = (c == 0) ? 0 : (c == 1) ? 8 : (c == 2) ? 24 : 32;
        const int kcol = blk + g * 8 + e, qcol = 16 * c + qi; int qstart = qcol - 8; qstart = qstart < 0 ? 0 : qstart; qstart = qstart > 48 ? 48 : qstart;
        const bool valid = (kcol >= qstart) && (kcol < qstart + 16); int dc = kcol - qcol + 15; dc = dc < 0 ? 0 : dc; dc = dc > 30 ? 30 : dc;
        EBt[i] = valid ? rpb[(h * 15 + dr) * 31 + dc] : -3.0e38f; } }
    int* cnt = (int*)(ws + OFF_CNT); int* rowl = (int*)(ws + OFF_ROWL);
    if (gt < 16) cnt[gt] = 0;
    if (blockIdx.x == 0) for (int i = tid; i < XCD_BAR_WORDS; i += 512) ((unsigned*)(ws + OFF_BAR))[i] = 0u;
    if (tid < 2) ((LAS unsigned*)(lds + LDS_TS + 80))[tid] = 0u;
    for (long i = gt; i < 102400; i += ngt) rowl[i] = -1;
  }
  }
  grid.sync();
  __syncthreads();
  const XcdBarrier xb = xcd_barrier_post((unsigned*)(ws + OFF_BAR), (volatile LAS unsigned*)(lds + LDS_TS + 80));
  { PH_VARS
  { Gemm g{(const bf16_t*)(ws + OFF_XB), (const bf16_t*)(ws + OFF_WQKT), 1024}; StaticOrder S; S.init(T, 2048); EpiQK2 E{(bf16_t*)(ws + OFF_QK)}; gemm_phase(lds, g, S, E); }
  { Gemm g{(const bf16_t*)(ws + OFF_WVT), (const bf16_t*)(ws + OFF_XB), 1024}; StaticOrder S; S.init(1024, T); EpiVT E{(bf16_t*)(ws + OFF_VT)}; gemm_phase(lds, g, S, E); }
  }
  xcd_barrier(xb);
  { PH_VARS
  attn_phase((const bf16_t*)(ws + OFF_QK), (const bf16_t*)(ws + OFF_VT), (const float*)(ws + OFF_EB), (bf16_t*)(ws + OFF_O));
  }
  xcd_barrier(xb);
  { PH_VARS
  { Gemm g{(const bf16_t*)(ws + OFF_O), (const bf16_t*)(ws + OFF_WOT), 1024}; StaticOrder S; S.init(T, 1024); EpiResid E{X}; gemm_phase(lds, g, S, E); }
  }
  xcd_barrier(xb);
  { PH_VARS
  { bf16_t* xb = (bf16_t*)(ws + OFF_XB);
    for (int row = gw; row < T; row += 2 * nw) { const int rw1 = (row + nw < T) ? row + nw : row; f32x4 oo[2][4]; ln_row2(X + (size_t)row * 1024, X + (size_t)rw1 * 1024, INP(29), INP(30), lane, oo[0], oo[1]);
#pragma unroll
      for (int h = 0; h < 2; ++h) { const int rr = h ? rw1 : row;
#pragma unroll
        for (int k = 0; k < 4; ++k) { *(f32x4*)(X + (size_t)rr * 1024 + k * 256 + lane * 4) = oo[h][k]; u32x2 q; q[0] = cvt_pk_bf16(oo[h][k][0], oo[h][k][1]); q[1] = cvt_pk_bf16(oo[h][k][2], oo[h][k][3]); *(u32x2*)(xb + (size_t)rr * 1024 + k * 256 + lane * 4) = q; } } } }
  }
  xcd_barrier(xb);
  { PH_VARS
  { Gemm g{(const bf16_t*)(ws + OFF_XB), (const bf16_t*)(ws + OFF_WGUT), 1024}; StaticOrder S; S.init(T, 5632); EpiSwiglu E{(bf16_t*)(ws + OFF_H), 2816, 1 << 20, 0}; gemm_phase(lds, g, S, E); }
  }
  xcd_barrier(xb);
  { Gemm g{(const bf16_t*)(ws + OFF_H), (const bf16_t*)(ws + OFF_WDT), 2816}; StaticOrder S; S.init(T, 1024); EpiResid E{X}; gemm_phase(lds, g, S, E); }
  xcd_barrier(xb);
  { PH_VARS
  for (int row = gw; row < T; row += 2 * nw) { const int rw1 = (row + nw < T) ? row + nw : row; f32x4 oo[2][4]; ln_row2(X + (size_t)row * 1024, X + (size_t)rw1 * 1024, INP(31), INP(32), lane, oo[0], oo[1]);
#pragma unroll
    for (int h = 0; h < 2; ++h)
#pragma unroll
      for (int k = 0; k < 4; ++k) *(f32x4*)(X + (size_t)(h ? rw1 : row) * 1024 + k * 256 + lane * 4) = oo[h][k]; }
  }
  xcd_barrier(xb);
  { PH_VARS
  { bf16_t* xb2 = (bf16_t*)(ws + OFF_XB2);
    for (int row = gw; row < T; row += nw) {
      const int s0 = row < 16384 ? (row & ~8191) : 16384 + ((row - 16384) & ~4095), len = row < 16384 ? 8192 : 4096;
      const bool hm = row > s0, hp = row < s0 + len - 1;
#pragma unroll
      for (int k = 0; k < 4; ++k) { const size_t off = (size_t)row * 1024 + k * 256 + lane * 4; const f32x4 x = *(const f32x4*)(X + off);
        const f32x4 xm = hm ? *(const f32x4*)(X + off - 1024) : (f32x4){0.f, 0.f, 0.f, 0.f}, xp = hp ? *(const f32x4*)(X + off + 1024) : (f32x4){0.f, 0.f, 0.f, 0.f};
        const f32x4 xx = (xm + xp) * 0.5f - x; u32x2 a, b; a[0] = cvt_pk_bf16(x[0], x[1]); a[1] = cvt_pk_bf16(x[2], x[3]); b[0] = cvt_pk_bf16(xx[0], xx[1]); b[1] = cvt_pk_bf16(xx[2], xx[3]);
        bf16_t* dp = xb2 + (size_t)row * 2048 + k * 256 + lane * 4; *(u32x2*)dp = a; *(u32x2*)(dp + 1024) = b; } } }
  }
  xcd_barrier(xb);
  { PH_VARS
  { Gemm g{(const bf16_t*)(ws + OFF_XB2), (const bf16_t*)(ws + OFF_WRT), 2048}; StaticOrder S; S.init(T, 3584); EpiRwkv E{(bf16_t*)(ws + OFF_RKV), (bf16_t*)(ws + OFF_LBWA), (bf16_t*)(ws + OFF_LBG)}; gemm_phase(lds, g, S, E); }
  }
  xcd_barrier(xb);
  { PH_VARS
  { LAS float* L = (LAS float*)lds; const int b = blockIdx.x;
    for (int round = 0; round < 320; ++round) {
      int cA, mA = 0, rA = 0, cB = -1, mB = 0;
      if (G == 256) { if (round > 0) break; if (b < 128) { cA = b >> 1; mA = 1; rA = (b & 1) * 32; cB = cA; mB = 2; } else { cA = 64 + (b - 128) * 2; cB = cA + 1; } }
      else { cA = b + round * G; if (cA >= 320) break; }
      scan_block(ws, L, cA, mA, rA, cB, mB, 0);
    }
  }
  }
  xcd_barrier(xb);
  { PH_VARS
  { bf16_t* yf = (bf16_t*)(ws + OFF_YF); const bf16_t* yb = (const bf16_t*)(ws + OFF_YB); const bf16_t* rkv = (const bf16_t*)(ws + OFF_RKV); const float* bonus = (const float*)(ws + OFF_BONUS);
    for (int row = gw; row < T; row += nw) {
      const size_t off = (size_t)row * 1024 + lane * 16; const u32x4 a0 = *(const u32x4*)(yf + off), a1 = *(const u32x4*)(yf + off + 8), b0 = *(const u32x4*)(yb + off), b1 = *(const u32x4*)(yb + off + 8);
      const u32x4 v0 = *(const u32x4*)(rkv + (size_t)row * 3072 + 2048 + lane * 16), v1 = *(const u32x4*)(rkv + (size_t)row * 3072 + 2048 + lane * 16 + 8);
      float y[16], vv[16]; float s = 0.f;
#pragma unroll
      for (int j = 0; j < 4; ++j) { y[2 * j] = bflo(a0[j]) + bflo(b0[j]); y[2 * j + 1] = bfhi(a0[j]) + bfhi(b0[j]); y[8 + 2 * j] = bflo(a1[j]) + bflo(b1[j]); y[8 + 2 * j + 1] = bfhi(a1[j]) + bfhi(b1[j]);
        vv[2 * j] = bflo(v0[j]); vv[2 * j + 1] = bfhi(v0[j]); vv[8 + 2 * j] = bflo(v1[j]); vv[8 + 2 * j + 1] = bfhi(v1[j]); }
#pragma unroll
      for (int j = 0; j < 16; ++j) s += y[j];
      const float mean = red4(s) * (1.f / 64.f); float q = 0.f;
#pragma unroll
      for (int j = 0; j < 16; ++j) { y[j] -= mean; q += y[j] * y[j]; }
      const float rstd = rsqrtf(red4(q) * (1.f / 64.f) + 64e-5f);
      const float* bp = bonus + ((size_t)row * 16 + (lane >> 2)) * 2; const float bsum = bp[0] + bp[1];
      u32x4 o0, o1;
#pragma unroll
      for (int j = 0; j < 4; ++j) { const f32x4 gg = *(const f32x4*)(INP(21) + lane * 16 + j * 4), bb = *(const f32x4*)(INP(22) + lane * 16 + j * 4); float t[4];
#pragma unroll
        for (int e = 0; e < 4; ++e) t[e] = y[j * 4 + e] * rstd * gg[e] + bb[e] + bsum * vv[j * 4 + e];
        const unsigned lo = cvt_pk_bf16(t[0], t[1]), hi = cvt_pk_bf16(t[2], t[3]);
        if (j < 2) { o0[2 * j] = lo; o0[2 * j + 1] = hi; } else { o1[2 * (j - 2)] = lo; o1[2 * (j - 2) + 1] = hi; } }
      *(u32x4*)(yf + off) = o0; *(u32x4*)(yf + off + 8) = o1; } }
  }
  xcd_barrier(xb);
  { PH_VARS
  { Gemm g{(const bf16_t*)(ws + OFF_LBG), (const bf16_t*)(ws + OFF_G2T), 256}; StaticOrder S; S.init(T, 1024); EpiMulPre E{(bf16_t*)(ws + OFF_YF)}; gemm_phase(lds, g, S, E); }
  }
  xcd_barrier(xb);
  { PH_VARS
  { Gemm g{(const bf16_t*)(ws + OFF_YF), (const bf16_t*)(ws + OFF_RWOT), 1024}; StaticOrder S; S.init(T, 1024); EpiResid E{X}; gemm_phase(lds, g, S, E); }
  }
  xcd_barrier(xb);
  { PH_VARS
  { bf16_t* xb = (bf16_t*)(ws + OFF_XBM); int* cnt = (int*)(ws + OFF_CNT); int* tokE = (int*)(ws + OFF_TOKE); float* tokG = (float*)(ws + OFF_TOKG); int* tokP = (int*)(ws + OFF_TOKP);
    const float* wr = INP(24); const float* br = INP(25);
    LAS int* lc = (LAS int*)(lds + 100000);
    if (tid < 16) lc[tid] = 0;
    __syncthreads();
    for (int row = gw; row < T; row += nw) { f32x4 o[4]; ln_row(X + (size_t)row * 1024, INP(29) + 1024, INP(30) + 1024, lane, o);
      float lg[8];
#pragma unroll
      for (int e = 0; e < 8; ++e) lg[e] = 0.f;
#pragma unroll
      for (int k = 0; k < 4; ++k) {
#pragma unroll
        for (int j = 0; j < 4; ++j) { const float* wp = wr + (size_t)(k * 256 + lane * 4 + j) * 8; const f32x4 wa = *(const f32x4*)wp, wb = *(const f32x4*)(wp + 4); const float xv = o[k][j];
          lg[0] += xv * wa[0]; lg[1] += xv * wa[1]; lg[2] += xv * wa[2]; lg[3] += xv * wa[3]; lg[4] += xv * wb[0]; lg[5] += xv * wb[1]; lg[6] += xv * wb[2]; lg[7] += xv * wb[3]; }
        *(f32x4*)(X + (size_t)row * 1024 + k * 256 + lane * 4) = o[k] * ALPHA; u32x2 q; q[0] = cvt_pk_bf16(o[k][0], o[k][1]); q[1] = cvt_pk_bf16(o[k][2], o[k][3]); *(u32x2*)(xb + (size_t)row * 1024 + k * 256 + lane * 4) = q; }
#pragma unroll
      for (int e = 0; e < 8; ++e) lg[e] = wave_sum(lg[e]) + br[e];
      int e0 = 0; float v0 = lg[0];
#pragma unroll
      for (int e = 1; e < 8; ++e) if (lg[e] > v0) { v0 = lg[e]; e0 = e; }
      int e1 = -1; float v1 = -3.0e38f;
#pragma unroll
      for (int e = 0; e < 8; ++e) if (e != e0 && lg[e] > v1) { v1 = lg[e]; e1 = e; }
      if (lane == 0) { const float ex = __expf(v1 - v0), g0 = 1.f / (1.f + ex), g1 = ex * g0;
        const int p0 = __hip_atomic_fetch_add(lc + e0, 1, __ATOMIC_RELAXED, __HIP_MEMORY_SCOPE_WORKGROUP), p1 = __hip_atomic_fetch_add(lc + 8 + e1, 1, __ATOMIC_RELAXED, __HIP_MEMORY_SCOPE_WORKGROUP);
        tokE[row * 2] = e0; tokE[row * 2 + 1] = e1; tokG[row * 2] = g0; tokG[row * 2 + 1] = g1; tokP[row * 2] = p0; tokP[row * 2 + 1] = p1; } }
    __syncthreads();
    if (tid < 16) lc[16 + tid] = atomicAdd(cnt + tid, lc[tid]);
    __syncthreads();
    if (lane < 2) for (int row = gw; row < T; row += nw) tokP[row * 2 + lane] += lc[16 + lane * 8 + tokE[row * 2 + lane]];
    __syncthreads();
    int rot = 0; float* tile = (float*)shm;
    for (int e = 0; e < 8; ++e) {
      rot = cvt_run(mkjob(INP(26) + (size_t)e * 1024 * 3584, 3584, 1024, 3584, (bf16_t*)(ws + OFF_WMGU) + (size_t)e * 7168 * 1024, 1024, 0, 0, nullptr, 1.f, 1), tile, rot);
      rot = cvt_run(mkjob(INP(27) + (size_t)e * 1024 * 3584, 3584, 1024, 3584, (bf16_t*)(ws + OFF_WMGU) + (size_t)e * 7168 * 1024, 1024, 128, 0, nullptr, 1.f, 1), tile, rot);
      rot = cvt_run(mkjob(INP(28) + (size_t)e * 3584 * 1024, 1024, 3584, 1024, (bf16_t*)(ws + OFF_WMD) + (size_t)e * 1024 * 3584, 3584, 0, 0, nullptr, 1.f, 0), tile, rot);
    }
  }
  }
  xcd_barrier(xb);
  { PH_VARS
  { const int* cnt = (const int*)(ws + OFF_CNT);
    __syncthreads();
    if (tid == 0) { int a = 0; for (int k = 0; k < 16; ++k) { TS[k] = a; a += (cnt[k] + 255) >> 8; } TS[16] = a; }
    __syncthreads();
    const int* tokE = (const int*)(ws + OFF_TOKE); const float* tokG = (const float*)(ws + OFF_TOKG); const int* tokP = (const int*)(ws + OFF_TOKP);
    int* rowl = (int*)(ws + OFF_ROWL); float* rowg = (float*)(ws + OFF_ROWG); const bf16_t* xb = (const bf16_t*)(ws + OFF_XBM); bf16_t* xs = (bf16_t*)(ws + OFF_XS);
    for (int pr0 = gw; pr0 < T * 2; pr0 += 4 * nw) { u32x4 va[4], vb[4]; int rows[4];
#pragma unroll
      for (int u = 0; u < 4; ++u) { const int pr = pr0 + u * nw; rows[u] = -1; if (pr < T * 2) { const int tok = pr >> 1, rk = pr & 1; const int e = tokE[pr]; const int row = TS[rk * 8 + e] * 256 + tokP[pr]; rows[u] = row;
        if (lane == 0) { rowl[row] = tok; rowg[row] = tokG[pr]; }
        const u32x4* sp = (const u32x4*)(xb + (size_t)tok * 1024); va[u] = sp[lane]; vb[u] = sp[lane + 64]; } }
#pragma unroll
      for (int u = 0; u < 4; ++u) if (rows[u] >= 0) { u32x4* dp = (u32x4*)(xs + (size_t)rows[u] * 1024); dp[lane] = va[u]; dp[lane + 64] = vb[u]; } }
  }
  }
  xcd_barrier(xb);
  { PH_VARS
  { const int ts8 = TS[8], ts16 = TS[16]; const int b = blockIdx.x;
    int pcs = -1, pnt = 0, pbuf = 0, buf = 0;
    for (int rk = 0; rk < 2; ++rk) { const int t0 = rk ? ts16 * 0 + ts8 : 0, t1 = rk ? ts16 : ts8;
      for (int cs = t0; cs < t1; cs += MOE_CHUNK) { const int ntile = (t1 - cs) < MOE_CHUNK ? (t1 - cs) : MOE_CHUNK;
        int nd = 0;
        if (pcs >= 0) { nd = pnt * 4; nd = nd > G ? G : nd;
          Gemm g{(const bf16_t*)(ws + OFF_HID + (size_t)pbuf * HID_BUF), (const bf16_t*)(ws + OFF_WMD), 3584}; MoeDownOrder S{pcs, pnt, G, b, TS}; EpiMoeDown E{X, (const int*)(ws + OFF_ROWL), (const float*)(ws + OFF_ROWG), pcs * 256}; gemm_phase(lds, g, S, E); }
        { Gemm g{(const bf16_t*)(ws + OFF_XS), (const bf16_t*)(ws + OFF_WMGU), 1024}; MoeUpSkewOrder S{cs, ntile, nd, G, b, TS}; EpiSwiglu E{(bf16_t*)(ws + OFF_HID + (size_t)buf * HID_BUF), 3584, 28, cs * 256}; gemm_phase(lds, g, S, E); }
        xcd_barrier(xb);
        pcs = cs; pnt = ntile; pbuf = buf; buf ^= 1;
      } }
    if (pcs >= 0) { Gemm g{(const bf16_t*)(ws + OFF_HID + (size_t)pbuf * HID_BUF), (const bf16_t*)(ws + OFF_WMD), 3584}; MoeDownOrder S{pcs, pnt, G, b, TS}; EpiMoeDown E{X, (const int*)(ws + OFF_ROWL), (const float*)(ws + OFF_ROWG), pcs * 256}; gemm_phase(lds, g, S, E); }
    xcd_barrier(xb);
  }
  }
  { PH_VARS
  for (int row = gw; row < T; row += 2 * nw) { const int rw1 = (row + nw < T) ? row + nw : row; f32x4 oo[2][4]; ln_row2(X + (size_t)row * 1024, X + (size_t)rw1 * 1024, INP(31) + 1024, INP(32) + 1024, lane, oo[0], oo[1]);
#pragma unroll
    for (int h = 0; h < 2; ++h)
#pragma unroll
      for (int k = 0; k < 4; ++k) *(f32x4*)(X + (size_t)(h ? rw1 : row) * 1024 + k * 256 + lane * 4) = oo[h][k]; }
  }
}

extern "C" void kernel_launch(void* const* d_in, const int* in_sizes, int n_in, void* d_out, int out_size, void* d_ws, size_t ws_size, hipStream_t stream) {
  static int grid_blocks = 0;
  if (!grid_blocks) {
    int dev = 0, cus = 0, per_cu = 0;
    (void)hipGetDevice(&dev);
    (void)hipDeviceGetAttribute(&cus, hipDeviceAttributeMultiprocessorCount, dev);
    (void)hipFuncSetAttribute((const void*)mega, hipFuncAttributeMaxDynamicSharedMemorySize, LDS_BYTES);
    (void)hipOccupancyMaxActiveBlocksPerMultiprocessor(&per_cu, mega, 512, LDS_BYTES);
    if (per_cu > 1) per_cu = 1;
    grid_blocks = cus * per_cu;
    if (ws_size < WS_NEED) fprintf(stderr, "workspace too small: %zu < %zu\n", ws_size, (size_t)WS_NEED);
  }
  Params p{};
  for (int i = 0; i < 33; ++i) p.in[i] = (const float*)d_in[i];
  p.X = (float*)d_out; p.ws = (unsigned char*)d_ws;
  void* args[] = {&p};
  hipError_t e = hipLaunchCooperativeKernel((void*)mega, dim3(grid_blocks), dim3(512), args, LDS_BYTES, stream);
  if (e != hipSuccess) fprintf(stderr, "cooperative launch failed: %s (grid %d)\n", hipGetErrorString(e), grid_blocks);
}
```
